# Optimizing an MI355X kernel written in HIP

```python
import jax, jax.numpy as jnp
from jax import lax
import numpy as np

D_MODEL = 1024
BATCH = 4
SEQ = 4096
DEPTH = 1
DEC_BATCH = 32
DEC_SEQ = 1
PAST_LEN = 16384
PAGE_SIZE = 128

N_HEADS = 8
HEAD_DIM = 64
N_KV = 2
Q_PER_KV = N_HEADS // N_KV
CMP_LEN = 32
CMP_STRIDE = 16
CMP_HALVES = CMP_LEN // CMP_STRIDE
CMP_HID = 128
SEL_BLOCK = 64
N_SEL = 16
N_LOCAL_SEL = 2
WINDOW = 512
Q_BLOCK = 128
GMLP_WIDTH = 512
GMLP_GROUPS = 4
GMLP_GROUP_DIM = GMLP_WIDTH // GMLP_GROUPS
CHUNK = 128
D_FF = 2816
CONV_W = 3

EPS = 1e-6
NEG = -1e30
SEL_BONUS = 1e6
ATTN_SCALE = HEAD_DIM ** -0.5
Q_COLS = N_HEADS * HEAD_DIM
KV_COLS = N_KV * HEAD_DIM
IN_COLS = Q_COLS + 6 * KV_COLS + 3 * N_HEADS + 2 * GMLP_WIDTH + 2 * D_MODEL

kernel_name = 'nsa_gmlp_convffn_hybrid_step'


def rmsnorm(x, g):
    xf = x.astype(jnp.float32)
    xf = xf * lax.rsqrt(jnp.mean(xf * xf, axis=-1, keepdims=True) + EPS)
    return xf.astype(x.dtype) * g


def masked_softmax(s, mask):
    s = jnp.where(mask, s, NEG)
    m = jnp.max(s, axis=-1, keepdims=True)
    e = jnp.where(mask, jnp.exp(s - m), 0.0)
    d = jnp.sum(e, axis=-1, keepdims=True)
    return e / jnp.where(d > 0, d, 1.0)


def project(h, w_in):
    B, T = h.shape[:2]
    z = h @ w_in
    q = z[..., :Q_COLS].reshape(B, T, N_HEADS, HEAD_DIM)
    off = Q_COLS
    kv = z[..., off:off + 6 * KV_COLS].reshape(B, T, 3, 2, N_KV, HEAD_DIM)
    off += 6 * KV_COLS
    nsa_g = jax.nn.sigmoid(z[..., off:off + 3 * N_HEADS].reshape(B, T, N_HEADS, 3))
    off += 3 * N_HEADS
    uv = jax.nn.gelu(z[..., off:off + 2 * GMLP_WIDTH])
    u, v = uv[..., :GMLP_WIDTH], uv[..., GMLP_WIDTH:]
    off += 2 * GMLP_WIDTH
    gates = jax.nn.sigmoid(z[..., off:].reshape(B, T, 2, D_MODEL))
    return q, kv, nsa_g, u, v, gates


def dense_gqa(q, k, v, mask):
    B, Tq, H, D = q.shape
    G = k.shape[2]
    qg = q.reshape(B, Tq, G, H // G, D)
    s = jnp.einsum('btgrd,bsgd->bgrts', qg, k).astype(jnp.float32) * ATTN_SCALE
    p = masked_softmax(s, mask)
    o = jnp.einsum('bgrts,bsgd->btgrd', p.astype(v.dtype), v).reshape(B, Tq, H, D)
    return o, p


def compress(x, pe, w1, b1, w2):
    B, T, G, D = x.shape
    n_seg = T // CMP_STRIDE
    n_cmp = n_seg - CMP_HALVES + 1
    seg = x[:, :n_seg * CMP_STRIDE].reshape(B, n_seg, CMP_STRIDE, G, D)
    pe_h = pe.reshape(CMP_HALVES, CMP_STRIDE, D)
    w1_h = w1.reshape(CMP_HALVES, CMP_STRIDE, D, CMP_HID)
    hid = b1
    for r in range(CMP_HALVES):
        part = jnp.einsum('bnsgd,sdh->bngh', seg + pe_h[r][:, None, :], w1_h[r])
        hid = hid + part[:, r:r + n_cmp]
    return jnp.einsum('bngh,hd->bngd', jax.nn.gelu(hid), w2)


def select_blocks(p_cmp, q_pos, n_blocks):
    imp_c = jnp.sum(p_cmp, axis=2)
    n_cmp = imp_c.shape[-1]
    ratio = SEL_BLOCK // CMP_STRIDE
    n_back = CMP_HALVES - 1
    padded = jnp.pad(imp_c, ((0, 0), (0, 0), (0, 0), (n_back, ratio * (n_blocks + 1) - n_cmp)))
    imp = padded[..., 0::ratio][..., :n_blocks]
    for m in range(1, ratio + n_back):
        imp = imp + padded[..., m::ratio][..., :n_blocks]
    blk = jnp.arange(n_blocks, dtype=jnp.int32)[None, :]
    cur = (q_pos // SEL_BLOCK)[:, None]
    valid = blk * SEL_BLOCK <= q_pos[:, None]
    forced = (blk == 0) | ((blk <= cur) & (blk > cur - N_LOCAL_SEL))
    score = jnp.where(valid, imp + jnp.where(forced, SEL_BONUS, 0.0), NEG)
    vals, idx = lax.top_k(score, min(N_SEL, n_blocks))
    return idx, vals > NEG / 2


def to_blocks(x, n_blocks):
    B, T, G, D = x.shape
    xp = jnp.pad(x, ((0, 0), (0, n_blocks * SEL_BLOCK - T), (0, 0), (0, 0)))
    return xp.reshape(B, n_blocks, SEL_BLOCK, G, D).transpose(0, 3, 1, 2, 4)


def nsa_global(q, q_pos, kv_cmp, kv_slc, n_blocks, cmp_pe, cmp_w1, cmp_b1, cmp_w2):
    kc = compress(kv_cmp[:, :, 0], cmp_pe[0], cmp_w1[0], cmp_b1[0], cmp_w2[0])
    vc = compress(kv_cmp[:, :, 1], cmp_pe[1], cmp_w1[1], cmp_b1[1], cmp_w2[1])
    ends = jnp.arange(kc.shape[1], dtype=jnp.int32) * CMP_STRIDE + CMP_LEN - 1
    o_cmp, p_cmp = dense_gqa(q, kc, vc, ends[None, :] <= q_pos[:, None])
    idx, ok = select_blocks(p_cmp, q_pos, n_blocks)
    kb = to_blocks(kv_slc[:, :, 0], n_blocks)
    vb = to_blocks(kv_slc[:, :, 1], n_blocks)
    return o_cmp, idx, ok, kb, vb


def sel_attention(q, kb, vb, idx, ok, q_pos):
    B, Tq, H, D = q.shape
    G = kb.shape[1]
    K = idx.shape[-1]
    take = jax.vmap(jax.vmap(lambda a, i: a[i]))
    kg = take(kb, idx)
    vg = take(vb, idx)
    qg = q.reshape(B, Tq, G, H // G, D)
    s = jnp.einsum('btgrd,bgtksd->bgrtks', qg, kg).astype(jnp.float32) * ATTN_SCALE
    kpos = idx[..., None] * SEL_BLOCK + jnp.arange(SEL_BLOCK, dtype=jnp.int32)
    mask = (kpos <= q_pos[:, None, None]) & ok[..., None]
    mask = mask.reshape(B, G, Tq, K * SEL_BLOCK)[:, :, None]
    p = masked_softmax(s.reshape(B, G, H // G, Tq, K * SEL_BLOCK), mask)
    o = jnp.einsum('bgrtn,bgtnd->btgrd', p.astype(vg.dtype), vg.reshape(B, G, Tq, K * SEL_BLOCK, D))
    return o.reshape(B, Tq, H, D)


def sel_attention_blocked(q, kb, vb, idx, ok, q_pos):
    B, T, H, D = q.shape
    G, K = idx.shape[1], idx.shape[-1]
    nb = T // Q_BLOCK
    qb = q.reshape(B, nb, Q_BLOCK, H, D).transpose(1, 0, 2, 3, 4)
    ib = idx.reshape(B, G, nb, Q_BLOCK, K).transpose(2, 0, 1, 3, 4)
    okb = ok.reshape(B, G, nb, Q_BLOCK, K).transpose(2, 0, 1, 3, 4)
    pb = q_pos.reshape(nb, Q_BLOCK)
    out = lax.map(lambda a: sel_attention(a[0], kb, vb, a[1], a[2], a[3]), (qb, ib, okb, pb))
    return out.transpose(1, 0, 2, 3, 4).reshape(B, T, H, D)


def window_prompt(q, k, v):
    B, T, H, D = q.shape
    G = k.shape[2]
    nb = T // Q_BLOCK
    nband = WINDOW // Q_BLOCK
    pad = nband * Q_BLOCK

    def band(x):
        xp = jnp.pad(x, ((0, 0), (pad, 0), (0, 0), (0, 0))).reshape(B, nb + nband, Q_BLOCK, G, D)
        return jnp.concatenate([xp[:, j:j + nb] for j in range(nband + 1)], axis=2)

    kb, vb = band(k), band(v)
    qb = q.reshape(B, nb, Q_BLOCK, G, H // G, D)
    s = jnp.einsum('bctgrd,bcsgd->bgrcts', qb, kb).astype(jnp.float32) * ATTN_SCALE
    base = jnp.arange(nb, dtype=jnp.int32)[:, None] * Q_BLOCK
    qpos = base + jnp.arange(Q_BLOCK, dtype=jnp.int32)[None, :]
    kpos = base - pad + jnp.arange((nband + 1) * Q_BLOCK, dtype=jnp.int32)[None, :]
    dlt = qpos[:, :, None] - kpos[:, None, :]
    mask = (kpos[:, None, :] >= 0) & (dlt >= 0) & (dlt <= WINDOW)
    p = masked_softmax(s, mask)
    o = jnp.einsum('bgrcts,bcsgd->bctgrd', p.astype(v.dtype), vb)
    return o.reshape(B, T, H, D)


def chunk_mix(u, v, ws, bs):
    B, T, W = v.shape
    nc = -(-T // CHUNK)
    vp = jnp.pad(v, ((0, 0), (0, nc * CHUNK - T), (0, 0))).reshape(B, nc, CHUNK, GMLP_GROUPS, GMLP_GROUP_DIM)
    tri = jnp.tril(jnp.ones((CHUNK, CHUNK), dtype=bool))
    wm = jnp.where(tri, ws, 0.0)
    z = jnp.einsum('gij,bcjgd->bcigd', wm, vp) + bs.T[None, None, :, :, None]
    return u * z.reshape(B, nc * CHUNK, W)[:, :T]


def conv_ffn(h, prev, w_up, conv_w, conv_b, w_down):
    ab = h @ w_up
    a, b = ab[..., :D_FF], ab[..., D_FF:]
    T = a.shape[1]
    ext = jnp.concatenate([prev.astype(a.dtype), a], axis=1)
    c = conv_b + ext[:, 0:T] * conv_w[0]
    for j in range(1, CONV_W):
        c = c + ext[:, j:j + T] * conv_w[j]
    y = (jax.nn.gelu(c) * b) @ w_down
    return y, ext[:, -(CONV_W - 1):]


def front(x, norm_mix, w_in, gmlp_norm):
    h = rmsnorm(x, norm_mix)
    q, kv, nsa_g, u, v, gates = project(h, w_in)
    return q, kv, nsa_g, u, rmsnorm(v, gmlp_norm), gates


def back(x, o_cmp, o_slc, o_win, nsa_g, u, vn, gates, conv_prev,
         gmlp_ws, gmlp_bs, w_proj_a, w_proj_b, w_out, norm_ffn, w_up, conv_w, conv_b, w_down):
    B, T = x.shape[:2]
    o_nsa = nsa_g[..., 0:1] * o_cmp + nsa_g[..., 1:2] * o_slc + nsa_g[..., 2:3] * o_win
    br_a = o_nsa.reshape(B, T, Q_COLS) @ w_proj_a
    br_b = chunk_mix(u, vn, gmlp_ws, gmlp_bs) @ w_proj_b
    x1 = x + (gates[:, :, 0] * br_a + gates[:, :, 1] * br_b) @ w_out
    f, conv_state = conv_ffn(rmsnorm(x1, norm_ffn), conv_prev, w_up, conv_w, conv_b, w_down)
    return x1 + f, conv_state


def setup_inputs(seed: int = 0) -> dict:
    key = jax.random.key(seed)
    ks = jax.random.split(key, 32)
    f32 = jnp.float32

    def nrm(k, shape, scale):
        return jax.random.normal(k, shape, f32) * scale

    n_pages = PAST_LEN // PAGE_SIZE
    n_used = DEC_BATCH * n_pages
    n_pool = n_used + (n_used + 3) // 4
    win_buf = min(WINDOW, PAST_LEN)
    page_table = jax.random.permutation(ks[0], n_pool)[:n_used].reshape(DEC_BATCH, n_pages).astype(jnp.int32)
    return dict(
        x_prompt=nrm(ks[1], (BATCH, SEQ, D_MODEL), 1.0),
        x_sample=nrm(ks[2], (DEC_BATCH, DEC_SEQ, D_MODEL), 1.0),
        cache_cmp=nrm(ks[3], (DEPTH, n_pool, PAGE_SIZE, 2, N_KV, HEAD_DIM), 1.0),
        cache_slc=nrm(ks[4], (DEPTH, n_pool, PAGE_SIZE, 2, N_KV, HEAD_DIM), 1.0),
        cache_win=nrm(ks[5], (DEPTH, DEC_BATCH, win_buf, 2, N_KV, HEAD_DIM), 1.0),
        state_conv=nrm(ks[6], (DEPTH, DEC_BATCH, CONV_W - 1, D_FF), 1.0),
        page_table=page_table,
        norm_mix=1.0 + nrm(ks[7], (DEPTH, D_MODEL), 0.02),
        w_in=nrm(ks[8], (DEPTH, D_MODEL, IN_COLS), D_MODEL ** -0.5),
        cmp_pe=nrm(ks[9], (DEPTH, 2, CMP_LEN, HEAD_DIM), 0.1),
        cmp_w1=nrm(ks[10], (DEPTH, 2, CMP_LEN * HEAD_DIM, CMP_HID), (CMP_LEN * HEAD_DIM) ** -0.5),
        cmp_b1=nrm(ks[11], (DEPTH, 2, CMP_HID), 0.02),
        cmp_w2=nrm(ks[12], (DEPTH, 2, CMP_HID, HEAD_DIM), CMP_HID ** -0.5),
        gmlp_norm=1.0 + nrm(ks[13], (DEPTH, GMLP_WIDTH), 0.02),
        gmlp_ws=nrm(ks[14], (DEPTH, GMLP_GROUPS, CHUNK, CHUNK), CHUNK ** -0.5),
        gmlp_bs=1.0 + nrm(ks[15], (DEPTH, GMLP_GROUPS, CHUNK), 0.02),
        w_proj_a=nrm(ks[16], (DEPTH, Q_COLS, D_MODEL), Q_COLS ** -0.5),
        w_proj_b=nrm(ks[17], (DEPTH, GMLP_WIDTH, D_MODEL), GMLP_WIDTH ** -0.5),
        w_out=nrm(ks[18], (DEPTH, D_MODEL, D_MODEL), D_MODEL ** -0.5),
        norm_ffn=1.0 + nrm(ks[19], (DEPTH, D_MODEL), 0.02),
        w_up=nrm(ks[20], (DEPTH, D_MODEL, 2 * D_FF), D_MODEL ** -0.5),
        conv_w=nrm(ks[21], (DEPTH, CONV_W, D_FF), CONV_W ** -0.5),
        conv_b=nrm(ks[22], (DEPTH, D_FF), 0.02),
        w_down=nrm(ks[23], (DEPTH, D_FF, D_MODEL), D_FF ** -0.5),
        norm_final=1.0 + nrm(ks[24], (D_MODEL,), 0.02),
    )


def reference(x_prompt, x_sample, cache_cmp, cache_slc, cache_win, state_conv, page_table,
              norm_mix, w_in, cmp_pe, cmp_w1, cmp_b1, cmp_w2, gmlp_norm, gmlp_ws, gmlp_bs,
              w_proj_a, w_proj_b, w_out, norm_ffn, w_up, conv_w, conv_b, w_down, norm_final):
    xp, xs = x_prompt, x_sample
    Bp, T = xp.shape[:2]
    Bd, Tn = xs.shape[:2]
    n_pages = page_table.shape[1]
    past_len = n_pages * cache_cmp.shape[2]
    pos_p = jnp.arange(T, dtype=jnp.int32)
    pos_s = past_len + jnp.arange(Tn, dtype=jnp.int32)
    nblk_p = -(-T // SEL_BLOCK)
    nblk_s = -(-(past_len + Tn) // SEL_BLOCK)
    st = {n: [] for n in ('cmp_p', 'slc_p', 'win_p', 'v_p', 'conv_p', 'cmp_s', 'slc_s', 'win_s', 'v_s', 'conv_s')}
    for l in range(DEPTH):
        cw = (cmp_pe[l], cmp_w1[l], cmp_b1[l], cmp_w2[l])
        bw = (gmlp_ws[l], gmlp_bs[l], w_proj_a[l], w_proj_b[l], w_out[l],
              norm_ffn[l], w_up[l], conv_w[l], conv_b[l], w_down[l])
        q, kv, g, u, vn, gates = front(xp, norm_mix[l], w_in[l], gmlp_norm[l])
        kv_cmp, kv_slc, kv_win = kv[:, :, 0], kv[:, :, 1], kv[:, :, 2]
        o_cmp, idx, ok, kb, vb = nsa_global(q, pos_p, kv_cmp, kv_slc, nblk_p, *cw)
        o_slc = sel_attention_blocked(q, kb, vb, idx, ok, pos_p)
        o_win = window_prompt(q, kv_win[:, :, 0], kv_win[:, :, 1])
        conv0 = jnp.zeros((Bp, CONV_W - 1, D_FF), xp.dtype)
        xp, conv_p = back(xp, o_cmp, o_slc, o_win, g, u, vn, gates, conv0, *bw)
        st['cmp_p'].append(kv_cmp)
        st['slc_p'].append(kv_slc)
        st['win_p'].append(kv_win[:, -min(WINDOW, T):])
        st['v_p'].append(vn[:, ((T - 1) // CHUNK) * CHUNK:])
        st['conv_p'].append(conv_p)
        q, kv, g, u, vn, gates = front(xs, norm_mix[l], w_in[l], gmlp_norm[l])
        kv_cmp, kv_slc, kv_win = kv[:, :, 0], kv[:, :, 1], kv[:, :, 2]
        rows = (Bd, past_len) + cache_cmp.shape[3:]
        full_cmp = jnp.concatenate([cache_cmp[l][page_table].reshape(rows), kv_cmp], axis=1)
        full_slc = jnp.concatenate([cache_slc[l][page_table].reshape(rows), kv_slc], axis=1)
        o_cmp, idx, ok, kb, vb = nsa_global(q, pos_s, full_cmp, full_slc, nblk_s, *cw)
        o_slc = sel_attention(q, kb, vb, idx, ok, pos_s)
        win_all = jnp.concatenate([cache_win[l], kv_win], axis=1)
        lb = cache_win.shape[2]
        kpos = past_len - lb + jnp.arange(lb + Tn, dtype=jnp.int32)
        dlt = pos_s[:, None] - kpos[None, :]
        o_win, _ = dense_gqa(q, win_all[:, :, 0], win_all[:, :, 1], (dlt >= 0) & (dlt <= WINDOW))
        xs, conv_s = back(xs, o_cmp, o_slc, o_win, g, u, vn, gates, state_conv[l], *bw)
        st['cmp_s'].append(kv_cmp)
        st['slc_s'].append(kv_slc)
        st['win_s'].append(win_all[:, -min(WINDOW, lb + Tn):])
        st['v_s'].append(vn[:, ((Tn - 1) // CHUNK) * CHUNK:])
        st['conv_s'].append(conv_s)
    y_prompt = rmsnorm(xp, norm_final)
    y_sample = rmsnorm(xs, norm_final)
    return (y_prompt, y_sample,
            jnp.stack(st['cmp_p']), jnp.stack(st['slc_p']), jnp.stack(st['win_p']),
            jnp.stack(st['v_p']), jnp.stack(st['conv_p']),
            jnp.stack(st['cmp_s']), jnp.stack(st['slc_s']), jnp.stack(st['win_s']),
            jnp.stack(st['v_s']), jnp.stack(st['conv_s']))
```

```cpp
#include <hip/hip_runtime.h>
#include <cstdio>
#include <cstdint>

namespace cfg {
constexpr int DM = 1024, BATCH = 4, SEQ = 4096, MP = BATCH * SEQ, DB = 32, MROWS = MP + DB, MPAD = 16640;
constexpr int PAST = 16384, PAGE = 128, NPAGES = PAST / PAGE;
constexpr int NH = 8, HD = 64, NKV = 2;
constexpr int INC = 4376, INP = 4608;
constexpr int GW = 512, DFF = 2816, UPN = 2 * DFF;
constexpr float EPS = 1e-6f, NEGF = -1e30f, L2E = 1.4426950408889634f;
constexpr size_t OFF_YP = 0, OFF_YS = 16777216, OFF_CMP_P = 16809984, OFF_SLC_P = 21004288, OFF_WIN_P = 25198592, OFF_V_P = 25722880, OFF_CONV_P = 25985024,
                 OFF_CMP_S = 26007552, OFF_SLC_S = 26015744, OFF_WIN_S = 26023936, OFF_V_S = 30218240, OFF_CONV_S = 30234624, OUT_TOTAL = 30414848;
constexpr size_t MiB = 1u << 20;
constexpr size_t WS_CTL = 0, CTL_ZERO_BYTES = 1 * MiB;
constexpr size_t WS_WIN_T = 2 * MiB, WS_WPA_T = 12 * MiB, WS_WPB_T = 13 * MiB, WS_WOUT_T = 14 * MiB, WS_WUP_T = 16 * MiB, WS_WDN_T = 28 * MiB;
constexpr size_t WS_RSTD1 = 34 * MiB, WS_SSV = 35 * MiB, WS_SS2 = 36 * MiB, WS_SS3 = 38 * MiB, WS_NSAG = 40 * MiB, WS_KCP = 43 * MiB, WS_VCP = 44 * MiB;
constexpr size_t WS_KCS = 48 * MiB, WS_VCS = 64 * MiB;
constexpr size_t WS_XB = 80 * MiB, WS_Q = 113 * MiB, WS_KVB = 130 * MiB, WS_U = 155 * MiB, WS_VG = 172 * MiB, WS_GT = 189 * MiB, WS_ONSA = 254 * MiB, WS_CM = 271 * MiB;
constexpr size_t WS_T = 288 * MiB, WS_MIX = 353 * MiB, WS_X1F = 386 * MiB, WS_X1B = 451 * MiB, WS_AB = 484 * MiB, WS_ACT = 663 * MiB, WS_END = 753 * MiB;
constexpr int CW_BAR = 4096;
constexpr int RING_BYTES = 131072, LDSCTL_OFF = RING_BYTES, MISC_OFF = LDSCTL_OFF + 320, LDS_BYTES = 147456;
}

#define GAS __attribute__((address_space(1)))
#define LAS __attribute__((address_space(3)))
#define DI __device__ __forceinline__
typedef unsigned short bf16;
typedef GAS unsigned gu32;
typedef unsigned v4u __attribute__((ext_vector_type(4)));
typedef unsigned v2u __attribute__((ext_vector_type(2)));
typedef float v4f __attribute__((ext_vector_type(4)));

struct Args {
    const float* x_prompt; const float* x_sample; const float* cache_cmp; const float* cache_slc; const float* cache_win; const float* state_conv;
    const int* page_table; const float* norm_mix; const float* w_in; const float* cmp_pe; const float* cmp_w1; const float* cmp_b1; const float* cmp_w2;
    const float* gmlp_norm; const float* gmlp_ws; const float* gmlp_bs; const float* w_proj_a; const float* w_proj_b; const float* w_out; const float* norm_ffn;
    const float* w_up; const float* conv_w; const float* conv_b; const float* w_down; const float* norm_final;
    float* out; unsigned char* ws;
    int ph_lo, ph_hi;
};

DI float bf2f(bf16 b) { return __uint_as_float(((unsigned)b) << 16); }
DI unsigned f2bf(float f) { unsigned u = __float_as_uint(f); return (u + 0x7fffu + ((u >> 16) & 1u)) >> 16; }
DI unsigned pk2(float lo, float hi) { return f2bf(lo) | (f2bf(hi) << 16); }
DI float fast_sigmoid(float x) { return __builtin_amdgcn_rcpf(1.0f + __builtin_amdgcn_exp2f(-1.4426950408889634f * x)); }
DI float gelu_tanh(float x) { const float u = x * (1.0f + 0.044715f * x * x); return x * __builtin_amdgcn_rcpf(1.0f + __builtin_amdgcn_exp2f(-2.302208198f * u)); }
DI float wave_sum(float v) {
#pragma unroll
    for (int o = 1; o < 64; o <<= 1) v += __shfl_xor(v, o);
    return v;
}
DI float wave_max(float v) {
#pragma unroll
    for (int o = 1; o < 64; o <<= 1) v = fmaxf(v, __shfl_xor(v, o));
    return v;
}
namespace pg8 {
#define PG8_LAS __attribute__((address_space(3)))
typedef unsigned short bf16_t;
typedef short bf16x8 __attribute__((ext_vector_type(8)));
typedef float f32x4 __attribute__((ext_vector_type(4)));
typedef unsigned u32x4 __attribute__((ext_vector_type(4)));
constexpr int BM = 256, BK = 64, HALF = 128, HTB = HALF * BK * 2  , STAGE_BYTES = 8 * HTB, NXCD = 8, WGM = 8;

__host__ __device__ __forceinline__ int lds_byte(int r, int c) { const int st = (r >> 4) * 2 + (c >> 5), rr = r & 15, cc = c & 31, ob = rr * 64 + cc * 2; return st * 1024 + (ob ^ (((ob >> 9) & 1) << 5)); }
__host__ __device__ __forceinline__ void stage_rc(int b, int& R, int& C) { const int st = b / 1024, sb = b % 1024, swz = sb ^ (((sb >> 9) & 1) << 5); R = (st >> 1) * 16 + swz / 64; C = (st & 1) * 32 + (swz % 64) / 2; }
__host__ __device__ __forceinline__ int perm32(int rho) { const int n = rho >> 4, i = rho & 15; return 8 * (i >> 2) + 4 * n + (i & 3); }

struct Unit { int pm, pn; };
struct Gemm { const bf16_t* A; const bf16_t* Bt; int M, N, K; };

struct StaticOrder {
    int nM, nN, nwg, G, c;
    __host__ __device__ void init(int M, int N, int G_, int c_) { nM = M / BM; nN = N / BM; nwg = nM * nN; G = G_; c = c_; }
    __host__ __device__ bool next(int i, Unit& u) const {
        const long L = (long)i * G + c; if (L >= nwg) return false;
        int wgid = (int)L; { const int q = nwg / NXCD, r = nwg % NXCD, xcd = wgid % NXCD, off = wgid / NXCD; wgid = (xcd < r ? xcd * (q + 1) : r * (q + 1) + (xcd - r) * q) + off; }
        const int nig = WGM * nN, gid = wgid / nig, fm = gid * WGM, gsz = (nM - fm) < WGM ? (nM - fm) : WGM;
        u.pm = fm + ((wgid % nig) % gsz); u.pn = (wgid % nig) / gsz; return true;
    }
    __device__ __forceinline__ void a_ready(const Unit&) const {}
    __device__ __forceinline__ void done(const Unit&) const {}
};

typedef float f32x2c_t __attribute__((ext_vector_type(2))); typedef __bf16 bf16x2c_t __attribute__((ext_vector_type(2)));
__device__ __forceinline__ unsigned cvt_pk_bf16(float lo, float hi) { f32x2c_t v = {lo, hi}; bf16x2c_t b = __builtin_convertvector(v, bf16x2c_t); return __builtin_bit_cast(unsigned, b); }
typedef unsigned u32x2 __attribute__((ext_vector_type(2)));
__device__ __forceinline__ u32x4 pack8(const f32x4& v0, const f32x4& v1) { u32x4 w; w.x = cvt_pk_bf16(v0[0], v0[1]); w.y = cvt_pk_bf16(v0[2], v0[3]); w.z = cvt_pk_bf16(v1[0], v1[1]); w.w = cvt_pk_bf16(v1[2], v1[3]); return w; }
__device__ __forceinline__ f32x4 sig4(const f32x4& v) { return (f32x4){fast_sigmoid(v[0]), fast_sigmoid(v[1]), fast_sigmoid(v[2]), fast_sigmoid(v[3])}; }
__device__ __forceinline__ f32x4 gelu4(const f32x4& v) { return (f32x4){gelu_tanh(v[0]), gelu_tanh(v[1]), gelu_tanh(v[2]), gelu_tanh(v[3])}; }
__device__ __forceinline__ float sq4(const f32x4& v) { return (v[0] * v[0] + v[1] * v[1]) + (v[2] * v[2] + v[3] * v[3]); }

struct EpiIn {
    static constexpr bool PERM = true, AFTER_DRAIN = false;
    const float* rstd; bf16_t* Q; bf16_t* KVB; bf16_t* U; bf16_t* VG; float* SSV; bf16_t* GT; float* NSAG; float* out;
    __device__ __forceinline__ void operator()(const f32x4 (&acc)[2][2][4][2], const Unit& u, int wr, int wc, int fr, int fq) const {
        const int row0 = u.pm * BM + wr * 64 + fr, cl0 = wc * 32 + 8 * fq, pn = u.pn;
#pragma unroll
        for (int ai = 0; ai < 2; ++ai)
#pragma unroll
            for (int m = 0; m < 4; ++m) {
                const int row = row0 + ai * HALF + m * 16; const float rs = rstd[row];
                if (pn < 2) {
                    const float s = rs * 0.125f;
#pragma unroll
                    for (int bj = 0; bj < 2; ++bj) *(u32x4*)(Q + (size_t)row * 512 + pn * 256 + bj * HALF + cl0) = pack8(acc[ai][bj][m][0] * s, acc[ai][bj][m][1] * s);
                } else if (pn < 5) {
                    float* dst = nullptr;
                    if (pn == 2) dst = row < cfg::MP ? out + cfg::OFF_CMP_P + (size_t)row * 256 : (row < cfg::MROWS ? out + cfg::OFF_CMP_S + (size_t)(row - cfg::MP) * 256 : nullptr);
                    else if (pn == 3) dst = row < cfg::MP ? out + cfg::OFF_SLC_P + (size_t)row * 256 : (row < cfg::MROWS ? out + cfg::OFF_SLC_S + (size_t)(row - cfg::MP) * 256 : nullptr);
                    else { if (row < cfg::MP) { const int t = row & 4095, b = row >> 12; if (t >= 3584) dst = out + cfg::OFF_WIN_P + (size_t)(b * 512 + (t - 3584)) * 256; }
                           else if (row < cfg::MROWS) dst = out + cfg::OFF_WIN_S + ((size_t)(row - cfg::MP) * 512 + 511) * 256; }
#pragma unroll
                    for (int bj = 0; bj < 2; ++bj) { const f32x4 v0 = acc[ai][bj][m][0] * rs, v1 = acc[ai][bj][m][1] * rs; const int cl = bj * HALF + cl0;
                        *(u32x4*)(KVB + (size_t)row * 768 + (pn - 2) * 256 + cl) = pack8(v0, v1);
                        if (dst) { *(f32x4*)(dst + cl) = v0; *(f32x4*)(dst + cl + 4) = v1; } }
                } else if (pn < 7) {
#pragma unroll
                    for (int bj = 0; bj < 2; ++bj) *(u32x4*)(U + (size_t)row * 512 + (pn - 5) * 256 + bj * HALF + cl0) = pack8(gelu4(acc[ai][bj][m][0] * rs), gelu4(acc[ai][bj][m][1] * rs));
                } else if (pn < 9) {
                    float ss = 0.f;
#pragma unroll
                    for (int bj = 0; bj < 2; ++bj) { const f32x4 v0 = gelu4(acc[ai][bj][m][0] * rs), v1 = gelu4(acc[ai][bj][m][1] * rs); ss += sq4(v0) + sq4(v1);
                        *(u32x4*)(VG + (size_t)row * 512 + (pn - 7) * 256 + bj * HALF + cl0) = pack8(v0, v1); }
                    ss += __shfl_xor(ss, 16); ss += __shfl_xor(ss, 32);
                    if (fq == 0) SSV[(size_t)row * 8 + (pn - 7) * 4 + wc] = ss;
                } else if (pn < 17) {
#pragma unroll
                    for (int bj = 0; bj < 2; ++bj) *(u32x4*)(GT + (size_t)row * 2048 + (pn - 9) * 256 + bj * HALF + cl0) = pack8(sig4(acc[ai][bj][m][0] * rs), sig4(acc[ai][bj][m][1] * rs));
                } else {
                    if (wc == 0 && fq < 3) { float* d = NSAG + (size_t)row * 32 + 8 * fq; *(f32x4*)d = sig4(acc[ai][0][m][0] * rs); *(f32x4*)(d + 4) = sig4(acc[ai][0][m][1] * rs); }
                }
            }
    }
};
struct EpiPA {
    static constexpr bool PERM = true, AFTER_DRAIN = false;
    const bf16_t* GT; float* T;
    __device__ __forceinline__ void operator()(const f32x4 (&acc)[2][2][4][2], const Unit& u, int wr, int wc, int fr, int fq) const {
        const int row0 = u.pm * BM + wr * 64 + fr, col0 = u.pn * BM + wc * 32 + 8 * fq;
#pragma unroll
        for (int ai = 0; ai < 2; ++ai)
#pragma unroll
            for (int m = 0; m < 4; ++m) { const int row = row0 + ai * HALF + m * 16;
#pragma unroll
                for (int bj = 0; bj < 2; ++bj) { const int col = col0 + bj * HALF; const u32x4 g = *(const u32x4*)(GT + (size_t)row * 2048 + col);
                    f32x4 g0 = (f32x4){__uint_as_float(g.x << 16), __uint_as_float(g.x & 0xffff0000u), __uint_as_float(g.y << 16), __uint_as_float(g.y & 0xffff0000u)};
                    f32x4 g1 = (f32x4){__uint_as_float(g.z << 16), __uint_as_float(g.z & 0xffff0000u), __uint_as_float(g.w << 16), __uint_as_float(g.w & 0xffff0000u)};
                    float* d = T + (size_t)row * 1024 + col; *(f32x4*)d = acc[ai][bj][m][0] * g0; *(f32x4*)(d + 4) = acc[ai][bj][m][1] * g1; } }
    }
};
struct EpiPB {
    static constexpr bool PERM = true, AFTER_DRAIN = false;
    const bf16_t* GT; const float* T; bf16_t* MIX;
    __device__ __forceinline__ void operator()(const f32x4 (&acc)[2][2][4][2], const Unit& u, int wr, int wc, int fr, int fq) const {
        const int row0 = u.pm * BM + wr * 64 + fr, col0 = u.pn * BM + wc * 32 + 8 * fq;
#pragma unroll
        for (int ai = 0; ai < 2; ++ai)
#pragma unroll
            for (int m = 0; m < 4; ++m) { const int row = row0 + ai * HALF + m * 16;
#pragma unroll
                for (int bj = 0; bj < 2; ++bj) { const int col = col0 + bj * HALF; const u32x4 g = *(const u32x4*)(GT + (size_t)row * 2048 + 1024 + col);
                    f32x4 g0 = (f32x4){__uint_as_float(g.x << 16), __uint_as_float(g.x & 0xffff0000u), __uint_as_float(g.y << 16), __uint_as_float(g.y & 0xffff0000u)};
                    f32x4 g1 = (f32x4){__uint_as_float(g.z << 16), __uint_as_float(g.z & 0xffff0000u), __uint_as_float(g.w << 16), __uint_as_float(g.w & 0xffff0000u)};
                    const float* t = T + (size_t)row * 1024 + col; const f32x4 t0 = *(const f32x4*)t, t1 = *(const f32x4*)(t + 4);
                    *(u32x4*)(MIX + (size_t)row * 1024 + col) = pack8(t0 + acc[ai][bj][m][0] * g0, t1 + acc[ai][bj][m][1] * g1); } }
    }
};
struct EpiOut {
    static constexpr bool PERM = true, AFTER_DRAIN = false;
    const float* xp; const float* xs; float* X1F; bf16_t* X1B; float* SS2;
    __device__ __forceinline__ void operator()(const f32x4 (&acc)[2][2][4][2], const Unit& u, int wr, int wc, int fr, int fq) const {
        const int row0 = u.pm * BM + wr * 64 + fr, col0 = u.pn * BM + wc * 32 + 8 * fq;
#pragma unroll
        for (int ai = 0; ai < 2; ++ai)
#pragma unroll
            for (int m = 0; m < 4; ++m) { const int row = row0 + ai * HALF + m * 16;
                const float* xr = row < cfg::MP ? xp + (size_t)row * 1024 : (row < cfg::MROWS ? xs + (size_t)(row - cfg::MP) * 1024 : nullptr);
                float ss = 0.f;
#pragma unroll
                for (int bj = 0; bj < 2; ++bj) { const int col = col0 + bj * HALF;
                    f32x4 x0 = (f32x4){0.f, 0.f, 0.f, 0.f}, x1 = x0; if (xr) { x0 = *(const f32x4*)(xr + col); x1 = *(const f32x4*)(xr + col + 4); }
                    x0 = x0 + acc[ai][bj][m][0]; x1 = x1 + acc[ai][bj][m][1]; ss += sq4(x0) + sq4(x1);
                    float* d = X1F + (size_t)row * 1024 + col; *(f32x4*)d = x0; *(f32x4*)(d + 4) = x1;
                    *(u32x4*)(X1B + (size_t)row * 1024 + col) = pack8(x0, x1); }
                ss += __shfl_xor(ss, 16); ss += __shfl_xor(ss, 32);
                if (fq == 0) SS2[(size_t)row * 16 + u.pn * 4 + wc] = ss; }
    }
};
struct EpiUp {
    static constexpr bool PERM = true, AFTER_DRAIN = false;
    const float* SS2; bf16_t* AB; float* out;
    __device__ __forceinline__ void operator()(const f32x4 (&acc)[2][2][4][2], const Unit& u, int wr, int wc, int fr, int fq) const {
        const int row0 = u.pm * BM + wr * 64 + fr, col0 = u.pn * BM + wc * 32 + 8 * fq;
#pragma unroll
        for (int ai = 0; ai < 2; ++ai)
#pragma unroll
            for (int m = 0; m < 4; ++m) { const int row = row0 + ai * HALF + m * 16;
                const f32x4* sp = (const f32x4*)(SS2 + (size_t)row * 16); const f32x4 s0 = sp[0], s1 = sp[1], s2 = sp[2], s3 = sp[3];
                const float ssum = ((s0[0] + s0[1]) + (s0[2] + s0[3])) + ((s1[0] + s1[1]) + (s1[2] + s1[3])) + ((s2[0] + s2[1]) + (s2[2] + s2[3])) + ((s3[0] + s3[1]) + (s3[2] + s3[3]));
                const float rs = 1.0f / sqrtf(ssum * (1.0f / 1024.0f) + cfg::EPS);
                float* dst = nullptr;
                if (u.pn < 11) { if (row < cfg::MP) { const int t = row & 4095, b = row >> 12; if (t >= 4094) dst = out + cfg::OFF_CONV_P + (size_t)(b * 2 + (t - 4094)) * 2816; }
                                 else if (row < cfg::MROWS) dst = out + cfg::OFF_CONV_S + ((size_t)(row - cfg::MP) * 2 + 1) * 2816; }
#pragma unroll
                for (int bj = 0; bj < 2; ++bj) { const int col = col0 + bj * HALF; const f32x4 v0 = acc[ai][bj][m][0] * rs, v1 = acc[ai][bj][m][1] * rs;
                    *(u32x4*)(AB + (size_t)row * 5632 + col) = pack8(v0, v1);
                    if (dst) { *(f32x4*)(dst + col) = v0; *(f32x4*)(dst + col + 4) = v1; } } }
    }
};
struct EpiDown {
    static constexpr bool PERM = true, AFTER_DRAIN = false;
    const float* X1F; float* out; float* SS3;
    __device__ __forceinline__ void operator()(const f32x4 (&acc)[2][2][4][2], const Unit& u, int wr, int wc, int fr, int fq) const {
        const int row0 = u.pm * BM + wr * 64 + fr, col0 = u.pn * BM + wc * 32 + 8 * fq;
#pragma unroll
        for (int ai = 0; ai < 2; ++ai)
#pragma unroll
            for (int m = 0; m < 4; ++m) { const int row = row0 + ai * HALF + m * 16; float ss = 0.f;
#pragma unroll
                for (int bj = 0; bj < 2; ++bj) { const int col = col0 + bj * HALF; const float* xr = X1F + (size_t)row * 1024 + col;
                    const f32x4 x0 = *(const f32x4*)xr + acc[ai][bj][m][0], x1 = *(const f32x4*)(xr + 4) + acc[ai][bj][m][1]; ss += sq4(x0) + sq4(x1);
                    if (row < cfg::MROWS) { float* d = out + (size_t)row * 1024 + col; *(f32x4*)d = x0; *(f32x4*)(d + 4) = x1; } }
                ss += __shfl_xor(ss, 16); ss += __shfl_xor(ss, 32);
                if (fq == 0) SS3[(size_t)row * 16 + u.pn * 4 + wc] = ss; }
    }
};
template <class Epi, class Sched, bool ALIGN_EPI = false, bool SP2 = false>
__device__ __forceinline__ void gemm_phase(PG8_LAS unsigned char* lds, const Gemm g, const Sched& S, const Epi& E) {
    const int tid = threadIdx.x, wid = __builtin_amdgcn_readfirstlane(tid >> 6), lane = tid & 63, wr = wid >> 2, wc = wid & 3, fr = lane & 15, fq = lane >> 4;
    const int K = g.K, nt = K / BK;
    unsigned voffA[2], voffB[2];
#pragma unroll
    for (int i = 0; i < 2; ++i) { int R, C; stage_rc(tid * 16 + i * 8192, R, C); const int Rb = Epi::PERM ? ((R & ~31) + perm32(R & 31)) : R;
        voffA[i] = (unsigned)(R * K + C) * 2u; voffB[i] = (unsigned)(Rb * K + C) * 2u; }
    const size_t kstep = (size_t)(BK * 2);
    const size_t hstep = (size_t)HALF * K * 2;
    const size_t tstep = 2 * hstep;
    const unsigned ldsw = (unsigned)wid * 1024u;
    const int aoff = lds_byte(wr * 64 + fr, fq * 8), boff = lds_byte(wc * 32 + fr, fq * 8);
#define PG8_SA(b, h) (((b) * 2 + (h)) * HTB)
#define PG8_SB(b, h) ((4 + (b) * 2 + (h)) * HTB)
#define PG8_STAGE(bufoff, gbase, voff) do { _Pragma("unroll") for (int _i = 0; _i < 2; ++_i) \
        __builtin_amdgcn_global_load_lds((const unsigned*)((const char*)(gbase) + (voff)[_i]), (PG8_LAS unsigned*)(lds + (bufoff) + ldsw + _i * 8192), 16, 0, 0); } while (0)
#define PG8_LDA(dst, b, h) do { _Pragma("unroll") for (int m = 0; m < 4; ++m) _Pragma("unroll") for (int k = 0; k < 2; ++k) dst[m][k] = *(const PG8_LAS bf16x8*)(lds + PG8_SA(b, h) + aoff + m * 2048 + k * 1024); } while (0)
#define PG8_LDB(dst, b, h) do { _Pragma("unroll") for (int n = 0; n < 2; ++n) _Pragma("unroll") for (int k = 0; k < 2; ++k) dst[n][k] = *(const PG8_LAS bf16x8*)(lds + PG8_SB(b, h) + boff + n * 2048 + k * 1024); } while (0)
#define PG8_MMA(ai, bj, At, Bt) do { __builtin_amdgcn_s_setprio(1); _Pragma("unroll") for (int m = 0; m < 4; ++m) _Pragma("unroll") for (int n = 0; n < 2; ++n) _Pragma("unroll") for (int k = 0; k < 2; ++k) \
        acc[ai][bj][m][n] = __builtin_amdgcn_mfma_f32_16x16x32_bf16(Bt[n][k], At[m][k], acc[ai][bj][m][n], 0, 0, 0); __builtin_amdgcn_s_setprio(0); } while (0)
#define PG8_WAIT_V(n) asm volatile("s_waitcnt vmcnt(" #n ")" ::: "memory")
#define PG8_WAIT_L(n) asm volatile("s_waitcnt lgkmcnt(" #n ")" ::: "memory")
#define PG8_BAR __builtin_amdgcn_s_barrier()
#define PG8_SCHED __builtin_amdgcn_sched_barrier(0)
    Unit cur, nxt; int ui = 0;
    if (!S.next(0, cur)) return;
    f32x4 acc[2][2][4][2];
#pragma unroll
    for (int a = 0; a < 2; ++a)
#pragma unroll
        for (int b = 0; b < 2; ++b)
#pragma unroll
            for (int m = 0; m < 4; ++m)
#pragma unroll
                for (int n = 0; n < 2; ++n) acc[a][b][m][n] = (f32x4){0.f, 0.f, 0.f, 0.f};
    bf16x8 At[4][2], B0[2][2], B1[2][2];
    const char* cA = (const char*)g.A + (size_t)cur.pm * tstep; const char* cB = (const char*)g.Bt + (size_t)cur.pn * tstep;
    S.a_ready(cur);
    if constexpr (SP2) {
        PG8_STAGE(PG8_SB(0, 0), cB, voffB); PG8_STAGE(PG8_SB(0, 1), cB + hstep, voffB); PG8_STAGE(PG8_SA(0, 0), cA, voffA); PG8_STAGE(PG8_SA(0, 1), cA + hstep, voffA);
        if (wr == 1) PG8_BAR;
        PG8_WAIT_V(2); PG8_BAR;
        PG8_STAGE(PG8_SB(1, 0), cB + kstep, voffB); PG8_STAGE(PG8_SA(1, 0), cA + kstep, voffA); PG8_STAGE(PG8_SB(1, 1), cB + hstep + kstep, voffB);
        PG8_WAIT_V(6); PG8_BAR;
    } else {
        PG8_STAGE(PG8_SB(0, 0), cB, voffB); PG8_STAGE(PG8_SA(0, 0), cA, voffA); PG8_STAGE(PG8_SB(0, 1), cB + hstep, voffB); PG8_STAGE(PG8_SA(0, 1), cA + hstep, voffA);
        if (wr == 1) PG8_BAR;
        PG8_WAIT_V(4); PG8_BAR;
        PG8_STAGE(PG8_SB(1, 0), cB + kstep, voffB); PG8_STAGE(PG8_SA(1, 0), cA + kstep, voffA); PG8_STAGE(PG8_SB(1, 1), cB + hstep + kstep, voffB);
        PG8_WAIT_V(6); PG8_BAR;
    }
    for (;;) {
        const bool has_next = S.next(ui + 1, nxt);
        const char* nA = has_next ? (const char*)g.A + (size_t)nxt.pm * tstep : cA; const char* nB = has_next ? (const char*)g.Bt + (size_t)nxt.pn * tstep : cB;
        for (int t = 0; t < nt; t += 2) {
            const bool last = (t == nt - 2);
            const char* a1 = cA + (size_t)(t + 1) * kstep;
            const char* a2 = last ? nA : cA + (size_t)(t + 2) * kstep; const char* b2 = last ? nB : cB + (size_t)(t + 2) * kstep;
            const char* a3 = a2 + kstep; const char* b3 = b2 + kstep;
            if (last && has_next) S.a_ready(nxt);
            if constexpr (SP2) {
            PG8_LDB(B0, 0, 0); PG8_LDB(B1, 0, 1); PG8_SCHED; PG8_LDA(At, 0, 0); PG8_STAGE(PG8_SA(1, 1), a1 + hstep, voffA);
            PG8_WAIT_V(8); PG8_WAIT_L(0); PG8_BAR; PG8_MMA(0, 0, At, B0); PG8_MMA(0, 1, At, B1); PG8_BAR; PG8_SCHED;
            PG8_LDA(At, 0, 1); PG8_STAGE(PG8_SB(0, 0), b2, voffB); PG8_STAGE(PG8_SB(0, 1), b2 + hstep, voffB); PG8_STAGE(PG8_SA(0, 0), a2, voffA);
            PG8_WAIT_V(8); PG8_WAIT_L(0); PG8_BAR; PG8_MMA(1, 0, At, B0); PG8_MMA(1, 1, At, B1); PG8_BAR; PG8_SCHED;
            PG8_LDB(B0, 1, 0); PG8_LDB(B1, 1, 1); PG8_SCHED; PG8_LDA(At, 1, 0); PG8_STAGE(PG8_SA(0, 1), a2 + hstep, voffA);
            PG8_WAIT_V(8); PG8_WAIT_L(0); PG8_BAR; PG8_MMA(0, 0, At, B0); PG8_MMA(0, 1, At, B1); PG8_BAR; PG8_SCHED;
            PG8_LDA(At, 1, 1); PG8_STAGE(PG8_SB(1, 0), b3, voffB); PG8_STAGE(PG8_SB(1, 1), b3 + hstep, voffB); PG8_STAGE(PG8_SA(1, 0), a3, voffA);
            PG8_WAIT_V(8); PG8_WAIT_L(0); PG8_BAR; PG8_MMA(1, 0, At, B0); PG8_MMA(1, 1, At, B1); PG8_BAR; PG8_SCHED;
            } else {
            PG8_LDB(B0, 0, 0); PG8_SCHED; PG8_LDA(At, 0, 0); PG8_STAGE(PG8_SA(1, 1), a1 + hstep, voffA);
            PG8_WAIT_L(8); PG8_BAR; PG8_WAIT_L(0); PG8_MMA(0, 0, At, B0); PG8_BAR; PG8_SCHED;
            PG8_LDB(B1, 0, 1); PG8_STAGE(PG8_SB(0, 0), b2, voffB);
            PG8_BAR; PG8_WAIT_L(0); PG8_MMA(0, 1, At, B1); PG8_BAR;
            PG8_LDA(At, 0, 1); PG8_STAGE(PG8_SA(0, 0), a2, voffA);
            PG8_BAR; PG8_WAIT_L(0); PG8_MMA(1, 0, At, B0); PG8_BAR; PG8_SCHED;
            PG8_STAGE(PG8_SB(0, 1), b2 + hstep, voffB);
            PG8_WAIT_V(6); PG8_BAR; PG8_MMA(1, 1, At, B1); PG8_BAR;
            PG8_LDB(B0, 1, 0); PG8_SCHED; PG8_LDA(At, 1, 0); PG8_STAGE(PG8_SA(0, 1), a2 + hstep, voffA);
            PG8_WAIT_L(8); PG8_BAR; PG8_WAIT_L(0); PG8_MMA(0, 0, At, B0); PG8_BAR; PG8_SCHED;
            PG8_LDB(B1, 1, 1); PG8_STAGE(PG8_SB(1, 0), b3, voffB);
            PG8_BAR; PG8_WAIT_L(0); PG8_MMA(0, 1, At, B1); PG8_BAR;
            PG8_LDA(At, 1, 1); PG8_STAGE(PG8_SA(1, 0), a3, voffA);
            PG8_BAR; PG8_WAIT_L(0); PG8_MMA(1, 0, At, B0); PG8_BAR; PG8_SCHED;
            PG8_STAGE(PG8_SB(1, 1), b3 + hstep, voffB);
            PG8_WAIT_V(6); PG8_BAR; PG8_MMA(1, 1, At, B1); PG8_BAR;
            }
        }
        if constexpr (ALIGN_EPI) { if (wr == 0) PG8_BAR; }
        if constexpr (!Epi::AFTER_DRAIN) { E(acc, cur, wr, wc, fr, fq); S.done(cur); }
        if (!has_next) break;
#pragma unroll
        for (int a = 0; a < 2; ++a)
#pragma unroll
            for (int b = 0; b < 2; ++b)
#pragma unroll
                for (int m = 0; m < 4; ++m)
#pragma unroll
                    for (int n = 0; n < 2; ++n) acc[a][b][m][n] = (f32x4){0.f, 0.f, 0.f, 0.f};
        cur = nxt; cA = nA; cB = nB; ++ui;
        if constexpr (ALIGN_EPI) { if (wr == 1) PG8_BAR; }
    }
    PG8_WAIT_V(0);
    if constexpr (!ALIGN_EPI) { if (wr == 0) PG8_BAR; }
    PG8_BAR;
    if constexpr (Epi::AFTER_DRAIN) { E.fused(acc, cur, wr, wc, fr, fq, lds, wid, lane); S.done(cur); }
#undef PG8_SA
#undef PG8_SB
#undef PG8_STAGE
#undef PG8_LDA
#undef PG8_LDB
#undef PG8_MMA
#undef PG8_WAIT_V
#undef PG8_WAIT_L
#undef PG8_BAR
#undef PG8_SCHED
}
}
#define XB_TMO      128
#define XB_XCNT(j)  (256  + 64 * (j))
#define XB_XSUB(j)  (1280 + 64 * (j))
#define XB_XGEN(j)  (2304 + 64 * (j))
#define XB_TOP      3328
#define XB_TOPGEN   3392
#define XCD_BAR_WORDS 3456
#define XB_SPIN_CAP (1u << 22)

__device__ __forceinline__ unsigned xb_ld(unsigned* p)              { return __hip_atomic_load(p, __ATOMIC_RELAXED, __HIP_MEMORY_SCOPE_AGENT); }
__device__ __forceinline__ unsigned xb_add(unsigned* p, unsigned v) { return __hip_atomic_fetch_add(p, v, __ATOMIC_RELAXED, __HIP_MEMORY_SCOPE_AGENT); }
__device__ __forceinline__ unsigned xb_xcc_id() { return (unsigned)__builtin_amdgcn_s_getreg((3 << 11) | 20) & 0xFu; }
#define XB_SPIN(cond, bar) do { unsigned _sp = 0; while (cond) { __builtin_amdgcn_s_sleep(1); \
    if ((++_sp & 255u) == 0u) { if (xb_ld(&(bar)[XB_TMO])) break; if (_sp > XB_SPIN_CAP) { atomicAdd(&(bar)[XB_TMO], 1u); break; } } } } while (0)

struct XcdBarrier {
    unsigned* bar; unsigned x;
    volatile LAS unsigned* st;
};

__device__ __forceinline__ XcdBarrier xcd_barrier_post(unsigned* bar, volatile LAS unsigned* st) {
    XcdBarrier b; b.bar = bar; b.x = xb_xcc_id(); b.st = st;
    if (threadIdx.x == 0) (void)xb_add(&bar[XB_XCNT(b.x)], 1u);
    return b;
}
__device__ __forceinline__ void xcd_barrier_complete(unsigned* bar, unsigned x, unsigned& nloc, unsigned& nx) {
    const unsigned G = gridDim.x * gridDim.y * gridDim.z;
    unsigned sum, cnt, mine, sp = 0u;
    for (;;) {
        sum = 0u; cnt = 0u; mine = 0u;
#pragma unroll
        for (unsigned j = 0; j < 16; ++j) { const unsigned c = xb_ld(&bar[XB_XCNT(j)]); sum += c; cnt += (c > 0u) ? 1u : 0u; mine = (j == x) ? c : mine; }
        if (sum == G) break;
        __builtin_amdgcn_s_sleep(1);
        if ((++sp & 255u) == 0u) { if (xb_ld(&bar[XB_TMO])) break; if (sp > XB_SPIN_CAP) { atomicAdd(&bar[XB_TMO], 1u); break; } }
    }
    nloc = mine > 0u ? mine : 1u; nx = cnt > 0u ? cnt : 1u;
}

__device__ __forceinline__ void xcd_barrier(const XcdBarrier& b) {
    asm volatile("s_waitcnt vmcnt(0)" ::: "memory");
    __syncthreads();
    if (threadIdx.x == 0) {
        unsigned* bar = b.bar;
        __builtin_amdgcn_s_waitcnt(0);
        unsigned nloc = b.st[0], nx = b.st[1];
        if (nloc == 0u) { xcd_barrier_complete(bar, b.x, nloc, nx); b.st[0] = nloc; b.st[1] = nx; }
        const unsigned old = xb_add(&bar[XB_XSUB(b.x)], 1u);
        const unsigned gen = old / nloc;
        if (old + 1u == (gen + 1u) * nloc) {
            __builtin_amdgcn_fence(__ATOMIC_RELEASE, "agent");
            asm volatile("s_waitcnt vmcnt(0)" ::: "memory");
            const unsigned og = xb_add(&bar[XB_TOP], 1u);
            const unsigned tg = og / nx;
            if (og + 1u == (tg + 1u) * nx) xb_add(&bar[XB_TOPGEN], 1u);
            else XB_SPIN(xb_ld(&bar[XB_TOPGEN]) == tg, bar);
            __builtin_amdgcn_fence(__ATOMIC_ACQUIRE, "agent");
            xb_add(&bar[XB_XGEN(b.x)], 1u);
            asm volatile("s_waitcnt vmcnt(0)" ::: "memory");
        } else {
            XB_SPIN(xb_ld(&bar[XB_XGEN(b.x)]) == gen, bar);
            __builtin_amdgcn_fence(__ATOMIC_ACQUIRE, "agent");
            asm volatile("s_waitcnt vmcnt(0)" ::: "memory");
        }
    }
    __syncthreads();
}
constexpr int NWAVES = 8;
#ifndef MK_N_LAUNCHES
#define MK_N_LAUNCHES 1
#endif
#ifndef PHMASK
#define PHMASK 0x3ff
#endif
#define LDS_WAIT() asm volatile("s_waitcnt lgkmcnt(0)" ::: "memory")

template <int MAPK> DI int colmap(int n, int N) {
    if (MAPK == 0) return n < N ? n : -1;
    if (n < 1280) return n;
    if (n < 2304) return n + 24;
    if (n < 4352) return n + 24;
    if (n < 4376) return n - 4352 + 1280;
    return -1;
}
template <int MAPK> DI void transpose_item(const float* W, int K, int N, const float* kscale, bf16* WT, LAS float* scr, int item, int nblk, int lane) {
    const int kb = item / nblk, nb = item % nblk, k0 = 64 * kb, n0 = 32 * nb;
    const int sc = colmap<MAPK>(n0 + (lane & 31), N);
#pragma unroll 8
    for (int i = 0; i < 32; ++i) { const int kk = 2 * i + (lane >> 5); float v = 0.f; if (sc >= 0) { v = W[(size_t)(k0 + kk) * N + sc]; if (kscale) v *= kscale[k0 + kk]; } scr[kk * 33 + (lane & 31)] = v; }
    LDS_WAIT();
    const int c = lane & 7;
#pragma unroll
    for (int j = 0; j < 4; ++j) { const int n = (lane >> 3) + 8 * j; const LAS float* s = scr + (8 * c) * 33 + n;
        v4u o; o.x = pk2(s[0 * 33], s[1 * 33]); o.y = pk2(s[2 * 33], s[3 * 33]); o.z = pk2(s[4 * 33], s[5 * 33]); o.w = pk2(s[6 * 33], s[7 * 33]);
        *(v4u*)(WT + (size_t)(n0 + n) * K + k0 + 8 * c) = o; }
    LDS_WAIT();
}

template <bool SAMPLE> DI void compress_task(const Args& a, int task, LAS float* scr, int lane) {
    constexpr int NGRP = SAMPLE ? 128 : 32, NCMP = SAMPLE ? 1023 : 255, NSEG = NCMP + 1;
    const int ngrp = task % NGRP, t2 = task / NGRP, kv = t2 & 1, g = (t2 >> 1) & 1, b = t2 >> 2, n0 = ngrp * 8;
    const float* w1 = a.cmp_w1 + (size_t)kv * 2048 * 128; const float* pe = a.cmp_pe + kv * 2048; const float* b1 = a.cmp_b1 + kv * 128; const float* w2 = a.cmp_w2 + kv * 128 * 64;
    float acc[8][2];
#pragma unroll
    for (int i = 0; i < 8; ++i) { acc[i][0] = 0.f; acc[i][1] = 0.f; }
    for (int rs = 0; rs < 32; ++rs) {
        const int r = rs >> 4, s = rs & 15;
        const float* xp[8];
#pragma unroll
        for (int nb = 0; nb < 8; ++nb) { int seg = n0 + nb + r; seg = seg < NSEG ? seg : NSEG - 1; const int pos = seg * 16 + s;
            if (SAMPLE) { const int phys = a.page_table[b * cfg::NPAGES + (pos >> 7)]; xp[nb] = a.cache_cmp + (((size_t)phys * 128 + (pos & 127)) * 4 + kv * 2 + g) * 64; }
            else xp[nb] = a.out + cfg::OFF_CMP_P + (((size_t)b * 4096 + pos) * 4 + kv * 2 + g) * 64; }
        const float* per = pe + rs * 64; const float* wr = w1 + (size_t)rs * 64 * 128;
#pragma unroll 4
        for (int d = 0; d < 64; ++d) { const float pv = per[d], wl = wr[d * 128 + lane], wh = wr[d * 128 + 64 + lane];
#pragma unroll
            for (int nb = 0; nb < 8; ++nb) { const float xv = xp[nb][d] + pv; acc[nb][0] += xv * wl; acc[nb][1] += xv * wh; } }
    }
    const float bl = b1[lane], bh = b1[64 + lane];
#pragma unroll
    for (int nb = 0; nb < 8; ++nb) { scr[nb * 128 + lane] = gelu_tanh(acc[nb][0] + bl); scr[nb * 128 + 64 + lane] = gelu_tanh(acc[nb][1] + bh); }
    LDS_WAIT();
    float o[8];
#pragma unroll
    for (int i = 0; i < 8; ++i) o[i] = 0.f;
#pragma unroll 4
    for (int h = 0; h < 128; ++h) { const float w = w2[h * 64 + lane];
#pragma unroll
        for (int nb = 0; nb < 8; ++nb) o[nb] += scr[nb * 128 + h] * w; }
    float* dst = (float*)(a.ws + (kv ? (SAMPLE ? cfg::WS_VCS : cfg::WS_VCP) : (SAMPLE ? cfg::WS_KCS : cfg::WS_KCP))) + ((size_t)(b * 2 + g) * NSEG + n0) * 64 + lane;
#pragma unroll
    for (int nb = 0; nb < 8; ++nb) if (n0 + nb < NCMP) dst[nb * 64] = o[nb];
    LDS_WAIT();
}

struct Soft { float m[4], l[4], o[4]; };
DI void soft_init(Soft& S) {
#pragma unroll
    for (int r = 0; r < 4; ++r) { S.m[r] = cfg::NEGF; S.l[r] = 0.f; S.o[r] = 0.f; }
}
DI void load8(const float* p, float (&x)[8]) { const v4f a = *(const v4f*)p, b = *(const v4f*)(p + 4); x[0] = a.x; x[1] = a.y; x[2] = a.z; x[3] = a.w; x[4] = b.x; x[5] = b.y; x[6] = b.z; x[7] = b.w; }
DI void load8(const bf16* p, float (&x)[8]) { const v4u a = *(const v4u*)p; x[0] = __uint_as_float(a.x << 16); x[1] = __uint_as_float(a.x & 0xffff0000u); x[2] = __uint_as_float(a.y << 16); x[3] = __uint_as_float(a.y & 0xffff0000u);
    x[4] = __uint_as_float(a.z << 16); x[5] = __uint_as_float(a.z & 0xffff0000u); x[6] = __uint_as_float(a.w << 16); x[7] = __uint_as_float(a.w & 0xffff0000u); }
DI float load1(const float* p) { return *p; }
DI float load1(const bf16* p) { return bf2f(*p); }
template <typename KT> DI void score4(float (&s)[4], const KT* kptr, bool valid, const LAS float* qs) {
    float a0 = 0.f, a1 = 0.f, a2 = 0.f, a3 = 0.f;
#pragma unroll
    for (int c = 0; c < 8; ++c) { float k[8]; load8(kptr + 8 * c, k); asm volatile("" : "+v"(a0), "+v"(a1), "+v"(a2), "+v"(a3) :: "memory");
#pragma unroll
        for (int j = 0; j < 8; ++j) { const int d = 8 * c + j; a0 += k[j] * qs[d]; a1 += k[j] * qs[64 + d]; a2 += k[j] * qs[128 + d]; a3 += k[j] * qs[192 + d]; } }
    s[0] = valid ? a0 : cfg::NEGF; s[1] = valid ? a1 : cfg::NEGF; s[2] = valid ? a2 : cfg::NEGF; s[3] = valid ? a3 : cfg::NEGF;
}
DI void online_update(Soft& S, const float (&s)[4], bool valid, LAS float* ps, int lane) {
#pragma unroll
    for (int r = 0; r < 4; ++r) { const float mn = fmaxf(S.m[r], wave_max(s[r])); const float p = valid ? __builtin_amdgcn_exp2f((s[r] - mn) * cfg::L2E) : 0.f; const float ls = wave_sum(p);
        const float al = __builtin_amdgcn_exp2f((S.m[r] - mn) * cfg::L2E); S.l[r] = S.l[r] * al + ls; S.m[r] = mn; S.o[r] *= al; ps[r * 64 + lane] = p; }
}
template <typename KT> DI void pv4(Soft& S, const LAS float* ps, const LAS unsigned long long* vp, int lane) {
#pragma unroll 4
    for (int key = 0; key < 64; ++key) { const KT* v = (const KT*)vp[key]; const float vv = load1(v + lane);
        S.o[0] += ps[key] * vv; S.o[1] += ps[64 + key] * vv; S.o[2] += ps[128 + key] * vv; S.o[3] += ps[192 + key] * vv; }
}
template <typename KT> DI void attend_tile(Soft& S, const KT* kptr, const KT* vptr, bool valid, const LAS float* qs, LAS float* ps, LAS unsigned long long* vp, int lane) {
    float s[4]; score4<KT>(s, kptr, valid, qs);
    LDS_WAIT();
    online_update(S, s, valid, ps, lane); vp[lane] = (unsigned long long)(uintptr_t)vptr;
    LDS_WAIT();
    pv4<KT>(S, ps, vp, lane);
}

constexpr int ATT_SCR_FLOATS = 2048;

DI void attn_prompt_task(const Args& a, int task, LAS float* scr, int lane) {
    const int t = task & 4095, g = (task >> 12) & 1, b = task >> 13, row = b * 4096 + t;
    LAS float* qs = scr; LAS float* ps = scr + 256; LAS unsigned long long* vp = (LAS unsigned long long*)(scr + 512); LAS float* sc = scr + 640; LAS float* ic = scr + 960;
    const bf16* Q = (const bf16*)(a.ws + cfg::WS_Q); const bf16* KVB = (const bf16*)(a.ws + cfg::WS_KVB);
    const float* KCP = (const float*)(a.ws + cfg::WS_KCP) + (size_t)(b * 2 + g) * 256 * 64; const float* VCP = (const float*)(a.ws + cfg::WS_VCP) + (size_t)(b * 2 + g) * 256 * 64;
    LDS_WAIT();
#pragma unroll
    for (int r = 0; r < 4; ++r) qs[r * 64 + lane] = bf2f(Q[(size_t)row * 512 + (g * 4 + r) * 64 + lane]);
#pragma unroll
    for (int i = 0; i < 5; ++i) ic[i * 64 + lane] = 0.f;
    LDS_WAIT();
    const int nvis = t < 31 ? 0 : (((t - 31) >> 4) + 1 < 255 ? ((t - 31) >> 4) + 1 : 255);
    const int ntile = (nvis + 63) >> 6;
    Soft C; soft_init(C);
    for (int tl = 0; tl < ntile; ++tl) { const int key = tl * 64 + lane; const bool valid = key < nvis; const int kc = key < 254 ? key : 254; float s[4]; score4<float>(s, KCP + kc * 64, valid, qs);
#pragma unroll
        for (int r = 0; r < 4; ++r) { const float mn = fmaxf(C.m[r], wave_max(s[r])); const float p = valid ? __builtin_amdgcn_exp2f((s[r] - mn) * cfg::L2E) : 0.f;
            C.l[r] = C.l[r] * __builtin_amdgcn_exp2f((C.m[r] - mn) * cfg::L2E) + wave_sum(p); C.m[r] = mn; } }
    float linv[4];
#pragma unroll
    for (int r = 0; r < 4; ++r) linv[r] = C.l[r] > 0.f ? 1.0f / C.l[r] : 0.f;
    for (int tl = 0; tl < ntile; ++tl) { const int key = tl * 64 + lane; const bool valid = key < nvis; const int kc = key < 254 ? key : 254; float s[4]; score4<float>(s, KCP + kc * 64, valid, qs);
        LDS_WAIT(); float isum = 0.f;
#pragma unroll
        for (int r = 0; r < 4; ++r) { const float p = valid ? __builtin_amdgcn_exp2f((s[r] - C.m[r]) * cfg::L2E) * linv[r] : 0.f; ps[r * 64 + lane] = p; isum += p; }
        ic[key] = isum; vp[lane] = (unsigned long long)(uintptr_t)(VCP + kc * 64);
        LDS_WAIT(); pv4<float>(C, ps, vp, lane); }
    LDS_WAIT();
    unsigned long long mask;
    { const int j = lane; float imp = 0.f;
#pragma unroll
      for (int m = -1; m < 4; ++m) { const int idx = 4 * j + m; if (idx >= 0 && idx < 255) imp += ic[idx]; }
      const int cur = t >> 6; const bool valid = j * 64 <= t; const bool forced = (j == 0) || (j <= cur && j > cur - 2);
      const float score = valid ? imp + (forced ? 1e6f : 0.f) : cfg::NEGF;
      sc[j] = score; LDS_WAIT();
      int rank = 0;
#pragma unroll 8
      for (int k = 0; k < 64; ++k) { const float o = sc[k]; rank += (o > score || (o == score && k < j)) ? 1 : 0; }
      mask = __ballot(valid && rank < 16); }
    Soft SL; soft_init(SL);
    { unsigned long long mm = mask;
      while (mm) { const int j = __builtin_ctzll(mm); mm &= mm - 1; const int pos = 64 * j + lane; const bool valid = pos <= t; const int pc = valid ? pos : t;
          const bf16* kp = KVB + (size_t)(b * 4096 + pc) * 768 + 256 + g * 64; attend_tile<bf16>(SL, kp, kp + 128, valid, qs, ps, vp, lane); } }
    Soft W; soft_init(W);
    { const int start = t > 512 ? t - 512 : 0;
      for (int base = start; base <= t; base += 64) { const int pos = base + lane; const bool valid = pos <= t; const int pc = valid ? pos : t;
          const bf16* kp = KVB + (size_t)(b * 4096 + pc) * 768 + 512 + g * 64; attend_tile<bf16>(W, kp, kp + 128, valid, qs, ps, vp, lane); } }
    const float* ng = (const float*)(a.ws + cfg::WS_NSAG) + (size_t)row * 32; bf16* O = (bf16*)(a.ws + cfg::WS_ONSA) + (size_t)row * 512;
#pragma unroll
    for (int r = 0; r < 4; ++r) { const int h = g * 4 + r; const float oc = C.o[r], os = SL.l[r] > 0.f ? SL.o[r] / SL.l[r] : 0.f, ow = W.l[r] > 0.f ? W.o[r] / W.l[r] : 0.f;
        O[h * 64 + lane] = (bf16)f2bf(ng[h * 3 + 0] * oc + ng[h * 3 + 1] * os + ng[h * 3 + 2] * ow); }
}

DI void attn_sample_task(const Args& a, int task, LAS float* scr, int lane) {
    const int g = task & 1, b = task >> 1, row = cfg::MP + b;
    LAS float* qs = scr; LAS float* ps = scr + 256; LAS unsigned long long* vp = (LAS unsigned long long*)(scr + 512); LAS float* sc = scr + 640; LAS float* ic = scr + 960;
    const bf16* Q = (const bf16*)(a.ws + cfg::WS_Q);
    const float* KCS = (const float*)(a.ws + cfg::WS_KCS) + (size_t)(b * 2 + g) * 1024 * 64; const float* VCS = (const float*)(a.ws + cfg::WS_VCS) + (size_t)(b * 2 + g) * 1024 * 64;
    LDS_WAIT();
#pragma unroll
    for (int r = 0; r < 4; ++r) qs[r * 64 + lane] = bf2f(Q[(size_t)row * 512 + (g * 4 + r) * 64 + lane]);
#pragma unroll
    for (int i = 0; i < 17; ++i) ic[i * 64 + lane] = 0.f;
    LDS_WAIT();
    Soft C; soft_init(C);
    for (int tl = 0; tl < 16; ++tl) { const int key = tl * 64 + lane; const bool valid = key < 1023; const int kc = valid ? key : 1022; float s[4]; score4<float>(s, KCS + kc * 64, valid, qs);
#pragma unroll
        for (int r = 0; r < 4; ++r) { const float mn = fmaxf(C.m[r], wave_max(s[r])); const float p = valid ? __builtin_amdgcn_exp2f((s[r] - mn) * cfg::L2E) : 0.f;
            C.l[r] = C.l[r] * __builtin_amdgcn_exp2f((C.m[r] - mn) * cfg::L2E) + wave_sum(p); C.m[r] = mn; } }
    float linv[4];
#pragma unroll
    for (int r = 0; r < 4; ++r) linv[r] = C.l[r] > 0.f ? 1.0f / C.l[r] : 0.f;
    for (int tl = 0; tl < 16; ++tl) { const int key = tl * 64 + lane; const bool valid = key < 1023; const int kc = valid ? key : 1022; float s[4]; score4<float>(s, KCS + kc * 64, valid, qs);
        LDS_WAIT(); float isum = 0.f;
#pragma unroll
        for (int r = 0; r < 4; ++r) { const float p = valid ? __builtin_amdgcn_exp2f((s[r] - C.m[r]) * cfg::L2E) * linv[r] : 0.f; ps[r * 64 + lane] = p; isum += p; }
        ic[key] = isum; vp[lane] = (unsigned long long)(uintptr_t)(VCS + kc * 64);
        LDS_WAIT(); pv4<float>(C, ps, vp, lane); }
    LDS_WAIT();
    unsigned long long msk[5];
    {
#pragma unroll
      for (int c = 0; c < 5; ++c) { const int j = c * 64 + lane; float imp = 0.f;
#pragma unroll
          for (int m = -1; m < 4; ++m) { const int idx = 4 * j + m; if (idx >= 0 && idx < 1023) imp += ic[idx]; }
          const bool forced = (j == 0) || (j == 255) || (j == 256);
          if (j < 257) sc[j] = imp + (forced ? 1e6f : 0.f); }
      LDS_WAIT();
#pragma unroll
      for (int c = 0; c < 5; ++c) { const int j = c * 64 + lane; const float score = sc[j < 257 ? j : 256]; int rank = 0;
#pragma unroll 8
          for (int k = 0; k < 257; ++k) { const float o = sc[k]; rank += (o > score || (o == score && k < j)) ? 1 : 0; }
          msk[c] = __ballot(j < 257 && rank < 16); } }
    Soft SL; soft_init(SL);
#pragma unroll
    for (int c = 0; c < 5; ++c) { unsigned long long mm = msk[c];
        while (mm) { const int j = c * 64 + __builtin_ctzll(mm); mm &= mm - 1;
            if (j < 256) { const int phys = a.page_table[b * cfg::NPAGES + (j >> 1)]; const float* kp = a.cache_slc + (((size_t)phys * 128 + (j & 1) * 64 + lane) * 4 + g) * 64; attend_tile<float>(SL, kp, kp + 128, true, qs, ps, vp, lane); }
            else { const float* kp = a.out + cfg::OFF_SLC_S + (size_t)(b * 4 + g) * 64; attend_tile<float>(SL, kp, kp + 128, lane == 0, qs, ps, vp, lane); } } }
    Soft W; soft_init(W);
    for (int tl = 0; tl < 8; ++tl) { const float* kp = a.cache_win + (((size_t)b * 512 + tl * 64 + lane) * 4 + g) * 64; attend_tile<float>(W, kp, kp + 128, true, qs, ps, vp, lane); }
    { const float* kp = a.out + cfg::OFF_WIN_S + (((size_t)b * 512 + 511) * 4 + g) * 64; attend_tile<float>(W, kp, kp + 128, lane == 0, qs, ps, vp, lane); }
    const float* ng = (const float*)(a.ws + cfg::WS_NSAG) + (size_t)row * 32; bf16* O = (bf16*)(a.ws + cfg::WS_ONSA) + (size_t)row * 512;
#pragma unroll
    for (int r = 0; r < 4; ++r) { const int h = g * 4 + r; const float oc = C.o[r], os = SL.l[r] > 0.f ? SL.o[r] / SL.l[r] : 0.f, ow = W.l[r] > 0.f ? W.o[r] / W.l[r] : 0.f;
        O[h * 64 + lane] = (bf16)f2bf(ng[h * 3 + 0] * oc + ng[h * 3 + 1] * os + ng[h * 3 + 2] * ow); }
}

DI float rstd_v(const float* SSV, int row) { const v4f a = *(const v4f*)(SSV + (size_t)row * 8), b = *(const v4f*)(SSV + (size_t)row * 8 + 4);
    return 1.0f / sqrtf((((a.x + a.y) + (a.z + a.w)) + ((b.x + b.y) + (b.z + b.w))) * (1.0f / 512.0f) + cfg::EPS); }
DI float rstd16(const float* SS, int row) { const v4f* p = (const v4f*)(SS + (size_t)row * 16); const v4f s0 = p[0], s1 = p[1], s2 = p[2], s3 = p[3];
    const float t = ((s0.x + s0.y) + (s0.z + s0.w)) + ((s1.x + s1.y) + (s1.z + s1.w)) + ((s2.x + s2.y) + (s2.z + s2.w)) + ((s3.x + s3.y) + (s3.z + s3.w));
    return 1.0f / sqrtf(t * (1.0f / 1024.0f) + cfg::EPS); }

DI void chunkmix_task(const Args& a, int task, int lane) {
    const int ib = task & 15, gi = (task >> 4) & 3, c = (task >> 6) & 31, b = task >> 11, i0 = ib * 8;
    const bf16* VG = (const bf16*)(a.ws + cfg::WS_VG); const bf16* U = (const bf16*)(a.ws + cfg::WS_U); const float* SSV = (const float*)(a.ws + cfg::WS_SSV); bf16* CM = (bf16*)(a.ws + cfg::WS_CM);
    const float* Ws = a.gmlp_ws + (size_t)gi * 128 * 128; const int rbase = b * 4096 + c * 128, ch = gi * 128 + lane;
    const float g0 = a.gmlp_norm[ch], g1 = a.gmlp_norm[ch + 64];
    float acc[8][2];
#pragma unroll
    for (int i = 0; i < 8; ++i) { acc[i][0] = 0.f; acc[i][1] = 0.f; }
    for (int j = 0; j <= i0 + 7; ++j) { const int rj = rbase + j; const float rs = rstd_v(SSV, rj);
        const float v0 = bf2f(VG[(size_t)rj * 512 + ch]) * rs * g0, v1 = bf2f(VG[(size_t)rj * 512 + ch + 64]) * rs * g1;
#pragma unroll
        for (int ii = 0; ii < 8; ++ii) { const float w = (j <= i0 + ii) ? Ws[(i0 + ii) * 128 + j] : 0.f; acc[ii][0] += w * v0; acc[ii][1] += w * v1; } }
#pragma unroll
    for (int ii = 0; ii < 8; ++ii) { const int r = rbase + i0 + ii; const float bs = a.gmlp_bs[gi * 128 + i0 + ii];
        CM[(size_t)r * 512 + ch] = (bf16)f2bf(bf2f(U[(size_t)r * 512 + ch]) * (acc[ii][0] + bs)); CM[(size_t)r * 512 + ch + 64] = (bf16)f2bf(bf2f(U[(size_t)r * 512 + ch + 64]) * (acc[ii][1] + bs)); }
}

__global__ void __launch_bounds__(NWAVES * 64, 2) nsa_hybrid_fwd(Args a) {
    extern __shared__ __attribute__((aligned(16))) unsigned char lds_raw[];
    LAS unsigned char* lds = (LAS unsigned char*)lds_raw;
    const int tid = threadIdx.x, lane = tid & 63, wave = __builtin_amdgcn_readfirstlane(tid >> 6);
    const int G = gridDim.x, gw = blockIdx.x * NWAVES + wave, NGW = G * NWAVES;
    unsigned char* ws = a.ws;
    for (int u = tid; u < (cfg::LDS_BYTES - cfg::LDSCTL_OFF) / 4; u += NWAVES * 64) ((LAS unsigned*)(lds + cfg::LDSCTL_OFF))[u] = 0u;
    __syncthreads();
    volatile LAS unsigned* MISC = (volatile LAS unsigned*)(lds + cfg::MISC_OFF);
    XcdBarrier bar = xcd_barrier_post((unsigned*)(ws + cfg::WS_CTL) + cfg::CW_BAR, MISC + 8);

    bf16* W_in_t = (bf16*)(ws + cfg::WS_WIN_T); bf16* W_pa_t = (bf16*)(ws + cfg::WS_WPA_T); bf16* W_pb_t = (bf16*)(ws + cfg::WS_WPB_T); bf16* W_out_t = (bf16*)(ws + cfg::WS_WOUT_T);
    bf16* W_up_t = (bf16*)(ws + cfg::WS_WUP_T); bf16* W_dn_t = (bf16*)(ws + cfg::WS_WDN_T);
    float* RSTD1 = (float*)(ws + cfg::WS_RSTD1); float* SSV = (float*)(ws + cfg::WS_SSV); float* SS2 = (float*)(ws + cfg::WS_SS2); float* SS3 = (float*)(ws + cfg::WS_SS3); float* NSAG = (float*)(ws + cfg::WS_NSAG);
    bf16* XB = (bf16*)(ws + cfg::WS_XB); bf16* Qb = (bf16*)(ws + cfg::WS_Q); bf16* KVB = (bf16*)(ws + cfg::WS_KVB); bf16* Ub = (bf16*)(ws + cfg::WS_U); bf16* VG = (bf16*)(ws + cfg::WS_VG); bf16* GT = (bf16*)(ws + cfg::WS_GT);
    bf16* ONSA = (bf16*)(ws + cfg::WS_ONSA); bf16* CM = (bf16*)(ws + cfg::WS_CM); float* Tb = (float*)(ws + cfg::WS_T); bf16* MIX = (bf16*)(ws + cfg::WS_MIX);
    float* X1F = (float*)(ws + cfg::WS_X1F); bf16* X1B = (bf16*)(ws + cfg::WS_X1B); bf16* AB = (bf16*)(ws + cfg::WS_AB); bf16* ACT = (bf16*)(ws + cfg::WS_ACT);

    #if (PHMASK >> 0) & 1
    if (a.ph_lo <= 0 && 0 < a.ph_hi) {
    {
        LAS float* scr = (LAS float*)(lds + wave * 16384);
        constexpr int I_IN = 16 * (cfg::INP / 32), I_PA = 8 * 32, I_PB = 8 * 32, I_OUT = 16 * 32, I_UP = 16 * (cfg::UPN / 32), I_DN = (cfg::DFF / 64) * 32;
        constexpr int NITEMS = I_IN + I_PA + I_PB + I_OUT + I_UP + I_DN;
        for (int it = gw; it < NITEMS; it += NGW) { int r = it;
            if (r < I_IN) { transpose_item<1>(a.w_in, 1024, cfg::INC, a.norm_mix, W_in_t, scr, r, cfg::INP / 32, lane); continue; } r -= I_IN;
            if (r < I_PA) { transpose_item<0>(a.w_proj_a, 512, 1024, nullptr, W_pa_t, scr, r, 32, lane); continue; } r -= I_PA;
            if (r < I_PB) { transpose_item<0>(a.w_proj_b, 512, 1024, nullptr, W_pb_t, scr, r, 32, lane); continue; } r -= I_PB;
            if (r < I_OUT) { transpose_item<0>(a.w_out, 1024, 1024, nullptr, W_out_t, scr, r, 32, lane); continue; } r -= I_OUT;
            if (r < I_UP) { transpose_item<0>(a.w_up, 1024, cfg::UPN, a.norm_ffn, W_up_t, scr, r, cfg::UPN / 32, lane); continue; } r -= I_UP;
            transpose_item<0>(a.w_down, cfg::DFF, 1024, nullptr, W_dn_t, scr, r, 32, lane); }
        for (int m = gw; m < cfg::MPAD; m += NGW) {
            const float* xr = m < cfg::MP ? a.x_prompt + (size_t)m * 1024 : (m < cfg::MROWS ? a.x_sample + (size_t)(m - cfg::MP) * 1024 : nullptr);
            v4f v[4]; float s = 0.f;
#pragma unroll
            for (int j = 0; j < 4; ++j) { v[j] = xr ? *(const v4f*)(xr + j * 256 + lane * 4) : (v4f){0.f, 0.f, 0.f, 0.f}; s += (v[j].x * v[j].x + v[j].y * v[j].y) + (v[j].z * v[j].z + v[j].w * v[j].w); }
            s = wave_sum(s);
            if (lane == 0) RSTD1[m] = xr ? 1.0f / sqrtf(s * (1.0f / 1024.0f) + cfg::EPS) : 0.f;
#pragma unroll
            for (int j = 0; j < 4; ++j) { v2u o; o.x = pk2(v[j].x, v[j].y); o.y = pk2(v[j].z, v[j].w); *(v2u*)(XB + (size_t)m * 1024 + j * 256 + lane * 4) = o; }
            if (m >= cfg::MROWS) {
                v4u z = (v4u){0u, 0u, 0u, 0u}; *(v4u*)(ONSA + (size_t)m * 512 + lane * 8) = z; *(v4u*)(CM + (size_t)m * 512 + lane * 8) = z; }
        }
        { const size_t n4 = (size_t)cfg::DB * 511 * 64;
          for (size_t i = (size_t)blockIdx.x * 512 + tid; i < n4; i += (size_t)G * 512) { const size_t bb = i / (511 * 64), rem = i % (511 * 64);
              ((v4f*)(a.out + cfg::OFF_WIN_S))[bb * 512 * 64 + rem] = ((const v4f*)a.cache_win)[bb * 512 * 64 + 64 + rem]; }
          for (int i = blockIdx.x * 512 + tid; i < cfg::DB * cfg::DFF; i += G * 512) { const int bb = i / cfg::DFF, f = i % cfg::DFF; a.out[cfg::OFF_CONV_S + (size_t)bb * 2 * cfg::DFF + f] = a.state_conv[(size_t)bb * 2 * cfg::DFF + cfg::DFF + f]; } }
        { LAS float* cs = (LAS float*)(lds + wave * 16384);
          for (int task = gw; task < 32 * 2 * 2 * 128; task += NGW) compress_task<true>(a, task, cs, lane); }
    }
    if (1 < a.ph_hi) xcd_barrier(bar);
    }

    #endif
#if (PHMASK >> 1) & 1
    if (a.ph_lo <= 1 && 1 < a.ph_hi) {
    { pg8::Gemm g{XB, W_in_t, cfg::MPAD, cfg::INP, 1024}; pg8::StaticOrder S; S.init(cfg::MPAD, cfg::INP, G, (int)blockIdx.x);
      pg8::EpiIn E{RSTD1, Qb, KVB, Ub, VG, SSV, GT, NSAG, a.out};
      pg8::gemm_phase<pg8::EpiIn, pg8::StaticOrder, true, true>(lds, g, S, E); }
    if (2 < a.ph_hi) xcd_barrier(bar);
    }

    #endif
#if (PHMASK >> 2) & 1
    if (a.ph_lo <= 2 && 2 < a.ph_hi) {
    {
        { LAS float* cs = (LAS float*)(lds + wave * 16384);
          for (int task = gw; task < 4 * 2 * 2 * 32; task += NGW) compress_task<false>(a, task, cs, lane); }
        for (int task = gw; task < 4 * 32 * 4 * 16; task += NGW) chunkmix_task(a, task, lane);
        for (int i = gw; i < 4 * 128 + cfg::DB; i += NGW) {
            const bool smp = i >= 512; const int row = smp ? cfg::MP + (i - 512) : (i >> 7) * 4096 + 3968 + (i & 127);
            float* dst = smp ? a.out + cfg::OFF_V_S + (size_t)(i - 512) * 512 : a.out + cfg::OFF_V_P + (size_t)i * 512;
            const float rs = rstd_v(SSV, row); float vn[8]; load8(VG + (size_t)row * 512 + lane * 8, vn);
#pragma unroll
            for (int j = 0; j < 8; ++j) vn[j] = vn[j] * rs * a.gmlp_norm[lane * 8 + j];
            *(v4f*)(dst + lane * 8) = (v4f){vn[0], vn[1], vn[2], vn[3]}; *(v4f*)(dst + lane * 8 + 4) = (v4f){vn[4], vn[5], vn[6], vn[7]};
            if (smp) { const int gi = lane >> 4; const float w00 = a.gmlp_ws[(size_t)gi * 128 * 128], bs = a.gmlp_bs[gi * 128]; float uu[8]; load8(Ub + (size_t)row * 512 + lane * 8, uu);
                v4u o; o.x = pk2(uu[0] * (w00 * vn[0] + bs), uu[1] * (w00 * vn[1] + bs)); o.y = pk2(uu[2] * (w00 * vn[2] + bs), uu[3] * (w00 * vn[3] + bs));
                o.z = pk2(uu[4] * (w00 * vn[4] + bs), uu[5] * (w00 * vn[5] + bs)); o.w = pk2(uu[6] * (w00 * vn[6] + bs), uu[7] * (w00 * vn[7] + bs));
                *(v4u*)(CM + (size_t)row * 512 + lane * 8) = o; }
        }
    }
    if (3 < a.ph_hi) xcd_barrier(bar);
    }

    #endif
#if (PHMASK >> 3) & 1
    if (a.ph_lo <= 3 && 3 < a.ph_hi) {
    {
        LAS float* scr = (LAS float*)(lds + wave * 16384);
        for (int task = gw; task < 64 + 32768; task += NGW) { if (task < 64) attn_sample_task(a, task, scr, lane); else attn_prompt_task(a, task - 64, scr, lane); }
    }
    if (4 < a.ph_hi) xcd_barrier(bar);
    }

    #endif
#if (PHMASK >> 4) & 1
    if (a.ph_lo <= 4 && 4 < a.ph_hi) {
    { pg8::StaticOrder S; S.init(cfg::MPAD, 1024, G, (int)blockIdx.x);
      { pg8::Gemm g{ONSA, W_pa_t, cfg::MPAD, 1024, 512}; pg8::EpiPA E{GT, Tb}; pg8::gemm_phase<pg8::EpiPA, pg8::StaticOrder, true, true>(lds, g, S, E); }
      asm volatile("s_waitcnt vmcnt(0)" ::: "memory"); __syncthreads();
      { pg8::Gemm g{CM, W_pb_t, cfg::MPAD, 1024, 512}; pg8::EpiPB E{GT, Tb, MIX}; pg8::gemm_phase<pg8::EpiPB, pg8::StaticOrder, true, true>(lds, g, S, E); } }
    if (5 < a.ph_hi) xcd_barrier(bar);
    }

    #endif
#if (PHMASK >> 5) & 1
    if (a.ph_lo <= 5 && 5 < a.ph_hi) {
    { pg8::Gemm g{MIX, W_out_t, cfg::MPAD, 1024, 1024}; pg8::StaticOrder S; S.init(cfg::MPAD, 1024, G, (int)blockIdx.x);
      pg8::EpiOut E{a.x_prompt, a.x_sample, X1F, X1B, SS2}; pg8::gemm_phase<pg8::EpiOut, pg8::StaticOrder, true, true>(lds, g, S, E); }
    if (6 < a.ph_hi) xcd_barrier(bar);
    }

    #endif
#if (PHMASK >> 6) & 1
    if (a.ph_lo <= 6 && 6 < a.ph_hi) {
    { pg8::Gemm g{X1B, W_up_t, cfg::MPAD, cfg::UPN, 1024}; pg8::StaticOrder S; S.init(cfg::MPAD, cfg::UPN, G, (int)blockIdx.x);
      pg8::EpiUp E{SS2, AB, a.out}; pg8::gemm_phase<pg8::EpiUp, pg8::StaticOrder, true, true>(lds, g, S, E); }
    if (7 < a.ph_hi) xcd_barrier(bar);
    }

    #endif
#if (PHMASK >> 7) & 1
    if (a.ph_lo <= 7 && 7 < a.ph_hi) {
    {
        constexpr int FV = cfg::DFF / 8;
        for (size_t i = (size_t)blockIdx.x * 512 + tid; i < (size_t)cfg::MPAD * FV; i += (size_t)G * 512) {
            const int row = (int)(i / FV), f = (int)(i % FV) * 8;
            float a0[8], a1[8], a2[8], bb[8], c[8];
            load8(AB + (size_t)row * cfg::UPN + f, a2); load8(AB + (size_t)row * cfg::UPN + cfg::DFF + f, bb);
            if (row < cfg::MP) { const int t = row & 4095;
                if (t >= 1) load8(AB + (size_t)(row - 1) * cfg::UPN + f, a1); else {
#pragma unroll
                    for (int j = 0; j < 8; ++j) a1[j] = 0.f; }
                if (t >= 2) load8(AB + (size_t)(row - 2) * cfg::UPN + f, a0); else {
#pragma unroll
                    for (int j = 0; j < 8; ++j) a0[j] = 0.f; } }
            else if (row < cfg::MROWS) { const float* sp = a.state_conv + (size_t)(row - cfg::MP) * 2 * cfg::DFF + f; load8(sp, a0); load8(sp + cfg::DFF, a1); }
            else {
#pragma unroll
                for (int j = 0; j < 8; ++j) { a0[j] = 0.f; a1[j] = 0.f; } }
            float w0[8], w1[8], w2[8], cb[8]; load8(a.conv_w + f, w0); load8(a.conv_w + cfg::DFF + f, w1); load8(a.conv_w + 2 * cfg::DFF + f, w2); load8(a.conv_b + f, cb);
#pragma unroll
            for (int j = 0; j < 8; ++j) c[j] = gelu_tanh(cb[j] + a0[j] * w0[j] + a1[j] * w1[j] + a2[j] * w2[j]) * bb[j];
            v4u o; o.x = pk2(c[0], c[1]); o.y = pk2(c[2], c[3]); o.z = pk2(c[4], c[5]); o.w = pk2(c[6], c[7]);
            *(v4u*)(ACT + (size_t)row * cfg::DFF + f) = o;
        }
    }
    if (8 < a.ph_hi) xcd_barrier(bar);
    }

    #endif
#if (PHMASK >> 8) & 1
    if (a.ph_lo <= 8 && 8 < a.ph_hi) {
    { pg8::Gemm g{ACT, W_dn_t, cfg::MPAD, 1024, cfg::DFF}; pg8::StaticOrder S; S.init(cfg::MPAD, 1024, G, (int)blockIdx.x);
      pg8::EpiDown E{X1F, a.out, SS3}; pg8::gemm_phase<pg8::EpiDown, pg8::StaticOrder, true, true>(lds, g, S, E); }
    if (9 < a.ph_hi) xcd_barrier(bar);
    }

    #endif
#if (PHMASK >> 9) & 1
    if (a.ph_lo <= 9 && 9 < a.ph_hi) {
#ifdef DUMP
    for (int m = gw; m < cfg::MROWS; m += NGW) { float* yr = a.out + (size_t)m * 1024;
        if (DUMP == 4) continue;
#pragma unroll
        for (int j = 0; j < 4; ++j) { const int c = j * 256 + lane * 4; v4f v;
            if (DUMP == 1) { v.x = bf2f(MIX[(size_t)m * 1024 + c]); v.y = bf2f(MIX[(size_t)m * 1024 + c + 1]); v.z = bf2f(MIX[(size_t)m * 1024 + c + 2]); v.w = bf2f(MIX[(size_t)m * 1024 + c + 3]); }
            else if (DUMP == 2) v = *(const v4f*)(X1F + (size_t)m * 1024 + c);
            else if (DUMP == 3) { v.x = bf2f(ACT[(size_t)m * 2816 + c]); v.y = bf2f(ACT[(size_t)m * 2816 + c + 1]); v.z = bf2f(ACT[(size_t)m * 2816 + c + 2]); v.w = bf2f(ACT[(size_t)m * 2816 + c + 3]); }
            else { v.x = bf2f(AB[(size_t)m * 5632 + c]); v.y = bf2f(AB[(size_t)m * 5632 + c + 1]); v.z = bf2f(AB[(size_t)m * 5632 + c + 2]); v.w = bf2f(AB[(size_t)m * 5632 + c + 3]); }
            *(v4f*)(yr + c) = v; } }
#else
    for (int m = gw; m < cfg::MROWS; m += NGW) { const float rs = rstd16(SS3, m); float* yr = a.out + (size_t)m * 1024;
#pragma unroll
        for (int j = 0; j < 4; ++j) { const v4f v = *(const v4f*)(yr + j * 256 + lane * 4), gn = *(const v4f*)(a.norm_final + j * 256 + lane * 4); *(v4f*)(yr + j * 256 + lane * 4) = v * rs * gn; } }
#endif
    }
#endif
}

extern "C" void kernel_launch(void* const* d_in, const int* in_sizes, int n_in, void* d_out, int out_size, void* d_ws, size_t ws_size, hipStream_t stream) {
    static int grid = 0;
    if (grid == 0) {
        if (n_in != 25 || in_sizes[0] != cfg::MP * 1024 || (size_t)out_size != cfg::OUT_TOTAL || ws_size < cfg::WS_END) {
            fprintf(stderr, "kernel_launch: unexpected shapes (n_in %d, in0 %d, out %d, ws %zu); nothing launched\n", n_in, n_in > 0 ? in_sizes[0] : -1, out_size, ws_size); grid = -1; return; }
        int dev = 0, cus = 0, per_cu = 0;
        if (hipGetDevice(&dev) != hipSuccess || hipDeviceGetAttribute(&cus, hipDeviceAttributeMultiprocessorCount, dev) != hipSuccess) { grid = -1; return; }
        if (hipFuncSetAttribute((const void*)nsa_hybrid_fwd, hipFuncAttributeMaxDynamicSharedMemorySize, cfg::LDS_BYTES) != hipSuccess) { fprintf(stderr, "kernel_launch: hipFuncSetAttribute failed\n"); grid = -1; return; }
        if (hipOccupancyMaxActiveBlocksPerMultiprocessor(&per_cu, (const void*)nsa_hybrid_fwd, NWAVES * 64, cfg::LDS_BYTES) != hipSuccess || per_cu < 1)
            fprintf(stderr, "kernel_launch: note: occupancy query reports %d workgroups per CU\n", per_cu);
        (void)hipGetLastError();
        grid = cus;
    }
    if (grid < 0) return;
    if (hipMemsetAsync((char*)d_ws + cfg::WS_CTL, 0, cfg::CTL_ZERO_BYTES, stream) != hipSuccess) return;
    Args a{};
    a.x_prompt = (const float*)d_in[0]; a.x_sample = (const float*)d_in[1]; a.cache_cmp = (const float*)d_in[2]; a.cache_slc = (const float*)d_in[3]; a.cache_win = (const float*)d_in[4];
    a.state_conv = (const float*)d_in[5]; a.page_table = (const int*)d_in[6]; a.norm_mix = (const float*)d_in[7]; a.w_in = (const float*)d_in[8]; a.cmp_pe = (const float*)d_in[9];
    a.cmp_w1 = (const float*)d_in[10]; a.cmp_b1 = (const float*)d_in[11]; a.cmp_w2 = (const float*)d_in[12]; a.gmlp_norm = (const float*)d_in[13]; a.gmlp_ws = (const float*)d_in[14];
    a.gmlp_bs = (const float*)d_in[15]; a.w_proj_a = (const float*)d_in[16]; a.w_proj_b = (const float*)d_in[17]; a.w_out = (const float*)d_in[18]; a.norm_ffn = (const float*)d_in[19];
    a.w_up = (const float*)d_in[20]; a.conv_w = (const float*)d_in[21]; a.conv_b = (const float*)d_in[22]; a.w_down = (const float*)d_in[23]; a.norm_final = (const float*)d_in[24];
    a.out = (float*)d_out; a.ws = (unsigned char*)d_ws;
    for (int li = 0; li < MK_N_LAUNCHES; ++li) {
        a.ph_lo = (MK_N_LAUNCHES == 1) ? 0 : li; a.ph_hi = (MK_N_LAUNCHES == 1) ? 10 : li + 1;
        hipLaunchKernelGGL(nsa_hybrid_fwd, dim3(grid), dim3(NWAVES * 64), cfg::LDS_BYTES, stream, a);
        const hipError_t le = hipPeekAtLastError();
        if (le != hipSuccess) { fprintf(stderr, "kernel_launch: launch failed: %s\n", hipGetErrorName(le)); break; }
    }
}
```

```cpp
#include <hip/hip_runtime.h>
#include <cstdio>
#include <cstdint>

namespace cfg {
constexpr int DM = 1024, BATCH = 4, SEQ = 4096, MP = BATCH * SEQ, DB = 32, MROWS = MP + DB, MPAD = 16640;
constexpr int PAST = 16384, PAGE = 128, NPAGES = PAST / PAGE;
constexpr int NH = 8, HD = 64, NKV = 2;
constexpr int INC = 4376, INP = 4608;
constexpr int GW = 512, DFF = 2816, UPN = 2 * DFF;
constexpr float EPS = 1e-6f, NEGF = -1e30f, L2E = 1.4426950408889634f;
constexpr size_t OFF_YP = 0, OFF_YS = 16777216, OFF_CMP_P = 16809984, OFF_SLC_P = 21004288, OFF_WIN_P = 25198592, OFF_V_P = 25722880, OFF_CONV_P = 25985024,
                 OFF_CMP_S = 26007552, OFF_SLC_S = 26015744, OFF_WIN_S = 26023936, OFF_V_S = 30218240, OFF_CONV_S = 30234624, OUT_TOTAL = 30414848;
constexpr size_t MiB = 1u << 20;
constexpr size_t WS_CTL = 0, CTL_ZERO_BYTES = 1 * MiB;
constexpr size_t WS_WIN_T = 2 * MiB, WS_WPA_T = 12 * MiB, WS_WPB_T = 13 * MiB, WS_WOUT_T = 14 * MiB, WS_WUP_T = 16 * MiB, WS_WDN_T = 28 * MiB;
constexpr size_t WS_RSTD1 = 34 * MiB, WS_SSV = 35 * MiB, WS_SS2 = 36 * MiB, WS_SS3 = 38 * MiB, WS_NSAG = 40 * MiB, WS_KCP = 43 * MiB, WS_VCP = 44 * MiB;
constexpr size_t WS_KCS = 48 * MiB, WS_VCS = 64 * MiB;
constexpr size_t WS_XB = 80 * MiB, WS_Q = 113 * MiB, WS_KVB = 130 * MiB, WS_U = 155 * MiB, WS_VG = 172 * MiB, WS_GT = 189 * MiB, WS_ONSA = 254 * MiB, WS_CM = 271 * MiB;
constexpr size_t WS_T = 288 * MiB, WS_MIX = 353 * MiB, WS_X1F = 386 * MiB, WS_X1B = 451 * MiB, WS_AB = 484 * MiB, WS_ACT = 663 * MiB;
constexpr size_t WS_W1T = 45 * MiB, WS_W2F = 46 * MiB, WS_PB = 46 * MiB + 512 * 1024;
constexpr size_t WS_CB = 753 * MiB, WS_CBP = 1009 * MiB, WS_PS = 1017 * MiB, WS_PP = 1081 * MiB, WS_END = 1083 * MiB;
constexpr int CW_BAR = 4096;
constexpr int RING_BYTES = 131072, LDSCTL_OFF = RING_BYTES, MISC_OFF = LDSCTL_OFF + 320, BIAS_OFF = LDSCTL_OFF + 1024, LDS_BYTES = 147456;
}

#define GAS __attribute__((address_space(1)))
#define LAS __attribute__((address_space(3)))
#define DI __device__ __forceinline__
typedef unsigned short bf16;
typedef GAS unsigned gu32;
typedef unsigned v4u __attribute__((ext_vector_type(4)));
typedef unsigned v2u __attribute__((ext_vector_type(2)));
typedef float v4f __attribute__((ext_vector_type(4)));

struct Args {
    const float* x_prompt; const float* x_sample; const float* cache_cmp; const float* cache_slc; const float* cache_win; const float* state_conv;
    const int* page_table; const float* norm_mix; const float* w_in; const float* cmp_pe; const float* cmp_w1; const float* cmp_b1; const float* cmp_w2;
    const float* gmlp_norm; const float* gmlp_ws; const float* gmlp_bs; const float* w_proj_a; const float* w_proj_b; const float* w_out; const float* norm_ffn;
    const float* w_up; const float* conv_w; const float* conv_b; const float* w_down; const float* norm_final;
    float* out; unsigned char* ws;
    int ph_lo, ph_hi;
};

DI float bf2f(bf16 b) { return __uint_as_float(((unsigned)b) << 16); }
DI unsigned f2bf(float f) { unsigned u = __float_as_uint(f); return (u + 0x7fffu + ((u >> 16) & 1u)) >> 16; }
DI unsigned pk2(float lo, float hi) { return f2bf(lo) | (f2bf(hi) << 16); }
DI float fast_sigmoid(float x) { return __builtin_amdgcn_rcpf(1.0f + __builtin_amdgcn_exp2f(-1.4426950408889634f * x)); }
DI float gelu_tanh(float x) { const float u = x * (1.0f + 0.044715f * x * x); return x * __builtin_amdgcn_rcpf(1.0f + __builtin_amdgcn_exp2f(-2.302208198f * u)); }
DI float wave_sum(float v) {
#pragma unroll
    for (int o = 1; o < 64; o <<= 1) v += __shfl_xor(v, o);
    return v;
}
DI float wave_max(float v) {
#pragma unroll
    for (int o = 1; o < 64; o <<= 1) v = fmaxf(v, __shfl_xor(v, o));
    return v;
}
namespace pg8 {
#define PG8_LAS __attribute__((address_space(3)))
typedef unsigned short bf16_t;
typedef short bf16x8 __attribute__((ext_vector_type(8)));
typedef float f32x4 __attribute__((ext_vector_type(4)));
typedef unsigned u32x4 __attribute__((ext_vector_type(4)));
constexpr int BM = 256, BK = 64, HALF = 128, HTB = HALF * BK * 2  , STAGE_BYTES = 8 * HTB, NXCD = 8, WGM = 8;

__host__ __device__ __forceinline__ int lds_byte(int r, int c) { const int st = (r >> 4) * 2 + (c >> 5), rr = r & 15, cc = c & 31, ob = rr * 64 + cc * 2; return st * 1024 + (ob ^ (((ob >> 9) & 1) << 5)); }
__host__ __device__ __forceinline__ void stage_rc(int b, int& R, int& C) { const int st = b / 1024, sb = b % 1024, swz = sb ^ (((sb >> 9) & 1) << 5); R = (st >> 1) * 16 + swz / 64; C = (st & 1) * 32 + (swz % 64) / 2; }
__host__ __device__ __forceinline__ int perm32(int rho) { const int n = rho >> 4, i = rho & 15; return 8 * (i >> 2) + 4 * n + (i & 3); }

struct Unit { int pm, pn, kind; const char* a; const char* b; };
struct Gemm { const bf16_t* A; const bf16_t* Bt; int M, N, K; };

struct StaticOrder {
    int nM, nN, nwg, G, c; const char* A; const char* Bt; size_t tstep;
    __host__ __device__ void init(int M, int N, int G_, int c_, const void* A_ = nullptr, const void* Bt_ = nullptr, int K_ = 0) { nM = M / BM; nN = N / BM; nwg = nM * nN; G = G_; c = c_; A = (const char*)A_; Bt = (const char*)Bt_; tstep = (size_t)BM * K_ * 2; }
    __host__ __device__ bool next(int i, Unit& u) const {
        const long L = (long)i * G + c; if (L >= nwg) return false;
        return unit_of((int)L, u);
    }
    __host__ __device__ bool unit_of(int L, Unit& u) const {
        int wgid = L; { const int q = nwg / NXCD, r = nwg % NXCD, xcd = wgid % NXCD, off = wgid / NXCD; wgid = (xcd < r ? xcd * (q + 1) : r * (q + 1) + (xcd - r) * q) + off; }
        const int nig = WGM * nN, gid = wgid / nig, fm = gid * WGM, gsz = (nM - fm) < WGM ? (nM - fm) : WGM;
        u.pm = fm + ((wgid % nig) % gsz); u.pn = (wgid % nig) / gsz; u.kind = 0; u.a = A + (size_t)u.pm * tstep; u.b = Bt + (size_t)u.pn * tstep; return true;
    }
    __device__ __forceinline__ void a_ready(const Unit&) const {}
    __device__ __forceinline__ void done(const Unit&) const {}
};

typedef float f32x2c_t __attribute__((ext_vector_type(2))); typedef __bf16 bf16x2c_t __attribute__((ext_vector_type(2)));
__device__ __forceinline__ unsigned cvt_pk_bf16(float lo, float hi) { f32x2c_t v = {lo, hi}; bf16x2c_t b = __builtin_convertvector(v, bf16x2c_t); return __builtin_bit_cast(unsigned, b); }
typedef unsigned u32x2 __attribute__((ext_vector_type(2)));
__device__ __forceinline__ u32x4 pack8(const f32x4& v0, const f32x4& v1) { u32x4 w; w.x = cvt_pk_bf16(v0[0], v0[1]); w.y = cvt_pk_bf16(v0[2], v0[3]); w.z = cvt_pk_bf16(v1[0], v1[1]); w.w = cvt_pk_bf16(v1[2], v1[3]); return w; }
__device__ __forceinline__ f32x4 sig4(const f32x4& v) { return (f32x4){fast_sigmoid(v[0]), fast_sigmoid(v[1]), fast_sigmoid(v[2]), fast_sigmoid(v[3])}; }
__device__ __forceinline__ f32x4 gelu4(const f32x4& v) { return (f32x4){gelu_tanh(v[0]), gelu_tanh(v[1]), gelu_tanh(v[2]), gelu_tanh(v[3])}; }
__device__ __forceinline__ float sq4(const f32x4& v) { return (v[0] * v[0] + v[1] * v[1]) + (v[2] * v[2] + v[3] * v[3]); }

struct EpiIn {
    static constexpr bool PERM = true, AFTER_DRAIN = false;
    const float* rstd; bf16_t* Q; bf16_t* KVB; bf16_t* U; bf16_t* VG; float* SSV; bf16_t* GT; float* NSAG; float* out; bf16_t* CBP;
    __device__ __forceinline__ void operator()(const f32x4 (&acc)[2][2][4][2], const Unit& u, int wr, int wc, int fr, int fq) const {
        const int row0 = u.pm * BM + wr * 64 + fr, cl0 = wc * 32 + 8 * fq, pn = u.pn;
#pragma unroll
        for (int ai = 0; ai < 2; ++ai)
#pragma unroll
            for (int m = 0; m < 4; ++m) {
                const int row = row0 + ai * HALF + m * 16; const float rs = rstd[row];
                if (pn < 2) {
                    const float s = rs * 0.125f;
#pragma unroll
                    for (int bj = 0; bj < 2; ++bj) *(u32x4*)(Q + (size_t)row * 512 + pn * 256 + bj * HALF + cl0) = pack8(acc[ai][bj][m][0] * s, acc[ai][bj][m][1] * s);
                } else if (pn < 5) {
                    float* dst = nullptr;
                    if (pn == 2) dst = row < cfg::MP ? out + cfg::OFF_CMP_P + (size_t)row * 256 : (row < cfg::MROWS ? out + cfg::OFF_CMP_S + (size_t)(row - cfg::MP) * 256 : nullptr);
                    else if (pn == 3) dst = row < cfg::MP ? out + cfg::OFF_SLC_P + (size_t)row * 256 : (row < cfg::MROWS ? out + cfg::OFF_SLC_S + (size_t)(row - cfg::MP) * 256 : nullptr);
                    else { if (row < cfg::MP) { const int t = row & 4095, b = row >> 12; if (t >= 3584) dst = out + cfg::OFF_WIN_P + (size_t)(b * 512 + (t - 3584)) * 256; }
                           else if (row < cfg::MROWS) dst = out + cfg::OFF_WIN_S + ((size_t)(row - cfg::MP) * 512 + 511) * 256; }
#pragma unroll
                    for (int bj = 0; bj < 2; ++bj) { const f32x4 v0 = acc[ai][bj][m][0] * rs, v1 = acc[ai][bj][m][1] * rs; const int cl = bj * HALF + cl0;
                        const u32x4 pk = pack8(v0, v1); *(u32x4*)(KVB + (size_t)row * 768 + (pn - 2) * 256 + cl) = pk;
                        if (pn == 2 && row < cfg::MP) *(u32x4*)(CBP + ((size_t)((bj * 4 + (row >> 12)) * 2 + (cl0 >> 6)) * 4096 + (row & 4095)) * 64 + (cl0 & 63)) = pk;
                        if (dst) { *(f32x4*)(dst + cl) = v0; *(f32x4*)(dst + cl + 4) = v1; } }
                } else if (pn < 7) {
#pragma unroll
                    for (int bj = 0; bj < 2; ++bj) *(u32x4*)(U + (size_t)row * 512 + (pn - 5) * 256 + bj * HALF + cl0) = pack8(gelu4(acc[ai][bj][m][0] * rs), gelu4(acc[ai][bj][m][1] * rs));
                } else if (pn < 9) {
                    float ss = 0.f;
#pragma unroll
                    for (int bj = 0; bj < 2; ++bj) { const f32x4 v0 = gelu4(acc[ai][bj][m][0] * rs), v1 = gelu4(acc[ai][bj][m][1] * rs); ss += sq4(v0) + sq4(v1);
                        *(u32x4*)(VG + (size_t)row * 512 + (pn - 7) * 256 + bj * HALF + cl0) = pack8(v0, v1); }
                    ss += __shfl_xor(ss, 16); ss += __shfl_xor(ss, 32);
                    if (fq == 0) SSV[(size_t)row * 8 + (pn - 7) * 4 + wc] = ss;
                } else if (pn < 17) {
#pragma unroll
                    for (int bj = 0; bj < 2; ++bj) *(u32x4*)(GT + (size_t)row * 2048 + (pn - 9) * 256 + bj * HALF + cl0) = pack8(sig4(acc[ai][bj][m][0] * rs), sig4(acc[ai][bj][m][1] * rs));
                } else {
                    if (wc == 0 && fq < 3) { float* d = NSAG + (size_t)row * 32 + 8 * fq; *(f32x4*)d = sig4(acc[ai][0][m][0] * rs); *(f32x4*)(d + 4) = sig4(acc[ai][0][m][1] * rs); }
                }
            }
    }
};
struct EpiP {
    static constexpr bool PERM = true, AFTER_DRAIN = false;
    bf16_t* P; size_t kv_stride; const PG8_LAS float* biasL;
    __device__ __forceinline__ void operator()(const f32x4 (&acc)[2][2][4][2], const Unit& u, int wr, int wc, int fr, int fq) const {
        const int kv = u.kind - 1, row0 = u.pm * BM + wr * 64 + fr, cl0 = wc * 32 + 8 * fq;
        const f32x4 b0 = *(const PG8_LAS f32x4*)(biasL + kv * 128 + cl0), b1 = *(const PG8_LAS f32x4*)(biasL + kv * 128 + cl0 + 4);
        bf16_t* Pk = P + (size_t)kv * kv_stride;
#pragma unroll
        for (int ai = 0; ai < 2; ++ai)
#pragma unroll
            for (int m = 0; m < 4; ++m) { bf16_t* pr = Pk + (size_t)(row0 + ai * HALF + m * 16) * 256 + cl0;
                *(u32x4*)pr = pack8(acc[ai][0][m][0] + b0, acc[ai][0][m][1] + b1); *(u32x4*)(pr + HALF) = pack8(acc[ai][1][m][0], acc[ai][1][m][1]); }
    }
};
struct EpiMix {
    static constexpr bool PERM = true, AFTER_DRAIN = false;
    EpiIn in; EpiP p;
    __device__ __forceinline__ void operator()(const f32x4 (&acc)[2][2][4][2], const Unit& u, int wr, int wc, int fr, int fq) const { if (u.kind == 0) in(acc, u, wr, wc, fr, fq); else p(acc, u, wr, wc, fr, fq); }
};
struct EpiPA {
    static constexpr bool PERM = true, AFTER_DRAIN = false;
    const bf16_t* GT; float* T;
    __device__ __forceinline__ void operator()(const f32x4 (&acc)[2][2][4][2], const Unit& u, int wr, int wc, int fr, int fq) const {
        const int row0 = u.pm * BM + wr * 64 + fr, col0 = u.pn * BM + wc * 32 + 8 * fq;
#pragma unroll
        for (int ai = 0; ai < 2; ++ai)
#pragma unroll
            for (int m = 0; m < 4; ++m) { const int row = row0 + ai * HALF + m * 16;
#pragma unroll
                for (int bj = 0; bj < 2; ++bj) { const int col = col0 + bj * HALF; const u32x4 g = *(const u32x4*)(GT + (size_t)row * 2048 + col);
                    f32x4 g0 = (f32x4){__uint_as_float(g.x << 16), __uint_as_float(g.x & 0xffff0000u), __uint_as_float(g.y << 16), __uint_as_float(g.y & 0xffff0000u)};
                    f32x4 g1 = (f32x4){__uint_as_float(g.z << 16), __uint_as_float(g.z & 0xffff0000u), __uint_as_float(g.w << 16), __uint_as_float(g.w & 0xffff0000u)};
                    float* d = T + (size_t)row * 1024 + col; *(f32x4*)d = acc[ai][bj][m][0] * g0; *(f32x4*)(d + 4) = acc[ai][bj][m][1] * g1; } }
    }
};
struct EpiPB {
    static constexpr bool PERM = true, AFTER_DRAIN = false;
    const bf16_t* GT; const float* T; bf16_t* MIX;
    __device__ __forceinline__ void operator()(const f32x4 (&acc)[2][2][4][2], const Unit& u, int wr, int wc, int fr, int fq) const {
        const int row0 = u.pm * BM + wr * 64 + fr, col0 = u.pn * BM + wc * 32 + 8 * fq;
#pragma unroll
        for (int ai = 0; ai < 2; ++ai)
#pragma unroll
            for (int m = 0; m < 4; ++m) { const int row = row0 + ai * HALF + m * 16;
#pragma unroll
                for (int bj = 0; bj < 2; ++bj) { const int col = col0 + bj * HALF; const u32x4 g = *(const u32x4*)(GT + (size_t)row * 2048 + 1024 + col);
                    f32x4 g0 = (f32x4){__uint_as_float(g.x << 16), __uint_as_float(g.x & 0xffff0000u), __uint_as_float(g.y << 16), __uint_as_float(g.y & 0xffff0000u)};
                    f32x4 g1 = (f32x4){__uint_as_float(g.z << 16), __uint_as_float(g.z & 0xffff0000u), __uint_as_float(g.w << 16), __uint_as_float(g.w & 0xffff0000u)};
                    const float* t = T + (size_t)row * 1024 + col; const f32x4 t0 = *(const f32x4*)t, t1 = *(const f32x4*)(t + 4);
                    *(u32x4*)(MIX + (size_t)row * 1024 + col) = pack8(t0 + acc[ai][bj][m][0] * g0, t1 + acc[ai][bj][m][1] * g1); } }
    }
};
struct EpiOut {
    static constexpr bool PERM = true, AFTER_DRAIN = false;
    const float* xp; const float* xs; float* X1F; bf16_t* X1B; float* SS2;
    __device__ __forceinline__ void operator()(const f32x4 (&acc)[2][2][4][2], const Unit& u, int wr, int wc, int fr, int fq) const {
        const int row0 = u.pm * BM + wr * 64 + fr, col0 = u.pn * BM + wc * 32 + 8 * fq;
#pragma unroll
        for (int ai = 0; ai < 2; ++ai)
#pragma unroll
            for (int m = 0; m < 4; ++m) { const int row = row0 + ai * HALF + m * 16;
                const float* xr = row < cfg::MP ? xp + (size_t)row * 1024 : (row < cfg::MROWS ? xs + (size_t)(row - cfg::MP) * 1024 : nullptr);
                float ss = 0.f;
#pragma unroll
                for (int bj = 0; bj < 2; ++bj) { const int col = col0 + bj * HALF;
                    f32x4 x0 = (f32x4){0.f, 0.f, 0.f, 0.f}, x1 = x0; if (xr) { x0 = *(const f32x4*)(xr + col); x1 = *(const f32x4*)(xr + col + 4); }
                    x0 = x0 + acc[ai][bj][m][0]; x1 = x1 + acc[ai][bj][m][1]; ss += sq4(x0) + sq4(x1);
                    float* d = X1F + (size_t)row * 1024 + col; *(f32x4*)d = x0; *(f32x4*)(d + 4) = x1;
                    *(u32x4*)(X1B + (size_t)row * 1024 + col) = pack8(x0, x1); }
                ss += __shfl_xor(ss, 16); ss += __shfl_xor(ss, 32);
                if (fq == 0) SS2[(size_t)row * 16 + u.pn * 4 + wc] = ss; }
    }
};
struct EpiUp {
    static constexpr bool PERM = true, AFTER_DRAIN = false;
    const float* SS2; bf16_t* AB; float* out;
    __device__ __forceinline__ void operator()(const f32x4 (&acc)[2][2][4][2], const Unit& u, int wr, int wc, int fr, int fq) const {
        const int row0 = u.pm * BM + wr * 64 + fr, col0 = u.pn * BM + wc * 32 + 8 * fq;
#pragma unroll
        for (int ai = 0; ai < 2; ++ai)
#pragma unroll
            for (int m = 0; m < 4; ++m) { const int row = row0 + ai * HALF + m * 16;
                const f32x4* sp = (const f32x4*)(SS2 + (size_t)row * 16); const f32x4 s0 = sp[0], s1 = sp[1], s2 = sp[2], s3 = sp[3];
                const float ssum = ((s0[0] + s0[1]) + (s0[2] + s0[3])) + ((s1[0] + s1[1]) + (s1[2] + s1[3])) + ((s2[0] + s2[1]) + (s2[2] + s2[3])) + ((s3[0] + s3[1]) + (s3[2] + s3[3]));
                const float rs = 1.0f / sqrtf(ssum * (1.0f / 1024.0f) + cfg::EPS);
                float* dst = nullptr;
                if (u.pn < 11) { if (row < cfg::MP) { const int t = row & 4095, b = row >> 12; if (t >= 4094) dst = out + cfg::OFF_CONV_P + (size_t)(b * 2 + (t - 4094)) * 2816; }
                                 else if (row < cfg::MROWS) dst = out + cfg::OFF_CONV_S + ((size_t)(row - cfg::MP) * 2 + 1) * 2816; }
#pragma unroll
                for (int bj = 0; bj < 2; ++bj) { const int col = col0 + bj * HALF; const f32x4 v0 = acc[ai][bj][m][0] * rs, v1 = acc[ai][bj][m][1] * rs;
                    *(u32x4*)(AB + (size_t)row * 5632 + col) = pack8(v0, v1);
                    if (dst) { *(f32x4*)(dst + col) = v0; *(f32x4*)(dst + col + 4) = v1; } } }
    }
};
struct EpiDown {
    static constexpr bool PERM = true, AFTER_DRAIN = false;
    const float* X1F; float* out; float* SS3;
    __device__ __forceinline__ void operator()(const f32x4 (&acc)[2][2][4][2], const Unit& u, int wr, int wc, int fr, int fq) const {
        const int row0 = u.pm * BM + wr * 64 + fr, col0 = u.pn * BM + wc * 32 + 8 * fq;
#pragma unroll
        for (int ai = 0; ai < 2; ++ai)
#pragma unroll
            for (int m = 0; m < 4; ++m) { const int row = row0 + ai * HALF + m * 16; float ss = 0.f;
#pragma unroll
                for (int bj = 0; bj < 2; ++bj) { const int col = col0 + bj * HALF; const float* xr = X1F + (size_t)row * 1024 + col;
                    const f32x4 x0 = *(const f32x4*)xr + acc[ai][bj][m][0], x1 = *(const f32x4*)(xr + 4) + acc[ai][bj][m][1]; ss += sq4(x0) + sq4(x1);
                    if (row < cfg::MROWS) { float* d = out + (size_t)row * 1024 + col; *(f32x4*)d = x0; *(f32x4*)(d + 4) = x1; } }
                ss += __shfl_xor(ss, 16); ss += __shfl_xor(ss, 32);
                if (fq == 0) SS3[(size_t)row * 16 + u.pn * 4 + wc] = ss; }
    }
};
template <class Epi, class Sched, bool ALIGN_EPI = false, bool SP2 = false>
__device__ __forceinline__ void gemm_phase(PG8_LAS unsigned char* lds, const Gemm g, const Sched& S, const Epi& E) {
    const int tid = threadIdx.x, wid = __builtin_amdgcn_readfirstlane(tid >> 6), lane = tid & 63, wr = wid >> 2, wc = wid & 3, fr = lane & 15, fq = lane >> 4;
    const int K = g.K, nt = K / BK;
    unsigned voffA[2], voffB[2];
#pragma unroll
    for (int i = 0; i < 2; ++i) { int R, C; stage_rc(tid * 16 + i * 8192, R, C); const int Rb = Epi::PERM ? ((R & ~31) + perm32(R & 31)) : R;
        voffA[i] = (unsigned)(R * K + C) * 2u; voffB[i] = (unsigned)(Rb * K + C) * 2u; }
    const size_t kstep = (size_t)(BK * 2);
    const size_t hstep = (size_t)HALF * K * 2;
    const size_t tstep = 2 * hstep;
    const unsigned ldsw = (unsigned)wid * 1024u;
    const int aoff = lds_byte(wr * 64 + fr, fq * 8), boff = lds_byte(wc * 32 + fr, fq * 8);
#define PG8_SA(b, h) (((b) * 2 + (h)) * HTB)
#define PG8_SB(b, h) ((4 + (b) * 2 + (h)) * HTB)
#define PG8_STAGE(bufoff, gbase, voff) do { _Pragma("unroll") for (int _i = 0; _i < 2; ++_i) \
        __builtin_amdgcn_global_load_lds((const unsigned*)((const char*)(gbase) + (voff)[_i]), (PG8_LAS unsigned*)(lds + (bufoff) + ldsw + _i * 8192), 16, 0, 0); } while (0)
#define PG8_LDA(dst, b, h) do { _Pragma("unroll") for (int m = 0; m < 4; ++m) _Pragma("unroll") for (int k = 0; k < 2; ++k) dst[m][k] = *(const PG8_LAS bf16x8*)(lds + PG8_SA(b, h) + aoff + m * 2048 + k * 1024); } while (0)
#define PG8_LDB(dst, b, h) do { _Pragma("unroll") for (int n = 0; n < 2; ++n) _Pragma("unroll") for (int k = 0; k < 2; ++k) dst[n][k] = *(const PG8_LAS bf16x8*)(lds + PG8_SB(b, h) + boff + n * 2048 + k * 1024); } while (0)
#define PG8_MMA(ai, bj, At, Bt) do { __builtin_amdgcn_s_setprio(1); _Pragma("unroll") for (int m = 0; m < 4; ++m) _Pragma("unroll") for (int n = 0; n < 2; ++n) _Pragma("unroll") for (int k = 0; k < 2; ++k) \
        acc[ai][bj][m][n] = __builtin_amdgcn_mfma_f32_16x16x32_bf16(Bt[n][k], At[m][k], acc[ai][bj][m][n], 0, 0, 0); __builtin_amdgcn_s_setprio(0); } while (0)
#define PG8_WAIT_V(n) asm volatile("s_waitcnt vmcnt(" #n ")" ::: "memory")
#define PG8_WAIT_L(n) asm volatile("s_waitcnt lgkmcnt(" #n ")" ::: "memory")
#define PG8_BAR __builtin_amdgcn_s_barrier()
#define PG8_SCHED __builtin_amdgcn_sched_barrier(0)
    Unit cur, nxt; int ui = 0;
    if (!S.next(0, cur)) return;
    f32x4 acc[2][2][4][2];
#pragma unroll
    for (int a = 0; a < 2; ++a)
#pragma unroll
        for (int b = 0; b < 2; ++b)
#pragma unroll
            for (int m = 0; m < 4; ++m)
#pragma unroll
                for (int n = 0; n < 2; ++n) acc[a][b][m][n] = (f32x4){0.f, 0.f, 0.f, 0.f};
    bf16x8 At[4][2], B0[2][2], B1[2][2];
    const char* cA = cur.a; const char* cB = cur.b;
    S.a_ready(cur);
    if constexpr (SP2) {
        PG8_STAGE(PG8_SB(0, 0), cB, voffB); PG8_STAGE(PG8_SB(0, 1), cB + hstep, voffB); PG8_STAGE(PG8_SA(0, 0), cA, voffA); PG8_STAGE(PG8_SA(0, 1), cA + hstep, voffA);
        if (wr == 1) PG8_BAR;
        PG8_WAIT_V(2); PG8_BAR;
        PG8_STAGE(PG8_SB(1, 0), cB + kstep, voffB); PG8_STAGE(PG8_SA(1, 0), cA + kstep, voffA); PG8_STAGE(PG8_SB(1, 1), cB + hstep + kstep, voffB);
        PG8_WAIT_V(6); PG8_BAR;
    } else {
        PG8_STAGE(PG8_SB(0, 0), cB, voffB); PG8_STAGE(PG8_SA(0, 0), cA, voffA); PG8_STAGE(PG8_SB(0, 1), cB + hstep, voffB); PG8_STAGE(PG8_SA(0, 1), cA + hstep, voffA);
        if (wr == 1) PG8_BAR;
        PG8_WAIT_V(4); PG8_BAR;
        PG8_STAGE(PG8_SB(1, 0), cB + kstep, voffB); PG8_STAGE(PG8_SA(1, 0), cA + kstep, voffA); PG8_STAGE(PG8_SB(1, 1), cB + hstep + kstep, voffB);
        PG8_WAIT_V(6); PG8_BAR;
    }
    for (;;) {
        const bool has_next = S.next(ui + 1, nxt);
        const char* nA = has_next ? nxt.a : cA; const char* nB = has_next ? nxt.b : cB;
        for (int t = 0; t < nt; t += 2) {
            const bool last = (t == nt - 2);
            const char* a1 = cA + (size_t)(t + 1) * kstep;
            const char* a2 = last ? nA : cA + (size_t)(t + 2) * kstep; const char* b2 = last ? nB : cB + (size_t)(t + 2) * kstep;
            const char* a3 = a2 + kstep; const char* b3 = b2 + kstep;
            if (last && has_next) S.a_ready(nxt);
            if constexpr (SP2) {
            PG8_LDB(B0, 0, 0); PG8_LDB(B1, 0, 1); PG8_SCHED; PG8_LDA(At, 0, 0); PG8_STAGE(PG8_SA(1, 1), a1 + hstep, voffA);
            PG8_WAIT_V(8); PG8_WAIT_L(0); PG8_BAR; PG8_MMA(0, 0, At, B0); PG8_MMA(0, 1, At, B1); PG8_BAR; PG8_SCHED;
            PG8_LDA(At, 0, 1); PG8_STAGE(PG8_SB(0, 0), b2, voffB); PG8_STAGE(PG8_SB(0, 1), b2 + hstep, voffB); PG8_STAGE(PG8_SA(0, 0), a2, voffA);
            PG8_WAIT_V(8); PG8_WAIT_L(0); PG8_BAR; PG8_MMA(1, 0, At, B0); PG8_MMA(1, 1, At, B1); PG8_BAR; PG8_SCHED;
            PG8_LDB(B0, 1, 0); PG8_LDB(B1, 1, 1); PG8_SCHED; PG8_LDA(At, 1, 0); PG8_STAGE(PG8_SA(0, 1), a2 + hstep, voffA);
            PG8_WAIT_V(8); PG8_WAIT_L(0); PG8_BAR; PG8_MMA(0, 0, At, B0); PG8_MMA(0, 1, At, B1); PG8_BAR; PG8_SCHED;
            PG8_LDA(At, 1, 1); PG8_STAGE(PG8_SB(1, 0), b3, voffB); PG8_STAGE(PG8_SB(1, 1), b3 + hstep, voffB); PG8_STAGE(PG8_SA(1, 0), a3, voffA);
            PG8_WAIT_V(8); PG8_WAIT_L(0); PG8_BAR; PG8_MMA(1, 0, At, B0); PG8_MMA(1, 1, At, B1); PG8_BAR; PG8_SCHED;
            } else {
            PG8_LDB(B0, 0, 0); PG8_SCHED; PG8_LDA(At, 0, 0); PG8_STAGE(PG8_SA(1, 1), a1 + hstep, voffA);
            PG8_WAIT_L(8); PG8_BAR; PG8_WAIT_L(0); PG8_MMA(0, 0, At, B0); PG8_BAR; PG8_SCHED;
            PG8_LDB(B1, 0, 1); PG8_STAGE(PG8_SB(0, 0), b2, voffB);
            PG8_BAR; PG8_WAIT_L(0); PG8_MMA(0, 1, At, B1); PG8_BAR;
            PG8_LDA(At, 0, 1); PG8_STAGE(PG8_SA(0, 0), a2, voffA);
            PG8_BAR; PG8_WAIT_L(0); PG8_MMA(1, 0, At, B0); PG8_BAR; PG8_SCHED;
            PG8_STAGE(PG8_SB(0, 1), b2 + hstep, voffB);
            PG8_WAIT_V(6); PG8_BAR; PG8_MMA(1, 1, At, B1); PG8_BAR;
            PG8_LDB(B0, 1, 0); PG8_SCHED; PG8_LDA(At, 1, 0); PG8_STAGE(PG8_SA(0, 1), a2 + hstep, voffA);
            PG8_WAIT_L(8); PG8_BAR; PG8_WAIT_L(0); PG8_MMA(0, 0, At, B0); PG8_BAR; PG8_SCHED;
            PG8_LDB(B1, 1, 1); PG8_STAGE(PG8_SB(1, 0), b3, voffB);
            PG8_BAR; PG8_WAIT_L(0); PG8_MMA(0, 1, At, B1); PG8_BAR;
            PG8_LDA(At, 1, 1); PG8_STAGE(PG8_SA(1, 0), a3, voffA);
            PG8_BAR; PG8_WAIT_L(0); PG8_MMA(1, 0, At, B0); PG8_BAR; PG8_SCHED;
            PG8_STAGE(PG8_SB(1, 1), b3 + hstep, voffB);
            PG8_WAIT_V(6); PG8_BAR; PG8_MMA(1, 1, At, B1); PG8_BAR;
            }
        }
        if constexpr (ALIGN_EPI) { if (wr == 0) PG8_BAR; }
        if constexpr (!Epi::AFTER_DRAIN) { E(acc, cur, wr, wc, fr, fq); S.done(cur); }
        if (!has_next) break;
#pragma unroll
        for (int a = 0; a < 2; ++a)
#pragma unroll
            for (int b = 0; b < 2; ++b)
#pragma unroll
                for (int m = 0; m < 4; ++m)
#pragma unroll
                    for (int n = 0; n < 2; ++n) acc[a][b][m][n] = (f32x4){0.f, 0.f, 0.f, 0.f};
        cur = nxt; cA = nA; cB = nB; ++ui;
        if constexpr (ALIGN_EPI) { if (wr == 1) PG8_BAR; }
    }
    PG8_WAIT_V(0);
    if constexpr (!ALIGN_EPI) { if (wr == 0) PG8_BAR; }
    PG8_BAR;
    if constexpr (Epi::AFTER_DRAIN) { E.fused(acc, cur, wr, wc, fr, fq, lds, wid, lane); S.done(cur); }
#undef PG8_SA
#undef PG8_SB
#undef PG8_STAGE
#undef PG8_LDA
#undef PG8_LDB
#undef PG8_MMA
#undef PG8_WAIT_V
#undef PG8_WAIT_L
#undef PG8_BAR
#undef PG8_SCHED
}
}
#define XB_TMO      128
#define XB_XCNT(j)  (256  + 64 * (j))
#define XB_XSUB(j)  (1280 + 64 * (j))
#define XB_XGEN(j)  (2304 + 64 * (j))
#define XB_TOP      3328
#define XB_TOPGEN   3392
#define XCD_BAR_WORDS 3456
#define XB_SPIN_CAP (1u << 22)

__device__ __forceinline__ unsigned xb_ld(unsigned* p)              { return __hip_atomic_load(p, __ATOMIC_RELAXED, __HIP_MEMORY_SCOPE_AGENT); }
__device__ __forceinline__ unsigned xb_add(unsigned* p, unsigned v) { return __hip_atomic_fetch_add(p, v, __ATOMIC_RELAXED, __HIP_MEMORY_SCOPE_AGENT); }
__device__ __forceinline__ unsigned xb_xcc_id() { return (unsigned)__builtin_amdgcn_s_getreg((3 << 11) | 20) & 0xFu; }
#define XB_SPIN(cond, bar) do { unsigned _sp = 0; while (cond) { __builtin_amdgcn_s_sleep(1); \
    if ((++_sp & 255u) == 0u) { if (xb_ld(&(bar)[XB_TMO])) break; if (_sp > XB_SPIN_CAP) { atomicAdd(&(bar)[XB_TMO], 1u); break; } } } } while (0)

struct XcdBarrier {
    unsigned* bar; unsigned x;
    volatile LAS unsigned* st;
};

__device__ __forceinline__ XcdBarrier xcd_barrier_post(unsigned* bar, volatile LAS unsigned* st) {
    XcdBarrier b; b.bar = bar; b.x = xb_xcc_id(); b.st = st;
    if (threadIdx.x == 0) (void)xb_add(&bar[XB_XCNT(b.x)], 1u);
    return b;
}
__device__ __forceinline__ void xcd_barrier_complete(unsigned* bar, unsigned x, unsigned& nloc, unsigned& nx) {
    const unsigned G = gridDim.x * gridDim.y * gridDim.z;
    unsigned sum, cnt, mine, sp = 0u;
    for (;;) {
        sum = 0u; cnt = 0u; mine = 0u;
#pragma unroll
        for (unsigned j = 0; j < 16; ++j) { const unsigned c = xb_ld(&bar[XB_XCNT(j)]); sum += c; cnt += (c > 0u) ? 1u : 0u; mine = (j == x) ? c : mine; }
        if (sum == G) break;
        __builtin_amdgcn_s_sleep(1);
        if ((++sp & 255u) == 0u) { if (xb_ld(&bar[XB_TMO])) break; if (sp > XB_SPIN_CAP) { atomicAdd(&bar[XB_TMO], 1u); break; } }
    }
    nloc = mine > 0u ? mine : 1u; nx = cnt > 0u ? cnt : 1u;
}

__device__ __forceinline__ void xcd_barrier(const XcdBarrier& b) {
    asm volatile("s_waitcnt vmcnt(0)" ::: "memory");
    __syncthreads();
    if (threadIdx.x == 0) {
        unsigned* bar = b.bar;
        __builtin_amdgcn_s_waitcnt(0);
        unsigned nloc = b.st[0], nx = b.st[1];
        if (nloc == 0u) { xcd_barrier_complete(bar, b.x, nloc, nx); b.st[0] = nloc; b.st[1] = nx; }
        const unsigned old = xb_add(&bar[XB_XSUB(b.x)], 1u);
        const unsigned gen = old / nloc;
        if (old + 1u == (gen + 1u) * nloc) {
            __builtin_amdgcn_fence(__ATOMIC_RELEASE, "agent");
            asm volatile("s_waitcnt vmcnt(0)" ::: "memory");
            const unsigned og = xb_add(&bar[XB_TOP], 1u);
            const unsigned tg = og / nx;
            if (og + 1u == (tg + 1u) * nx) xb_add(&bar[XB_TOPGEN], 1u);
            else XB_SPIN(xb_ld(&bar[XB_TOPGEN]) == tg, bar);
            __builtin_amdgcn_fence(__ATOMIC_ACQUIRE, "agent");
            xb_add(&bar[XB_XGEN(b.x)], 1u);
            asm volatile("s_waitcnt vmcnt(0)" ::: "memory");
        } else {
            XB_SPIN(xb_ld(&bar[XB_XGEN(b.x)]) == gen, bar);
            __builtin_amdgcn_fence(__ATOMIC_ACQUIRE, "agent");
            asm volatile("s_waitcnt vmcnt(0)" ::: "memory");
        }
    }
    __syncthreads();
}
constexpr int NWAVES = 8;
#ifndef MK_N_LAUNCHES
#define MK_N_LAUNCHES 1
#endif
#ifndef PHMASK
#define PHMASK 0x3ff
#endif
#define LDS_WAIT() asm volatile("s_waitcnt lgkmcnt(0)" ::: "memory")

template <int MAPK> DI int colmap(int n, int N) {
    if (MAPK == 0) return n < N ? n : -1;
    if (n < 1280) return n;
    if (n < 2304) return n + 24;
    if (n < 4352) return n + 24;
    if (n < 4376) return n - 4352 + 1280;
    return -1;
}
template <int MAPK> DI void transpose_item(const float* W, int K, int N, const float* kscale, bf16* WT, LAS float* scr, int item, int nblk, int lane) {
    const int kb = item / nblk, nb = item % nblk, k0 = 64 * kb, n0 = 32 * nb;
    const int sc = colmap<MAPK>(n0 + (lane & 31), N);
#pragma unroll 8
    for (int i = 0; i < 32; ++i) { const int kk = 2 * i + (lane >> 5); float v = 0.f; if (sc >= 0) { v = W[(size_t)(k0 + kk) * N + sc]; if (kscale) v *= kscale[k0 + kk]; } scr[kk * 33 + (lane & 31)] = v; }
    LDS_WAIT();
    const int c = lane & 7;
#pragma unroll
    for (int j = 0; j < 4; ++j) { const int n = (lane >> 3) + 8 * j; const LAS float* s = scr + (8 * c) * 33 + n;
        v4u o; o.x = pk2(s[0 * 33], s[1 * 33]); o.y = pk2(s[2 * 33], s[3 * 33]); o.z = pk2(s[4 * 33], s[5 * 33]); o.w = pk2(s[6 * 33], s[7 * 33]);
        *(v4u*)(WT + (size_t)(n0 + n) * K + k0 + 8 * c) = o; }
    LDS_WAIT();
}

struct Soft { float m[4], l[4], o[4]; };
DI void soft_init(Soft& S) {
#pragma unroll
    for (int r = 0; r < 4; ++r) { S.m[r] = cfg::NEGF; S.l[r] = 0.f; S.o[r] = 0.f; }
}
DI void load8(const float* p, float (&x)[8]) { const v4f a = *(const v4f*)p, b = *(const v4f*)(p + 4); x[0] = a.x; x[1] = a.y; x[2] = a.z; x[3] = a.w; x[4] = b.x; x[5] = b.y; x[6] = b.z; x[7] = b.w; }
DI void load8(const bf16* p, float (&x)[8]) { const v4u a = *(const v4u*)p; x[0] = __uint_as_float(a.x << 16); x[1] = __uint_as_float(a.x & 0xffff0000u); x[2] = __uint_as_float(a.y << 16); x[3] = __uint_as_float(a.y & 0xffff0000u);
    x[4] = __uint_as_float(a.z << 16); x[5] = __uint_as_float(a.z & 0xffff0000u); x[6] = __uint_as_float(a.w << 16); x[7] = __uint_as_float(a.w & 0xffff0000u); }
DI float load1(const float* p) { return *p; }
DI float load1(const bf16* p) { return bf2f(*p); }

typedef short s16x8 __attribute__((ext_vector_type(8)));
typedef float f32x16 __attribute__((ext_vector_type(16)));
DI void cmp_stage2_tile(const bf16* Pg, int nseg, int n0, const bf16* W2Fkv, float* OUTg, int ncmp, int lane) {
    const int r32 = lane & 31, hi = lane >> 5, ra = n0 + r32, rb = ra + 1 < nseg ? ra + 1 : nseg - 1;
    f32x16 acc0, acc1;
#pragma unroll
    for (int i = 0; i < 16; ++i) { acc0[i] = 0.f; acc1[i] = 0.f; }
#pragma unroll
    for (int ks = 0; ks < 8; ++ks) {
        float p0[8], p1[8]; load8(Pg + (size_t)ra * 256 + 16 * ks + 8 * hi, p0); load8(Pg + (size_t)rb * 256 + 128 + 16 * ks + 8 * hi, p1);
        v4u av; av.x = pg8::cvt_pk_bf16(gelu_tanh(p0[0] + p1[0]), gelu_tanh(p0[1] + p1[1])); av.y = pg8::cvt_pk_bf16(gelu_tanh(p0[2] + p1[2]), gelu_tanh(p0[3] + p1[3]));
        av.z = pg8::cvt_pk_bf16(gelu_tanh(p0[4] + p1[4]), gelu_tanh(p0[5] + p1[5])); av.w = pg8::cvt_pk_bf16(gelu_tanh(p0[6] + p1[6]), gelu_tanh(p0[7] + p1[7]));
        const v4u b0 = *(const v4u*)(W2Fkv + ((size_t)(ks * 2 + 0) * 64 + lane) * 8), b1 = *(const v4u*)(W2Fkv + ((size_t)(ks * 2 + 1) * 64 + lane) * 8);
        acc0 = __builtin_amdgcn_mfma_f32_32x32x16_bf16(__builtin_bit_cast(s16x8, av), __builtin_bit_cast(s16x8, b0), acc0, 0, 0, 0);
        acc1 = __builtin_amdgcn_mfma_f32_32x32x16_bf16(__builtin_bit_cast(s16x8, av), __builtin_bit_cast(s16x8, b1), acc1, 0, 0, 0);
    }
#pragma unroll
    for (int r = 0; r < 16; ++r) { const int row = n0 + (r & 3) + 8 * (r >> 2) + 4 * hi; if (row < ncmp) { OUTg[(size_t)row * 64 + r32] = acc0[r]; OUTg[(size_t)row * 64 + 32 + r32] = acc1[r]; } }
}
DI void load_cmp_bias(const Args& a, LAS float* biasL, int tid) {
    if (tid < 256) { const float* PB = (const float*)(a.ws + cfg::WS_PB); const int kv = tid >> 7, h = tid & 127; float s = a.cmp_b1[kv * 128 + h];
#pragma unroll 8
        for (int c = 0; c < 32; ++c) s += PB[(kv * 32 + c) * 128 + h];
        biasL[tid] = s; }
    LDS_WAIT(); __syncthreads();
}
struct MixOrder {
    pg8::StaticOrder s1; int G, c; const char* CB; const char* W1T;
    __device__ bool next(int i, pg8::Unit& u) const {
        long L = (long)i * G + c; if (L < s1.nwg) return s1.unit_of((int)L, u);
        L -= s1.nwg; if (L >= 512) return false;
        const int kv = (int)(L >> 8), rest = (int)(L & 255);
        u.pm = rest; u.pn = 0; u.kind = 1 + kv; u.a = CB + (((size_t)(kv * 64 + (rest >> 2)) * 16384 + (size_t)(rest & 3) * 4096) * 64) * 2; u.b = W1T + (size_t)kv * 256 * 1024 * 2; return true;
    }
    __device__ __forceinline__ void a_ready(const pg8::Unit&) const {}
    __device__ __forceinline__ void done(const pg8::Unit&) const {}
};
struct OneOrder {
    pg8::Unit u0;
    __device__ bool next(int i, pg8::Unit& u) const { if (i) return false; u = u0; return true; }
    __device__ __forceinline__ void a_ready(const pg8::Unit&) const {}
    __device__ __forceinline__ void done(const pg8::Unit&) const {}
};
template <typename KT> DI void score4(float (&s)[4], const KT* kptr, bool valid, const LAS float* qs) {
    float a0 = 0.f, a1 = 0.f, a2 = 0.f, a3 = 0.f;
#pragma unroll
    for (int c = 0; c < 8; ++c) { float k[8]; load8(kptr + 8 * c, k); asm volatile("" : "+v"(a0), "+v"(a1), "+v"(a2), "+v"(a3) :: "memory");
#pragma unroll
        for (int j = 0; j < 8; ++j) { const int d = 8 * c + j; a0 += k[j] * qs[d]; a1 += k[j] * qs[64 + d]; a2 += k[j] * qs[128 + d]; a3 += k[j] * qs[192 + d]; } }
    s[0] = valid ? a0 : cfg::NEGF; s[1] = valid ? a1 : cfg::NEGF; s[2] = valid ? a2 : cfg::NEGF; s[3] = valid ? a3 : cfg::NEGF;
}
DI void online_update(Soft& S, const float (&s)[4], bool valid, LAS float* ps, int lane) {
#pragma unroll
    for (int r = 0; r < 4; ++r) { const float mn = fmaxf(S.m[r], wave_max(s[r])); const float p = valid ? __builtin_amdgcn_exp2f((s[r] - mn) * cfg::L2E) : 0.f; const float ls = wave_sum(p);
        const float al = __builtin_amdgcn_exp2f((S.m[r] - mn) * cfg::L2E); S.l[r] = S.l[r] * al + ls; S.m[r] = mn; S.o[r] *= al; ps[r * 64 + lane] = p; }
}
template <typename KT> DI void pv4(Soft& S, const LAS float* ps, const LAS unsigned long long* vp, int lane) {
#pragma unroll 4
    for (int key = 0; key < 64; ++key) { const KT* v = (const KT*)vp[key]; const float vv = load1(v + lane);
        S.o[0] += ps[key] * vv; S.o[1] += ps[64 + key] * vv; S.o[2] += ps[128 + key] * vv; S.o[3] += ps[192 + key] * vv; }
}
template <typename KT> DI void attend_tile(Soft& S, const KT* kptr, const KT* vptr, bool valid, const LAS float* qs, LAS float* ps, LAS unsigned long long* vp, int lane) {
    float s[4]; score4<KT>(s, kptr, valid, qs);
    LDS_WAIT();
    online_update(S, s, valid, ps, lane); vp[lane] = (unsigned long long)(uintptr_t)vptr;
    LDS_WAIT();
    pv4<KT>(S, ps, vp, lane);
}

constexpr int ATT_SCR_FLOATS = 2048;

DI void attn_prompt_task(const Args& a, int task, LAS float* scr, int lane) {
    const int t = task & 4095, g = (task >> 12) & 1, b = task >> 13, row = b * 4096 + t;
    LAS float* qs = scr; LAS float* ps = scr + 256; LAS unsigned long long* vp = (LAS unsigned long long*)(scr + 512); LAS float* sc = scr + 640; LAS float* ic = scr + 960;
    const bf16* Q = (const bf16*)(a.ws + cfg::WS_Q); const bf16* KVB = (const bf16*)(a.ws + cfg::WS_KVB);
    const float* KCP = (const float*)(a.ws + cfg::WS_KCP) + (size_t)(b * 2 + g) * 256 * 64; const float* VCP = (const float*)(a.ws + cfg::WS_VCP) + (size_t)(b * 2 + g) * 256 * 64;
    LDS_WAIT();
#pragma unroll
    for (int r = 0; r < 4; ++r) qs[r * 64 + lane] = bf2f(Q[(size_t)row * 512 + (g * 4 + r) * 64 + lane]);
#pragma unroll
    for (int i = 0; i < 5; ++i) ic[i * 64 + lane] = 0.f;
    LDS_WAIT();
    const int nvis = t < 31 ? 0 : (((t - 31) >> 4) + 1 < 255 ? ((t - 31) >> 4) + 1 : 255);
    const int ntile = (nvis + 63) >> 6;
    Soft C; soft_init(C);
    for (int tl = 0; tl < ntile; ++tl) { const int key = tl * 64 + lane; const bool valid = key < nvis; const int kc = key < 254 ? key : 254; float s[4]; score4<float>(s, KCP + kc * 64, valid, qs);
#pragma unroll
        for (int r = 0; r < 4; ++r) { const float mn = fmaxf(C.m[r], wave_max(s[r])); const float p = valid ? __builtin_amdgcn_exp2f((s[r] - mn) * cfg::L2E) : 0.f;
            C.l[r] = C.l[r] * __builtin_amdgcn_exp2f((C.m[r] - mn) * cfg::L2E) + wave_sum(p); C.m[r] = mn; } }
    float linv[4];
#pragma unroll
    for (int r = 0; r < 4; ++r) linv[r] = C.l[r] > 0.f ? 1.0f / C.l[r] : 0.f;
    for (int tl = 0; tl < ntile; ++tl) { const int key = tl * 64 + lane; const bool valid = key < nvis; const int kc = key < 254 ? key : 254; float s[4]; score4<float>(s, KCP + kc * 64, valid, qs);
        LDS_WAIT(); float isum = 0.f;
#pragma unroll
        for (int r = 0; r < 4; ++r) { const float p = valid ? __builtin_amdgcn_exp2f((s[r] - C.m[r]) * cfg::L2E) * linv[r] : 0.f; ps[r * 64 + lane] = p; isum += p; }
        ic[key] = isum; vp[lane] = (unsigned long long)(uintptr_t)(VCP + kc * 64);
        LDS_WAIT(); pv4<float>(C, ps, vp, lane); }
    LDS_WAIT();
    unsigned long long mask;
    { const int j = lane; float imp = 0.f;
#pragma unroll
      for (int m = -1; m < 4; ++m) { const int idx = 4 * j + m; if (idx >= 0 && idx < 255) imp += ic[idx]; }
      const int cur = t >> 6; const bool valid = j * 64 <= t; const bool forced = (j == 0) || (j <= cur && j > cur - 2);
      const float score = valid ? imp + (forced ? 1e6f : 0.f) : cfg::NEGF;
      sc[j] = score; LDS_WAIT();
      int rank = 0;
#pragma unroll 8
      for (int k = 0; k < 64; ++k) { const float o = sc[k]; rank += (o > score || (o == score && k < j)) ? 1 : 0; }
      mask = __ballot(valid && rank < 16); }
    Soft SL; soft_init(SL);
    { unsigned long long mm = mask;
      while (mm) { const int j = __builtin_ctzll(mm); mm &= mm - 1; const int pos = 64 * j + lane; const bool valid = pos <= t; const int pc = valid ? pos : t;
          const bf16* kp = KVB + (size_t)(b * 4096 + pc) * 768 + 256 + g * 64; attend_tile<bf16>(SL, kp, kp + 128, valid, qs, ps, vp, lane); } }
    Soft W; soft_init(W);
    { const int start = t > 512 ? t - 512 : 0;
      for (int base = start; base <= t; base += 64) { const int pos = base + lane; const bool valid = pos <= t; const int pc = valid ? pos : t;
          const bf16* kp = KVB + (size_t)(b * 4096 + pc) * 768 + 512 + g * 64; attend_tile<bf16>(W, kp, kp + 128, valid, qs, ps, vp, lane); } }
    const float* ng = (const float*)(a.ws + cfg::WS_NSAG) + (size_t)row * 32; bf16* O = (bf16*)(a.ws + cfg::WS_ONSA) + (size_t)row * 512;
#pragma unroll
    for (int r = 0; r < 4; ++r) { const int h = g * 4 + r; const float oc = C.o[r], os = SL.l[r] > 0.f ? SL.o[r] / SL.l[r] : 0.f, ow = W.l[r] > 0.f ? W.o[r] / W.l[r] : 0.f;
        O[h * 64 + lane] = (bf16)f2bf(ng[h * 3 + 0] * oc + ng[h * 3 + 1] * os + ng[h * 3 + 2] * ow); }
}

DI void attn_sample_task(const Args& a, int task, LAS float* scr, int lane) {
    const int g = task & 1, b = task >> 1, row = cfg::MP + b;
    LAS float* qs = scr; LAS float* ps = scr + 256; LAS unsigned long long* vp = (LAS unsigned long long*)(scr + 512); LAS float* sc = scr + 640; LAS float* ic = scr + 960;
    const bf16* Q = (const bf16*)(a.ws + cfg::WS_Q);
    const float* KCS = (const float*)(a.ws + cfg::WS_KCS) + (size_t)(b * 2 + g) * 1024 * 64; const float* VCS = (const float*)(a.ws + cfg::WS_VCS) + (size_t)(b * 2 + g) * 1024 * 64;
    LDS_WAIT();
#pragma unroll
    for (int r = 0; r < 4; ++r) qs[r * 64 + lane] = bf2f(Q[(size_t)row * 512 + (g * 4 + r) * 64 + lane]);
#pragma unroll
    for (int i = 0; i < 17; ++i) ic[i * 64 + lane] = 0.f;
    LDS_WAIT();
    Soft C; soft_init(C);
    for (int tl = 0; tl < 16; ++tl) { const int key = tl * 64 + lane; const bool valid = key < 1023; const int kc = valid ? key : 1022; float s[4]; score4<float>(s, KCS + kc * 64, valid, qs);
#pragma unroll
        for (int r = 0; r < 4; ++r) { const float mn = fmaxf(C.m[r], wave_max(s[r])); const float p = valid ? __builtin_amdgcn_exp2f((s[r] - mn) * cfg::L2E) : 0.f;
            C.l[r] = C.l[r] * __builtin_amdgcn_exp2f((C.m[r] - mn) * cfg::L2E) + wave_sum(p); C.m[r] = mn; } }
    float linv[4];
#pragma unroll
    for (int r = 0; r < 4; ++r) linv[r] = C.l[r] > 0.f ? 1.0f / C.l[r] : 0.f;
    for (int tl = 0; tl < 16; ++tl) { const int key = tl * 64 + lane; const bool valid = key < 1023; const int kc = valid ? key : 1022; float s[4]; score4<float>(s, KCS + kc * 64, valid, qs);
        LDS_WAIT(); float isum = 0.f;
#pragma unroll
        for (int r = 0; r < 4; ++r) { const float p = valid ? __builtin_amdgcn_exp2f((s[r] - C.m[r]) * cfg::L2E) * linv[r] : 0.f; ps[r * 64 + lane] = p; isum += p; }
        ic[key] = isum; vp[lane] = (unsigned long long)(uintptr_t)(VCS + kc * 64);
        LDS_WAIT(); pv4<float>(C, ps, vp, lane); }
    LDS_WAIT();
    unsigned long long msk[5];
    {
#pragma unroll
      for (int c = 0; c < 5; ++c) { const int j = c * 64 + lane; float imp = 0.f;
#pragma unroll
          for (int m = -1; m < 4; ++m) { const int idx = 4 * j + m; if (idx >= 0 && idx < 1023) imp += ic[idx]; }
          const bool forced = (j == 0) || (j == 255) || (j == 256);
          if (j < 257) sc[j] = imp + (forced ? 1e6f : 0.f); }
      LDS_WAIT();
#pragma unroll
      for (int c = 0; c < 5; ++c) { const int j = c * 64 + lane; const float score = sc[j < 257 ? j : 256]; int rank = 0;
#pragma unroll 8
          for (int k = 0; k < 257; ++k) { const float o = sc[k]; rank += (o > score || (o == score && k < j)) ? 1 : 0; }
          msk[c] = __ballot(j < 257 && rank < 16); } }
    Soft SL; soft_init(SL);
#pragma unroll
    for (int c = 0; c < 5; ++c) { unsigned long long mm = msk[c];
        while (mm) { const int j = c * 64 + __builtin_ctzll(mm); mm &= mm - 1;
            if (j < 256) { const int phys = a.page_table[b * cfg::NPAGES + (j >> 1)]; const float* kp = a.cache_slc + (((size_t)phys * 128 + (j & 1) * 64 + lane) * 4 + g) * 64; attend_tile<float>(SL, kp, kp + 128, true, qs, ps, vp, lane); }
            else { const float* kp = a.out + cfg::OFF_SLC_S + (size_t)(b * 4 + g) * 64; attend_tile<float>(SL, kp, kp + 128, lane == 0, qs, ps, vp, lane); } } }
    Soft W; soft_init(W);
    for (int tl = 0; tl < 8; ++tl) { const float* kp = a.cache_win + (((size_t)b * 512 + tl * 64 + lane) * 4 + g) * 64; attend_tile<float>(W, kp, kp + 128, true, qs, ps, vp, lane); }
    { const float* kp = a.out + cfg::OFF_WIN_S + (((size_t)b * 512 + 511) * 4 + g) * 64; attend_tile<float>(W, kp, kp + 128, lane == 0, qs, ps, vp, lane); }
    const float* ng = (const float*)(a.ws + cfg::WS_NSAG) + (size_t)row * 32; bf16* O = (bf16*)(a.ws + cfg::WS_ONSA) + (size_t)row * 512;
#pragma unroll
    for (int r = 0; r < 4; ++r) { const int h = g * 4 + r; const float oc = C.o[r], os = SL.l[r] > 0.f ? SL.o[r] / SL.l[r] : 0.f, ow = W.l[r] > 0.f ? W.o[r] / W.l[r] : 0.f;
        O[h * 64 + lane] = (bf16)f2bf(ng[h * 3 + 0] * oc + ng[h * 3 + 1] * os + ng[h * 3 + 2] * ow); }
}

DI float rstd_v(const float* SSV, int row) { const v4f a = *(const v4f*)(SSV + (size_t)row * 8), b = *(const v4f*)(SSV + (size_t)row * 8 + 4);
    return 1.0f / sqrtf((((a.x + a.y) + (a.z + a.w)) + ((b.x + b.y) + (b.z + b.w))) * (1.0f / 512.0f) + cfg::EPS); }
DI float rstd16(const float* SS, int row) { const v4f* p = (const v4f*)(SS + (size_t)row * 16); const v4f s0 = p[0], s1 = p[1], s2 = p[2], s3 = p[3];
    const float t = ((s0.x + s0.y) + (s0.z + s0.w)) + ((s1.x + s1.y) + (s1.z + s1.w)) + ((s2.x + s2.y) + (s2.z + s2.w)) + ((s3.x + s3.y) + (s3.z + s3.w));
    return 1.0f / sqrtf(t * (1.0f / 1024.0f) + cfg::EPS); }

DI void chunkmix_task(const Args& a, int task, int lane) {
    const int ib = task & 15, gi = (task >> 4) & 3, c = (task >> 6) & 31, b = task >> 11, i0 = ib * 8;
    const bf16* VG = (const bf16*)(a.ws + cfg::WS_VG); const bf16* U = (const bf16*)(a.ws + cfg::WS_U); const float* SSV = (const float*)(a.ws + cfg::WS_SSV); bf16* CM = (bf16*)(a.ws + cfg::WS_CM);
    const float* Ws = a.gmlp_ws + (size_t)gi * 128 * 128; const int rbase = b * 4096 + c * 128, ch = gi * 128 + lane;
    const float g0 = a.gmlp_norm[ch], g1 = a.gmlp_norm[ch + 64];
    float acc[8][2];
#pragma unroll
    for (int i = 0; i < 8; ++i) { acc[i][0] = 0.f; acc[i][1] = 0.f; }
    for (int j = 0; j <= i0 + 7; ++j) { const int rj = rbase + j; const float rs = rstd_v(SSV, rj);
        const float v0 = bf2f(VG[(size_t)rj * 512 + ch]) * rs * g0, v1 = bf2f(VG[(size_t)rj * 512 + ch + 64]) * rs * g1;
#pragma unroll
        for (int ii = 0; ii < 8; ++ii) { const float w = (j <= i0 + ii) ? Ws[(i0 + ii) * 128 + j] : 0.f; acc[ii][0] += w * v0; acc[ii][1] += w * v1; } }
#pragma unroll
    for (int ii = 0; ii < 8; ++ii) { const int r = rbase + i0 + ii; const float bs = a.gmlp_bs[gi * 128 + i0 + ii];
        CM[(size_t)r * 512 + ch] = (bf16)f2bf(bf2f(U[(size_t)r * 512 + ch]) * (acc[ii][0] + bs)); CM[(size_t)r * 512 + ch + 64] = (bf16)f2bf(bf2f(U[(size_t)r * 512 + ch + 64]) * (acc[ii][1] + bs)); }
}

__global__ void __launch_bounds__(NWAVES * 64, 2) nsa_hybrid_fwd(Args a) {
    extern __shared__ __attribute__((aligned(16))) unsigned char lds_raw[];
    LAS unsigned char* lds = (LAS unsigned char*)lds_raw;
    const int tid = threadIdx.x, lane = tid & 63, wave = __builtin_amdgcn_readfirstlane(tid >> 6);
    const int G = gridDim.x, gw = blockIdx.x * NWAVES + wave, NGW = G * NWAVES;
    unsigned char* ws = a.ws;
    for (int u = tid; u < (cfg::LDS_BYTES - cfg::LDSCTL_OFF) / 4; u += NWAVES * 64) ((LAS unsigned*)(lds + cfg::LDSCTL_OFF))[u] = 0u;
    __syncthreads();
    volatile LAS unsigned* MISC = (volatile LAS unsigned*)(lds + cfg::MISC_OFF);
    XcdBarrier bar = xcd_barrier_post((unsigned*)(ws + cfg::WS_CTL) + cfg::CW_BAR, MISC + 8);

    bf16* W_in_t = (bf16*)(ws + cfg::WS_WIN_T); bf16* W_pa_t = (bf16*)(ws + cfg::WS_WPA_T); bf16* W_pb_t = (bf16*)(ws + cfg::WS_WPB_T); bf16* W_out_t = (bf16*)(ws + cfg::WS_WOUT_T);
    bf16* W_up_t = (bf16*)(ws + cfg::WS_WUP_T); bf16* W_dn_t = (bf16*)(ws + cfg::WS_WDN_T);
    float* RSTD1 = (float*)(ws + cfg::WS_RSTD1); float* SSV = (float*)(ws + cfg::WS_SSV); float* SS2 = (float*)(ws + cfg::WS_SS2); float* SS3 = (float*)(ws + cfg::WS_SS3); float* NSAG = (float*)(ws + cfg::WS_NSAG);
    bf16* XB = (bf16*)(ws + cfg::WS_XB); bf16* Qb = (bf16*)(ws + cfg::WS_Q); bf16* KVB = (bf16*)(ws + cfg::WS_KVB); bf16* Ub = (bf16*)(ws + cfg::WS_U); bf16* VG = (bf16*)(ws + cfg::WS_VG); bf16* GT = (bf16*)(ws + cfg::WS_GT);
    bf16* ONSA = (bf16*)(ws + cfg::WS_ONSA); bf16* CM = (bf16*)(ws + cfg::WS_CM); float* Tb = (float*)(ws + cfg::WS_T); bf16* MIX = (bf16*)(ws + cfg::WS_MIX);
    float* X1F = (float*)(ws + cfg::WS_X1F); bf16* X1B = (bf16*)(ws + cfg::WS_X1B); bf16* AB = (bf16*)(ws + cfg::WS_AB); bf16* ACT = (bf16*)(ws + cfg::WS_ACT);

    #if (PHMASK >> 0) & 1
    if (a.ph_lo <= 0 && 0 < a.ph_hi) {
    {
        LAS float* scr = (LAS float*)(lds + wave * 16384);
        constexpr int I_IN = 16 * (cfg::INP / 32), I_PA = 8 * 32, I_PB = 8 * 32, I_OUT = 16 * 32, I_UP = 16 * (cfg::UPN / 32), I_DN = (cfg::DFF / 64) * 32;
        constexpr int NITEMS = I_IN + I_PA + I_PB + I_OUT + I_UP + I_DN;
        for (int it = gw; it < NITEMS; it += NGW) { int r = it;
            if (r < I_IN) { transpose_item<1>(a.w_in, 1024, cfg::INC, a.norm_mix, W_in_t, scr, r, cfg::INP / 32, lane); continue; } r -= I_IN;
            if (r < I_PA) { transpose_item<0>(a.w_proj_a, 512, 1024, nullptr, W_pa_t, scr, r, 32, lane); continue; } r -= I_PA;
            if (r < I_PB) { transpose_item<0>(a.w_proj_b, 512, 1024, nullptr, W_pb_t, scr, r, 32, lane); continue; } r -= I_PB;
            if (r < I_OUT) { transpose_item<0>(a.w_out, 1024, 1024, nullptr, W_out_t, scr, r, 32, lane); continue; } r -= I_OUT;
            if (r < I_UP) { transpose_item<0>(a.w_up, 1024, cfg::UPN, a.norm_ffn, W_up_t, scr, r, cfg::UPN / 32, lane); continue; } r -= I_UP;
            transpose_item<0>(a.w_down, cfg::DFF, 1024, nullptr, W_dn_t, scr, r, 32, lane); }
        for (int m = gw; m < cfg::MPAD; m += NGW) {
            const float* xr = m < cfg::MP ? a.x_prompt + (size_t)m * 1024 : (m < cfg::MROWS ? a.x_sample + (size_t)(m - cfg::MP) * 1024 : nullptr);
            v4f v[4]; float s = 0.f;
#pragma unroll
            for (int j = 0; j < 4; ++j) { v[j] = xr ? *(const v4f*)(xr + j * 256 + lane * 4) : (v4f){0.f, 0.f, 0.f, 0.f}; s += (v[j].x * v[j].x + v[j].y * v[j].y) + (v[j].z * v[j].z + v[j].w * v[j].w); }
            s = wave_sum(s);
            if (lane == 0) RSTD1[m] = xr ? 1.0f / sqrtf(s * (1.0f / 1024.0f) + cfg::EPS) : 0.f;
#pragma unroll
            for (int j = 0; j < 4; ++j) { v2u o; o.x = pk2(v[j].x, v[j].y); o.y = pk2(v[j].z, v[j].w); *(v2u*)(XB + (size_t)m * 1024 + j * 256 + lane * 4) = o; }
            if (m >= cfg::MROWS) {
                v4u z = (v4u){0u, 0u, 0u, 0u}; *(v4u*)(ONSA + (size_t)m * 512 + lane * 8) = z; *(v4u*)(CM + (size_t)m * 512 + lane * 8) = z; }
        }
        { const size_t n4 = (size_t)cfg::DB * 511 * 64;
          for (size_t i = (size_t)blockIdx.x * 512 + tid; i < n4; i += (size_t)G * 512) { const size_t bb = i / (511 * 64), rem = i % (511 * 64);
              ((v4f*)(a.out + cfg::OFF_WIN_S))[bb * 512 * 64 + rem] = ((const v4f*)a.cache_win)[bb * 512 * 64 + 64 + rem]; }
          for (int i = blockIdx.x * 512 + tid; i < cfg::DB * cfg::DFF; i += G * 512) { const int bb = i / cfg::DFF, f = i % cfg::DFF; a.out[cfg::OFF_CONV_S + (size_t)bb * 2 * cfg::DFF + f] = a.state_conv[(size_t)bb * 2 * cfg::DFF + cfg::DFF + f]; } }
        { bf16* W1T = (bf16*)(ws + cfg::WS_W1T);
          for (int it = gw; it < 4 * 64; it += NGW) { const int kr = it >> 6; transpose_item<0>(a.cmp_w1 + (size_t)kr * 1024 * 128, 1024, 128, nullptr, W1T + (size_t)kr * 128 * 1024, scr, it & 63, 4, lane); }
          bf16* W2F = (bf16*)(ws + cfg::WS_W2F);
          for (int e = blockIdx.x * 512 + tid; e < 2 * 8 * 2 * 64 * 8; e += G * 512) { const int j = e & 7, ln = (e >> 3) & 63, cb = (e >> 9) & 1, ks = (e >> 10) & 7, kv = e >> 13;
              W2F[e] = (bf16)f2bf(a.cmp_w2[(size_t)kv * 128 * 64 + (16 * ks + 8 * (ln >> 5) + j) * 64 + 32 * cb + (ln & 31)]); }
          float* PB = (float*)(ws + cfg::WS_PB);
          for (int it = gw; it < 64; it += NGW) { const int kv = it >> 5, c = it & 31; float s0 = 0.f, s1 = 0.f;
#pragma unroll 8
              for (int i = 0; i < 64; ++i) { const int k = c * 64 + i; const float pv = a.cmp_pe[kv * 2048 + k]; s0 += pv * a.cmp_w1[((size_t)kv * 2048 + k) * 128 + lane]; s1 += pv * a.cmp_w1[((size_t)kv * 2048 + k) * 128 + 64 + lane]; }
              PB[(kv * 32 + c) * 128 + lane] = s0; PB[(kv * 32 + c) * 128 + 64 + lane] = s1; } }
        { bf16* CB = (bf16*)(ws + cfg::WS_CB); const int kvg = lane >> 4, d0 = (lane & 15) * 4;
          for (int r0 = gw * 4; r0 < cfg::DB * cfg::PAST; r0 += NGW * 4) { v4f v[4];
#pragma unroll
              for (int i = 0; i < 4; ++i) { const int r = r0 + i, b = r >> 14, pos = r & 16383; const int phys = a.page_table[b * cfg::NPAGES + (pos >> 7)];
                  v[i] = *(const v4f*)(a.cache_cmp + ((size_t)phys * 128 + (pos & 127)) * 256 + lane * 4); }
#pragma unroll
              for (int i = 0; i < 4; ++i) { const int r = r0 + i, b = r >> 14, pos = r & 16383; v2u o; o.x = pg8::cvt_pk_bf16(v[i].x, v[i].y); o.y = pg8::cvt_pk_bf16(v[i].z, v[i].w);
                  *(v2u*)(CB + (((size_t)((kvg >> 1) * 32 + b) * 2 + (kvg & 1)) * 16384 + pos) * 64 + d0) = o; } } }
    }
    if (1 < a.ph_hi) xcd_barrier(bar);
    }

    #endif
#if (PHMASK >> 1) & 1
    if (a.ph_lo <= 1 && 1 < a.ph_hi) {
    { LAS float* biasL = (LAS float*)(lds + cfg::BIAS_OFF); load_cmp_bias(a, biasL, tid);
      pg8::Gemm g{XB, W_in_t, cfg::MPAD, cfg::INP, 1024}; MixOrder S; S.s1.init(cfg::MPAD, cfg::INP, G, (int)blockIdx.x, XB, W_in_t, 1024); S.G = G; S.c = (int)blockIdx.x;
      S.CB = (const char*)(ws + cfg::WS_CB); S.W1T = (const char*)(ws + cfg::WS_W1T);
      pg8::EpiMix E{pg8::EpiIn{RSTD1, Qb, KVB, Ub, VG, SSV, GT, NSAG, a.out, (bf16*)(ws + cfg::WS_CBP)}, pg8::EpiP{(bf16*)(ws + cfg::WS_PS), (size_t)65536 * 256, biasL}};
      pg8::gemm_phase<pg8::EpiMix, MixOrder, true, true>(lds, g, S, E); }
    if (2 < a.ph_hi) xcd_barrier(bar);
    }

    #endif
#if (PHMASK >> 2) & 1
    if (a.ph_lo <= 2 && 2 < a.ph_hi) {
    {
        const bf16* W2F = (const bf16*)(ws + cfg::WS_W2F);
        if (blockIdx.x < 16) {
            const int kv = blockIdx.x >> 3, bg = blockIdx.x & 7; LAS float* biasL = (LAS float*)(lds + cfg::BIAS_OFF); load_cmp_bias(a, biasL, tid);
            bf16* PP = (bf16*)(ws + cfg::WS_PP);
            OneOrder S; S.u0.pm = bg; S.u0.pn = 0; S.u0.kind = 1 + kv; S.u0.a = (const char*)(ws + cfg::WS_CBP) + (size_t)(kv * 8 + bg) * 4096 * 64 * 2; S.u0.b = (const char*)(ws + cfg::WS_W1T) + (size_t)kv * 256 * 1024 * 2;
            pg8::Gemm g{nullptr, nullptr, 256, 256, 1024}; pg8::EpiP E{PP, (size_t)2048 * 256, biasL};
            pg8::gemm_phase<pg8::EpiP, OneOrder, false, true>(lds, g, S, E);
            asm volatile("s_waitcnt vmcnt(0)" ::: "memory"); __syncthreads();
            cmp_stage2_tile(PP + ((size_t)kv * 2048 + bg * 256) * 256, 256, wave * 32, W2F + (size_t)kv * 8192, (float*)(ws + (kv ? cfg::WS_VCP : cfg::WS_KCP)) + (size_t)bg * 256 * 64, 255, lane);
        } else {
            const int gw2 = (blockIdx.x - 16) * NWAVES + wave, NGW2 = (G - 16) * NWAVES;
            for (int task = gw2; task < 2 * 64 * 32; task += NGW2) { const int kv = task >> 11, bg = (task >> 5) & 63, tl = task & 31;
                cmp_stage2_tile((const bf16*)(ws + cfg::WS_PS) + ((size_t)kv * 65536 + bg * 1024) * 256, 1024, tl * 32, W2F + (size_t)kv * 8192, (float*)(ws + (kv ? cfg::WS_VCS : cfg::WS_KCS)) + (size_t)bg * 1024 * 64, 1023, lane); }
            for (int task = gw2; task < 4 * 32 * 4 * 16; task += NGW2) chunkmix_task(a, task, lane);
        }
        for (int i = gw; i < 4 * 128 + cfg::DB; i += NGW) {
            const bool smp = i >= 512; const int row = smp ? cfg::MP + (i - 512) : (i >> 7) * 4096 + 3968 + (i & 127);
            float* dst = smp ? a.out + cfg::OFF_V_S + (size_t)(i - 512) * 512 : a.out + cfg::OFF_V_P + (size_t)i * 512;
            const float rs = rstd_v(SSV, row); float vn[8]; load8(VG + (size_t)row * 512 + lane * 8, vn);
#pragma unroll
            for (int j = 0; j < 8; ++j) vn[j] = vn[j] * rs * a.gmlp_norm[lane * 8 + j];
            *(v4f*)(dst + lane * 8) = (v4f){vn[0], vn[1], vn[2], vn[3]}; *(v4f*)(dst + lane * 8 + 4) = (v4f){vn[4], vn[5], vn[6], vn[7]};
            if (smp) { const int gi = lane >> 4; const float w00 = a.gmlp_ws[(size_t)gi * 128 * 128], bs = a.gmlp_bs[gi * 128]; float uu[8]; load8(Ub + (size_t)row * 512 + lane * 8, uu);
                v4u o; o.x = pk2(uu[0] * (w00 * vn[0] + bs), uu[1] * (w00 * vn[1] + bs)); o.y = pk2(uu[2] * (w00 * vn[2] + bs), uu[3] * (w00 * vn[3] + bs));
                o.z = pk2(uu[4] * (w00 * vn[4] + bs), uu[5] * (w00 * vn[5] + bs)); o.w = pk2(uu[6] * (w00 * vn[6] + bs), uu[7] * (w00 * vn[7] + bs));
                *(v4u*)(CM + (size_t)row * 512 + lane * 8) = o; }
        }
    }
    if (3 < a.ph_hi) xcd_barrier(bar);
    }

    #endif
#if (PHMASK >> 3) & 1
    if (a.ph_lo <= 3 && 3 < a.ph_hi) {
    {
        LAS float* scr = (LAS float*)(lds + wave * 16384);
        for (int task = gw; task < 64 + 32768; task += NGW) { if (task < 64) attn_sample_task(a, task, scr, lane); else attn_prompt_task(a, task - 64, scr, lane); }
    }
    if (4 < a.ph_hi) xcd_barrier(bar);
    }

    #endif
#if (PHMASK >> 4) & 1
    if (a.ph_lo <= 4 && 4 < a.ph_hi) {
    { pg8::StaticOrder S;
      { S.init(cfg::MPAD, 1024, G, (int)blockIdx.x, ONSA, W_pa_t, 512); pg8::Gemm g{ONSA, W_pa_t, cfg::MPAD, 1024, 512}; pg8::EpiPA E{GT, Tb}; pg8::gemm_phase<pg8::EpiPA, pg8::StaticOrder, true, true>(lds, g, S, E); }
      asm volatile("s_waitcnt vmcnt(0)" ::: "memory"); __syncthreads();
      { S.init(cfg::MPAD, 1024, G, (int)blockIdx.x, CM, W_pb_t, 512); pg8::Gemm g{CM, W_pb_t, cfg::MPAD, 1024, 512}; pg8::EpiPB E{GT, Tb, MIX}; pg8::gemm_phase<pg8::EpiPB, pg8::StaticOrder, true, true>(lds, g, S, E); } }
    if (5 < a.ph_hi) xcd_barrier(bar);
    }

    #endif
#if (PHMASK >> 5) & 1
    if (a.ph_lo <= 5 && 5 < a.ph_hi) {
    { pg8::Gemm g{MIX, W_out_t, cfg::MPAD, 1024, 1024}; pg8::StaticOrder S; S.init(cfg::MPAD, 1024, G, (int)blockIdx.x, MIX, W_out_t, 1024);
      pg8::EpiOut E{a.x_prompt, a.x_sample, X1F, X1B, SS2}; pg8::gemm_phase<pg8::EpiOut, pg8::StaticOrder, true, true>(lds, g, S, E); }
    if (6 < a.ph_hi) xcd_barrier(bar);
    }

    #endif
#if (PHMASK >> 6) & 1
    if (a.ph_lo <= 6 && 6 < a.ph_hi) {
    { pg8::Gemm g{X1B, W_up_t, cfg::MPAD, cfg::UPN, 1024}; pg8::StaticOrder S; S.init(cfg::MPAD, cfg::UPN, G, (int)blockIdx.x, X1B, W_up_t, 1024);
      pg8::EpiUp E{SS2, AB, a.out}; pg8::gemm_phase<pg8::EpiUp, pg8::StaticOrder, true, true>(lds, g, S, E); }
    if (7 < a.ph_hi) xcd_barrier(bar);
    }

    #endif
#if (PHMASK >> 7) & 1
    if (a.ph_lo <= 7 && 7 < a.ph_hi) {
    {
        constexpr int FV = cfg::DFF / 8;
        for (size_t i = (size_t)blockIdx.x * 512 + tid; i < (size_t)cfg::MPAD * FV; i += (size_t)G * 512) {
            const int row = (int)(i / FV), f = (int)(i % FV) * 8;
            float a0[8], a1[8], a2[8], bb[8], c[8];
            load8(AB + (size_t)row * cfg::UPN + f, a2); load8(AB + (size_t)row * cfg::UPN + cfg::DFF + f, bb);
            if (row < cfg::MP) { const int t = row & 4095;
                if (t >= 1) load8(AB + (size_t)(row - 1) * cfg::UPN + f, a1); else {
#pragma unroll
                    for (int j = 0; j < 8; ++j) a1[j] = 0.f; }
                if (t >= 2) load8(AB + (size_t)(row - 2) * cfg::UPN + f, a0); else {
#pragma unroll
                    for (int j = 0; j < 8; ++j) a0[j] = 0.f; } }
            else if (row < cfg::MROWS) { const float* sp = a.state_conv + (size_t)(row - cfg::MP) * 2 * cfg::DFF + f; load8(sp, a0); load8(sp + cfg::DFF, a1); }
            else {
#pragma unroll
                for (int j = 0; j < 8; ++j) { a0[j] = 0.f; a1[j] = 0.f; } }
            float w0[8], w1[8], w2[8], cb[8]; load8(a.conv_w + f, w0); load8(a.conv_w + cfg::DFF + f, w1); load8(a.conv_w + 2 * cfg::DFF + f, w2); load8(a.conv_b + f, cb);
#pragma unroll
            for (int j = 0; j < 8; ++j) c[j] = gelu_tanh(cb[j] + a0[j] * w0[j] + a1[j] * w1[j] + a2[j] * w2[j]) * bb[j];
            v4u o; o.x = pk2(c[0], c[1]); o.y = pk2(c[2], c[3]); o.z = pk2(c[4], c[5]); o.w = pk2(c[6], c[7]);
            *(v4u*)(ACT + (size_t)row * cfg::DFF + f) = o;
        }
    }
    if (8 < a.ph_hi) xcd_barrier(bar);
    }

    #endif
#if (PHMASK >> 8) & 1
    if (a.ph_lo <= 8 && 8 < a.ph_hi) {
    { pg8::Gemm g{ACT, W_dn_t, cfg::MPAD, 1024, cfg::DFF}; pg8::StaticOrder S; S.init(cfg::MPAD, 1024, G, (int)blockIdx.x, ACT, W_dn_t, cfg::DFF);
      pg8::EpiDown E{X1F, a.out, SS3}; pg8::gemm_phase<pg8::EpiDown, pg8::StaticOrder, true, true>(lds, g, S, E); }
    if (9 < a.ph_hi) xcd_barrier(bar);
    }

    #endif
#if (PHMASK >> 9) & 1
    if (a.ph_lo <= 9 && 9 < a.ph_hi) {
#ifdef DUMP
    for (int m = gw; m < cfg::MROWS; m += NGW) { float* yr = a.out + (size_t)m * 1024;
        if (DUMP == 4) continue;
#pragma unroll
        for (int j = 0; j < 4; ++j) { const int c = j * 256 + lane * 4; v4f v;
            if (DUMP == 1) { v.x = bf2f(MIX[(size_t)m * 1024 + c]); v.y = bf2f(MIX[(size_t)m * 1024 + c + 1]); v.z = bf2f(MIX[(size_t)m * 1024 + c + 2]); v.w = bf2f(MIX[(size_t)m * 1024 + c + 3]); }
            else if (DUMP == 2) v = *(const v4f*)(X1F + (size_t)m * 1024 + c);
            else if (DUMP == 3) { v.x = bf2f(ACT[(size_t)m * 2816 + c]); v.y = bf2f(ACT[(size_t)m * 2816 + c + 1]); v.z = bf2f(ACT[(size_t)m * 2816 + c + 2]); v.w = bf2f(ACT[(size_t)m * 2816 + c + 3]); }
            else { v.x = bf2f(AB[(size_t)m * 5632 + c]); v.y = bf2f(AB[(size_t)m * 5632 + c + 1]); v.z = bf2f(AB[(size_t)m * 5632 + c + 2]); v.w = bf2f(AB[(size_t)m * 5632 + c + 3]); }
            *(v4f*)(yr + c) = v; } }
#else
    for (int m = gw; m < cfg::MROWS; m += NGW) { const float rs = rstd16(SS3, m); float* yr = a.out + (size_t)m * 1024;
#pragma unroll
        for (int j = 0; j < 4; ++j) { const v4f v = *(const v4f*)(yr + j * 256 + lane * 4), gn = *(const v4f*)(a.norm_final + j * 256 + lane * 4); *(v4f*)(yr + j * 256 + lane * 4) = v * rs * gn; } }
#endif
    }
#endif
}

extern "C" void kernel_launch(void* const* d_in, const int* in_sizes, int n_in, void* d_out, int out_size, void* d_ws, size_t ws_size, hipStream_t stream) {
    static int grid = 0;
    if (grid == 0) {
        if (n_in != 25 || in_sizes[0] != cfg::MP * 1024 || (size_t)out_size != cfg::OUT_TOTAL || ws_size < cfg::WS_END) {
            fprintf(stderr, "kernel_launch: unexpected shapes (n_in %d, in0 %d, out %d, ws %zu); nothing launched\n", n_in, n_in > 0 ? in_sizes[0] : -1, out_size, ws_size); grid = -1; return; }
        int dev = 0, cus = 0, per_cu = 0;
        if (hipGetDevice(&dev) != hipSuccess || hipDeviceGetAttribute(&cus, hipDeviceAttributeMultiprocessorCount, dev) != hipSuccess) { grid = -1; return; }
        if (hipFuncSetAttribute((const void*)nsa_hybrid_fwd, hipFuncAttributeMaxDynamicSharedMemorySize, cfg::LDS_BYTES) != hipSuccess) { fprintf(stderr, "kernel_launch: hipFuncSetAttribute failed\n"); grid = -1; return; }
        if (hipOccupancyMaxActiveBlocksPerMultiprocessor(&per_cu, (const void*)nsa_hybrid_fwd, NWAVES * 64, cfg::LDS_BYTES) != hipSuccess || per_cu < 1)
            fprintf(stderr, "kernel_launch: note: occupancy query reports %d workgroups per CU\n", per_cu);
        (void)hipGetLastError();
        grid = cus;
    }
    if (grid < 0) return;
    if (hipMemsetAsync((char*)d_ws + cfg::WS_CTL, 0, cfg::CTL_ZERO_BYTES, stream) != hipSuccess) return;
    Args a{};
    a.x_prompt = (const float*)d_in[0]; a.x_sample = (const float*)d_in[1]; a.cache_cmp = (const float*)d_in[2]; a.cache_slc = (const float*)d_in[3]; a.cache_win = (const float*)d_in[4];
    a.state_conv = (const float*)d_in[5]; a.page_table = (const int*)d_in[6]; a.norm_mix = (const float*)d_in[7]; a.w_in = (const float*)d_in[8]; a.cmp_pe = (const float*)d_in[9];
    a.cmp_w1 = (const float*)d_in[10]; a.cmp_b1 = (const float*)d_in[11]; a.cmp_w2 = (const float*)d_in[12]; a.gmlp_norm = (const float*)d_in[13]; a.gmlp_ws = (const float*)d_in[14];
    a.gmlp_bs = (const float*)d_in[15]; a.w_proj_a = (const float*)d_in[16]; a.w_proj_b = (const float*)d_in[17]; a.w_out = (const float*)d_in[18]; a.norm_ffn = (const float*)d_in[19];
    a.w_up = (const float*)d_in[20]; a.conv_w = (const float*)d_in[21]; a.conv_b = (const float*)d_in[22]; a.w_down = (const float*)d_in[23]; a.norm_final = (const float*)d_in[24];
    a.out = (float*)d_out; a.ws = (unsigned char*)d_ws;
    for (int li = 0; li < MK_N_LAUNCHES; ++li) {
        a.ph_lo = (MK_N_LAUNCHES == 1) ? 0 : li; a.ph_hi = (MK_N_LAUNCHES == 1) ? 10 : li + 1;
        hipLaunchKernelGGL(nsa_hybrid_fwd, dim3(grid), dim3(NWAVES * 64), cfg::LDS_BYTES, stream, a);
        const hipError_t le = hipPeekAtLastError();
        if (le != hipSuccess) { fprintf(stderr, "kernel_launch: launch failed: %s\n", hipGetErrorName(le)); break; }
    }
}
```

```cpp
#include <hip/hip_runtime.h>
#include <cstdio>
#include <cstdint>

namespace cfg {
constexpr int DM = 1024, BATCH = 4, SEQ = 4096, MP = BATCH * SEQ, DB = 32, MROWS = MP + DB, MPAD = 16640;
constexpr int PAST = 16384, PAGE = 128, NPAGES = PAST / PAGE;
constexpr int NH = 8, HD = 64, NKV = 2;
constexpr int INC = 4376, INP = 4608;
constexpr int GW = 512, DFF = 2816, UPN = 2 * DFF;
constexpr float EPS = 1e-6f, NEGF = -1e30f, L2E = 1.4426950408889634f;
constexpr size_t OFF_YP = 0, OFF_YS = 16777216, OFF_CMP_P = 16809984, OFF_SLC_P = 21004288, OFF_WIN_P = 25198592, OFF_V_P = 25722880, OFF_CONV_P = 25985024,
                 OFF_CMP_S = 26007552, OFF_SLC_S = 26015744, OFF_WIN_S = 26023936, OFF_V_S = 30218240, OFF_CONV_S = 30234624, OUT_TOTAL = 30414848;
constexpr size_t MiB = 1u << 20;
constexpr size_t WS_CTL = 0, CTL_ZERO_BYTES = 1 * MiB;
constexpr size_t WS_WIN_T = 2 * MiB, WS_WPA_T = 12 * MiB, WS_WPB_T = 13 * MiB, WS_WOUT_T = 14 * MiB, WS_WUP_T = 16 * MiB, WS_WDN_T = 28 * MiB;
constexpr size_t WS_RSTD1 = 34 * MiB, WS_SSV = 35 * MiB, WS_SS2 = 36 * MiB, WS_SS3 = 38 * MiB, WS_NSAG = 40 * MiB, WS_KCP = 43 * MiB, WS_VCP = 44 * MiB;
constexpr size_t WS_KCS = 48 * MiB, WS_VCS = 64 * MiB;
constexpr size_t WS_XB = 80 * MiB, WS_Q = 113 * MiB, WS_KVB = 130 * MiB, WS_U = 155 * MiB, WS_VG = 172 * MiB, WS_GT = 189 * MiB, WS_ONSA = 254 * MiB, WS_CM = 271 * MiB;
constexpr size_t WS_T = 288 * MiB, WS_MIX = 353 * MiB, WS_X1F = 386 * MiB, WS_X1B = 451 * MiB, WS_AB = 484 * MiB, WS_ACT = 663 * MiB;
constexpr size_t WS_W1T = 45 * MiB, WS_W2F = 46 * MiB, WS_PB = 46 * MiB + 512 * 1024;
constexpr size_t WS_CB = 753 * MiB, WS_CBP = 1009 * MiB, WS_PS = 1017 * MiB, WS_PP = 1081 * MiB, WS_END = 1083 * MiB;
constexpr int CW_BAR = 4096;
constexpr int RING_BYTES = 131072, LDSCTL_OFF = RING_BYTES, MISC_OFF = LDSCTL_OFF + 320, BIAS_OFF = LDSCTL_OFF + 1024, LDS_BYTES = 147456;
}

#define GAS __attribute__((address_space(1)))
#define LAS __attribute__((address_space(3)))
#define DI __device__ __forceinline__
typedef unsigned short bf16;
typedef GAS unsigned gu32;
typedef unsigned v4u __attribute__((ext_vector_type(4)));
typedef unsigned v2u __attribute__((ext_vector_type(2)));
typedef float v4f __attribute__((ext_vector_type(4)));

struct Args {
    const float* x_prompt; const float* x_sample; const float* cache_cmp; const float* cache_slc; const float* cache_win; const float* state_conv;
    const int* page_table; const float* norm_mix; const float* w_in; const float* cmp_pe; const float* cmp_w1; const float* cmp_b1; const float* cmp_w2;
    const float* gmlp_norm; const float* gmlp_ws; const float* gmlp_bs; const float* w_proj_a; const float* w_proj_b; const float* w_out; const float* norm_ffn;
    const float* w_up; const float* conv_w; const float* conv_b; const float* w_down; const float* norm_final;
    float* out; unsigned char* ws;
    int ph_lo, ph_hi;
};

DI float bf2f(bf16 b) { return __uint_as_float(((unsigned)b) << 16); }
DI unsigned f2bf(float f) { unsigned u = __float_as_uint(f); return (u + 0x7fffu + ((u >> 16) & 1u)) >> 16; }
DI unsigned pk2(float lo, float hi) { return f2bf(lo) | (f2bf(hi) << 16); }
DI float fast_sigmoid(float x) { return __builtin_amdgcn_rcpf(1.0f + __builtin_amdgcn_exp2f(-1.4426950408889634f * x)); }
DI float gelu_tanh(float x) { const float u = x * (1.0f + 0.044715f * x * x); return x * __builtin_amdgcn_rcpf(1.0f + __builtin_amdgcn_exp2f(-2.302208198f * u)); }
DI float wave_sum(float v) {
#pragma unroll
    for (int o = 1; o < 64; o <<= 1) v += __shfl_xor(v, o);
    return v;
}
DI float wave_max(float v) {
#pragma unroll
    for (int o = 1; o < 64; o <<= 1) v = fmaxf(v, __shfl_xor(v, o));
    return v;
}
namespace pg8 {
#define PG8_LAS __attribute__((address_space(3)))
typedef unsigned short bf16_t;
typedef short bf16x8 __attribute__((ext_vector_type(8)));
typedef float f32x4 __attribute__((ext_vector_type(4)));
typedef unsigned u32x4 __attribute__((ext_vector_type(4)));
constexpr int BM = 256, BK = 64, HALF = 128, HTB = HALF * BK * 2  , STAGE_BYTES = 8 * HTB, NXCD = 8, WGM = 8;

__host__ __device__ __forceinline__ int lds_byte(int r, int c) { const int st = (r >> 4) * 2 + (c >> 5), rr = r & 15, cc = c & 31, ob = rr * 64 + cc * 2; return st * 1024 + (ob ^ (((ob >> 9) & 1) << 5)); }
__host__ __device__ __forceinline__ void stage_rc(int b, int& R, int& C) { const int st = b / 1024, sb = b % 1024, swz = sb ^ (((sb >> 9) & 1) << 5); R = (st >> 1) * 16 + swz / 64; C = (st & 1) * 32 + (swz % 64) / 2; }
__host__ __device__ __forceinline__ int perm32(int rho) { const int n = rho >> 4, i = rho & 15; return 8 * (i >> 2) + 4 * n + (i & 3); }

struct Unit { int pm, pn, kind; const char* a; const char* b; };
struct Gemm { const bf16_t* A; const bf16_t* Bt; int M, N, K; };

struct StaticOrder {
    int nM, nN, nwg, G, c; const char* A; const char* Bt; size_t tstep;
    __host__ __device__ void init(int M, int N, int G_, int c_, const void* A_ = nullptr, const void* Bt_ = nullptr, int K_ = 0) { nM = M / BM; nN = N / BM; nwg = nM * nN; G = G_; c = c_; A = (const char*)A_; Bt = (const char*)Bt_; tstep = (size_t)BM * K_ * 2; }
    __host__ __device__ bool next(int i, Unit& u) const {
        const long L = (long)i * G + c; if (L >= nwg) return false;
        return unit_of((int)L, u);
    }
    __host__ __device__ bool unit_of(int L, Unit& u) const {
        int wgid = L; { const int q = nwg / NXCD, r = nwg % NXCD, xcd = wgid % NXCD, off = wgid / NXCD; wgid = (xcd < r ? xcd * (q + 1) : r * (q + 1) + (xcd - r) * q) + off; }
        const int nig = WGM * nN, gid = wgid / nig, fm = gid * WGM, gsz = (nM - fm) < WGM ? (nM - fm) : WGM;
        u.pm = fm + ((wgid % nig) % gsz); u.pn = (wgid % nig) / gsz; u.kind = 0; u.a = A + (size_t)u.pm * tstep; u.b = Bt + (size_t)u.pn * tstep; return true;
    }
    __device__ __forceinline__ void a_ready(const Unit&) const {}
    __device__ __forceinline__ void done(const Unit&) const {}
};

typedef float f32x2c_t __attribute__((ext_vector_type(2))); typedef __bf16 bf16x2c_t __attribute__((ext_vector_type(2)));
__device__ __forceinline__ unsigned cvt_pk_bf16(float lo, float hi) { f32x2c_t v = {lo, hi}; bf16x2c_t b = __builtin_convertvector(v, bf16x2c_t); return __builtin_bit_cast(unsigned, b); }
typedef unsigned u32x2 __attribute__((ext_vector_type(2)));
__device__ __forceinline__ u32x4 pack8(const f32x4& v0, const f32x4& v1) { u32x4 w; w.x = cvt_pk_bf16(v0[0], v0[1]); w.y = cvt_pk_bf16(v0[2], v0[3]); w.z = cvt_pk_bf16(v1[0], v1[1]); w.w = cvt_pk_bf16(v1[2], v1[3]); return w; }
__device__ __forceinline__ f32x4 sig4(const f32x4& v) { return (f32x4){fast_sigmoid(v[0]), fast_sigmoid(v[1]), fast_sigmoid(v[2]), fast_sigmoid(v[3])}; }
__device__ __forceinline__ f32x4 gelu4(const f32x4& v) { return (f32x4){gelu_tanh(v[0]), gelu_tanh(v[1]), gelu_tanh(v[2]), gelu_tanh(v[3])}; }
__device__ __forceinline__ float sq4(const f32x4& v) { return (v[0] * v[0] + v[1] * v[1]) + (v[2] * v[2] + v[3] * v[3]); }

struct EpiIn {
    static constexpr bool PERM = true, AFTER_DRAIN = false;
    const float* rstd; bf16_t* Q; bf16_t* KVB; bf16_t* U; bf16_t* VG; float* SSV; bf16_t* GT; float* NSAG; float* out; bf16_t* CBP;
    __device__ __forceinline__ void operator()(const f32x4 (&acc)[2][2][4][2], const Unit& u, int wr, int wc, int fr, int fq) const {
        const int row0 = u.pm * BM + wr * 64 + fr, cl0 = wc * 32 + 8 * fq, pn = u.pn;
#pragma unroll
        for (int ai = 0; ai < 2; ++ai)
#pragma unroll
            for (int m = 0; m < 4; ++m) {
                const int row = row0 + ai * HALF + m * 16; const float rs = rstd[row];
                if (pn < 2) {
                    const float s = rs * 0.125f;
#pragma unroll
                    for (int bj = 0; bj < 2; ++bj) *(u32x4*)(Q + (size_t)row * 512 + pn * 256 + bj * HALF + cl0) = pack8(acc[ai][bj][m][0] * s, acc[ai][bj][m][1] * s);
                } else if (pn < 5) {
                    float* dst = nullptr;
                    if (pn == 2) dst = row < cfg::MP ? out + cfg::OFF_CMP_P + (size_t)row * 256 : (row < cfg::MROWS ? out + cfg::OFF_CMP_S + (size_t)(row - cfg::MP) * 256 : nullptr);
                    else if (pn == 3) dst = row < cfg::MP ? out + cfg::OFF_SLC_P + (size_t)row * 256 : (row < cfg::MROWS ? out + cfg::OFF_SLC_S + (size_t)(row - cfg::MP) * 256 : nullptr);
                    else { if (row < cfg::MP) { const int t = row & 4095, b = row >> 12; if (t >= 3584) dst = out + cfg::OFF_WIN_P + (size_t)(b * 512 + (t - 3584)) * 256; }
                           else if (row < cfg::MROWS) dst = out + cfg::OFF_WIN_S + ((size_t)(row - cfg::MP) * 512 + 511) * 256; }
#pragma unroll
                    for (int bj = 0; bj < 2; ++bj) { const f32x4 v0 = acc[ai][bj][m][0] * rs, v1 = acc[ai][bj][m][1] * rs; const int cl = bj * HALF + cl0;
                        const u32x4 pk = pack8(v0, v1); *(u32x4*)(KVB + (size_t)row * 768 + (pn - 2) * 256 + cl) = pk;
                        if (pn == 2 && row < cfg::MP) *(u32x4*)(CBP + ((size_t)((bj * 4 + (row >> 12)) * 2 + (cl0 >> 6)) * 4096 + (row & 4095)) * 64 + (cl0 & 63)) = pk;
                        if (dst) { *(f32x4*)(dst + cl) = v0; *(f32x4*)(dst + cl + 4) = v1; } }
                } else if (pn < 7) {
#pragma unroll
                    for (int bj = 0; bj < 2; ++bj) *(u32x4*)(U + (size_t)row * 512 + (pn - 5) * 256 + bj * HALF + cl0) = pack8(gelu4(acc[ai][bj][m][0] * rs), gelu4(acc[ai][bj][m][1] * rs));
                } else if (pn < 9) {
                    float ss = 0.f;
#pragma unroll
                    for (int bj = 0; bj < 2; ++bj) { const f32x4 v0 = gelu4(acc[ai][bj][m][0] * rs), v1 = gelu4(acc[ai][bj][m][1] * rs); ss += sq4(v0) + sq4(v1);
                        *(u32x4*)(VG + (size_t)row * 512 + (pn - 7) * 256 + bj * HALF + cl0) = pack8(v0, v1); }
                    ss += __shfl_xor(ss, 16); ss += __shfl_xor(ss, 32);
                    if (fq == 0) SSV[(size_t)row * 8 + (pn - 7) * 4 + wc] = ss;
                } else if (pn < 17) {
#pragma unroll
                    for (int bj = 0; bj < 2; ++bj) *(u32x4*)(GT + (size_t)row * 2048 + (pn - 9) * 256 + bj * HALF + cl0) = pack8(sig4(acc[ai][bj][m][0] * rs), sig4(acc[ai][bj][m][1] * rs));
                } else {
                    if (wc == 0 && fq < 3) { float* d = NSAG + (size_t)row * 32 + 8 * fq; *(f32x4*)d = sig4(acc[ai][0][m][0] * rs); *(f32x4*)(d + 4) = sig4(acc[ai][0][m][1] * rs); }
                }
            }
    }
};
struct EpiP {
    static constexpr bool PERM = true, AFTER_DRAIN = false;
    bf16_t* P; size_t kv_stride; const PG8_LAS float* biasL;
    __device__ __forceinline__ void operator()(const f32x4 (&acc)[2][2][4][2], const Unit& u, int wr, int wc, int fr, int fq) const {
        const int kv = u.kind - 1, row0 = u.pm * BM + wr * 64 + fr, cl0 = wc * 32 + 8 * fq;
        const f32x4 b0 = *(const PG8_LAS f32x4*)(biasL + kv * 128 + cl0), b1 = *(const PG8_LAS f32x4*)(biasL + kv * 128 + cl0 + 4);
        bf16_t* Pk = P + (size_t)kv * kv_stride;
#pragma unroll
        for (int ai = 0; ai < 2; ++ai)
#pragma unroll
            for (int m = 0; m < 4; ++m) { bf16_t* pr = Pk + (size_t)(row0 + ai * HALF + m * 16) * 256 + cl0;
                *(u32x4*)pr = pack8(acc[ai][0][m][0] + b0, acc[ai][0][m][1] + b1); *(u32x4*)(pr + HALF) = pack8(acc[ai][1][m][0], acc[ai][1][m][1]); }
    }
};
struct EpiMix {
    static constexpr bool PERM = true, AFTER_DRAIN = false;
    EpiIn in; EpiP p;
    __device__ __forceinline__ void operator()(const f32x4 (&acc)[2][2][4][2], const Unit& u, int wr, int wc, int fr, int fq) const { if (u.kind == 0) in(acc, u, wr, wc, fr, fq); else p(acc, u, wr, wc, fr, fq); }
};
struct EpiPA {
    static constexpr bool PERM = true, AFTER_DRAIN = false;
    const bf16_t* GT; float* T;
    __device__ __forceinline__ void operator()(const f32x4 (&acc)[2][2][4][2], const Unit& u, int wr, int wc, int fr, int fq) const {
        const int row0 = u.pm * BM + wr * 64 + fr, col0 = u.pn * BM + wc * 32 + 8 * fq;
#pragma unroll
        for (int ai = 0; ai < 2; ++ai)
#pragma unroll
            for (int m = 0; m < 4; ++m) { const int row = row0 + ai * HALF + m * 16;
#pragma unroll
                for (int bj = 0; bj < 2; ++bj) { const int col = col0 + bj * HALF; const u32x4 g = *(const u32x4*)(GT + (size_t)row * 2048 + col);
                    f32x4 g0 = (f32x4){__uint_as_float(g.x << 16), __uint_as_float(g.x & 0xffff0000u), __uint_as_float(g.y << 16), __uint_as_float(g.y & 0xffff0000u)};
                    f32x4 g1 = (f32x4){__uint_as_float(g.z << 16), __uint_as_float(g.z & 0xffff0000u), __uint_as_float(g.w << 16), __uint_as_float(g.w & 0xffff0000u)};
                    float* d = T + (size_t)row * 1024 + col; *(f32x4*)d = acc[ai][bj][m][0] * g0; *(f32x4*)(d + 4) = acc[ai][bj][m][1] * g1; } }
    }
};
struct EpiPB {
    static constexpr bool PERM = true, AFTER_DRAIN = false;
    const bf16_t* GT; const float* T; bf16_t* MIX;
    __device__ __forceinline__ void operator()(const f32x4 (&acc)[2][2][4][2], const Unit& u, int wr, int wc, int fr, int fq) const {
        const int row0 = u.pm * BM + wr * 64 + fr, col0 = u.pn * BM + wc * 32 + 8 * fq;
#pragma unroll
        for (int ai = 0; ai < 2; ++ai)
#pragma unroll
            for (int m = 0; m < 4; ++m) { const int row = row0 + ai * HALF + m * 16;
#pragma unroll
                for (int bj = 0; bj < 2; ++bj) { const int col = col0 + bj * HALF; const u32x4 g = *(const u32x4*)(GT + (size_t)row * 2048 + 1024 + col);
                    f32x4 g0 = (f32x4){__uint_as_float(g.x << 16), __uint_as_float(g.x & 0xffff0000u), __uint_as_float(g.y << 16), __uint_as_float(g.y & 0xffff0000u)};
                    f32x4 g1 = (f32x4){__uint_as_float(g.z << 16), __uint_as_float(g.z & 0xffff0000u), __uint_as_float(g.w << 16), __uint_as_float(g.w & 0xffff0000u)};
                    const float* t = T + (size_t)row * 1024 + col; const f32x4 t0 = *(const f32x4*)t, t1 = *(const f32x4*)(t + 4);
                    *(u32x4*)(MIX + (size_t)row * 1024 + col) = pack8(t0 + acc[ai][bj][m][0] * g0, t1 + acc[ai][bj][m][1] * g1); } }
    }
};
struct EpiOut {
    static constexpr bool PERM = true, AFTER_DRAIN = false;
    const float* xp; const float* xs; float* X1F; bf16_t* X1B; float* SS2;
    __device__ __forceinline__ void operator()(const f32x4 (&acc)[2][2][4][2], const Unit& u, int wr, int wc, int fr, int fq) const {
        const int row0 = u.pm * BM + wr * 64 + fr, col0 = u.pn * BM + wc * 32 + 8 * fq;
#pragma unroll
        for (int ai = 0; ai < 2; ++ai)
#pragma unroll
            for (int m = 0; m < 4; ++m) { const int row = row0 + ai * HALF + m * 16;
                const float* xr = row < cfg::MP ? xp + (size_t)row * 1024 : (row < cfg::MROWS ? xs + (size_t)(row - cfg::MP) * 1024 : nullptr);
                float ss = 0.f;
#pragma unroll
                for (int bj = 0; bj < 2; ++bj) { const int col = col0 + bj * HALF;
                    f32x4 x0 = (f32x4){0.f, 0.f, 0.f, 0.f}, x1 = x0; if (xr) { x0 = *(const f32x4*)(xr + col); x1 = *(const f32x4*)(xr + col + 4); }
                    x0 = x0 + acc[ai][bj][m][0]; x1 = x1 + acc[ai][bj][m][1]; ss += sq4(x0) + sq4(x1);
                    float* d = X1F + (size_t)row * 1024 + col; *(f32x4*)d = x0; *(f32x4*)(d + 4) = x1;
                    *(u32x4*)(X1B + (size_t)row * 1024 + col) = pack8(x0, x1); }
                ss += __shfl_xor(ss, 16); ss += __shfl_xor(ss, 32);
                if (fq == 0) SS2[(size_t)row * 16 + u.pn * 4 + wc] = ss; }
    }
};
struct EpiUp {
    static constexpr bool PERM = true, AFTER_DRAIN = false;
    const float* SS2; bf16_t* AB; float* out;
    __device__ __forceinline__ void operator()(const f32x4 (&acc)[2][2][4][2], const Unit& u, int wr, int wc, int fr, int fq) const {
        const int row0 = u.pm * BM + wr * 64 + fr, col0 = u.pn * BM + wc * 32 + 8 * fq;
#pragma unroll
        for (int ai = 0; ai < 2; ++ai)
#pragma unroll
            for (int m = 0; m < 4; ++m) { const int row = row0 + ai * HALF + m * 16;
                const f32x4* sp = (const f32x4*)(SS2 + (size_t)row * 16); const f32x4 s0 = sp[0], s1 = sp[1], s2 = sp[2], s3 = sp[3];
                const float ssum = ((s0[0] + s0[1]) + (s0[2] + s0[3])) + ((s1[0] + s1[1]) + (s1[2] + s1[3])) + ((s2[0] + s2[1]) + (s2[2] + s2[3])) + ((s3[0] + s3[1]) + (s3[2] + s3[3]));
                const float rs = 1.0f / sqrtf(ssum * (1.0f / 1024.0f) + cfg::EPS);
                float* dst = nullptr;
                if (u.pn < 11) { if (row < cfg::MP) { const int t = row & 4095, b = row >> 12; if (t >= 4094) dst = out + cfg::OFF_CONV_P + (size_t)(b * 2 + (t - 4094)) * 2816; }
                                 else if (row < cfg::MROWS) dst = out + cfg::OFF_CONV_S + ((size_t)(row - cfg::MP) * 2 + 1) * 2816; }
#pragma unroll
                for (int bj = 0; bj < 2; ++bj) { const int col = col0 + bj * HALF; const f32x4 v0 = acc[ai][bj][m][0] * rs, v1 = acc[ai][bj][m][1] * rs;
                    *(u32x4*)(AB + (size_t)row * 5632 + col) = pack8(v0, v1);
                    if (dst) { *(f32x4*)(dst + col) = v0; *(f32x4*)(dst + col + 4) = v1; } } }
    }
};
struct EpiDown {
    static constexpr bool PERM = true, AFTER_DRAIN = false;
    const float* X1F; float* out; float* SS3;
    __device__ __forceinline__ void operator()(const f32x4 (&acc)[2][2][4][2], const Unit& u, int wr, int wc, int fr, int fq) const {
        const int row0 = u.pm * BM + wr * 64 + fr, col0 = u.pn * BM + wc * 32 + 8 * fq;
#pragma unroll
        for (int ai = 0; ai < 2; ++ai)
#pragma unroll
            for (int m = 0; m < 4; ++m) { const int row = row0 + ai * HALF + m * 16; float ss = 0.f;
#pragma unroll
                for (int bj = 0; bj < 2; ++bj) { const int col = col0 + bj * HALF; const float* xr = X1F + (size_t)row * 1024 + col;
                    const f32x4 x0 = *(const f32x4*)xr + acc[ai][bj][m][0], x1 = *(const f32x4*)(xr + 4) + acc[ai][bj][m][1]; ss += sq4(x0) + sq4(x1);
                    if (row < cfg::MROWS) { float* d = out + (size_t)row * 1024 + col; *(f32x4*)d = x0; *(f32x4*)(d + 4) = x1; } }
                ss += __shfl_xor(ss, 16); ss += __shfl_xor(ss, 32);
                if (fq == 0) SS3[(size_t)row * 16 + u.pn * 4 + wc] = ss; }
    }
};
template <class Epi, class Sched, bool ALIGN_EPI = false, bool SP2 = false>
__device__ __forceinline__ void gemm_phase(PG8_LAS unsigned char* lds, const Gemm g, const Sched& S, const Epi& E) {
    const int tid = threadIdx.x, wid = __builtin_amdgcn_readfirstlane(tid >> 6), lane = tid & 63, wr = wid >> 2, wc = wid & 3, fr = lane & 15, fq = lane >> 4;
    const int K = g.K, nt = K / BK;
    unsigned voffA[2], voffB[2];
#pragma unroll
    for (int i = 0; i < 2; ++i) { int R, C; stage_rc(tid * 16 + i * 8192, R, C); const int Rb = Epi::PERM ? ((R & ~31) + perm32(R & 31)) : R;
        voffA[i] = (unsigned)(R * K + C) * 2u; voffB[i] = (unsigned)(Rb * K + C) * 2u; }
    const size_t kstep = (size_t)(BK * 2);
    const size_t hstep = (size_t)HALF * K * 2;
    const size_t tstep = 2 * hstep;
    const unsigned ldsw = (unsigned)wid * 1024u;
    const int aoff = lds_byte(wr * 64 + fr, fq * 8), boff = lds_byte(wc * 32 + fr, fq * 8);
#define PG8_SA(b, h) (((b) * 2 + (h)) * HTB)
#define PG8_SB(b, h) ((4 + (b) * 2 + (h)) * HTB)
#define PG8_STAGE(bufoff, gbase, voff) do { _Pragma("unroll") for (int _i = 0; _i < 2; ++_i) \
        __builtin_amdgcn_global_load_lds((const unsigned*)((const char*)(gbase) + (voff)[_i]), (PG8_LAS unsigned*)(lds + (bufoff) + ldsw + _i * 8192), 16, 0, 0); } while (0)
#define PG8_LDA(dst, b, h) do { _Pragma("unroll") for (int m = 0; m < 4; ++m) _Pragma("unroll") for (int k = 0; k < 2; ++k) dst[m][k] = *(const PG8_LAS bf16x8*)(lds + PG8_SA(b, h) + aoff + m * 2048 + k * 1024); } while (0)
#define PG8_LDB(dst, b, h) do { _Pragma("unroll") for (int n = 0; n < 2; ++n) _Pragma("unroll") for (int k = 0; k < 2; ++k) dst[n][k] = *(const PG8_LAS bf16x8*)(lds + PG8_SB(b, h) + boff + n * 2048 + k * 1024); } while (0)
#define PG8_MMA(ai, bj, At, Bt) do { __builtin_amdgcn_s_setprio(1); _Pragma("unroll") for (int m = 0; m < 4; ++m) _Pragma("unroll") for (int n = 0; n < 2; ++n) _Pragma("unroll") for (int k = 0; k < 2; ++k) \
        acc[ai][bj][m][n] = __builtin_amdgcn_mfma_f32_16x16x32_bf16(Bt[n][k], At[m][k], acc[ai][bj][m][n], 0, 0, 0); __builtin_amdgcn_s_setprio(0); } while (0)
#define PG8_WAIT_V(n) asm volatile("s_waitcnt vmcnt(" #n ")" ::: "memory")
#define PG8_WAIT_L(n) asm volatile("s_waitcnt lgkmcnt(" #n ")" ::: "memory")
#define PG8_BAR __builtin_amdgcn_s_barrier()
#define PG8_SCHED __builtin_amdgcn_sched_barrier(0)
    Unit cur, nxt; int ui = 0;
    if (!S.next(0, cur)) return;
    f32x4 acc[2][2][4][2];
#pragma unroll
    for (int a = 0; a < 2; ++a)
#pragma unroll
        for (int b = 0; b < 2; ++b)
#pragma unroll
            for (int m = 0; m < 4; ++m)
#pragma unroll
                for (int n = 0; n < 2; ++n) acc[a][b][m][n] = (f32x4){0.f, 0.f, 0.f, 0.f};
    bf16x8 At[4][2], B0[2][2], B1[2][2];
    const char* cA = cur.a; const char* cB = cur.b;
    S.a_ready(cur);
    if constexpr (SP2) {
        PG8_STAGE(PG8_SB(0, 0), cB, voffB); PG8_STAGE(PG8_SB(0, 1), cB + hstep, voffB); PG8_STAGE(PG8_SA(0, 0), cA, voffA); PG8_STAGE(PG8_SA(0, 1), cA + hstep, voffA);
        if (wr == 1) PG8_BAR;
        PG8_WAIT_V(2); PG8_BAR;
        PG8_STAGE(PG8_SB(1, 0), cB + kstep, voffB); PG8_STAGE(PG8_SA(1, 0), cA + kstep, voffA); PG8_STAGE(PG8_SB(1, 1), cB + hstep + kstep, voffB);
        PG8_WAIT_V(6); PG8_BAR;
    } else {
        PG8_STAGE(PG8_SB(0, 0), cB, voffB); PG8_STAGE(PG8_SA(0, 0), cA, voffA); PG8_STAGE(PG8_SB(0, 1), cB + hstep, voffB); PG8_STAGE(PG8_SA(0, 1), cA + hstep, voffA);
        if (wr == 1) PG8_BAR;
        PG8_WAIT_V(4); PG8_BAR;
        PG8_STAGE(PG8_SB(1, 0), cB + kstep, voffB); PG8_STAGE(PG8_SA(1, 0), cA + kstep, voffA); PG8_STAGE(PG8_SB(1, 1), cB + hstep + kstep, voffB);
        PG8_WAIT_V(6); PG8_BAR;
    }
    for (;;) {
        const bool has_next = S.next(ui + 1, nxt);
        const char* nA = has_next ? nxt.a : cA; const char* nB = has_next ? nxt.b : cB;
        for (int t = 0; t < nt; t += 2) {
            const bool last = (t == nt - 2);
            const char* a1 = cA + (size_t)(t + 1) * kstep;
            const char* a2 = last ? nA : cA + (size_t)(t + 2) * kstep; const char* b2 = last ? nB : cB + (size_t)(t + 2) * kstep;
            const char* a3 = a2 + kstep; const char* b3 = b2 + kstep;
            if (last && has_next) S.a_ready(nxt);
            if constexpr (SP2) {
            PG8_LDB(B0, 0, 0); PG8_LDB(B1, 0, 1); PG8_SCHED; PG8_LDA(At, 0, 0); PG8_STAGE(PG8_SA(1, 1), a1 + hstep, voffA);
            PG8_WAIT_V(8); PG8_WAIT_L(0); PG8_BAR; PG8_MMA(0, 0, At, B0); PG8_MMA(0, 1, At, B1); PG8_BAR; PG8_SCHED;
            PG8_LDA(At, 0, 1); PG8_STAGE(PG8_SB(0, 0), b2, voffB); PG8_STAGE(PG8_SB(0, 1), b2 + hstep, voffB); PG8_STAGE(PG8_SA(0, 0), a2, voffA);
            PG8_WAIT_V(8); PG8_WAIT_L(0); PG8_BAR; PG8_MMA(1, 0, At, B0); PG8_MMA(1, 1, At, B1); PG8_BAR; PG8_SCHED;
            PG8_LDB(B0, 1, 0); PG8_LDB(B1, 1, 1); PG8_SCHED; PG8_LDA(At, 1, 0); PG8_STAGE(PG8_SA(0, 1), a2 + hstep, voffA);
            PG8_WAIT_V(8); PG8_WAIT_L(0); PG8_BAR; PG8_MMA(0, 0, At, B0); PG8_MMA(0, 1, At, B1); PG8_BAR; PG8_SCHED;
            PG8_LDA(At, 1, 1); PG8_STAGE(PG8_SB(1, 0), b3, voffB); PG8_STAGE(PG8_SB(1, 1), b3 + hstep, voffB); PG8_STAGE(PG8_SA(1, 0), a3, voffA);
            PG8_WAIT_V(8); PG8_WAIT_L(0); PG8_BAR; PG8_MMA(1, 0, At, B0); PG8_MMA(1, 1, At, B1); PG8_BAR; PG8_SCHED;
            } else {
            PG8_LDB(B0, 0, 0); PG8_SCHED; PG8_LDA(At, 0, 0); PG8_STAGE(PG8_SA(1, 1), a1 + hstep, voffA);
            PG8_WAIT_L(8); PG8_BAR; PG8_WAIT_L(0); PG8_MMA(0, 0, At, B0); PG8_BAR; PG8_SCHED;
            PG8_LDB(B1, 0, 1); PG8_STAGE(PG8_SB(0, 0), b2, voffB);
            PG8_BAR; PG8_WAIT_L(0); PG8_MMA(0, 1, At, B1); PG8_BAR;
            PG8_LDA(At, 0, 1); PG8_STAGE(PG8_SA(0, 0), a2, voffA);
            PG8_BAR; PG8_WAIT_L(0); PG8_MMA(1, 0, At, B0); PG8_BAR; PG8_SCHED;
            PG8_STAGE(PG8_SB(0, 1), b2 + hstep, voffB);
            PG8_WAIT_V(6); PG8_BAR; PG8_MMA(1, 1, At, B1); PG8_BAR;
            PG8_LDB(B0, 1, 0); PG8_SCHED; PG8_LDA(At, 1, 0); PG8_STAGE(PG8_SA(0, 1), a2 + hstep, voffA);
            PG8_WAIT_L(8); PG8_BAR; PG8_WAIT_L(0); PG8_MMA(0, 0, At, B0); PG8_BAR; PG8_SCHED;
            PG8_LDB(B1, 1, 1); PG8_STAGE(PG8_SB(1, 0), b3, voffB);
            PG8_BAR; PG8_WAIT_L(0); PG8_MMA(0, 1, At, B1); PG8_BAR;
            PG8_LDA(At, 1, 1); PG8_STAGE(PG8_SA(1, 0), a3, voffA);
            PG8_BAR; PG8_WAIT_L(0); PG8_MMA(1, 0, At, B0); PG8_BAR; PG8_SCHED;
            PG8_STAGE(PG8_SB(1, 1), b3 + hstep, voffB);
            PG8_WAIT_V(6); PG8_BAR; PG8_MMA(1, 1, At, B1); PG8_BAR;
            }
        }
        if constexpr (ALIGN_EPI) { if (wr == 0) PG8_BAR; }
        if constexpr (!Epi::AFTER_DRAIN) { E(acc, cur, wr, wc, fr, fq); S.done(cur); }
        if (!has_next) break;
#pragma unroll
        for (int a = 0; a < 2; ++a)
#pragma unroll
            for (int b = 0; b < 2; ++b)
#pragma unroll
                for (int m = 0; m < 4; ++m)
#pragma unroll
                    for (int n = 0; n < 2; ++n) acc[a][b][m][n] = (f32x4){0.f, 0.f, 0.f, 0.f};
        cur = nxt; cA = nA; cB = nB; ++ui;
        if constexpr (ALIGN_EPI) { if (wr == 1) PG8_BAR; }
    }
    PG8_WAIT_V(0);
    if constexpr (!ALIGN_EPI) { if (wr == 0) PG8_BAR; }
    PG8_BAR;
    if constexpr (Epi::AFTER_DRAIN) { E.fused(acc, cur, wr, wc, fr, fq, lds, wid, lane); S.done(cur); }
#undef PG8_SA
#undef PG8_SB
#undef PG8_STAGE
#undef PG8_LDA
#undef PG8_LDB
#undef PG8_MMA
#undef PG8_WAIT_V
#undef PG8_WAIT_L
#undef PG8_BAR
#undef PG8_SCHED
}
}
#define XB_TMO      128
#define XB_XCNT(j)  (256  + 64 * (j))
#define XB_XSUB(j)  (1280 + 64 * (j))
#define XB_XGEN(j)  (2304 + 64 * (j))
#define XB_TOP      3328
#define XB_TOPGEN   3392
#define XCD_BAR_WORDS 3456
#define XB_SPIN_CAP (1u << 22)

__device__ __forceinline__ unsigned xb_ld(unsigned* p)              { return __hip_atomic_load(p, __ATOMIC_RELAXED, __HIP_MEMORY_SCOPE_AGENT); }
__device__ __forceinline__ unsigned xb_add(unsigned* p, unsigned v) { return __hip_atomic_fetch_add(p, v, __ATOMIC_RELAXED, __HIP_MEMORY_SCOPE_AGENT); }
__device__ __forceinline__ unsigned xb_xcc_id() { return (unsigned)__builtin_amdgcn_s_getreg((3 << 11) | 20) & 0xFu; }
#define XB_SPIN(cond, bar) do { unsigned _sp = 0; while (cond) { __builtin_amdgcn_s_sleep(1); \
    if ((++_sp & 255u) == 0u) { if (xb_ld(&(bar)[XB_TMO])) break; if (_sp > XB_SPIN_CAP) { atomicAdd(&(bar)[XB_TMO], 1u); break; } } } } while (0)

struct XcdBarrier {
    unsigned* bar; unsigned x;
    volatile LAS unsigned* st;
};

__device__ __forceinline__ XcdBarrier xcd_barrier_post(unsigned* bar, volatile LAS unsigned* st) {
    XcdBarrier b; b.bar = bar; b.x = xb_xcc_id(); b.st = st;
    if (threadIdx.x == 0) (void)xb_add(&bar[XB_XCNT(b.x)], 1u);
    return b;
}
__device__ __forceinline__ void xcd_barrier_complete(unsigned* bar, unsigned x, unsigned& nloc, unsigned& nx) {
    const unsigned G = gridDim.x * gridDim.y * gridDim.z;
    unsigned sum, cnt, mine, sp = 0u;
    for (;;) {
        sum = 0u; cnt = 0u; mine = 0u;
#pragma unroll
        for (unsigned j = 0; j < 16; ++j) { const unsigned c = xb_ld(&bar[XB_XCNT(j)]); sum += c; cnt += (c > 0u) ? 1u : 0u; mine = (j == x) ? c : mine; }
        if (sum == G) break;
        __builtin_amdgcn_s_sleep(1);
        if ((++sp & 255u) == 0u) { if (xb_ld(&bar[XB_TMO])) break; if (sp > XB_SPIN_CAP) { atomicAdd(&bar[XB_TMO], 1u); break; } }
    }
    nloc = mine > 0u ? mine : 1u; nx = cnt > 0u ? cnt : 1u;
}

__device__ __forceinline__ void xcd_barrier(const XcdBarrier& b) {
    asm volatile("s_waitcnt vmcnt(0)" ::: "memory");
    __syncthreads();
    if (threadIdx.x == 0) {
        unsigned* bar = b.bar;
        __builtin_amdgcn_s_waitcnt(0);
        unsigned nloc = b.st[0], nx = b.st[1];
        if (nloc == 0u) { xcd_barrier_complete(bar, b.x, nloc, nx); b.st[0] = nloc; b.st[1] = nx; }
        const unsigned old = xb_add(&bar[XB_XSUB(b.x)], 1u);
        const unsigned gen = old / nloc;
        if (old + 1u == (gen + 1u) * nloc) {
            __builtin_amdgcn_fence(__ATOMIC_RELEASE, "agent");
            asm volatile("s_waitcnt vmcnt(0)" ::: "memory");
            const unsigned og = xb_add(&bar[XB_TOP], 1u);
            const unsigned tg = og / nx;
            if (og + 1u == (tg + 1u) * nx) xb_add(&bar[XB_TOPGEN], 1u);
            else XB_SPIN(xb_ld(&bar[XB_TOPGEN]) == tg, bar);
            __builtin_amdgcn_fence(__ATOMIC_ACQUIRE, "agent");
            xb_add(&bar[XB_XGEN(b.x)], 1u);
            asm volatile("s_waitcnt vmcnt(0)" ::: "memory");
        } else {
            XB_SPIN(xb_ld(&bar[XB_XGEN(b.x)]) == gen, bar);
            __builtin_amdgcn_fence(__ATOMIC_ACQUIRE, "agent");
            asm volatile("s_waitcnt vmcnt(0)" ::: "memory");
        }
    }
    __syncthreads();
}
constexpr int NWAVES = 8;
#ifndef MK_N_LAUNCHES
#define MK_N_LAUNCHES 1
#endif
#ifndef PHMASK
#define PHMASK 0x3ff
#endif
#define LDS_WAIT() asm volatile("s_waitcnt lgkmcnt(0)" ::: "memory")

template <int MAPK> DI int colmap(int n, int N) {
    if (MAPK == 0) return n < N ? n : -1;
    if (n < 1280) return n;
    if (n < 2304) return n + 24;
    if (n < 4352) return n + 24;
    if (n < 4376) return n - 4352 + 1280;
    return -1;
}
template <int MAPK> DI void transpose_item(const float* W, int K, int N, const float* kscale, bf16* WT, LAS float* scr, int item, int nblk, int lane) {
    const int kb = item / nblk, nb = item % nblk, k0 = 64 * kb, n0 = 32 * nb;
    const int sc = colmap<MAPK>(n0 + (lane & 31), N);
#pragma unroll 8
    for (int i = 0; i < 32; ++i) { const int kk = 2 * i + (lane >> 5); float v = 0.f; if (sc >= 0) { v = W[(size_t)(k0 + kk) * N + sc]; if (kscale) v *= kscale[k0 + kk]; } scr[kk * 33 + (lane & 31)] = v; }
    LDS_WAIT();
    const int c = lane & 7;
#pragma unroll
    for (int j = 0; j < 4; ++j) { const int n = (lane >> 3) + 8 * j; const LAS float* s = scr + (8 * c) * 33 + n;
        v4u o; o.x = pk2(s[0 * 33], s[1 * 33]); o.y = pk2(s[2 * 33], s[3 * 33]); o.z = pk2(s[4 * 33], s[5 * 33]); o.w = pk2(s[6 * 33], s[7 * 33]);
        *(v4u*)(WT + (size_t)(n0 + n) * K + k0 + 8 * c) = o; }
    LDS_WAIT();
}

struct Soft { float m[4], l[4], o[4]; };
DI void soft_init(Soft& S) {
#pragma unroll
    for (int r = 0; r < 4; ++r) { S.m[r] = cfg::NEGF; S.l[r] = 0.f; S.o[r] = 0.f; }
}
DI void load8(const float* p, float (&x)[8]) { const v4f a = *(const v4f*)p, b = *(const v4f*)(p + 4); x[0] = a.x; x[1] = a.y; x[2] = a.z; x[3] = a.w; x[4] = b.x; x[5] = b.y; x[6] = b.z; x[7] = b.w; }
DI void load8(const bf16* p, float (&x)[8]) { const v4u a = *(const v4u*)p; x[0] = __uint_as_float(a.x << 16); x[1] = __uint_as_float(a.x & 0xffff0000u); x[2] = __uint_as_float(a.y << 16); x[3] = __uint_as_float(a.y & 0xffff0000u);
    x[4] = __uint_as_float(a.z << 16); x[5] = __uint_as_float(a.z & 0xffff0000u); x[6] = __uint_as_float(a.w << 16); x[7] = __uint_as_float(a.w & 0xffff0000u); }
DI float load1(const float* p) { return *p; }
DI float load1(const bf16* p) { return bf2f(*p); }

typedef short s16x8 __attribute__((ext_vector_type(8)));
typedef float f32x16 __attribute__((ext_vector_type(16)));
template <typename OT> DI void cmp_stage2_tile(const bf16* Pg, int nseg, int n0, const bf16* W2Fkv, OT* OUTg, int ncmp, int lane) {
    const int r32 = lane & 31, hi = lane >> 5, ra = n0 + r32, rb = ra + 1 < nseg ? ra + 1 : nseg - 1;
    f32x16 acc0, acc1;
#pragma unroll
    for (int i = 0; i < 16; ++i) { acc0[i] = 0.f; acc1[i] = 0.f; }
#pragma unroll
    for (int ks = 0; ks < 8; ++ks) {
        float p0[8], p1[8]; load8(Pg + (size_t)ra * 256 + 16 * ks + 8 * hi, p0); load8(Pg + (size_t)rb * 256 + 128 + 16 * ks + 8 * hi, p1);
        v4u av; av.x = pg8::cvt_pk_bf16(gelu_tanh(p0[0] + p1[0]), gelu_tanh(p0[1] + p1[1])); av.y = pg8::cvt_pk_bf16(gelu_tanh(p0[2] + p1[2]), gelu_tanh(p0[3] + p1[3]));
        av.z = pg8::cvt_pk_bf16(gelu_tanh(p0[4] + p1[4]), gelu_tanh(p0[5] + p1[5])); av.w = pg8::cvt_pk_bf16(gelu_tanh(p0[6] + p1[6]), gelu_tanh(p0[7] + p1[7]));
        const v4u b0 = *(const v4u*)(W2Fkv + ((size_t)(ks * 2 + 0) * 64 + lane) * 8), b1 = *(const v4u*)(W2Fkv + ((size_t)(ks * 2 + 1) * 64 + lane) * 8);
        acc0 = __builtin_amdgcn_mfma_f32_32x32x16_bf16(__builtin_bit_cast(s16x8, av), __builtin_bit_cast(s16x8, b0), acc0, 0, 0, 0);
        acc1 = __builtin_amdgcn_mfma_f32_32x32x16_bf16(__builtin_bit_cast(s16x8, av), __builtin_bit_cast(s16x8, b1), acc1, 0, 0, 0);
    }
#pragma unroll
    for (int r = 0; r < 16; ++r) { const int row = n0 + (r & 3) + 8 * (r >> 2) + 4 * hi; if (row < ncmp) { if (sizeof(OT) == 4) { OUTg[(size_t)row * 64 + r32] = (OT)acc0[r]; OUTg[(size_t)row * 64 + 32 + r32] = (OT)acc1[r]; } else { OUTg[(size_t)row * 64 + r32] = (OT)f2bf(acc0[r]); OUTg[(size_t)row * 64 + 32 + r32] = (OT)f2bf(acc1[r]); } } }
}
DI void load_cmp_bias(const Args& a, LAS float* biasL, int tid) {
    if (tid < 256) { const float* PB = (const float*)(a.ws + cfg::WS_PB); const int kv = tid >> 7, h = tid & 127; float s = a.cmp_b1[kv * 128 + h];
#pragma unroll 8
        for (int c = 0; c < 32; ++c) s += PB[(kv * 32 + c) * 128 + h];
        biasL[tid] = s; }
    LDS_WAIT(); __syncthreads();
}
struct MixOrder {
    pg8::StaticOrder s1; int G, c; const char* CB; const char* W1T;
    __device__ bool next(int i, pg8::Unit& u) const {
        long L = (long)i * G + c; if (L < s1.nwg) return s1.unit_of((int)L, u);
        L -= s1.nwg; if (L >= 512) return false;
        const int kv = (int)(L >> 8), rest = (int)(L & 255);
        u.pm = rest; u.pn = 0; u.kind = 1 + kv; u.a = CB + (((size_t)(kv * 64 + (rest >> 2)) * 16384 + (size_t)(rest & 3) * 4096) * 64) * 2; u.b = W1T + (size_t)kv * 256 * 1024 * 2; return true;
    }
    __device__ __forceinline__ void a_ready(const pg8::Unit&) const {}
    __device__ __forceinline__ void done(const pg8::Unit&) const {}
};
struct OneOrder {
    pg8::Unit u0;
    __device__ bool next(int i, pg8::Unit& u) const { if (i) return false; u = u0; return true; }
    __device__ __forceinline__ void a_ready(const pg8::Unit&) const {}
    __device__ __forceinline__ void done(const pg8::Unit&) const {}
};
template <typename KT> DI void score4(float (&s)[4], const KT* kptr, bool valid, const LAS float* qs) {
    float a0 = 0.f, a1 = 0.f, a2 = 0.f, a3 = 0.f;
#pragma unroll
    for (int c = 0; c < 8; ++c) { float k[8]; load8(kptr + 8 * c, k); asm volatile("" : "+v"(a0), "+v"(a1), "+v"(a2), "+v"(a3) :: "memory");
#pragma unroll
        for (int j = 0; j < 8; ++j) { const int d = 8 * c + j; a0 += k[j] * qs[d]; a1 += k[j] * qs[64 + d]; a2 += k[j] * qs[128 + d]; a3 += k[j] * qs[192 + d]; } }
    s[0] = valid ? a0 : cfg::NEGF; s[1] = valid ? a1 : cfg::NEGF; s[2] = valid ? a2 : cfg::NEGF; s[3] = valid ? a3 : cfg::NEGF;
}
DI void online_update(Soft& S, const float (&s)[4], bool valid, LAS float* ps, int lane) {
#pragma unroll
    for (int r = 0; r < 4; ++r) { const float mn = fmaxf(S.m[r], wave_max(s[r])); const float p = valid ? __builtin_amdgcn_exp2f((s[r] - mn) * cfg::L2E) : 0.f; const float ls = wave_sum(p);
        const float al = __builtin_amdgcn_exp2f((S.m[r] - mn) * cfg::L2E); S.l[r] = S.l[r] * al + ls; S.m[r] = mn; S.o[r] *= al; ps[r * 64 + lane] = p; }
}
template <typename KT> DI void pv4(Soft& S, const LAS float* ps, const LAS unsigned long long* vp, int lane) {
#pragma unroll 4
    for (int key = 0; key < 64; ++key) { const KT* v = (const KT*)vp[key]; const float vv = load1(v + lane);
        S.o[0] += ps[key] * vv; S.o[1] += ps[64 + key] * vv; S.o[2] += ps[128 + key] * vv; S.o[3] += ps[192 + key] * vv; }
}
template <typename KT> DI void attend_tile(Soft& S, const KT* kptr, const KT* vptr, bool valid, const LAS float* qs, LAS float* ps, LAS unsigned long long* vp, int lane) {
    float s[4]; score4<KT>(s, kptr, valid, qs);
    LDS_WAIT();
    online_update(S, s, valid, ps, lane); vp[lane] = (unsigned long long)(uintptr_t)vptr;
    LDS_WAIT();
    pv4<KT>(S, ps, vp, lane);
}

constexpr int ATT_SCR_FLOATS = 2048;

DI void attn_sample_task(const Args& a, int task, LAS float* scr, int lane) {
    const int g = task & 1, b = task >> 1, row = cfg::MP + b;
    LAS float* qs = scr; LAS float* ps = scr + 256; LAS unsigned long long* vp = (LAS unsigned long long*)(scr + 512); LAS float* sc = scr + 640; LAS float* ic = scr + 960;
    const bf16* Q = (const bf16*)(a.ws + cfg::WS_Q);
    const float* KCS = (const float*)(a.ws + cfg::WS_KCS) + (size_t)(b * 2 + g) * 1024 * 64; const float* VCS = (const float*)(a.ws + cfg::WS_VCS) + (size_t)(b * 2 + g) * 1024 * 64;
    LDS_WAIT();
#pragma unroll
    for (int r = 0; r < 4; ++r) qs[r * 64 + lane] = bf2f(Q[(size_t)row * 512 + (g * 4 + r) * 64 + lane]);
#pragma unroll
    for (int i = 0; i < 17; ++i) ic[i * 64 + lane] = 0.f;
    LDS_WAIT();
    Soft C; soft_init(C);
    for (int tl = 0; tl < 16; ++tl) { const int key = tl * 64 + lane; const bool valid = key < 1023; const int kc = valid ? key : 1022; float s[4]; score4<float>(s, KCS + kc * 64, valid, qs);
#pragma unroll
        for (int r = 0; r < 4; ++r) { const float mn = fmaxf(C.m[r], wave_max(s[r])); const float p = valid ? __builtin_amdgcn_exp2f((s[r] - mn) * cfg::L2E) : 0.f;
            C.l[r] = C.l[r] * __builtin_amdgcn_exp2f((C.m[r] - mn) * cfg::L2E) + wave_sum(p); C.m[r] = mn; } }
    float linv[4];
#pragma unroll
    for (int r = 0; r < 4; ++r) linv[r] = C.l[r] > 0.f ? 1.0f / C.l[r] : 0.f;
    for (int tl = 0; tl < 16; ++tl) { const int key = tl * 64 + lane; const bool valid = key < 1023; const int kc = valid ? key : 1022; float s[4]; score4<float>(s, KCS + kc * 64, valid, qs);
        LDS_WAIT(); float isum = 0.f;
#pragma unroll
        for (int r = 0; r < 4; ++r) { const float p = valid ? __builtin_amdgcn_exp2f((s[r] - C.m[r]) * cfg::L2E) * linv[r] : 0.f; ps[r * 64 + lane] = p; isum += p; }
        ic[key] = isum; vp[lane] = (unsigned long long)(uintptr_t)(VCS + kc * 64);
        LDS_WAIT(); pv4<float>(C, ps, vp, lane); }
    LDS_WAIT();
    unsigned long long msk[5];
    {
#pragma unroll
      for (int c = 0; c < 5; ++c) { const int j = c * 64 + lane; float imp = 0.f;
#pragma unroll
          for (int m = -1; m < 4; ++m) { const int idx = 4 * j + m; if (idx >= 0 && idx < 1023) imp += ic[idx]; }
          const bool forced = (j == 0) || (j == 255) || (j == 256);
          if (j < 257) sc[j] = imp + (forced ? 1e6f : 0.f); }
      LDS_WAIT();
#pragma unroll
      for (int c = 0; c < 5; ++c) { const int j = c * 64 + lane; const float score = sc[j < 257 ? j : 256]; int rank = 0;
#pragma unroll 8
          for (int k = 0; k < 257; ++k) { const float o = sc[k]; rank += (o > score || (o == score && k < j)) ? 1 : 0; }
          msk[c] = __ballot(j < 257 && rank < 16); } }
    Soft SL; soft_init(SL);
#pragma unroll
    for (int c = 0; c < 5; ++c) { unsigned long long mm = msk[c];
        while (mm) { const int j = c * 64 + __builtin_ctzll(mm); mm &= mm - 1;
            if (j < 256) { const int phys = a.page_table[b * cfg::NPAGES + (j >> 1)]; const float* kp = a.cache_slc + (((size_t)phys * 128 + (j & 1) * 64 + lane) * 4 + g) * 64; attend_tile<float>(SL, kp, kp + 128, true, qs, ps, vp, lane); }
            else { const float* kp = a.out + cfg::OFF_SLC_S + (size_t)(b * 4 + g) * 64; attend_tile<float>(SL, kp, kp + 128, lane == 0, qs, ps, vp, lane); } } }
    Soft W; soft_init(W);
    for (int tl = 0; tl < 8; ++tl) { const float* kp = a.cache_win + (((size_t)b * 512 + tl * 64 + lane) * 4 + g) * 64; attend_tile<float>(W, kp, kp + 128, true, qs, ps, vp, lane); }
    { const float* kp = a.out + cfg::OFF_WIN_S + (((size_t)b * 512 + 511) * 4 + g) * 64; attend_tile<float>(W, kp, kp + 128, lane == 0, qs, ps, vp, lane); }
    const float* ng = (const float*)(a.ws + cfg::WS_NSAG) + (size_t)row * 32; bf16* O = (bf16*)(a.ws + cfg::WS_ONSA) + (size_t)row * 512;
#pragma unroll
    for (int r = 0; r < 4; ++r) { const int h = g * 4 + r; const float oc = C.o[r], os = SL.l[r] > 0.f ? SL.o[r] / SL.l[r] : 0.f, ow = W.l[r] > 0.f ? W.o[r] / W.l[r] : 0.f;
        O[h * 64 + lane] = (bf16)f2bf(ng[h * 3 + 0] * oc + ng[h * 3 + 1] * os + ng[h * 3 + 2] * ow); }
}

DI float rstd_v(const float* SSV, int row) { const v4f a = *(const v4f*)(SSV + (size_t)row * 8), b = *(const v4f*)(SSV + (size_t)row * 8 + 4);
    return 1.0f / sqrtf((((a.x + a.y) + (a.z + a.w)) + ((b.x + b.y) + (b.z + b.w))) * (1.0f / 512.0f) + cfg::EPS); }
DI float rstd16(const float* SS, int row) { const v4f* p = (const v4f*)(SS + (size_t)row * 16); const v4f s0 = p[0], s1 = p[1], s2 = p[2], s3 = p[3];
    const float t = ((s0.x + s0.y) + (s0.z + s0.w)) + ((s1.x + s1.y) + (s1.z + s1.w)) + ((s2.x + s2.y) + (s2.z + s2.w)) + ((s3.x + s3.y) + (s3.z + s3.w));
    return 1.0f / sqrtf(t * (1.0f / 1024.0f) + cfg::EPS); }

DI void chunkmix_task(const Args& a, int task, int lane) {
    const int ib = task & 15, gi = (task >> 4) & 3, c = (task >> 6) & 31, b = task >> 11, i0 = ib * 8;
    const bf16* VG = (const bf16*)(a.ws + cfg::WS_VG); const bf16* U = (const bf16*)(a.ws + cfg::WS_U); const float* SSV = (const float*)(a.ws + cfg::WS_SSV); bf16* CM = (bf16*)(a.ws + cfg::WS_CM);
    const float* Ws = a.gmlp_ws + (size_t)gi * 128 * 128; const int rbase = b * 4096 + c * 128, ch = gi * 128 + lane;
    const float g0 = a.gmlp_norm[ch], g1 = a.gmlp_norm[ch + 64];
    float acc[8][2];
#pragma unroll
    for (int i = 0; i < 8; ++i) { acc[i][0] = 0.f; acc[i][1] = 0.f; }
    for (int j = 0; j <= i0 + 7; ++j) { const int rj = rbase + j; const float rs = rstd_v(SSV, rj);
        const float v0 = bf2f(VG[(size_t)rj * 512 + ch]) * rs * g0, v1 = bf2f(VG[(size_t)rj * 512 + ch + 64]) * rs * g1;
#pragma unroll
        for (int ii = 0; ii < 8; ++ii) { const float w = (j <= i0 + ii) ? Ws[(i0 + ii) * 128 + j] : 0.f; acc[ii][0] += w * v0; acc[ii][1] += w * v1; } }
#pragma unroll
    for (int ii = 0; ii < 8; ++ii) { const int r = rbase + i0 + ii; const float bs = a.gmlp_bs[gi * 128 + i0 + ii];
        CM[(size_t)r * 512 + ch] = (bf16)f2bf(bf2f(U[(size_t)r * 512 + ch]) * (acc[ii][0] + bs)); CM[(size_t)r * 512 + ch + 64] = (bf16)f2bf(bf2f(U[(size_t)r * 512 + ch + 64]) * (acc[ii][1] + bs)); }
}

namespace att {
constexpr int KP = 144;
constexpr int TILE_B = 64 * KP;
constexpr int BUF_B = 2 * TILE_B;
constexpr int W_OFF = 2 * BUF_B;
constexpr int W_IC = 0, W_SC = 8192, W_TAB = 10240, W_MSK = 10496, W_BYTES = 10560;
static_assert(W_OFF + 8 * W_BYTES <= cfg::RING_BYTES, "attention LDS map");
constexpr float NEG_S = -2e30f, M_INIT = -1e30f;
typedef short s16x4 __attribute__((ext_vector_type(4)));

DI float pl32_max(float v) { const auto rr = __builtin_amdgcn_permlane32_swap(__float_as_uint(v), __float_as_uint(v), false, false); return fmaxf(__uint_as_float(rr[0]), __uint_as_float(rr[1])); }
DI float pl32_sum(float v) { const auto rr = __builtin_amdgcn_permlane32_swap(__float_as_uint(v), __float_as_uint(v), false, false); return __uint_as_float(rr[0]) + __uint_as_float(rr[1]); }
DI float quad_sum(float v) {
    v += __int_as_float(__builtin_amdgcn_mov_dpp(__float_as_int(v), 0xB1, 0xf, 0xf, true));
    v += __int_as_float(__builtin_amdgcn_mov_dpp(__float_as_int(v), 0x4E, 0xf, 0xf, true));
    return v;
}
DI s16x4 lds_tr(const LAS char* p) { return __builtin_bit_cast(s16x4, __builtin_amdgcn_ds_read_tr16_b64_v4i16((LAS s16x4*)p)); }

DI void tile_fetch(v4u& kr, v4u& vr, const bf16* kg, const bf16* vg, size_t rowstride, int tid) {
    const size_t off = (size_t)(tid >> 3) * rowstride + (tid & 7) * 8; kr = *(const v4u*)(kg + off); vr = *(const v4u*)(vg + off);
}
DI void tile_store(LAS char* buf, const v4u& kr, const v4u& vr, int tid) {
    LAS char* p = buf + (tid >> 3) * KP + (tid & 7) * 16; *(LAS v4u*)p = kr; *(LAS v4u*)(p + TILE_B) = vr;
}
DI void qk_tile(f32x16& s0, f32x16& s1, const LAS char* Kt, const s16x8 (&qf)[4], int r32, int hi) {
#pragma unroll
    for (int i = 0; i < 16; ++i) { s0[i] = 0.f; s1[i] = 0.f; }
#pragma unroll
    for (int d0 = 0; d0 < 4; ++d0) {
        const s16x8 a0 = *(const LAS s16x8*)(Kt + r32 * KP + (2 * d0 + hi) * 16), a1 = *(const LAS s16x8*)(Kt + (32 + r32) * KP + (2 * d0 + hi) * 16);
        s0 = __builtin_amdgcn_mfma_f32_32x32x16_bf16(a0, qf[d0], s0, 0, 0, 0); s1 = __builtin_amdgcn_mfma_f32_32x32x16_bf16(a1, qf[d0], s1, 0, 0, 0);
    }
}
DI void pv_tile(f32x16 (&o)[2], const LAS char* Vt, const unsigned (&pk)[16], int lane) {
    const int hi = lane >> 5, gq = (lane >> 4) & 1, qq = (lane & 15) >> 2, pp = lane & 3;
    const LAS char* vb = Vt + (4 * hi + qq) * KP + (16 * gq + 4 * pp) * 2;
#pragma unroll
    for (int ks = 0; ks < 4; ++ks) {
        v4u av; av.x = pk[4 * ks]; av.y = pk[4 * ks + 1]; av.z = pk[4 * ks + 2]; av.w = pk[4 * ks + 3];
#pragma unroll
        for (int db = 0; db < 2; ++db) {
            const s16x4 lo = lds_tr(vb + (16 * ks) * KP + db * 64), hh = lds_tr(vb + (16 * ks + 8) * KP + db * 64);
            const s16x8 bv = (s16x8){lo[0], lo[1], lo[2], lo[3], hh[0], hh[1], hh[2], hh[3]};
            o[db] = __builtin_amdgcn_mfma_f32_32x32x16_bf16(__builtin_bit_cast(s16x8, av), bv, o[db], 0, 0, 0);
        }
    }
}
DI void tab_publish(LAS float* tab, float v, int r32, int hi) { if (hi == 0) tab[r32] = v; LDS_WAIT(); }
DI float crowf(const LAS float* tab, int reg, int hi) { return tab[(reg & 3) + 8 * (reg >> 2) + 4 * hi]; }

struct Ctx {
    int b, g, qt, tid, lane, wave, r32, hi, tq;
    LAS char* lds; LAS float* ic; LAS float* sc; LAS float* tab; LAS unsigned* msk;
};

template <int MODE> DI void run_tiles(const Ctx& c, const s16x8 (&qf)[4], int j_lo, int j_hi, const bf16* kg, const bf16* vg, size_t rowstride,
                                      float& m, float& l, f32x16 (&o)[2], float linv, int vis, unsigned msk_lo, unsigned msk_hi) {
    v4u kr, vr; tile_fetch(kr, vr, kg + (size_t)j_lo * 64 * rowstride, vg + (size_t)j_lo * 64 * rowstride, rowstride, c.tid);
    tile_store(c.lds, kr, vr, c.tid);
    LDS_WAIT(); __syncthreads();
    for (int j = j_lo; j <= j_hi; ++j) {
        const int cur = (j - j_lo) & 1; const LAS char* Kt = c.lds + cur * BUF_B; const LAS char* Vt = Kt + TILE_B;
        if (j < j_hi) tile_fetch(kr, vr, kg + (size_t)(j + 1) * 64 * rowstride, vg + (size_t)(j + 1) * 64 * rowstride, rowstride, c.tid);
        int lo = 0, hi_ = 63; bool need_mask;
        if (MODE <= 1) { hi_ = vis - 64 * j; need_mask = true; }
        else if (MODE == 2) { const bool sel = ((j < 32 ? msk_lo >> j : msk_hi >> (j - 32)) & 1u) != 0u; if (j == c.qt) hi_ = c.tq; if (!sel) hi_ = -1; need_mask = __any(hi_ != 63) != 0; }
        else { if (j == c.qt) hi_ = c.tq; else if (j == c.qt - 8) lo = c.tq; need_mask = (j == c.qt) || (j == c.qt - 8); }
        f32x16 s0, s1; qk_tile(s0, s1, Kt, qf, c.r32, c.hi);
        if (need_mask) { const int l4 = lo - 4 * c.hi, h4 = hi_ - 4 * c.hi;
#pragma unroll
            for (int r = 0; r < 16; ++r) { const int k0 = (r & 3) + 8 * (r >> 2); s0[r] = (k0 >= l4 && k0 <= h4) ? s0[r] : NEG_S; s1[r] = (k0 + 32 >= l4 && k0 + 32 <= h4) ? s1[r] : NEG_S; } }
        unsigned pk[16];
        if (MODE == 1) {
            const float mL = m * cfg::L2E;
#pragma unroll
            for (int r = 0; r < 16; ++r) { s0[r] = __builtin_amdgcn_exp2f(__builtin_fmaf(s0[r], cfg::L2E, -mL)) * linv; s1[r] = __builtin_amdgcn_exp2f(__builtin_fmaf(s1[r], cfg::L2E, -mL)) * linv; }
#pragma unroll
            for (int r = 0; r < 16; ++r) { const float a0 = quad_sum(s0[r]), a1 = quad_sum(s1[r]); const int key = 64 * j + (r & 3) + 8 * (r >> 2) + 4 * c.hi;
                if ((c.r32 & 3) == 0) { c.ic[(c.r32 >> 2) * 256 + key] = a0; c.ic[(c.r32 >> 2) * 256 + key + 32] = a1; } }
        } else {
            float mt = fmaxf(s0[0], s1[0]);
#pragma unroll
            for (int r = 1; r < 16; ++r) mt = fmaxf(mt, fmaxf(s0[r], s1[r]));
            mt = pl32_max(mt);
            const float mn = fmaxf(m, mt);
            if (__any(mn > m)) { const float al = __builtin_amdgcn_exp2f((m - mn) * cfg::L2E); l *= al; m = mn;
                if (MODE >= 2) { tab_publish(c.tab, al, c.r32, c.hi);
#pragma unroll
                    for (int r = 0; r < 16; ++r) { const float f = crowf(c.tab, r, c.hi); o[0][r] *= f; o[1][r] *= f; } } }
            const float mL = m * cfg::L2E; float ls = 0.f;
#pragma unroll
            for (int r = 0; r < 16; ++r) { s0[r] = __builtin_amdgcn_exp2f(__builtin_fmaf(s0[r], cfg::L2E, -mL)); s1[r] = __builtin_amdgcn_exp2f(__builtin_fmaf(s1[r], cfg::L2E, -mL)); ls += s0[r] + s1[r]; }
            l += ls;
        }
        if (MODE >= 1) {
#pragma unroll
            for (int i = 0; i < 8; ++i) { pk[i] = pg8::cvt_pk_bf16(s0[2 * i], s0[2 * i + 1]); pk[8 + i] = pg8::cvt_pk_bf16(s1[2 * i], s1[2 * i + 1]); }
            pv_tile(o, Vt, pk, c.lane);
        }
        if (j < j_hi) tile_store(c.lds + (cur ^ 1) * BUF_B, kr, vr, c.tid);
        LDS_WAIT(); __syncthreads();
    }
}

template <bool FIRST> DI void merge_branch(const Ctx& c, LAS float* accl, const f32x16 (&o)[2], float fac) {
    tab_publish(c.tab, fac, c.r32, c.hi);
#pragma unroll
    for (int r = 0; r < 16; ++r) { const int q = (r & 3) + 8 * (r >> 2) + 4 * c.hi; const float f = c.tab[q]; LAS float* p = accl + q * 64 + c.r32;
        if (FIRST) { p[0] = o[0][r] * f; p[32] = o[1][r] * f; } else { p[0] += o[0][r] * f; p[32] += o[1][r] * f; } }
}
DI void prompt_unit(const Args& a, int b, int g, int qt, LAS unsigned char* lds_raw, int tid) {
    Ctx c; c.b = b; c.g = g; c.qt = qt; c.tid = tid; c.lane = tid & 63; c.wave = __builtin_amdgcn_readfirstlane(tid >> 6); c.r32 = c.lane & 31; c.hi = c.lane >> 5; c.tq = 8 * c.wave + (c.r32 >> 2);
    c.lds = (LAS char*)lds_raw; LAS char* wreg = c.lds + W_OFF + c.wave * W_BYTES;
    c.ic = (LAS float*)(wreg + W_IC); c.sc = (LAS float*)(wreg + W_SC); c.tab = (LAS float*)(wreg + W_TAB); c.msk = (LAS unsigned*)(wreg + W_MSK);
    const int t0 = 64 * qt, t = t0 + c.tq, rh = c.r32 & 3, row = b * 4096 + t, head = g * 4 + rh;
    const bf16* Q = (const bf16*)(a.ws + cfg::WS_Q); const bf16* KVB = (const bf16*)(a.ws + cfg::WS_KVB);
    const bf16* KC = (const bf16*)(a.ws + cfg::WS_KCP) + (size_t)(b * 2 + g) * 256 * 64; const bf16* VC = (const bf16*)(a.ws + cfg::WS_VCP) + (size_t)(b * 2 + g) * 256 * 64;
#pragma unroll
    for (int i = 0; i < 32; ++i) c.ic[i * 64 + c.lane] = 0.f;
    s16x8 qf[4];
#pragma unroll
    for (int d0 = 0; d0 < 4; ++d0) qf[d0] = *(const s16x8*)(Q + (size_t)row * 512 + head * 64 + 16 * d0 + 8 * c.hi);
    const float* ng = (const float*)(a.ws + cfg::WS_NSAG) + (size_t)row * 32 + head * 3; const float g_cmp = ng[0], g_slc = ng[1], g_win = ng[2];
    f32x16 o[2];
#pragma unroll
    for (int i = 0; i < 16; ++i) { o[0][i] = 0.f; o[1][i] = 0.f; }
    LDS_WAIT();
    const int vis = t >= 31 ? (t - 31) >> 4 : -1;
    { const int vmax = (t0 + 63 - 31) >> 4; int ntc = (vmax + 64) >> 6; ntc = ntc > 4 ? 4 : ntc;
      float m = M_INIT, l = 0.f;
      run_tiles<0>(c, qf, 0, ntc - 1, KC, VC, 64, m, l, o, 0.f, vis, 0u, 0u);
      const float lt = pl32_sum(l); const float linv = lt > 0.f ? 1.0f / lt : 0.f;
      run_tiles<1>(c, qf, 0, ntc - 1, KC, VC, 64, m, l, o, linv, vis, 0u, 0u); }
    unsigned msk_lo, msk_hi;
    { const int tl = c.lane >> 3, sub = c.lane & 7; const LAS float* icr = c.ic + tl * 256; float my[8];
#pragma unroll
      for (int e = 0; e < 8; ++e) { const int j = sub * 8 + e; float imp = 0.f;
#pragma unroll
          for (int mm = -1; mm < 4; ++mm) { const int idx = 4 * j + mm; if (idx >= 0 && idx < 255) imp += icr[idx]; }
          const bool valid = j <= qt, forced = (j == 0) || (j == qt) || (j == qt - 1);
          my[e] = valid ? imp + (forced ? 1e6f : 0.f) : cfg::NEGF; c.sc[tl * 64 + j] = my[e]; }
      LDS_WAIT();
      int rank[8];
#pragma unroll
      for (int e = 0; e < 8; ++e) rank[e] = 0;
      for (int k4 = 0; k4 < 16; ++k4) { const v4f ov = *(const LAS v4f*)(c.sc + tl * 64 + 4 * k4);
#pragma unroll
          for (int kk = 0; kk < 4; ++kk) { const float ovk = ov[kk]; const int k = 4 * k4 + kk;
#pragma unroll
              for (int e = 0; e < 8; ++e) rank[e] += (ovk > my[e] || (ovk == my[e] && k < sub * 8 + e)) ? 1 : 0; } }
      unsigned bits = 0u;
#pragma unroll
      for (int e = 0; e < 8; ++e) bits |= ((sub * 8 + e) <= qt && rank[e] < 16) ? (1u << e) : 0u;
      unsigned lo32 = sub < 4 ? bits << (8 * sub) : 0u, hi32 = sub >= 4 ? bits << (8 * (sub - 4)) : 0u;
#pragma unroll
      for (int x = 1; x < 8; x <<= 1) { lo32 |= (unsigned)__shfl_xor((int)lo32, x); hi32 |= (unsigned)__shfl_xor((int)hi32, x); }
      if (sub == 0) { c.msk[2 * tl] = lo32; c.msk[2 * tl + 1] = hi32; }
      LDS_WAIT();
      msk_lo = c.msk[2 * (c.r32 >> 2)]; msk_hi = c.msk[2 * (c.r32 >> 2) + 1]; }
    LAS float* accl = c.ic;
    merge_branch<true>(c, accl, o, g_cmp);
    {
#pragma unroll
      for (int i = 0; i < 16; ++i) { o[0][i] = 0.f; o[1][i] = 0.f; }
      float m = M_INIT, l = 0.f; const bf16* kg = KVB + (size_t)b * 4096 * 768 + 256 + g * 64;
      run_tiles<2>(c, qf, 0, qt, kg, kg + 128, 768, m, l, o, 0.f, 0, msk_lo, msk_hi);
      const float lt = pl32_sum(l); merge_branch<false>(c, accl, o, lt > 0.f ? g_slc / lt : 0.f); }
    {
#pragma unroll
      for (int i = 0; i < 16; ++i) { o[0][i] = 0.f; o[1][i] = 0.f; }
      float m = M_INIT, l = 0.f; const bf16* kg = KVB + (size_t)b * 4096 * 768 + 512 + g * 64;
      run_tiles<3>(c, qf, qt > 8 ? qt - 8 : 0, qt, kg, kg + 128, 768, m, l, o, 0.f, 0, 0u, 0u);
      const float lt = pl32_sum(l); merge_branch<false>(c, accl, o, lt > 0.f ? g_win / lt : 0.f); }
    LDS_WAIT();
    bf16* O = (bf16*)(a.ws + cfg::WS_ONSA);
#pragma unroll
    for (int r = 0; r < 16; ++r) { const int q = (r & 3) + 8 * (r >> 2) + 4 * c.hi; const size_t orow = (size_t)(b * 4096 + t0 + 8 * c.wave + (q >> 2)) * 512 + (g * 4 + (q & 3)) * 64;
        O[orow + c.r32] = (bf16)f2bf(accl[q * 64 + c.r32]); O[orow + 32 + c.r32] = (bf16)f2bf(accl[q * 64 + 32 + c.r32]); }
    LDS_WAIT();
}
}
__global__ void __launch_bounds__(NWAVES * 64, 2) nsa_hybrid_fwd(Args a) {
    extern __shared__ __attribute__((aligned(16))) unsigned char lds_raw[];
    LAS unsigned char* lds = (LAS unsigned char*)lds_raw;
    const int tid = threadIdx.x, lane = tid & 63, wave = __builtin_amdgcn_readfirstlane(tid >> 6);
    const int G = gridDim.x, gw = blockIdx.x * NWAVES + wave, NGW = G * NWAVES;
    unsigned char* ws = a.ws;
    for (int u = tid; u < (cfg::LDS_BYTES - cfg::LDSCTL_OFF) / 4; u += NWAVES * 64) ((LAS unsigned*)(lds + cfg::LDSCTL_OFF))[u] = 0u;
    __syncthreads();
    volatile LAS unsigned* MISC = (volatile LAS unsigned*)(lds + cfg::MISC_OFF);
    XcdBarrier bar = xcd_barrier_post((unsigned*)(ws + cfg::WS_CTL) + cfg::CW_BAR, MISC + 8);

    bf16* W_in_t = (bf16*)(ws + cfg::WS_WIN_T); bf16* W_pa_t = (bf16*)(ws + cfg::WS_WPA_T); bf16* W_pb_t = (bf16*)(ws + cfg::WS_WPB_T); bf16* W_out_t = (bf16*)(ws + cfg::WS_WOUT_T);
    bf16* W_up_t = (bf16*)(ws + cfg::WS_WUP_T); bf16* W_dn_t = (bf16*)(ws + cfg::WS_WDN_T);
    float* RSTD1 = (float*)(ws + cfg::WS_RSTD1); float* SSV = (float*)(ws + cfg::WS_SSV); float* SS2 = (float*)(ws + cfg::WS_SS2); float* SS3 = (float*)(ws + cfg::WS_SS3); float* NSAG = (float*)(ws + cfg::WS_NSAG);
    bf16* XB = (bf16*)(ws + cfg::WS_XB); bf16* Qb = (bf16*)(ws + cfg::WS_Q); bf16* KVB = (bf16*)(ws + cfg::WS_KVB); bf16* Ub = (bf16*)(ws + cfg::WS_U); bf16* VG = (bf16*)(ws + cfg::WS_VG); bf16* GT = (bf16*)(ws + cfg::WS_GT);
    bf16* ONSA = (bf16*)(ws + cfg::WS_ONSA); bf16* CM = (bf16*)(ws + cfg::WS_CM); float* Tb = (float*)(ws + cfg::WS_T); bf16* MIX = (bf16*)(ws + cfg::WS_MIX);
    float* X1F = (float*)(ws + cfg::WS_X1F); bf16* X1B = (bf16*)(ws + cfg::WS_X1B); bf16* AB = (bf16*)(ws + cfg::WS_AB); bf16* ACT = (bf16*)(ws + cfg::WS_ACT);

    #if (PHMASK >> 0) & 1
    if (a.ph_lo <= 0 && 0 < a.ph_hi) {
    {
        LAS float* scr = (LAS float*)(lds + wave * 16384);
        constexpr int I_IN = 16 * (cfg::INP / 32), I_PA = 8 * 32, I_PB = 8 * 32, I_OUT = 16 * 32, I_UP = 16 * (cfg::UPN / 32), I_DN = (cfg::DFF / 64) * 32;
        constexpr int NITEMS = I_IN + I_PA + I_PB + I_OUT + I_UP + I_DN;
        for (int it = gw; it < NITEMS; it += NGW) { int r = it;
            if (r < I_IN) { transpose_item<1>(a.w_in, 1024, cfg::INC, a.norm_mix, W_in_t, scr, r, cfg::INP / 32, lane); continue; } r -= I_IN;
            if (r < I_PA) { transpose_item<0>(a.w_proj_a, 512, 1024, nullptr, W_pa_t, scr, r, 32, lane); continue; } r -= I_PA;
            if (r < I_PB) { transpose_item<0>(a.w_proj_b, 512, 1024, nullptr, W_pb_t, scr, r, 32, lane); continue; } r -= I_PB;
            if (r < I_OUT) { transpose_item<0>(a.w_out, 1024, 1024, nullptr, W_out_t, scr, r, 32, lane); continue; } r -= I_OUT;
            if (r < I_UP) { transpose_item<0>(a.w_up, 1024, cfg::UPN, a.norm_ffn, W_up_t, scr, r, cfg::UPN / 32, lane); continue; } r -= I_UP;
            transpose_item<0>(a.w_down, cfg::DFF, 1024, nullptr, W_dn_t, scr, r, 32, lane); }
        for (int m = gw; m < cfg::MPAD; m += NGW) {
            const float* xr = m < cfg::MP ? a.x_prompt + (size_t)m * 1024 : (m < cfg::MROWS ? a.x_sample + (size_t)(m - cfg::MP) * 1024 : nullptr);
            v4f v[4]; float s = 0.f;
#pragma unroll
            for (int j = 0; j < 4; ++j) { v[j] = xr ? *(const v4f*)(xr + j * 256 + lane * 4) : (v4f){0.f, 0.f, 0.f, 0.f}; s += (v[j].x * v[j].x + v[j].y * v[j].y) + (v[j].z * v[j].z + v[j].w * v[j].w); }
            s = wave_sum(s);
            if (lane == 0) RSTD1[m] = xr ? 1.0f / sqrtf(s * (1.0f / 1024.0f) + cfg::EPS) : 0.f;
#pragma unroll
            for (int j = 0; j < 4; ++j) { v2u o; o.x = pk2(v[j].x, v[j].y); o.y = pk2(v[j].z, v[j].w); *(v2u*)(XB + (size_t)m * 1024 + j * 256 + lane * 4) = o; }
            if (m >= cfg::MROWS) {
                v4u z = (v4u){0u, 0u, 0u, 0u}; *(v4u*)(ONSA + (size_t)m * 512 + lane * 8) = z; *(v4u*)(CM + (size_t)m * 512 + lane * 8) = z; }
        }
        { const size_t n4 = (size_t)cfg::DB * 511 * 64;
          for (size_t i = (size_t)blockIdx.x * 512 + tid; i < n4; i += (size_t)G * 512) { const size_t bb = i / (511 * 64), rem = i % (511 * 64);
              ((v4f*)(a.out + cfg::OFF_WIN_S))[bb * 512 * 64 + rem] = ((const v4f*)a.cache_win)[bb * 512 * 64 + 64 + rem]; }
          for (int i = blockIdx.x * 512 + tid; i < cfg::DB * cfg::DFF; i += G * 512) { const int bb = i / cfg::DFF, f = i % cfg::DFF; a.out[cfg::OFF_CONV_S + (size_t)bb * 2 * cfg::DFF + f] = a.state_conv[(size_t)bb * 2 * cfg::DFF + cfg::DFF + f]; } }
        { bf16* W1T = (bf16*)(ws + cfg::WS_W1T);
          for (int it = gw; it < 4 * 64; it += NGW) { const int kr = it >> 6; transpose_item<0>(a.cmp_w1 + (size_t)kr * 1024 * 128, 1024, 128, nullptr, W1T + (size_t)kr * 128 * 1024, scr, it & 63, 4, lane); }
          bf16* W2F = (bf16*)(ws + cfg::WS_W2F);
          for (int e = blockIdx.x * 512 + tid; e < 2 * 8 * 2 * 64 * 8; e += G * 512) { const int j = e & 7, ln = (e >> 3) & 63, cb = (e >> 9) & 1, ks = (e >> 10) & 7, kv = e >> 13;
              W2F[e] = (bf16)f2bf(a.cmp_w2[(size_t)kv * 128 * 64 + (16 * ks + 8 * (ln >> 5) + j) * 64 + 32 * cb + (ln & 31)]); }
          float* PB = (float*)(ws + cfg::WS_PB);
          for (int it = gw; it < 64; it += NGW) { const int kv = it >> 5, c = it & 31; float s0 = 0.f, s1 = 0.f;
#pragma unroll 8
              for (int i = 0; i < 64; ++i) { const int k = c * 64 + i; const float pv = a.cmp_pe[kv * 2048 + k]; s0 += pv * a.cmp_w1[((size_t)kv * 2048 + k) * 128 + lane]; s1 += pv * a.cmp_w1[((size_t)kv * 2048 + k) * 128 + 64 + lane]; }
              PB[(kv * 32 + c) * 128 + lane] = s0; PB[(kv * 32 + c) * 128 + 64 + lane] = s1; } }
        { bf16* CB = (bf16*)(ws + cfg::WS_CB); const int kvg = lane >> 4, d0 = (lane & 15) * 4;
          for (int r0 = gw * 4; r0 < cfg::DB * cfg::PAST; r0 += NGW * 4) { v4f v[4];
#pragma unroll
              for (int i = 0; i < 4; ++i) { const int r = r0 + i, b = r >> 14, pos = r & 16383; const int phys = a.page_table[b * cfg::NPAGES + (pos >> 7)];
                  v[i] = *(const v4f*)(a.cache_cmp + ((size_t)phys * 128 + (pos & 127)) * 256 + lane * 4); }
#pragma unroll
              for (int i = 0; i < 4; ++i) { const int r = r0 + i, b = r >> 14, pos = r & 16383; v2u o; o.x = pg8::cvt_pk_bf16(v[i].x, v[i].y); o.y = pg8::cvt_pk_bf16(v[i].z, v[i].w);
                  *(v2u*)(CB + (((size_t)((kvg >> 1) * 32 + b) * 2 + (kvg & 1)) * 16384 + pos) * 64 + d0) = o; } } }
    }
    if (1 < a.ph_hi) xcd_barrier(bar);
    }

    #endif
#if (PHMASK >> 1) & 1
    if (a.ph_lo <= 1 && 1 < a.ph_hi) {
    { LAS float* biasL = (LAS float*)(lds + cfg::BIAS_OFF); load_cmp_bias(a, biasL, tid);
      pg8::Gemm g{XB, W_in_t, cfg::MPAD, cfg::INP, 1024}; MixOrder S; S.s1.init(cfg::MPAD, cfg::INP, G, (int)blockIdx.x, XB, W_in_t, 1024); S.G = G; S.c = (int)blockIdx.x;
      S.CB = (const char*)(ws + cfg::WS_CB); S.W1T = (const char*)(ws + cfg::WS_W1T);
      pg8::EpiMix E{pg8::EpiIn{RSTD1, Qb, KVB, Ub, VG, SSV, GT, NSAG, a.out, (bf16*)(ws + cfg::WS_CBP)}, pg8::EpiP{(bf16*)(ws + cfg::WS_PS), (size_t)65536 * 256, biasL}};
      pg8::gemm_phase<pg8::EpiMix, MixOrder, true, true>(lds, g, S, E); }
    if (2 < a.ph_hi) xcd_barrier(bar);
    }

    #endif
#if (PHMASK >> 2) & 1
    if (a.ph_lo <= 2 && 2 < a.ph_hi) {
    {
        const bf16* W2F = (const bf16*)(ws + cfg::WS_W2F);
        if (blockIdx.x < 16) {
            const int kv = blockIdx.x >> 3, bg = blockIdx.x & 7; LAS float* biasL = (LAS float*)(lds + cfg::BIAS_OFF); load_cmp_bias(a, biasL, tid);
            bf16* PP = (bf16*)(ws + cfg::WS_PP);
            OneOrder S; S.u0.pm = bg; S.u0.pn = 0; S.u0.kind = 1 + kv; S.u0.a = (const char*)(ws + cfg::WS_CBP) + (size_t)(kv * 8 + bg) * 4096 * 64 * 2; S.u0.b = (const char*)(ws + cfg::WS_W1T) + (size_t)kv * 256 * 1024 * 2;
            pg8::Gemm g{nullptr, nullptr, 256, 256, 1024}; pg8::EpiP E{PP, (size_t)2048 * 256, biasL};
            pg8::gemm_phase<pg8::EpiP, OneOrder, false, true>(lds, g, S, E);
            asm volatile("s_waitcnt vmcnt(0)" ::: "memory"); __syncthreads();
            cmp_stage2_tile<bf16>(PP + ((size_t)kv * 2048 + bg * 256) * 256, 256, wave * 32, W2F + (size_t)kv * 8192, (bf16*)(ws + (kv ? cfg::WS_VCP : cfg::WS_KCP)) + (size_t)bg * 256 * 64, 255, lane);
        } else {
            const int gw2 = (blockIdx.x - 16) * NWAVES + wave, NGW2 = (G - 16) * NWAVES;
            for (int task = gw2; task < 2 * 64 * 32; task += NGW2) { const int kv = task >> 11, bg = (task >> 5) & 63, tl = task & 31;
                cmp_stage2_tile<float>((const bf16*)(ws + cfg::WS_PS) + ((size_t)kv * 65536 + bg * 1024) * 256, 1024, tl * 32, W2F + (size_t)kv * 8192, (float*)(ws + (kv ? cfg::WS_VCS : cfg::WS_KCS)) + (size_t)bg * 1024 * 64, 1023, lane); }
            for (int task = gw2; task < 4 * 32 * 4 * 16; task += NGW2) chunkmix_task(a, task, lane);
        }
        for (int i = gw; i < 4 * 128 + cfg::DB; i += NGW) {
            const bool smp = i >= 512; const int row = smp ? cfg::MP + (i - 512) : (i >> 7) * 4096 + 3968 + (i & 127);
            float* dst = smp ? a.out + cfg::OFF_V_S + (size_t)(i - 512) * 512 : a.out + cfg::OFF_V_P + (size_t)i * 512;
            const float rs = rstd_v(SSV, row); float vn[8]; load8(VG + (size_t)row * 512 + lane * 8, vn);
#pragma unroll
            for (int j = 0; j < 8; ++j) vn[j] = vn[j] * rs * a.gmlp_norm[lane * 8 + j];
            *(v4f*)(dst + lane * 8) = (v4f){vn[0], vn[1], vn[2], vn[3]}; *(v4f*)(dst + lane * 8 + 4) = (v4f){vn[4], vn[5], vn[6], vn[7]};
            if (smp) { const int gi = lane >> 4; const float w00 = a.gmlp_ws[(size_t)gi * 128 * 128], bs = a.gmlp_bs[gi * 128]; float uu[8]; load8(Ub + (size_t)row * 512 + lane * 8, uu);
                v4u o; o.x = pk2(uu[0] * (w00 * vn[0] + bs), uu[1] * (w00 * vn[1] + bs)); o.y = pk2(uu[2] * (w00 * vn[2] + bs), uu[3] * (w00 * vn[3] + bs));
                o.z = pk2(uu[4] * (w00 * vn[4] + bs), uu[5] * (w00 * vn[5] + bs)); o.w = pk2(uu[6] * (w00 * vn[6] + bs), uu[7] * (w00 * vn[7] + bs));
                *(v4u*)(CM + (size_t)row * 512 + lane * 8) = o; }
        }
    }
    if (3 < a.ph_hi) xcd_barrier(bar);
    }

    #endif
#if (PHMASK >> 3) & 1
    if (a.ph_lo <= 3 && 3 < a.ph_hi) {
    {
        for (int pi = blockIdx.x; pi < 256; pi += G) { const int bgi = pi >> 5, p = pi & 31;
            for (int hh = 0; hh < 2; ++hh) att::prompt_unit(a, bgi >> 1, bgi & 1, hh ? p : 63 - p, lds, tid); }
        __syncthreads();
        LAS float* scr = (LAS float*)(lds + wave * 16384);
        for (int task = gw; task < 64; task += NGW) attn_sample_task(a, task, scr, lane);
    }
    if (4 < a.ph_hi) xcd_barrier(bar);
    }

    #endif
#if (PHMASK >> 4) & 1
    if (a.ph_lo <= 4 && 4 < a.ph_hi) {
    { pg8::StaticOrder S;
      { S.init(cfg::MPAD, 1024, G, (int)blockIdx.x, ONSA, W_pa_t, 512); pg8::Gemm g{ONSA, W_pa_t, cfg::MPAD, 1024, 512}; pg8::EpiPA E{GT, Tb}; pg8::gemm_phase<pg8::EpiPA, pg8::StaticOrder, true, true>(lds, g, S, E); }
      asm volatile("s_waitcnt vmcnt(0)" ::: "memory"); __syncthreads();
      { S.init(cfg::MPAD, 1024, G, (int)blockIdx.x, CM, W_pb_t, 512); pg8::Gemm g{CM, W_pb_t, cfg::MPAD, 1024, 512}; pg8::EpiPB E{GT, Tb, MIX}; pg8::gemm_phase<pg8::EpiPB, pg8::StaticOrder, true, true>(lds, g, S, E); } }
    if (5 < a.ph_hi) xcd_barrier(bar);
    }

    #endif
#if (PHMASK >> 5) & 1
    if (a.ph_lo <= 5 && 5 < a.ph_hi) {
    { pg8::Gemm g{MIX, W_out_t, cfg::MPAD, 1024, 1024}; pg8::StaticOrder S; S.init(cfg::MPAD, 1024, G, (int)blockIdx.x, MIX, W_out_t, 1024);
      pg8::EpiOut E{a.x_prompt, a.x_sample, X1F, X1B, SS2}; pg8::gemm_phase<pg8::EpiOut, pg8::StaticOrder, true, true>(lds, g, S, E); }
    if (6 < a.ph_hi) xcd_barrier(bar);
    }

    #endif
#if (PHMASK >> 6) & 1
    if (a.ph_lo <= 6 && 6 < a.ph_hi) {
    { pg8::Gemm g{X1B, W_up_t, cfg::MPAD, cfg::UPN, 1024}; pg8::StaticOrder S; S.init(cfg::MPAD, cfg::UPN, G, (int)blockIdx.x, X1B, W_up_t, 1024);
      pg8::EpiUp E{SS2, AB, a.out}; pg8::gemm_phase<pg8::EpiUp, pg8::StaticOrder, true, true>(lds, g, S, E); }
    if (7 < a.ph_hi) xcd_barrier(bar);
    }

    #endif
#if (PHMASK >> 7) & 1
    if (a.ph_lo <= 7 && 7 < a.ph_hi) {
    {
        constexpr int FV = cfg::DFF / 8;
        for (size_t i = (size_t)blockIdx.x * 512 + tid; i < (size_t)cfg::MPAD * FV; i += (size_t)G * 512) {
            const int row = (int)(i / FV), f = (int)(i % FV) * 8;
            float a0[8], a1[8], a2[8], bb[8], c[8];
            load8(AB + (size_t)row * cfg::UPN + f, a2); load8(AB + (size_t)row * cfg::UPN + cfg::DFF + f, bb);
            if (row < cfg::MP) { const int t = row & 4095;
                if (t >= 1) load8(AB + (size_t)(row - 1) * cfg::UPN + f, a1); else {
#pragma unroll
                    for (int j = 0; j < 8; ++j) a1[j] = 0.f; }
                if (t >= 2) load8(AB + (size_t)(row - 2) * cfg::UPN + f, a0); else {
#pragma unroll
                    for (int j = 0; j < 8; ++j) a0[j] = 0.f; } }
            else if (row < cfg::MROWS) { const float* sp = a.state_conv + (size_t)(row - cfg::MP) * 2 * cfg::DFF + f; load8(sp, a0); load8(sp + cfg::DFF, a1); }
            else {
#pragma unroll
                for (int j = 0; j < 8; ++j) { a0[j] = 0.f; a1[j] = 0.f; } }
            float w0[8], w1[8], w2[8], cb[8]; load8(a.conv_w + f, w0); load8(a.conv_w + cfg::DFF + f, w1); load8(a.conv_w + 2 * cfg::DFF + f, w2); load8(a.conv_b + f, cb);
#pragma unroll
            for (int j = 0; j < 8; ++j) c[j] = gelu_tanh(cb[j] + a0[j] * w0[j] + a1[j] * w1[j] + a2[j] * w2[j]) * bb[j];
            v4u o; o.x = pk2(c[0], c[1]); o.y = pk2(c[2], c[3]); o.z = pk2(c[4], c[5]); o.w = pk2(c[6], c[7]);
            *(v4u*)(ACT + (size_t)row * cfg::DFF + f) = o;
        }
    }
    if (8 < a.ph_hi) xcd_barrier(bar);
    }

    #endif
#if (PHMASK >> 8) & 1
    if (a.ph_lo <= 8 && 8 < a.ph_hi) {
    { pg8::Gemm g{ACT, W_dn_t, cfg::MPAD, 1024, cfg::DFF}; pg8::StaticOrder S; S.init(cfg::MPAD, 1024, G, (int)blockIdx.x, ACT, W_dn_t, cfg::DFF);
      pg8::EpiDown E{X1F, a.out, SS3}; pg8::gemm_phase<pg8::EpiDown, pg8::StaticOrder, true, true>(lds, g, S, E); }
    if (9 < a.ph_hi) xcd_barrier(bar);
    }

    #endif
#if (PHMASK >> 9) & 1
    if (a.ph_lo <= 9 && 9 < a.ph_hi) {
#ifdef DUMP
    for (int m = gw; m < cfg::MROWS; m += NGW) { float* yr = a.out + (size_t)m * 1024;
        if (DUMP == 4) continue;
#pragma unroll
        for (int j = 0; j < 4; ++j) { const int c = j * 256 + lane * 4; v4f v;
            if (DUMP == 1) { v.x = bf2f(MIX[(size_t)m * 1024 + c]); v.y = bf2f(MIX[(size_t)m * 1024 + c + 1]); v.z = bf2f(MIX[(size_t)m * 1024 + c + 2]); v.w = bf2f(MIX[(size_t)m * 1024 + c + 3]); }
            else if (DUMP == 2) v = *(const v4f*)(X1F + (size_t)m * 1024 + c);
            else if (DUMP == 3) { v.x = bf2f(ACT[(size_t)m * 2816 + c]); v.y = bf2f(ACT[(size_t)m * 2816 + c + 1]); v.z = bf2f(ACT[(size_t)m * 2816 + c + 2]); v.w = bf2f(ACT[(size_t)m * 2816 + c + 3]); }
            else { v.x = bf2f(AB[(size_t)m * 5632 + c]); v.y = bf2f(AB[(size_t)m * 5632 + c + 1]); v.z = bf2f(AB[(size_t)m * 5632 + c + 2]); v.w = bf2f(AB[(size_t)m * 5632 + c + 3]); }
            *(v4f*)(yr + c) = v; } }
#else
    for (int m = gw; m < cfg::MROWS; m += NGW) { const float rs = rstd16(SS3, m); float* yr = a.out + (size_t)m * 1024;
#pragma unroll
        for (int j = 0; j < 4; ++j) { const v4f v = *(const v4f*)(yr + j * 256 + lane * 4), gn = *(const v4f*)(a.norm_final + j * 256 + lane * 4); *(v4f*)(yr + j * 256 + lane * 4) = v * rs * gn; } }
#endif
    }
#endif
}

extern "C" void kernel_launch(void* const* d_in, const int* in_sizes, int n_in, void* d_out, int out_size, void* d_ws, size_t ws_size, hipStream_t stream) {
    static int grid = 0;
    if (grid == 0) {
        if (n_in != 25 || in_sizes[0] != cfg::MP * 1024 || (size_t)out_size != cfg::OUT_TOTAL || ws_size < cfg::WS_END) {
            fprintf(stderr, "kernel_launch: unexpected shapes (n_in %d, in0 %d, out %d, ws %zu); nothing launched\n", n_in, n_in > 0 ? in_sizes[0] : -1, out_size, ws_size); grid = -1; return; }
        int dev = 0, cus = 0, per_cu = 0;
        if (hipGetDevice(&dev) != hipSuccess || hipDeviceGetAttribute(&cus, hipDeviceAttributeMultiprocessorCount, dev) != hipSuccess) { grid = -1; return; }
        if (hipFuncSetAttribute((const void*)nsa_hybrid_fwd, hipFuncAttributeMaxDynamicSharedMemorySize, cfg::LDS_BYTES) != hipSuccess) { fprintf(stderr, "kernel_launch: hipFuncSetAttribute failed\n"); grid = -1; return; }
        if (hipOccupancyMaxActiveBlocksPerMultiprocessor(&per_cu, (const void*)nsa_hybrid_fwd, NWAVES * 64, cfg::LDS_BYTES) != hipSuccess || per_cu < 1)
            fprintf(stderr, "kernel_launch: note: occupancy query reports %d workgroups per CU\n", per_cu);
        (void)hipGetLastError();
        grid = cus;
    }
    if (grid < 0) return;
    if (hipMemsetAsync((char*)d_ws + cfg::WS_CTL, 0, cfg::CTL_ZERO_BYTES, stream) != hipSuccess) return;
    Args a{};
    a.x_prompt = (const float*)d_in[0]; a.x_sample = (const float*)d_in[1]; a.cache_cmp = (const float*)d_in[2]; a.cache_slc = (const float*)d_in[3]; a.cache_win = (const float*)d_in[4];
    a.state_conv = (const float*)d_in[5]; a.page_table = (const int*)d_in[6]; a.norm_mix = (const float*)d_in[7]; a.w_in = (const float*)d_in[8]; a.cmp_pe = (const float*)d_in[9];
    a.cmp_w1 = (const float*)d_in[10]; a.cmp_b1 = (const float*)d_in[11]; a.cmp_w2 = (const float*)d_in[12]; a.gmlp_norm = (const float*)d_in[13]; a.gmlp_ws = (const float*)d_in[14];
    a.gmlp_bs = (const float*)d_in[15]; a.w_proj_a = (const float*)d_in[16]; a.w_proj_b = (const float*)d_in[17]; a.w_out = (const float*)d_in[18]; a.norm_ffn = (const float*)d_in[19];
    a.w_up = (const float*)d_in[20]; a.conv_w = (const float*)d_in[21]; a.conv_b = (const float*)d_in[22]; a.w_down = (const float*)d_in[23]; a.norm_final = (const float*)d_in[24];
    a.out = (float*)d_out; a.ws = (unsigned char*)d_ws;
    for (int li = 0; li < MK_N_LAUNCHES; ++li) {
        a.ph_lo = (MK_N_LAUNCHES == 1) ? 0 : li; a.ph_hi = (MK_N_LAUNCHES == 1) ? 10 : li + 1;
        hipLaunchKernelGGL(nsa_hybrid_fwd, dim3(grid), dim3(NWAVES * 64), cfg::LDS_BYTES, stream, a);
        const hipError_t le = hipPeekAtLastError();
        if (le != hipSuccess) { fprintf(stderr, "kernel_launch: launch failed: %s\n", hipGetErrorName(le)); break; }
    }
}
```

```cpp
#include <hip/hip_runtime.h>
#include <cstdio>
#include <cstdint>

namespace cfg {
constexpr int DM = 1024, BATCH = 4, SEQ = 4096, MP = BATCH * SEQ, DB = 32, MROWS = MP + DB, MPAD = 16640;
constexpr int PAST = 16384, PAGE = 128, NPAGES = PAST / PAGE;
constexpr int NH = 8, HD = 64, NKV = 2;
constexpr int INC = 4376, INP = 4608;
constexpr int GW = 512, DFF = 2816, UPN = 2 * DFF;
constexpr float EPS = 1e-6f, NEGF = -1e30f, L2E = 1.4426950408889634f;
constexpr size_t OFF_YP = 0, OFF_YS = 16777216, OFF_CMP_P = 16809984, OFF_SLC_P = 21004288, OFF_WIN_P = 25198592, OFF_V_P = 25722880, OFF_CONV_P = 25985024,
                 OFF_CMP_S = 26007552, OFF_SLC_S = 26015744, OFF_WIN_S = 26023936, OFF_V_S = 30218240, OFF_CONV_S = 30234624, OUT_TOTAL = 30414848;
constexpr size_t MiB = 1u << 20;
constexpr size_t WS_CTL = 0, CTL_ZERO_BYTES = 1 * MiB;
constexpr size_t WS_WIN_T = 2 * MiB, WS_WPA_T = 12 * MiB, WS_WPB_T = 13 * MiB, WS_WOUT_T = 14 * MiB, WS_WUP_T = 16 * MiB, WS_WDN_T = 28 * MiB;
constexpr size_t WS_RSTD1 = 34 * MiB, WS_SSV = 35 * MiB, WS_SS2 = 36 * MiB, WS_SS3 = 38 * MiB, WS_NSAG = 40 * MiB, WS_KCP = 43 * MiB, WS_VCP = 44 * MiB;
constexpr size_t WS_KCS = 48 * MiB, WS_VCS = 64 * MiB;
constexpr size_t WS_XB = 80 * MiB, WS_Q = 113 * MiB, WS_KVB = 130 * MiB, WS_U = 155 * MiB, WS_VG = 172 * MiB, WS_GT = 189 * MiB, WS_ONSA = 254 * MiB, WS_CM = 271 * MiB;
constexpr size_t WS_T = 288 * MiB, WS_MIX = 353 * MiB, WS_X1F = 386 * MiB, WS_X1B = 451 * MiB, WS_AB = 484 * MiB, WS_ACT = 663 * MiB;
constexpr size_t WS_W1T = 45 * MiB, WS_W2F = 46 * MiB, WS_PB = 46 * MiB + 512 * 1024, WS_WTRIL = 47 * MiB;
constexpr size_t WS_CB = 753 * MiB, WS_CBP = 1009 * MiB, WS_PS = 1017 * MiB, WS_PP = 1081 * MiB, WS_END = 1083 * MiB;
constexpr int CW_BAR = 4096;
constexpr int RING_BYTES = 131072, LDSCTL_OFF = RING_BYTES, MISC_OFF = LDSCTL_OFF + 320, BIAS_OFF = LDSCTL_OFF + 1024, LDS_BYTES = 147456;
}

#define GAS __attribute__((address_space(1)))
#define LAS __attribute__((address_space(3)))
#define DI __device__ __forceinline__
typedef unsigned short bf16;
typedef GAS unsigned gu32;
typedef unsigned v4u __attribute__((ext_vector_type(4)));
typedef unsigned v2u __attribute__((ext_vector_type(2)));
typedef float v4f __attribute__((ext_vector_type(4)));

struct Args {
    const float* x_prompt; const float* x_sample; const float* cache_cmp; const float* cache_slc; const float* cache_win; const float* state_conv;
    const int* page_table; const float* norm_mix; const float* w_in; const float* cmp_pe; const float* cmp_w1; const float* cmp_b1; const float* cmp_w2;
    const float* gmlp_norm; const float* gmlp_ws; const float* gmlp_bs; const float* w_proj_a; const float* w_proj_b; const float* w_out; const float* norm_ffn;
    const float* w_up; const float* conv_w; const float* conv_b; const float* w_down; const float* norm_final;
    float* out; unsigned char* ws;
    int ph_lo, ph_hi;
};

DI float bf2f(bf16 b) { return __uint_as_float(((unsigned)b) << 16); }
DI unsigned f2bf(float f) { unsigned u = __float_as_uint(f); return (u + 0x7fffu + ((u >> 16) & 1u)) >> 16; }
DI unsigned pk2(float lo, float hi) { return f2bf(lo) | (f2bf(hi) << 16); }
DI float fast_sigmoid(float x) { return __builtin_amdgcn_rcpf(1.0f + __builtin_amdgcn_exp2f(-1.4426950408889634f * x)); }
DI float gelu_tanh(float x) { const float u = x * (1.0f + 0.044715f * x * x); return x * __builtin_amdgcn_rcpf(1.0f + __builtin_amdgcn_exp2f(-2.302208198f * u)); }
DI float wave_sum(float v) {
#pragma unroll
    for (int o = 1; o < 64; o <<= 1) v += __shfl_xor(v, o);
    return v;
}
DI float wave_max(float v) {
#pragma unroll
    for (int o = 1; o < 64; o <<= 1) v = fmaxf(v, __shfl_xor(v, o));
    return v;
}
namespace pg8 {
#define PG8_LAS __attribute__((address_space(3)))
typedef unsigned short bf16_t;
typedef short bf16x8 __attribute__((ext_vector_type(8)));
typedef float f32x4 __attribute__((ext_vector_type(4)));
typedef unsigned u32x4 __attribute__((ext_vector_type(4)));
constexpr int BM = 256, BK = 64, HALF = 128, HTB = HALF * BK * 2  , STAGE_BYTES = 8 * HTB, NXCD = 8, WGM = 8;

__host__ __device__ __forceinline__ int lds_byte(int r, int c) { const int st = (r >> 4) * 2 + (c >> 5), rr = r & 15, cc = c & 31, ob = rr * 64 + cc * 2; return st * 1024 + (ob ^ (((ob >> 9) & 1) << 5)); }
__host__ __device__ __forceinline__ void stage_rc(int b, int& R, int& C) { const int st = b / 1024, sb = b % 1024, swz = sb ^ (((sb >> 9) & 1) << 5); R = (st >> 1) * 16 + swz / 64; C = (st & 1) * 32 + (swz % 64) / 2; }
__host__ __device__ __forceinline__ int perm32(int rho) { const int n = rho >> 4, i = rho & 15; return 8 * (i >> 2) + 4 * n + (i & 3); }

struct Unit { int pm, pn, kind; const char* a; const char* b; };
struct Gemm { const bf16_t* A; const bf16_t* Bt; int M, N, K; };

struct StaticOrder {
    int nM, nN, nwg, G, c; const char* A; const char* Bt; size_t tstep;
    __host__ __device__ void init(int M, int N, int G_, int c_, const void* A_ = nullptr, const void* Bt_ = nullptr, int K_ = 0) { nM = M / BM; nN = N / BM; nwg = nM * nN; G = G_; c = c_; A = (const char*)A_; Bt = (const char*)Bt_; tstep = (size_t)BM * K_ * 2; }
    __host__ __device__ bool next(int i, Unit& u) const {
        const long L = (long)i * G + c; if (L >= nwg) return false;
        return unit_of((int)L, u);
    }
    __host__ __device__ bool unit_of(int L, Unit& u) const {
        int wgid = L; { const int q = nwg / NXCD, r = nwg % NXCD, xcd = wgid % NXCD, off = wgid / NXCD; wgid = (xcd < r ? xcd * (q + 1) : r * (q + 1) + (xcd - r) * q) + off; }
        const int nig = WGM * nN, gid = wgid / nig, fm = gid * WGM, gsz = (nM - fm) < WGM ? (nM - fm) : WGM;
        u.pm = fm + ((wgid % nig) % gsz); u.pn = (wgid % nig) / gsz; u.kind = 0; u.a = A + (size_t)u.pm * tstep; u.b = Bt + (size_t)u.pn * tstep; return true;
    }
    __device__ __forceinline__ void a_ready(const Unit&) const {}
    __device__ __forceinline__ void done(const Unit&) const {}
};

typedef float f32x2c_t __attribute__((ext_vector_type(2))); typedef __bf16 bf16x2c_t __attribute__((ext_vector_type(2)));
__device__ __forceinline__ unsigned cvt_pk_bf16(float lo, float hi) { f32x2c_t v = {lo, hi}; bf16x2c_t b = __builtin_convertvector(v, bf16x2c_t); return __builtin_bit_cast(unsigned, b); }
typedef unsigned u32x2 __attribute__((ext_vector_type(2)));
__device__ __forceinline__ u32x4 pack8(const f32x4& v0, const f32x4& v1) { u32x4 w; w.x = cvt_pk_bf16(v0[0], v0[1]); w.y = cvt_pk_bf16(v0[2], v0[3]); w.z = cvt_pk_bf16(v1[0], v1[1]); w.w = cvt_pk_bf16(v1[2], v1[3]); return w; }
__device__ __forceinline__ f32x4 sig4(const f32x4& v) { return (f32x4){fast_sigmoid(v[0]), fast_sigmoid(v[1]), fast_sigmoid(v[2]), fast_sigmoid(v[3])}; }
__device__ __forceinline__ f32x4 gelu4(const f32x4& v) { return (f32x4){gelu_tanh(v[0]), gelu_tanh(v[1]), gelu_tanh(v[2]), gelu_tanh(v[3])}; }
__device__ __forceinline__ float sq4(const f32x4& v) { return (v[0] * v[0] + v[1] * v[1]) + (v[2] * v[2] + v[3] * v[3]); }

struct EpiIn {
    static constexpr bool PERM = true, AFTER_DRAIN = false;
    const float* rstd; bf16_t* Q; bf16_t* KVB; bf16_t* U; bf16_t* VG; float* SSV; bf16_t* GT; float* NSAG; float* out; bf16_t* CBP;
    __device__ __forceinline__ void operator()(const f32x4 (&acc)[2][2][4][2], const Unit& u, int wr, int wc, int fr, int fq) const {
        const int row0 = u.pm * BM + wr * 64 + fr, cl0 = wc * 32 + 8 * fq, pn = u.pn;
#pragma unroll
        for (int ai = 0; ai < 2; ++ai)
#pragma unroll
            for (int m = 0; m < 4; ++m) {
                const int row = row0 + ai * HALF + m * 16; const float rs = rstd[row];
                if (pn < 2) {
                    const float s = rs * 0.125f;
#pragma unroll
                    for (int bj = 0; bj < 2; ++bj) *(u32x4*)(Q + (size_t)row * 512 + pn * 256 + bj * HALF + cl0) = pack8(acc[ai][bj][m][0] * s, acc[ai][bj][m][1] * s);
                } else if (pn < 5) {
                    float* dst = nullptr;
                    if (pn == 2) dst = row < cfg::MP ? out + cfg::OFF_CMP_P + (size_t)row * 256 : (row < cfg::MROWS ? out + cfg::OFF_CMP_S + (size_t)(row - cfg::MP) * 256 : nullptr);
                    else if (pn == 3) dst = row < cfg::MP ? out + cfg::OFF_SLC_P + (size_t)row * 256 : (row < cfg::MROWS ? out + cfg::OFF_SLC_S + (size_t)(row - cfg::MP) * 256 : nullptr);
                    else { if (row < cfg::MP) { const int t = row & 4095, b = row >> 12; if (t >= 3584) dst = out + cfg::OFF_WIN_P + (size_t)(b * 512 + (t - 3584)) * 256; }
                           else if (row < cfg::MROWS) dst = out + cfg::OFF_WIN_S + ((size_t)(row - cfg::MP) * 512 + 511) * 256; }
#pragma unroll
                    for (int bj = 0; bj < 2; ++bj) { const f32x4 v0 = acc[ai][bj][m][0] * rs, v1 = acc[ai][bj][m][1] * rs; const int cl = bj * HALF + cl0;
                        const u32x4 pk = pack8(v0, v1); *(u32x4*)(KVB + (size_t)row * 768 + (pn - 2) * 256 + cl) = pk;
                        if (pn == 2 && row < cfg::MP) *(u32x4*)(CBP + ((size_t)((bj * 4 + (row >> 12)) * 2 + (cl0 >> 6)) * 4096 + (row & 4095)) * 64 + (cl0 & 63)) = pk;
                        if (dst) { *(f32x4*)(dst + cl) = v0; *(f32x4*)(dst + cl + 4) = v1; } }
                } else if (pn < 7) {
#pragma unroll
                    for (int bj = 0; bj < 2; ++bj) *(u32x4*)(U + (size_t)row * 512 + (pn - 5) * 256 + bj * HALF + cl0) = pack8(gelu4(acc[ai][bj][m][0] * rs), gelu4(acc[ai][bj][m][1] * rs));
                } else if (pn < 9) {
                    float ss = 0.f;
#pragma unroll
                    for (int bj = 0; bj < 2; ++bj) { const f32x4 v0 = gelu4(acc[ai][bj][m][0] * rs), v1 = gelu4(acc[ai][bj][m][1] * rs); ss += sq4(v0) + sq4(v1);
                        *(u32x4*)(VG + (size_t)row * 512 + (pn - 7) * 256 + bj * HALF + cl0) = pack8(v0, v1); }
                    ss += __shfl_xor(ss, 16); ss += __shfl_xor(ss, 32);
                    if (fq == 0) SSV[(size_t)row * 8 + (pn - 7) * 4 + wc] = ss;
                } else if (pn < 17) {
#pragma unroll
                    for (int bj = 0; bj < 2; ++bj) *(u32x4*)(GT + (size_t)row * 2048 + (pn - 9) * 256 + bj * HALF + cl0) = pack8(sig4(acc[ai][bj][m][0] * rs), sig4(acc[ai][bj][m][1] * rs));
                } else {
                    if (wc == 0 && fq < 3) { float* d = NSAG + (size_t)row * 32 + 8 * fq; *(f32x4*)d = sig4(acc[ai][0][m][0] * rs); *(f32x4*)(d + 4) = sig4(acc[ai][0][m][1] * rs); }
                }
            }
    }
};
struct EpiP {
    static constexpr bool PERM = true, AFTER_DRAIN = false;
    bf16_t* P; size_t kv_stride; const PG8_LAS float* biasL;
    __device__ __forceinline__ void operator()(const f32x4 (&acc)[2][2][4][2], const Unit& u, int wr, int wc, int fr, int fq) const {
        const int kv = u.kind - 1, row0 = u.pm * BM + wr * 64 + fr, cl0 = wc * 32 + 8 * fq;
        const f32x4 b0 = *(const PG8_LAS f32x4*)(biasL + kv * 128 + cl0), b1 = *(const PG8_LAS f32x4*)(biasL + kv * 128 + cl0 + 4);
        bf16_t* Pk = P + (size_t)kv * kv_stride;
#pragma unroll
        for (int ai = 0; ai < 2; ++ai)
#pragma unroll
            for (int m = 0; m < 4; ++m) { bf16_t* pr = Pk + (size_t)(row0 + ai * HALF + m * 16) * 256 + cl0;
                *(u32x4*)pr = pack8(acc[ai][0][m][0] + b0, acc[ai][0][m][1] + b1); *(u32x4*)(pr + HALF) = pack8(acc[ai][1][m][0], acc[ai][1][m][1]); }
    }
};
struct EpiMix {
    static constexpr bool PERM = true, AFTER_DRAIN = false;
    EpiIn in; EpiP p;
    __device__ __forceinline__ void operator()(const f32x4 (&acc)[2][2][4][2], const Unit& u, int wr, int wc, int fr, int fq) const { if (u.kind == 0) in(acc, u, wr, wc, fr, fq); else p(acc, u, wr, wc, fr, fq); }
};
struct EpiPA {
    static constexpr bool PERM = true, AFTER_DRAIN = false;
    const bf16_t* GT; float* T;
    __device__ __forceinline__ void operator()(const f32x4 (&acc)[2][2][4][2], const Unit& u, int wr, int wc, int fr, int fq) const {
        const int row0 = u.pm * BM + wr * 64 + fr, col0 = u.pn * BM + wc * 32 + 8 * fq;
#pragma unroll
        for (int ai = 0; ai < 2; ++ai)
#pragma unroll
            for (int m = 0; m < 4; ++m) { const int row = row0 + ai * HALF + m * 16;
#pragma unroll
                for (int bj = 0; bj < 2; ++bj) { const int col = col0 + bj * HALF; const u32x4 g = *(const u32x4*)(GT + (size_t)row * 2048 + col);
                    f32x4 g0 = (f32x4){__uint_as_float(g.x << 16), __uint_as_float(g.x & 0xffff0000u), __uint_as_float(g.y << 16), __uint_as_float(g.y & 0xffff0000u)};
                    f32x4 g1 = (f32x4){__uint_as_float(g.z << 16), __uint_as_float(g.z & 0xffff0000u), __uint_as_float(g.w << 16), __uint_as_float(g.w & 0xffff0000u)};
                    float* d = T + (size_t)row * 1024 + col; *(f32x4*)d = acc[ai][bj][m][0] * g0; *(f32x4*)(d + 4) = acc[ai][bj][m][1] * g1; } }
    }
};
struct EpiPB {
    static constexpr bool PERM = true, AFTER_DRAIN = false;
    const bf16_t* GT; const float* T; bf16_t* MIX;
    __device__ __forceinline__ void operator()(const f32x4 (&acc)[2][2][4][2], const Unit& u, int wr, int wc, int fr, int fq) const {
        const int row0 = u.pm * BM + wr * 64 + fr, col0 = u.pn * BM + wc * 32 + 8 * fq;
#pragma unroll
        for (int ai = 0; ai < 2; ++ai)
#pragma unroll
            for (int m = 0; m < 4; ++m) { const int row = row0 + ai * HALF + m * 16;
#pragma unroll
                for (int bj = 0; bj < 2; ++bj) { const int col = col0 + bj * HALF; const u32x4 g = *(const u32x4*)(GT + (size_t)row * 2048 + 1024 + col);
                    f32x4 g0 = (f32x4){__uint_as_float(g.x << 16), __uint_as_float(g.x & 0xffff0000u), __uint_as_float(g.y << 16), __uint_as_float(g.y & 0xffff0000u)};
                    f32x4 g1 = (f32x4){__uint_as_float(g.z << 16), __uint_as_float(g.z & 0xffff0000u), __uint_as_float(g.w << 16), __uint_as_float(g.w & 0xffff0000u)};
                    const float* t = T + (size_t)row * 1024 + col; const f32x4 t0 = *(const f32x4*)t, t1 = *(const f32x4*)(t + 4);
                    *(u32x4*)(MIX + (size_t)row * 1024 + col) = pack8(t0 + acc[ai][bj][m][0] * g0, t1 + acc[ai][bj][m][1] * g1); } }
    }
};
struct EpiOut {
    static constexpr bool PERM = true, AFTER_DRAIN = false;
    const float* xp; const float* xs; float* X1F; bf16_t* X1B; float* SS2;
    __device__ __forceinline__ void operator()(const f32x4 (&acc)[2][2][4][2], const Unit& u, int wr, int wc, int fr, int fq) const {
        const int row0 = u.pm * BM + wr * 64 + fr, col0 = u.pn * BM + wc * 32 + 8 * fq;
#pragma unroll
        for (int ai = 0; ai < 2; ++ai)
#pragma unroll
            for (int m = 0; m < 4; ++m) { const int row = row0 + ai * HALF + m * 16;
                const float* xr = row < cfg::MP ? xp + (size_t)row * 1024 : (row < cfg::MROWS ? xs + (size_t)(row - cfg::MP) * 1024 : nullptr);
                float ss = 0.f;
#pragma unroll
                for (int bj = 0; bj < 2; ++bj) { const int col = col0 + bj * HALF;
                    f32x4 x0 = (f32x4){0.f, 0.f, 0.f, 0.f}, x1 = x0; if (xr) { x0 = *(const f32x4*)(xr + col); x1 = *(const f32x4*)(xr + col + 4); }
                    x0 = x0 + acc[ai][bj][m][0]; x1 = x1 + acc[ai][bj][m][1]; ss += sq4(x0) + sq4(x1);
                    float* d = X1F + (size_t)row * 1024 + col; *(f32x4*)d = x0; *(f32x4*)(d + 4) = x1;
                    *(u32x4*)(X1B + (size_t)row * 1024 + col) = pack8(x0, x1); }
                ss += __shfl_xor(ss, 16); ss += __shfl_xor(ss, 32);
                if (fq == 0) SS2[(size_t)row * 16 + u.pn * 4 + wc] = ss; }
    }
};
struct EpiUp {
    static constexpr bool PERM = true, AFTER_DRAIN = false;
    const float* SS2; bf16_t* AB; float* out;
    __device__ __forceinline__ void operator()(const f32x4 (&acc)[2][2][4][2], const Unit& u, int wr, int wc, int fr, int fq) const {
        const int row0 = u.pm * BM + wr * 64 + fr, col0 = u.pn * BM + wc * 32 + 8 * fq;
#pragma unroll
        for (int ai = 0; ai < 2; ++ai)
#pragma unroll
            for (int m = 0; m < 4; ++m) { const int row = row0 + ai * HALF + m * 16;
                const f32x4* sp = (const f32x4*)(SS2 + (size_t)row * 16); const f32x4 s0 = sp[0], s1 = sp[1], s2 = sp[2], s3 = sp[3];
                const float ssum = ((s0[0] + s0[1]) + (s0[2] + s0[3])) + ((s1[0] + s1[1]) + (s1[2] + s1[3])) + ((s2[0] + s2[1]) + (s2[2] + s2[3])) + ((s3[0] + s3[1]) + (s3[2] + s3[3]));
                const float rs = 1.0f / sqrtf(ssum * (1.0f / 1024.0f) + cfg::EPS);
                float* dst = nullptr;
                if (u.pn < 11) { if (row < cfg::MP) { const int t = row & 4095, b = row >> 12; if (t >= 4094) dst = out + cfg::OFF_CONV_P + (size_t)(b * 2 + (t - 4094)) * 2816; }
                                 else if (row < cfg::MROWS) dst = out + cfg::OFF_CONV_S + ((size_t)(row - cfg::MP) * 2 + 1) * 2816; }
#pragma unroll
                for (int bj = 0; bj < 2; ++bj) { const int col = col0 + bj * HALF; const f32x4 v0 = acc[ai][bj][m][0] * rs, v1 = acc[ai][bj][m][1] * rs;
                    *(u32x4*)(AB + (size_t)row * 5632 + col) = pack8(v0, v1);
                    if (dst) { *(f32x4*)(dst + col) = v0; *(f32x4*)(dst + col + 4) = v1; } } }
    }
};
struct EpiDown {
    static constexpr bool PERM = true, AFTER_DRAIN = false;
    const float* X1F; float* out; float* SS3;
    __device__ __forceinline__ void operator()(const f32x4 (&acc)[2][2][4][2], const Unit& u, int wr, int wc, int fr, int fq) const {
        const int row0 = u.pm * BM + wr * 64 + fr, col0 = u.pn * BM + wc * 32 + 8 * fq;
#pragma unroll
        for (int ai = 0; ai < 2; ++ai)
#pragma unroll
            for (int m = 0; m < 4; ++m) { const int row = row0 + ai * HALF + m * 16; float ss = 0.f;
#pragma unroll
                for (int bj = 0; bj < 2; ++bj) { const int col = col0 + bj * HALF; const float* xr = X1F + (size_t)row * 1024 + col;
                    const f32x4 x0 = *(const f32x4*)xr + acc[ai][bj][m][0], x1 = *(const f32x4*)(xr + 4) + acc[ai][bj][m][1]; ss += sq4(x0) + sq4(x1);
                    if (row < cfg::MROWS) { float* d = out + (size_t)row * 1024 + col; *(f32x4*)d = x0; *(f32x4*)(d + 4) = x1; } }
                ss += __shfl_xor(ss, 16); ss += __shfl_xor(ss, 32);
                if (fq == 0) SS3[(size_t)row * 16 + u.pn * 4 + wc] = ss; }
    }
};
template <class Epi, class Sched, bool ALIGN_EPI = false, bool SP2 = false>
__device__ __forceinline__ void gemm_phase(PG8_LAS unsigned char* lds, const Gemm g, const Sched& S, const Epi& E) {
    const int tid = threadIdx.x, wid = __builtin_amdgcn_readfirstlane(tid >> 6), lane = tid & 63, wr = wid >> 2, wc = wid & 3, fr = lane & 15, fq = lane >> 4;
    const int K = g.K, nt = K / BK;
    unsigned voffA[2], voffB[2];
#pragma unroll
    for (int i = 0; i < 2; ++i) { int R, C; stage_rc(tid * 16 + i * 8192, R, C); const int Rb = Epi::PERM ? ((R & ~31) + perm32(R & 31)) : R;
        voffA[i] = (unsigned)(R * K + C) * 2u; voffB[i] = (unsigned)(Rb * K + C) * 2u; }
    const size_t kstep = (size_t)(BK * 2);
    const size_t hstep = (size_t)HALF * K * 2;
    const size_t tstep = 2 * hstep;
    const unsigned ldsw = (unsigned)wid * 1024u;
    const int aoff = lds_byte(wr * 64 + fr, fq * 8), boff = lds_byte(wc * 32 + fr, fq * 8);
#define PG8_SA(b, h) (((b) * 2 + (h)) * HTB)
#define PG8_SB(b, h) ((4 + (b) * 2 + (h)) * HTB)
#define PG8_STAGE(bufoff, gbase, voff) do { _Pragma("unroll") for (int _i = 0; _i < 2; ++_i) \
        __builtin_amdgcn_global_load_lds((const unsigned*)((const char*)(gbase) + (voff)[_i]), (PG8_LAS unsigned*)(lds + (bufoff) + ldsw + _i * 8192), 16, 0, 0); } while (0)
#define PG8_LDA(dst, b, h) do { _Pragma("unroll") for (int m = 0; m < 4; ++m) _Pragma("unroll") for (int k = 0; k < 2; ++k) dst[m][k] = *(const PG8_LAS bf16x8*)(lds + PG8_SA(b, h) + aoff + m * 2048 + k * 1024); } while (0)
#define PG8_LDB(dst, b, h) do { _Pragma("unroll") for (int n = 0; n < 2; ++n) _Pragma("unroll") for (int k = 0; k < 2; ++k) dst[n][k] = *(const PG8_LAS bf16x8*)(lds + PG8_SB(b, h) + boff + n * 2048 + k * 1024); } while (0)
#define PG8_MMA(ai, bj, At, Bt) do { __builtin_amdgcn_s_setprio(1); _Pragma("unroll") for (int m = 0; m < 4; ++m) _Pragma("unroll") for (int n = 0; n < 2; ++n) _Pragma("unroll") for (int k = 0; k < 2; ++k) \
        acc[ai][bj][m][n] = __builtin_amdgcn_mfma_f32_16x16x32_bf16(Bt[n][k], At[m][k], acc[ai][bj][m][n], 0, 0, 0); __builtin_amdgcn_s_setprio(0); } while (0)
#define PG8_WAIT_V(n) asm volatile("s_waitcnt vmcnt(" #n ")" ::: "memory")
#define PG8_WAIT_L(n) asm volatile("s_waitcnt lgkmcnt(" #n ")" ::: "memory")
#define PG8_BAR __builtin_amdgcn_s_barrier()
#define PG8_SCHED __builtin_amdgcn_sched_barrier(0)
    Unit cur, nxt; int ui = 0;
    if (!S.next(0, cur)) return;
    f32x4 acc[2][2][4][2];
#pragma unroll
    for (int a = 0; a < 2; ++a)
#pragma unroll
        for (int b = 0; b < 2; ++b)
#pragma unroll
            for (int m = 0; m < 4; ++m)
#pragma unroll
                for (int n = 0; n < 2; ++n) acc[a][b][m][n] = (f32x4){0.f, 0.f, 0.f, 0.f};
    bf16x8 At[4][2], B0[2][2], B1[2][2];
    const char* cA = cur.a; const char* cB = cur.b;
    S.a_ready(cur);
    if constexpr (SP2) {
        PG8_STAGE(PG8_SB(0, 0), cB, voffB); PG8_STAGE(PG8_SB(0, 1), cB + hstep, voffB); PG8_STAGE(PG8_SA(0, 0), cA, voffA); PG8_STAGE(PG8_SA(0, 1), cA + hstep, voffA);
        if (wr == 1) PG8_BAR;
        PG8_WAIT_V(2); PG8_BAR;
        PG8_STAGE(PG8_SB(1, 0), cB + kstep, voffB); PG8_STAGE(PG8_SA(1, 0), cA + kstep, voffA); PG8_STAGE(PG8_SB(1, 1), cB + hstep + kstep, voffB);
        PG8_WAIT_V(6); PG8_BAR;
    } else {
        PG8_STAGE(PG8_SB(0, 0), cB, voffB); PG8_STAGE(PG8_SA(0, 0), cA, voffA); PG8_STAGE(PG8_SB(0, 1), cB + hstep, voffB); PG8_STAGE(PG8_SA(0, 1), cA + hstep, voffA);
        if (wr == 1) PG8_BAR;
        PG8_WAIT_V(4); PG8_BAR;
        PG8_STAGE(PG8_SB(1, 0), cB + kstep, voffB); PG8_STAGE(PG8_SA(1, 0), cA + kstep, voffA); PG8_STAGE(PG8_SB(1, 1), cB + hstep + kstep, voffB);
        PG8_WAIT_V(6); PG8_BAR;
    }
    for (;;) {
        const bool has_next = S.next(ui + 1, nxt);
        const char* nA = has_next ? nxt.a : cA; const char* nB = has_next ? nxt.b : cB;
        for (int t = 0; t < nt; t += 2) {
            const bool last = (t == nt - 2);
            const char* a1 = cA + (size_t)(t + 1) * kstep;
            const char* a2 = last ? nA : cA + (size_t)(t + 2) * kstep; const char* b2 = last ? nB : cB + (size_t)(t + 2) * kstep;
            const char* a3 = a2 + kstep; const char* b3 = b2 + kstep;
            if (last && has_next) S.a_ready(nxt);
            if constexpr (SP2) {
            PG8_LDB(B0, 0, 0); PG8_LDB(B1, 0, 1); PG8_SCHED; PG8_LDA(At, 0, 0); PG8_STAGE(PG8_SA(1, 1), a1 + hstep, voffA);
            PG8_WAIT_V(8); PG8_WAIT_L(0); PG8_BAR; PG8_MMA(0, 0, At, B0); PG8_MMA(0, 1, At, B1); PG8_BAR; PG8_SCHED;
            PG8_LDA(At, 0, 1); PG8_STAGE(PG8_SB(0, 0), b2, voffB); PG8_STAGE(PG8_SB(0, 1), b2 + hstep, voffB); PG8_STAGE(PG8_SA(0, 0), a2, voffA);
            PG8_WAIT_V(8); PG8_WAIT_L(0); PG8_BAR; PG8_MMA(1, 0, At, B0); PG8_MMA(1, 1, At, B1); PG8_BAR; PG8_SCHED;
            PG8_LDB(B0, 1, 0); PG8_LDB(B1, 1, 1); PG8_SCHED; PG8_LDA(At, 1, 0); PG8_STAGE(PG8_SA(0, 1), a2 + hstep, voffA);
            PG8_WAIT_V(8); PG8_WAIT_L(0); PG8_BAR; PG8_MMA(0, 0, At, B0); PG8_MMA(0, 1, At, B1); PG8_BAR; PG8_SCHED;
            PG8_LDA(At, 1, 1); PG8_STAGE(PG8_SB(1, 0), b3, voffB); PG8_STAGE(PG8_SB(1, 1), b3 + hstep, voffB); PG8_STAGE(PG8_SA(1, 0), a3, voffA);
            PG8_WAIT_V(8); PG8_WAIT_L(0); PG8_BAR; PG8_MMA(1, 0, At, B0); PG8_MMA(1, 1, At, B1); PG8_BAR; PG8_SCHED;
            } else {
            PG8_LDB(B0, 0, 0); PG8_SCHED; PG8_LDA(At, 0, 0); PG8_STAGE(PG8_SA(1, 1), a1 + hstep, voffA);
            PG8_WAIT_L(8); PG8_BAR; PG8_WAIT_L(0); PG8_MMA(0, 0, At, B0); PG8_BAR; PG8_SCHED;
            PG8_LDB(B1, 0, 1); PG8_STAGE(PG8_SB(0, 0), b2, voffB);
            PG8_BAR; PG8_WAIT_L(0); PG8_MMA(0, 1, At, B1); PG8_BAR;
            PG8_LDA(At, 0, 1); PG8_STAGE(PG8_SA(0, 0), a2, voffA);
            PG8_BAR; PG8_WAIT_L(0); PG8_MMA(1, 0, At, B0); PG8_BAR; PG8_SCHED;
            PG8_STAGE(PG8_SB(0, 1), b2 + hstep, voffB);
            PG8_WAIT_V(6); PG8_BAR; PG8_MMA(1, 1, At, B1); PG8_BAR;
            PG8_LDB(B0, 1, 0); PG8_SCHED; PG8_LDA(At, 1, 0); PG8_STAGE(PG8_SA(0, 1), a2 + hstep, voffA);
            PG8_WAIT_L(8); PG8_BAR; PG8_WAIT_L(0); PG8_MMA(0, 0, At, B0); PG8_BAR; PG8_SCHED;
            PG8_LDB(B1, 1, 1); PG8_STAGE(PG8_SB(1, 0), b3, voffB);
            PG8_BAR; PG8_WAIT_L(0); PG8_MMA(0, 1, At, B1); PG8_BAR;
            PG8_LDA(At, 1, 1); PG8_STAGE(PG8_SA(1, 0), a3, voffA);
            PG8_BAR; PG8_WAIT_L(0); PG8_MMA(1, 0, At, B0); PG8_BAR; PG8_SCHED;
            PG8_STAGE(PG8_SB(1, 1), b3 + hstep, voffB);
            PG8_WAIT_V(6); PG8_BAR; PG8_MMA(1, 1, At, B1); PG8_BAR;
            }
        }
        if constexpr (ALIGN_EPI) { if (wr == 0) PG8_BAR; }
        if constexpr (!Epi::AFTER_DRAIN) { E(acc, cur, wr, wc, fr, fq); S.done(cur); }
        if (!has_next) break;
#pragma unroll
        for (int a = 0; a < 2; ++a)
#pragma unroll
            for (int b = 0; b < 2; ++b)
#pragma unroll
                for (int m = 0; m < 4; ++m)
#pragma unroll
                    for (int n = 0; n < 2; ++n) acc[a][b][m][n] = (f32x4){0.f, 0.f, 0.f, 0.f};
        cur = nxt; cA = nA; cB = nB; ++ui;
        if constexpr (ALIGN_EPI) { if (wr == 1) PG8_BAR; }
    }
    PG8_WAIT_V(0);
    if constexpr (!ALIGN_EPI) { if (wr == 0) PG8_BAR; }
    PG8_BAR;
    if constexpr (Epi::AFTER_DRAIN) { E.fused(acc, cur, wr, wc, fr, fq, lds, wid, lane); S.done(cur); }
#undef PG8_SA
#undef PG8_SB
#undef PG8_STAGE
#undef PG8_LDA
#undef PG8_LDB
#undef PG8_MMA
#undef PG8_WAIT_V
#undef PG8_WAIT_L
#undef PG8_BAR
#undef PG8_SCHED
}
}
#define XB_TMO      128
#define XB_XCNT(j)  (256  + 64 * (j))
#define XB_XSUB(j)  (1280 + 64 * (j))
#define XB_XGEN(j)  (2304 + 64 * (j))
#define XB_TOP      3328
#define XB_TOPGEN   3392
#define XCD_BAR_WORDS 3456
#define XB_SPIN_CAP (1u << 22)

__device__ __forceinline__ unsigned xb_ld(unsigned* p)              { return __hip_atomic_load(p, __ATOMIC_RELAXED, __HIP_MEMORY_SCOPE_AGENT); }
__device__ __forceinline__ unsigned xb_add(unsigned* p, unsigned v) { return __hip_atomic_fetch_add(p, v, __ATOMIC_RELAXED, __HIP_MEMORY_SCOPE_AGENT); }
__device__ __forceinline__ unsigned xb_xcc_id() { return (unsigned)__builtin_amdgcn_s_getreg((3 << 11) | 20) & 0xFu; }
#define XB_SPIN(cond, bar) do { unsigned _sp = 0; while (cond) { __builtin_amdgcn_s_sleep(1); \
    if ((++_sp & 255u) == 0u) { if (xb_ld(&(bar)[XB_TMO])) break; if (_sp > XB_SPIN_CAP) { atomicAdd(&(bar)[XB_TMO], 1u); break; } } } } while (0)

struct XcdBarrier {
    unsigned* bar; unsigned x;
    volatile LAS unsigned* st;
};

__device__ __forceinline__ XcdBarrier xcd_barrier_post(unsigned* bar, volatile LAS unsigned* st) {
    XcdBarrier b; b.bar = bar; b.x = xb_xcc_id(); b.st = st;
    if (threadIdx.x == 0) (void)xb_add(&bar[XB_XCNT(b.x)], 1u);
    return b;
}
__device__ __forceinline__ void xcd_barrier_complete(unsigned* bar, unsigned x, unsigned& nloc, unsigned& nx) {
    const unsigned G = gridDim.x * gridDim.y * gridDim.z;
    unsigned sum, cnt, mine, sp = 0u;
    for (;;) {
        sum = 0u; cnt = 0u; mine = 0u;
#pragma unroll
        for (unsigned j = 0; j < 16; ++j) { const unsigned c = xb_ld(&bar[XB_XCNT(j)]); sum += c; cnt += (c > 0u) ? 1u : 0u; mine = (j == x) ? c : mine; }
        if (sum == G) break;
        __builtin_amdgcn_s_sleep(1);
        if ((++sp & 255u) == 0u) { if (xb_ld(&bar[XB_TMO])) break; if (sp > XB_SPIN_CAP) { atomicAdd(&bar[XB_TMO], 1u); break; } }
    }
    nloc = mine > 0u ? mine : 1u; nx = cnt > 0u ? cnt : 1u;
}

__device__ __forceinline__ void xcd_barrier(const XcdBarrier& b) {
    asm volatile("s_waitcnt vmcnt(0)" ::: "memory");
    __syncthreads();
    if (threadIdx.x == 0) {
        unsigned* bar = b.bar;
        __builtin_amdgcn_s_waitcnt(0);
        unsigned nloc = b.st[0], nx = b.st[1];
        if (nloc == 0u) { xcd_barrier_complete(bar, b.x, nloc, nx); b.st[0] = nloc; b.st[1] = nx; }
        const unsigned old = xb_add(&bar[XB_XSUB(b.x)], 1u);
        const unsigned gen = old / nloc;
        if (old + 1u == (gen + 1u) * nloc) {
            __builtin_amdgcn_fence(__ATOMIC_RELEASE, "agent");
            asm volatile("s_waitcnt vmcnt(0)" ::: "memory");
            const unsigned og = xb_add(&bar[XB_TOP], 1u);
            const unsigned tg = og / nx;
            if (og + 1u == (tg + 1u) * nx) xb_add(&bar[XB_TOPGEN], 1u);
            else XB_SPIN(xb_ld(&bar[XB_TOPGEN]) == tg, bar);
            __builtin_amdgcn_fence(__ATOMIC_ACQUIRE, "agent");
            xb_add(&bar[XB_XGEN(b.x)], 1u);
            asm volatile("s_waitcnt vmcnt(0)" ::: "memory");
        } else {
            XB_SPIN(xb_ld(&bar[XB_XGEN(b.x)]) == gen, bar);
            __builtin_amdgcn_fence(__ATOMIC_ACQUIRE, "agent");
            asm volatile("s_waitcnt vmcnt(0)" ::: "memory");
        }
    }
    __syncthreads();
}
constexpr int NWAVES = 8;
#ifndef MK_N_LAUNCHES
#define MK_N_LAUNCHES 1
#endif
#ifndef REPMASK
#define REPMASK 0
#endif
#ifndef PHMASK
#define PHMASK 0x3ff
#endif
#define LDS_WAIT() asm volatile("s_waitcnt lgkmcnt(0)" ::: "memory")

template <int MAPK> DI int colmap(int n, int N) {
    if (MAPK == 0) return n < N ? n : -1;
    if (n < 1280) return n;
    if (n < 2304) return n + 24;
    if (n < 4352) return n + 24;
    if (n < 4376) return n - 4352 + 1280;
    return -1;
}
template <int MAPK> DI void transpose_item(const float* W, int K, int N, const float* kscale, bf16* WT, LAS float* scr, int item, int nblk, int lane) {
    const int kb = item / nblk, nb = item % nblk, k0 = 64 * kb, n0 = 32 * nb;
    const int sc = colmap<MAPK>(n0 + (lane & 31), N);
#pragma unroll 8
    for (int i = 0; i < 32; ++i) { const int kk = 2 * i + (lane >> 5); float v = 0.f; if (sc >= 0) { v = W[(size_t)(k0 + kk) * N + sc]; if (kscale) v *= kscale[k0 + kk]; } scr[kk * 33 + (lane & 31)] = v; }
    LDS_WAIT();
    const int c = lane & 7;
#pragma unroll
    for (int j = 0; j < 4; ++j) { const int n = (lane >> 3) + 8 * j; const LAS float* s = scr + (8 * c) * 33 + n;
        v4u o; o.x = pk2(s[0 * 33], s[1 * 33]); o.y = pk2(s[2 * 33], s[3 * 33]); o.z = pk2(s[4 * 33], s[5 * 33]); o.w = pk2(s[6 * 33], s[7 * 33]);
        *(v4u*)(WT + (size_t)(n0 + n) * K + k0 + 8 * c) = o; }
    LDS_WAIT();
}

DI void load8(const float* p, float (&x)[8]) { const v4f a = *(const v4f*)p, b = *(const v4f*)(p + 4); x[0] = a.x; x[1] = a.y; x[2] = a.z; x[3] = a.w; x[4] = b.x; x[5] = b.y; x[6] = b.z; x[7] = b.w; }
DI void load8(const bf16* p, float (&x)[8]) { const v4u a = *(const v4u*)p; x[0] = __uint_as_float(a.x << 16); x[1] = __uint_as_float(a.x & 0xffff0000u); x[2] = __uint_as_float(a.y << 16); x[3] = __uint_as_float(a.y & 0xffff0000u);
    x[4] = __uint_as_float(a.z << 16); x[5] = __uint_as_float(a.z & 0xffff0000u); x[6] = __uint_as_float(a.w << 16); x[7] = __uint_as_float(a.w & 0xffff0000u); }
DI float load1(const float* p) { return *p; }
DI float load1(const bf16* p) { return bf2f(*p); }

typedef short s16x8 __attribute__((ext_vector_type(8)));
typedef float f32x16 __attribute__((ext_vector_type(16)));
template <typename OT> DI void cmp_stage2_tile(const bf16* Pg, int nseg, int n0, const bf16* W2Fkv, OT* OUTg, int ncmp, int lane) {
    const int r32 = lane & 31, hi = lane >> 5, ra = n0 + r32, rb = ra + 1 < nseg ? ra + 1 : nseg - 1;
    f32x16 acc0, acc1;
#pragma unroll
    for (int i = 0; i < 16; ++i) { acc0[i] = 0.f; acc1[i] = 0.f; }
#pragma unroll
    for (int ks = 0; ks < 8; ++ks) {
        float p0[8], p1[8]; load8(Pg + (size_t)ra * 256 + 16 * ks + 8 * hi, p0); load8(Pg + (size_t)rb * 256 + 128 + 16 * ks + 8 * hi, p1);
        v4u av; av.x = pg8::cvt_pk_bf16(gelu_tanh(p0[0] + p1[0]), gelu_tanh(p0[1] + p1[1])); av.y = pg8::cvt_pk_bf16(gelu_tanh(p0[2] + p1[2]), gelu_tanh(p0[3] + p1[3]));
        av.z = pg8::cvt_pk_bf16(gelu_tanh(p0[4] + p1[4]), gelu_tanh(p0[5] + p1[5])); av.w = pg8::cvt_pk_bf16(gelu_tanh(p0[6] + p1[6]), gelu_tanh(p0[7] + p1[7]));
        const v4u b0 = *(const v4u*)(W2Fkv + ((size_t)(ks * 2 + 0) * 64 + lane) * 8), b1 = *(const v4u*)(W2Fkv + ((size_t)(ks * 2 + 1) * 64 + lane) * 8);
        acc0 = __builtin_amdgcn_mfma_f32_32x32x16_bf16(__builtin_bit_cast(s16x8, av), __builtin_bit_cast(s16x8, b0), acc0, 0, 0, 0);
        acc1 = __builtin_amdgcn_mfma_f32_32x32x16_bf16(__builtin_bit_cast(s16x8, av), __builtin_bit_cast(s16x8, b1), acc1, 0, 0, 0);
    }
#pragma unroll
    for (int r = 0; r < 16; ++r) { const int row = n0 + (r & 3) + 8 * (r >> 2) + 4 * hi; if (row < ncmp) { if (sizeof(OT) == 4) { OUTg[(size_t)row * 64 + r32] = (OT)acc0[r]; OUTg[(size_t)row * 64 + 32 + r32] = (OT)acc1[r]; } else { OUTg[(size_t)row * 64 + r32] = (OT)f2bf(acc0[r]); OUTg[(size_t)row * 64 + 32 + r32] = (OT)f2bf(acc1[r]); } } }
}
DI void load_cmp_bias(const Args& a, LAS float* biasL, int tid) {
    if (tid < 256) { const float* PB = (const float*)(a.ws + cfg::WS_PB); const int kv = tid >> 7, h = tid & 127; float s = a.cmp_b1[kv * 128 + h];
#pragma unroll 8
        for (int c = 0; c < 32; ++c) s += PB[(kv * 32 + c) * 128 + h];
        biasL[tid] = s; }
    LDS_WAIT(); __syncthreads();
}
struct MixOrder {
    pg8::StaticOrder s1; int G, c; const char* CB; const char* W1T;
    __device__ bool next(int i, pg8::Unit& u) const {
        long L = (long)i * G + c; if (L < s1.nwg) return s1.unit_of((int)L, u);
        L -= s1.nwg; if (L >= 512) return false;
        const int kv = (int)(L >> 8), rest = (int)(L & 255);
        u.pm = rest; u.pn = 0; u.kind = 1 + kv; u.a = CB + (((size_t)(kv * 64 + (rest >> 2)) * 16384 + (size_t)(rest & 3) * 4096) * 64) * 2; u.b = W1T + (size_t)kv * 256 * 1024 * 2; return true;
    }
    __device__ __forceinline__ void a_ready(const pg8::Unit&) const {}
    __device__ __forceinline__ void done(const pg8::Unit&) const {}
};
struct OneOrder {
    pg8::Unit u0;
    __device__ bool next(int i, pg8::Unit& u) const { if (i) return false; u = u0; return true; }
    __device__ __forceinline__ void a_ready(const pg8::Unit&) const {}
    __device__ __forceinline__ void done(const pg8::Unit&) const {}
};
template <typename KT> DI void score4(float (&s)[4], const KT* kptr, bool valid, const LAS float* qs) {
    float a0 = 0.f, a1 = 0.f, a2 = 0.f, a3 = 0.f;
#pragma unroll
    for (int c = 0; c < 8; ++c) { float k[8]; load8(kptr + 8 * c, k); asm volatile("" : "+v"(a0), "+v"(a1), "+v"(a2), "+v"(a3) :: "memory");
#pragma unroll
        for (int j = 0; j < 8; ++j) { const int d = 8 * c + j; a0 += k[j] * qs[d]; a1 += k[j] * qs[64 + d]; a2 += k[j] * qs[128 + d]; a3 += k[j] * qs[192 + d]; } }
    s[0] = valid ? a0 : cfg::NEGF; s[1] = valid ? a1 : cfg::NEGF; s[2] = valid ? a2 : cfg::NEGF; s[3] = valid ? a3 : cfg::NEGF;
}
namespace dec {
constexpr int L_QS = 0, L_S = 1024, L_RED = L_S + 4 * 1024 * 4, L_OS = L_RED + 512, L_IC = L_OS + 8 * 4 * 64 * 4, L_SC = L_IC + 1056 * 4, L_LIST = L_SC + 272 * 4, L_O = L_LIST + 128, L_END = L_O + 3 * 256 * 4;
static_assert(L_END <= cfg::RING_BYTES, "decode attention LDS map");
struct KeyCmp { const float* kc; const float* vc; DI bool valid(int k) const { return k < 1023; } DI const float* kp(int k) const { return kc + (size_t)(k < 1023 ? k : 1022) * 64; } DI const float* vp(int k) const { return vc + (size_t)(k < 1023 ? k : 1022) * 64; } };
struct KeyWin { const float* cw; const float* nw; DI bool valid(int k) const { return k < 513; } DI const float* kp(int k) const { return k < 512 ? cw + (size_t)k * 256 : nw; } DI const float* vp(int k) const { return kp(k) + 128; } };
struct KeySlc { const float* cs; const int* pt; const LAS int* list; const float* ns; int g;
    DI bool valid(int k) const { return list[k >> 6] < 256 || (k & 63) == 0; }
    DI const float* kp(int k) const { const int blk = list[k >> 6]; if (blk >= 256) return ns; const int phys = pt[blk >> 1]; return cs + (((size_t)phys * 128 + (blk & 1) * 64 + (k & 63)) * 4 + g) * 64; }
    DI const float* vp(int k) const { return kp(k) + 128; } };
template <int NK, bool IMP, class KM> DI void attend(const KM& km, LAS char* L, int slot, int tid) {
    const int lane = tid & 63, wave = __builtin_amdgcn_readfirstlane(tid >> 6);
    const LAS float* qs = (const LAS float*)(L + L_QS); LAS float* sb = (LAS float*)(L + L_S); LAS float* red = (LAS float*)(L + L_RED); LAS float* os = (LAS float*)(L + L_OS); LAS float* ic = (LAS float*)(L + L_IC);
    float s[NK][4]; bool ok[NK]; float mx[4] = {cfg::NEGF, cfg::NEGF, cfg::NEGF, cfg::NEGF};
#pragma unroll
    for (int i = 0; i < NK; ++i) { const int k = tid + 512 * i; ok[i] = km.valid(k); score4<float>(s[i], km.kp(k), ok[i], qs);
#pragma unroll
        for (int r = 0; r < 4; ++r) mx[r] = fmaxf(mx[r], s[i][r]); }
#pragma unroll
    for (int r = 0; r < 4; ++r) { mx[r] = wave_max(mx[r]); if (lane == 0) red[wave * 4 + r] = mx[r]; }
    LDS_WAIT(); __syncthreads();
    float sm[4];
#pragma unroll
    for (int r = 0; r < 4; ++r) { float m = red[r];
#pragma unroll
        for (int w = 1; w < 8; ++w) m = fmaxf(m, red[w * 4 + r]);
        mx[r] = m; sm[r] = 0.f; }
#pragma unroll
    for (int i = 0; i < NK; ++i)
#pragma unroll
        for (int r = 0; r < 4; ++r) { s[i][r] = ok[i] ? __builtin_amdgcn_exp2f((s[i][r] - mx[r]) * cfg::L2E) : 0.f; sm[r] += s[i][r]; }
#pragma unroll
    for (int r = 0; r < 4; ++r) { sm[r] = wave_sum(sm[r]); if (lane == 0) red[32 + wave * 4 + r] = sm[r]; }
    LDS_WAIT(); __syncthreads();
#pragma unroll
    for (int r = 0; r < 4; ++r) { float t = red[32 + r];
#pragma unroll
        for (int w = 1; w < 8; ++w) t += red[32 + w * 4 + r];
        sm[r] = t > 0.f ? 1.0f / t : 0.f; }
#pragma unroll
    for (int i = 0; i < NK; ++i) { const int k = tid + 512 * i; float isum = 0.f;
#pragma unroll
        for (int r = 0; r < 4; ++r) { const float p = s[i][r] * sm[r]; sb[r * 1024 + k] = p; isum += p; }
        if (IMP) ic[k] = isum; }
    LDS_WAIT(); __syncthreads();
    constexpr int KW = NK * 64; float o0 = 0.f, o1 = 0.f, o2 = 0.f, o3 = 0.f;
#pragma unroll 8
    for (int kk = 0; kk < KW; ++kk) { const int k = wave * KW + kk; const float v = km.vp(k)[lane];
        o0 += sb[k] * v; o1 += sb[1024 + k] * v; o2 += sb[2048 + k] * v; o3 += sb[3072 + k] * v; }
    os[(wave * 4 + 0) * 64 + lane] = o0; os[(wave * 4 + 1) * 64 + lane] = o1; os[(wave * 4 + 2) * 64 + lane] = o2; os[(wave * 4 + 3) * 64 + lane] = o3;
    LDS_WAIT(); __syncthreads();
    if (tid < 256) { float t = 0.f;
#pragma unroll
        for (int w = 0; w < 8; ++w) t += os[w * 256 + tid];
        ((LAS float*)(L + L_O))[slot * 256 + tid] = t; }
    LDS_WAIT(); __syncthreads();
}
DI void sample_unit(const Args& a, int b, int g, LAS unsigned char* lds_raw, int tid) {
    LAS char* L = (LAS char*)lds_raw; const int row = cfg::MP + b;
    LAS float* qs = (LAS float*)(L + L_QS); LAS float* ic = (LAS float*)(L + L_IC); LAS float* sc = (LAS float*)(L + L_SC); LAS int* list = (LAS int*)(L + L_LIST);
    const bf16* Q = (const bf16*)(a.ws + cfg::WS_Q);
    if (tid < 256) qs[tid] = bf2f(Q[(size_t)row * 512 + g * 256 + tid]);
    for (int i = tid; i < 1056; i += 512) ic[i] = 0.f;
    LDS_WAIT(); __syncthreads();
    { KeyCmp km{(const float*)(a.ws + cfg::WS_KCS) + (size_t)(b * 2 + g) * 1024 * 64, (const float*)(a.ws + cfg::WS_VCS) + (size_t)(b * 2 + g) * 1024 * 64}; attend<2, true>(km, L, 0, tid); }
    if (tid < 257) { const int j = tid; float imp = 0.f;
#pragma unroll
        for (int mm = -1; mm < 4; ++mm) { const int idx = 4 * j + mm; if (idx >= 0 && idx < 1023) imp += ic[idx]; }
        sc[j] = imp + ((j == 0 || j >= 255) ? 1e6f : 0.f); }
    LDS_WAIT(); __syncthreads();
    { const int j = tid < 257 ? tid : 256; const float my = sc[j]; int rank = 0;
#pragma unroll 8
      for (int k = 0; k < 257; ++k) { const float o = sc[k]; rank += (o > my || (o == my && k < j)) ? 1 : 0; }
      __syncthreads();
      if (tid < 257 && rank < 16) list[rank] = j; }
    LDS_WAIT(); __syncthreads();
    { KeySlc km{a.cache_slc, a.page_table + b * cfg::NPAGES, list, a.out + cfg::OFF_SLC_S + (size_t)(b * 4 + g) * 64, g}; attend<2, false>(km, L, 1, tid); }
    { KeyWin km{a.cache_win + ((size_t)b * 512 * 4 + g) * 64, a.out + cfg::OFF_WIN_S + (((size_t)b * 512 + 511) * 4 + g) * 64}; attend<2, false>(km, L, 2, tid); }
    if (tid < 256) { const int r = tid >> 6, h = g * 4 + r; const float* ng = (const float*)(a.ws + cfg::WS_NSAG) + (size_t)row * 32 + h * 3; const LAS float* O = (const LAS float*)(L + L_O);
        ((bf16*)(a.ws + cfg::WS_ONSA))[(size_t)row * 512 + h * 64 + (tid & 63)] = (bf16)f2bf(ng[0] * O[tid] + ng[1] * O[256 + tid] + ng[2] * O[512 + tid]); }
    LDS_WAIT(); __syncthreads();
}
}

DI float rstd_v(const float* SSV, int row) { const v4f a = *(const v4f*)(SSV + (size_t)row * 8), b = *(const v4f*)(SSV + (size_t)row * 8 + 4);
    return 1.0f / sqrtf((((a.x + a.y) + (a.z + a.w)) + ((b.x + b.y) + (b.z + b.w))) * (1.0f / 512.0f) + cfg::EPS); }
DI float rstd16(const float* SS, int row) { const v4f* p = (const v4f*)(SS + (size_t)row * 16); const v4f s0 = p[0], s1 = p[1], s2 = p[2], s3 = p[3];
    const float t = ((s0.x + s0.y) + (s0.z + s0.w)) + ((s1.x + s1.y) + (s1.z + s1.w)) + ((s2.x + s2.y) + (s2.z + s2.w)) + ((s3.x + s3.y) + (s3.z + s3.w));
    return 1.0f / sqrtf(t * (1.0f / 1024.0f) + cfg::EPS); }

namespace att {
constexpr int KP = 144;
constexpr int TILE_B = 64 * KP;
constexpr int BUF_B = 2 * TILE_B;
constexpr int W_OFF = 2 * BUF_B;
constexpr int W_IC = 0, W_SC = 8192, W_TAB = 10240, W_MSK = 10496, W_BYTES = 10560;
static_assert(W_OFF + 8 * W_BYTES <= cfg::RING_BYTES, "attention LDS map");
constexpr float NEG_S = -2e30f, M_INIT = -1e30f;
typedef short s16x4 __attribute__((ext_vector_type(4)));

DI float pl32_max(float v) { const auto rr = __builtin_amdgcn_permlane32_swap(__float_as_uint(v), __float_as_uint(v), false, false); return fmaxf(__uint_as_float(rr[0]), __uint_as_float(rr[1])); }
DI float pl32_sum(float v) { const auto rr = __builtin_amdgcn_permlane32_swap(__float_as_uint(v), __float_as_uint(v), false, false); return __uint_as_float(rr[0]) + __uint_as_float(rr[1]); }
DI float quad_sum(float v) {
    v += __int_as_float(__builtin_amdgcn_mov_dpp(__float_as_int(v), 0xB1, 0xf, 0xf, true));
    v += __int_as_float(__builtin_amdgcn_mov_dpp(__float_as_int(v), 0x4E, 0xf, 0xf, true));
    return v;
}
DI s16x4 lds_tr(const LAS char* p) { return __builtin_bit_cast(s16x4, __builtin_amdgcn_ds_read_tr16_b64_v4i16((LAS s16x4*)p)); }

DI void tile_fetch(v4u& kr, v4u& vr, const bf16* kg, const bf16* vg, size_t rowstride, int tid) {
    const size_t off = (size_t)(tid >> 3) * rowstride + (tid & 7) * 8; kr = *(const v4u*)(kg + off); vr = *(const v4u*)(vg + off);
}
DI void tile_store(LAS char* buf, const v4u& kr, const v4u& vr, int tid) {
    LAS char* p = buf + (tid >> 3) * KP + (tid & 7) * 16; *(LAS v4u*)p = kr; *(LAS v4u*)(p + TILE_B) = vr;
}
DI void qk_tile(f32x16& s0, f32x16& s1, const LAS char* Kt, const s16x8 (&qf)[4], int r32, int hi) {
#pragma unroll
    for (int i = 0; i < 16; ++i) { s0[i] = 0.f; s1[i] = 0.f; }
#pragma unroll
    for (int d0 = 0; d0 < 4; ++d0) {
        const s16x8 a0 = *(const LAS s16x8*)(Kt + r32 * KP + (2 * d0 + hi) * 16), a1 = *(const LAS s16x8*)(Kt + (32 + r32) * KP + (2 * d0 + hi) * 16);
        s0 = __builtin_amdgcn_mfma_f32_32x32x16_bf16(a0, qf[d0], s0, 0, 0, 0); s1 = __builtin_amdgcn_mfma_f32_32x32x16_bf16(a1, qf[d0], s1, 0, 0, 0);
    }
}
DI void pv_tile(f32x16 (&o)[2], const LAS char* Vt, const unsigned (&pk)[16], int lane) {
    const int hi = lane >> 5, gq = (lane >> 4) & 1, qq = (lane & 15) >> 2, pp = lane & 3;
    const LAS char* vb = Vt + (4 * hi + qq) * KP + (16 * gq + 4 * pp) * 2;
#pragma unroll
    for (int ks = 0; ks < 4; ++ks) {
        v4u av; av.x = pk[4 * ks]; av.y = pk[4 * ks + 1]; av.z = pk[4 * ks + 2]; av.w = pk[4 * ks + 3];
#pragma unroll
        for (int db = 0; db < 2; ++db) {
            const s16x4 lo = lds_tr(vb + (16 * ks) * KP + db * 64), hh = lds_tr(vb + (16 * ks + 8) * KP + db * 64);
            const s16x8 bv = (s16x8){lo[0], lo[1], lo[2], lo[3], hh[0], hh[1], hh[2], hh[3]};
            o[db] = __builtin_amdgcn_mfma_f32_32x32x16_bf16(__builtin_bit_cast(s16x8, av), bv, o[db], 0, 0, 0);
        }
    }
}
DI void tab_publish(LAS float* tab, float v, int r32, int hi) { if (hi == 0) tab[r32] = v; LDS_WAIT(); }
DI float crowf(const LAS float* tab, int reg, int hi) { return tab[(reg & 3) + 8 * (reg >> 2) + 4 * hi]; }

struct Ctx {
    int b, g, qt, tid, lane, wave, r32, hi, tq;
    LAS char* lds; LAS float* ic; LAS float* sc; LAS float* tab; LAS unsigned* msk;
};

template <int MODE> DI void run_tiles(const Ctx& c, const s16x8 (&qf)[4], int j_lo, int j_hi, const bf16* kg, const bf16* vg, size_t rowstride,
                                      float& m, float& l, f32x16 (&o)[2], float linv, int vis, unsigned msk_lo, unsigned msk_hi) {
    v4u kr, vr; tile_fetch(kr, vr, kg + (size_t)j_lo * 64 * rowstride, vg + (size_t)j_lo * 64 * rowstride, rowstride, c.tid);
    tile_store(c.lds, kr, vr, c.tid);
    LDS_WAIT(); __syncthreads();
    for (int j = j_lo; j <= j_hi; ++j) {
        const int cur = (j - j_lo) & 1; const LAS char* Kt = c.lds + cur * BUF_B; const LAS char* Vt = Kt + TILE_B;
        if (j < j_hi) tile_fetch(kr, vr, kg + (size_t)(j + 1) * 64 * rowstride, vg + (size_t)(j + 1) * 64 * rowstride, rowstride, c.tid);
        int lo = 0, hi_ = 63; bool need_mask;
        if (MODE <= 1) { hi_ = vis - 64 * j; need_mask = true; }
        else if (MODE == 2) { const bool sel = ((j < 32 ? msk_lo >> j : msk_hi >> (j - 32)) & 1u) != 0u; if (j == c.qt) hi_ = c.tq; if (!sel) hi_ = -1; need_mask = __any(hi_ != 63) != 0; }
        else { if (j == c.qt) hi_ = c.tq; else if (j == c.qt - 8) lo = c.tq; need_mask = (j == c.qt) || (j == c.qt - 8); }
        f32x16 s0, s1; qk_tile(s0, s1, Kt, qf, c.r32, c.hi);
        if (need_mask) { const int l4 = lo - 4 * c.hi, h4 = hi_ - 4 * c.hi;
#pragma unroll
            for (int r = 0; r < 16; ++r) { const int k0 = (r & 3) + 8 * (r >> 2); s0[r] = (k0 >= l4 && k0 <= h4) ? s0[r] : NEG_S; s1[r] = (k0 + 32 >= l4 && k0 + 32 <= h4) ? s1[r] : NEG_S; } }
        unsigned pk[16];
        if (MODE == 1) {
            const float mL = m * cfg::L2E;
#pragma unroll
            for (int r = 0; r < 16; ++r) { s0[r] = __builtin_amdgcn_exp2f(__builtin_fmaf(s0[r], cfg::L2E, -mL)) * linv; s1[r] = __builtin_amdgcn_exp2f(__builtin_fmaf(s1[r], cfg::L2E, -mL)) * linv; }
#pragma unroll
            for (int r = 0; r < 16; ++r) { const float a0 = quad_sum(s0[r]), a1 = quad_sum(s1[r]); const int key = 64 * j + (r & 3) + 8 * (r >> 2) + 4 * c.hi;
                if ((c.r32 & 3) == 0) { c.ic[(c.r32 >> 2) * 256 + key] = a0; c.ic[(c.r32 >> 2) * 256 + key + 32] = a1; } }
        } else {
            float mt = fmaxf(s0[0], s1[0]);
#pragma unroll
            for (int r = 1; r < 16; ++r) mt = fmaxf(mt, fmaxf(s0[r], s1[r]));
            mt = pl32_max(mt);
            const float mn = fmaxf(m, mt);
            if (__any(mn > m)) { const float al = __builtin_amdgcn_exp2f((m - mn) * cfg::L2E); l *= al; m = mn;
                if (MODE >= 2) { tab_publish(c.tab, al, c.r32, c.hi);
#pragma unroll
                    for (int r = 0; r < 16; ++r) { const float f = crowf(c.tab, r, c.hi); o[0][r] *= f; o[1][r] *= f; } } }
            const float mL = m * cfg::L2E; float ls = 0.f;
#pragma unroll
            for (int r = 0; r < 16; ++r) { s0[r] = __builtin_amdgcn_exp2f(__builtin_fmaf(s0[r], cfg::L2E, -mL)); s1[r] = __builtin_amdgcn_exp2f(__builtin_fmaf(s1[r], cfg::L2E, -mL)); ls += s0[r] + s1[r]; }
            l += ls;
        }
        if (MODE >= 1) {
#pragma unroll
            for (int i = 0; i < 8; ++i) { pk[i] = pg8::cvt_pk_bf16(s0[2 * i], s0[2 * i + 1]); pk[8 + i] = pg8::cvt_pk_bf16(s1[2 * i], s1[2 * i + 1]); }
            pv_tile(o, Vt, pk, c.lane);
        }
        if (j < j_hi) tile_store(c.lds + (cur ^ 1) * BUF_B, kr, vr, c.tid);
        LDS_WAIT(); __syncthreads();
    }
}

template <bool FIRST> DI void merge_branch(const Ctx& c, LAS float* accl, const f32x16 (&o)[2], float fac) {
    tab_publish(c.tab, fac, c.r32, c.hi);
#pragma unroll
    for (int r = 0; r < 16; ++r) { const int q = (r & 3) + 8 * (r >> 2) + 4 * c.hi; const float f = c.tab[q]; LAS float* p = accl + q * 64 + c.r32;
        if (FIRST) { p[0] = o[0][r] * f; p[32] = o[1][r] * f; } else { p[0] += o[0][r] * f; p[32] += o[1][r] * f; } }
}
DI void prompt_unit(const Args& a, int b, int g, int qt, LAS unsigned char* lds_raw, int tid) {
    Ctx c; c.b = b; c.g = g; c.qt = qt; c.tid = tid; c.lane = tid & 63; c.wave = __builtin_amdgcn_readfirstlane(tid >> 6); c.r32 = c.lane & 31; c.hi = c.lane >> 5; c.tq = 8 * c.wave + (c.r32 >> 2);
    c.lds = (LAS char*)lds_raw; LAS char* wreg = c.lds + W_OFF + c.wave * W_BYTES;
    c.ic = (LAS float*)(wreg + W_IC); c.sc = (LAS float*)(wreg + W_SC); c.tab = (LAS float*)(wreg + W_TAB); c.msk = (LAS unsigned*)(wreg + W_MSK);
    const int t0 = 64 * qt, t = t0 + c.tq, rh = c.r32 & 3, row = b * 4096 + t, head = g * 4 + rh;
    const bf16* Q = (const bf16*)(a.ws + cfg::WS_Q); const bf16* KVB = (const bf16*)(a.ws + cfg::WS_KVB);
    const bf16* KC = (const bf16*)(a.ws + cfg::WS_KCP) + (size_t)(b * 2 + g) * 256 * 64; const bf16* VC = (const bf16*)(a.ws + cfg::WS_VCP) + (size_t)(b * 2 + g) * 256 * 64;
#pragma unroll
    for (int i = 0; i < 32; ++i) c.ic[i * 64 + c.lane] = 0.f;
    s16x8 qf[4];
#pragma unroll
    for (int d0 = 0; d0 < 4; ++d0) qf[d0] = *(const s16x8*)(Q + (size_t)row * 512 + head * 64 + 16 * d0 + 8 * c.hi);
    const float* ng = (const float*)(a.ws + cfg::WS_NSAG) + (size_t)row * 32 + head * 3; const float g_cmp = ng[0], g_slc = ng[1], g_win = ng[2];
    f32x16 o[2];
#pragma unroll
    for (int i = 0; i < 16; ++i) { o[0][i] = 0.f; o[1][i] = 0.f; }
    LDS_WAIT();
    const int vis = t >= 31 ? (t - 31) >> 4 : -1;
    { const int vmax = (t0 + 63 - 31) >> 4; int ntc = (vmax + 64) >> 6; ntc = ntc > 4 ? 4 : ntc;
      float m = M_INIT, l = 0.f;
      run_tiles<0>(c, qf, 0, ntc - 1, KC, VC, 64, m, l, o, 0.f, vis, 0u, 0u);
      const float lt = pl32_sum(l); const float linv = lt > 0.f ? 1.0f / lt : 0.f;
      run_tiles<1>(c, qf, 0, ntc - 1, KC, VC, 64, m, l, o, linv, vis, 0u, 0u); }
    unsigned msk_lo, msk_hi;
    { const int tl = c.lane >> 3, sub = c.lane & 7; const LAS float* icr = c.ic + tl * 256; float my[8];
#pragma unroll
      for (int e = 0; e < 8; ++e) { const int j = sub * 8 + e; float imp = 0.f;
#pragma unroll
          for (int mm = -1; mm < 4; ++mm) { const int idx = 4 * j + mm; if (idx >= 0 && idx < 255) imp += icr[idx]; }
          const bool valid = j <= qt, forced = (j == 0) || (j == qt) || (j == qt - 1);
          my[e] = valid ? imp + (forced ? 1e6f : 0.f) : cfg::NEGF; c.sc[tl * 64 + j] = my[e]; }
      LDS_WAIT();
      int rank[8];
#pragma unroll
      for (int e = 0; e < 8; ++e) rank[e] = 0;
      for (int k4 = 0; k4 < 16; ++k4) { const v4f ov = *(const LAS v4f*)(c.sc + tl * 64 + 4 * k4);
#pragma unroll
          for (int kk = 0; kk < 4; ++kk) { const float ovk = ov[kk]; const int k = 4 * k4 + kk;
#pragma unroll
              for (int e = 0; e < 8; ++e) rank[e] += (ovk > my[e] || (ovk == my[e] && k < sub * 8 + e)) ? 1 : 0; } }
      unsigned bits = 0u;
#pragma unroll
      for (int e = 0; e < 8; ++e) bits |= ((sub * 8 + e) <= qt && rank[e] < 16) ? (1u << e) : 0u;
      unsigned lo32 = sub < 4 ? bits << (8 * sub) : 0u, hi32 = sub >= 4 ? bits << (8 * (sub - 4)) : 0u;
#pragma unroll
      for (int x = 1; x < 8; x <<= 1) { lo32 |= (unsigned)__shfl_xor((int)lo32, x); hi32 |= (unsigned)__shfl_xor((int)hi32, x); }
      if (sub == 0) { c.msk[2 * tl] = lo32; c.msk[2 * tl + 1] = hi32; }
      LDS_WAIT();
      msk_lo = c.msk[2 * (c.r32 >> 2)]; msk_hi = c.msk[2 * (c.r32 >> 2) + 1]; }
    LAS float* accl = c.ic;
    merge_branch<true>(c, accl, o, g_cmp);
    {
#pragma unroll
      for (int i = 0; i < 16; ++i) { o[0][i] = 0.f; o[1][i] = 0.f; }
      float m = M_INIT, l = 0.f; const bf16* kg = KVB + (size_t)b * 4096 * 768 + 256 + g * 64;
      run_tiles<2>(c, qf, 0, qt, kg, kg + 128, 768, m, l, o, 0.f, 0, msk_lo, msk_hi);
      const float lt = pl32_sum(l); merge_branch<false>(c, accl, o, lt > 0.f ? g_slc / lt : 0.f); }
    {
#pragma unroll
      for (int i = 0; i < 16; ++i) { o[0][i] = 0.f; o[1][i] = 0.f; }
      float m = M_INIT, l = 0.f; const bf16* kg = KVB + (size_t)b * 4096 * 768 + 512 + g * 64;
      run_tiles<3>(c, qf, qt > 8 ? qt - 8 : 0, qt, kg, kg + 128, 768, m, l, o, 0.f, 0, 0u, 0u);
      const float lt = pl32_sum(l); merge_branch<false>(c, accl, o, lt > 0.f ? g_win / lt : 0.f); }
    LDS_WAIT();
    bf16* O = (bf16*)(a.ws + cfg::WS_ONSA);
#pragma unroll
    for (int r = 0; r < 16; ++r) { const int q = (r & 3) + 8 * (r >> 2) + 4 * c.hi; const size_t orow = (size_t)(b * 4096 + t0 + 8 * c.wave + (q >> 2)) * 512 + (g * 4 + (q & 3)) * 64;
        O[orow + c.r32] = (bf16)f2bf(accl[q * 64 + c.r32]); O[orow + 32 + c.r32] = (bf16)f2bf(accl[q * 64 + 32 + c.r32]); }
    LDS_WAIT();
}
}
namespace cmx {
constexpr int VP = 272;
DI void unit(const Args& a, int b, int c, int gi, LAS unsigned char* lds_raw, int tid) {
    LAS char* L = (LAS char*)lds_raw; const int lane = tid & 63, wave = __builtin_amdgcn_readfirstlane(tid >> 6);
    const bf16* VG = (const bf16*)(a.ws + cfg::WS_VG); const bf16* U = (const bf16*)(a.ws + cfg::WS_U); const float* SSV = (const float*)(a.ws + cfg::WS_SSV); bf16* CM = (bf16*)(a.ws + cfg::WS_CM);
    const bf16* Wt = (const bf16*)(a.ws + cfg::WS_WTRIL) + (size_t)gi * 128 * 128; const int rbase = b * 4096 + c * 128;
#pragma unroll
    for (int k = 0; k < 4; ++k) { const int p = tid + 512 * k, j = p >> 4, ch = p & 15, row = rbase + j; const float rs = rstd_v(SSV, row);
        float v[8], gn[8]; load8(VG + (size_t)row * 512 + gi * 128 + ch * 8, v); load8(a.gmlp_norm + gi * 128 + ch * 8, gn);
#pragma unroll
        for (int e = 0; e < 8; ++e) v[e] = v[e] * rs * gn[e];
        if (c == 31) { float* d = a.out + cfg::OFF_V_P + ((size_t)(b * 128 + j)) * 512 + gi * 128 + ch * 8; *(v4f*)d = (v4f){v[0], v[1], v[2], v[3]}; *(v4f*)(d + 4) = (v4f){v[4], v[5], v[6], v[7]}; }
        v4u o; o.x = pg8::cvt_pk_bf16(v[0], v[1]); o.y = pg8::cvt_pk_bf16(v[2], v[3]); o.z = pg8::cvt_pk_bf16(v[4], v[5]); o.w = pg8::cvt_pk_bf16(v[6], v[7]);
        *(LAS v4u*)(L + j * VP + ch * 16) = o; }
    LDS_WAIT(); __syncthreads();
    const int ib = wave & 3, chh = wave >> 2, r32 = lane & 31, hi = lane >> 5, gq = (lane >> 4) & 1, qq = (lane & 15) >> 2, pp = lane & 3;
    f32x16 acc[2];
#pragma unroll
    for (int i = 0; i < 16; ++i) { acc[0][i] = 0.f; acc[1][i] = 0.f; }
    const bf16* wrow = Wt + (size_t)(32 * ib + r32) * 128 + 4 * hi; const LAS char* vb = L + (4 * hi + qq) * VP + (64 * chh + 16 * gq + 4 * pp) * 2;
    for (int ks = 0; ks < 2 * ib + 2; ++ks) {
        const v2u a0 = *(const v2u*)(wrow + 16 * ks), a1 = *(const v2u*)(wrow + 16 * ks + 8);
        const v4u av = (v4u){a0.x, a0.y, a1.x, a1.y};
#pragma unroll
        for (int cb = 0; cb < 2; ++cb) { const att::s16x4 lo = att::lds_tr(vb + (16 * ks) * VP + cb * 64), hh = att::lds_tr(vb + (16 * ks + 8) * VP + cb * 64);
            const s16x8 bv = (s16x8){lo[0], lo[1], lo[2], lo[3], hh[0], hh[1], hh[2], hh[3]};
            acc[cb] = __builtin_amdgcn_mfma_f32_32x32x16_bf16(__builtin_bit_cast(s16x8, av), bv, acc[cb], 0, 0, 0); }
    }
#pragma unroll
    for (int r = 0; r < 16; ++r) { const int i = 32 * ib + (r & 3) + 8 * (r >> 2) + 4 * hi; const float bs = a.gmlp_bs[gi * 128 + i]; const size_t off = (size_t)(rbase + i) * 512 + gi * 128 + 64 * chh + r32;
        CM[off] = (bf16)f2bf(bf2f(U[off]) * (acc[0][r] + bs)); CM[off + 32] = (bf16)f2bf(bf2f(U[off + 32]) * (acc[1][r] + bs)); }
    LDS_WAIT(); __syncthreads();
}
}

__global__ void __launch_bounds__(NWAVES * 64, 2) nsa_hybrid_fwd(Args a) {
    extern __shared__ __attribute__((aligned(16))) unsigned char lds_raw[];
    LAS unsigned char* lds = (LAS unsigned char*)lds_raw;
    const int tid = threadIdx.x, lane = tid & 63, wave = __builtin_amdgcn_readfirstlane(tid >> 6);
    const int G = gridDim.x, gw = blockIdx.x * NWAVES + wave, NGW = G * NWAVES;
    unsigned char* ws = a.ws;
    for (int u = tid; u < (cfg::LDS_BYTES - cfg::LDSCTL_OFF) / 4; u += NWAVES * 64) ((LAS unsigned*)(lds + cfg::LDSCTL_OFF))[u] = 0u;
    __syncthreads();
    volatile LAS unsigned* MISC = (volatile LAS unsigned*)(lds + cfg::MISC_OFF);
    XcdBarrier bar = xcd_barrier_post((unsigned*)(ws + cfg::WS_CTL) + cfg::CW_BAR, MISC + 8);

    bf16* W_in_t = (bf16*)(ws + cfg::WS_WIN_T); bf16* W_pa_t = (bf16*)(ws + cfg::WS_WPA_T); bf16* W_pb_t = (bf16*)(ws + cfg::WS_WPB_T); bf16* W_out_t = (bf16*)(ws + cfg::WS_WOUT_T);
    bf16* W_up_t = (bf16*)(ws + cfg::WS_WUP_T); bf16* W_dn_t = (bf16*)(ws + cfg::WS_WDN_T);
    float* RSTD1 = (float*)(ws + cfg::WS_RSTD1); float* SSV = (float*)(ws + cfg::WS_SSV); float* SS2 = (float*)(ws + cfg::WS_SS2); float* SS3 = (float*)(ws + cfg::WS_SS3); float* NSAG = (float*)(ws + cfg::WS_NSAG);
    bf16* XB = (bf16*)(ws + cfg::WS_XB); bf16* Qb = (bf16*)(ws + cfg::WS_Q); bf16* KVB = (bf16*)(ws + cfg::WS_KVB); bf16* Ub = (bf16*)(ws + cfg::WS_U); bf16* VG = (bf16*)(ws + cfg::WS_VG); bf16* GT = (bf16*)(ws + cfg::WS_GT);
    bf16* ONSA = (bf16*)(ws + cfg::WS_ONSA); bf16* CM = (bf16*)(ws + cfg::WS_CM); float* Tb = (float*)(ws + cfg::WS_T); bf16* MIX = (bf16*)(ws + cfg::WS_MIX);
    float* X1F = (float*)(ws + cfg::WS_X1F); bf16* X1B = (bf16*)(ws + cfg::WS_X1B); bf16* AB = (bf16*)(ws + cfg::WS_AB); bf16* ACT = (bf16*)(ws + cfg::WS_ACT);

    #if (PHMASK >> 0) & 1
    if (a.ph_lo <= 0 && 0 < a.ph_hi) {
    for (int rep_ = 0; rep_ < (int)((REPMASK >> 0) & 1) + 1; ++rep_) {
    {
        LAS float* scr = (LAS float*)(lds + wave * 16384);
        constexpr int I_IN = 16 * (cfg::INP / 32), I_PA = 8 * 32, I_PB = 8 * 32, I_OUT = 16 * 32, I_UP = 16 * (cfg::UPN / 32), I_DN = (cfg::DFF / 64) * 32;
        constexpr int NITEMS = I_IN + I_PA + I_PB + I_OUT + I_UP + I_DN;
        for (int it = gw; it < NITEMS; it += NGW) { int r = it;
            if (r < I_IN) { transpose_item<1>(a.w_in, 1024, cfg::INC, a.norm_mix, W_in_t, scr, r, cfg::INP / 32, lane); continue; } r -= I_IN;
            if (r < I_PA) { transpose_item<0>(a.w_proj_a, 512, 1024, nullptr, W_pa_t, scr, r, 32, lane); continue; } r -= I_PA;
            if (r < I_PB) { transpose_item<0>(a.w_proj_b, 512, 1024, nullptr, W_pb_t, scr, r, 32, lane); continue; } r -= I_PB;
            if (r < I_OUT) { transpose_item<0>(a.w_out, 1024, 1024, nullptr, W_out_t, scr, r, 32, lane); continue; } r -= I_OUT;
            if (r < I_UP) { transpose_item<0>(a.w_up, 1024, cfg::UPN, a.norm_ffn, W_up_t, scr, r, cfg::UPN / 32, lane); continue; } r -= I_UP;
            transpose_item<0>(a.w_down, cfg::DFF, 1024, nullptr, W_dn_t, scr, r, 32, lane); }
        for (int m = gw; m < cfg::MPAD; m += NGW) {
            const float* xr = m < cfg::MP ? a.x_prompt + (size_t)m * 1024 : (m < cfg::MROWS ? a.x_sample + (size_t)(m - cfg::MP) * 1024 : nullptr);
            v4f v[4]; float s = 0.f;
#pragma unroll
            for (int j = 0; j < 4; ++j) { v[j] = xr ? *(const v4f*)(xr + j * 256 + lane * 4) : (v4f){0.f, 0.f, 0.f, 0.f}; s += (v[j].x * v[j].x + v[j].y * v[j].y) + (v[j].z * v[j].z + v[j].w * v[j].w); }
            s = wave_sum(s);
            if (lane == 0) RSTD1[m] = xr ? 1.0f / sqrtf(s * (1.0f / 1024.0f) + cfg::EPS) : 0.f;
#pragma unroll
            for (int j = 0; j < 4; ++j) { v2u o; o.x = pk2(v[j].x, v[j].y); o.y = pk2(v[j].z, v[j].w); *(v2u*)(XB + (size_t)m * 1024 + j * 256 + lane * 4) = o; }
            if (m >= cfg::MROWS) {
                v4u z = (v4u){0u, 0u, 0u, 0u}; *(v4u*)(ONSA + (size_t)m * 512 + lane * 8) = z; *(v4u*)(CM + (size_t)m * 512 + lane * 8) = z; }
        }
        { const size_t n4 = (size_t)cfg::DB * 511 * 64;
          for (size_t i = (size_t)blockIdx.x * 512 + tid; i < n4; i += (size_t)G * 512) { const size_t bb = i / (511 * 64), rem = i % (511 * 64);
              ((v4f*)(a.out + cfg::OFF_WIN_S))[bb * 512 * 64 + rem] = ((const v4f*)a.cache_win)[bb * 512 * 64 + 64 + rem]; }
          for (int i = blockIdx.x * 512 + tid; i < cfg::DB * cfg::DFF; i += G * 512) { const int bb = i / cfg::DFF, f = i % cfg::DFF; a.out[cfg::OFF_CONV_S + (size_t)bb * 2 * cfg::DFF + f] = a.state_conv[(size_t)bb * 2 * cfg::DFF + cfg::DFF + f]; } }
        { bf16* W1T = (bf16*)(ws + cfg::WS_W1T);
          for (int it = gw; it < 4 * 64; it += NGW) { const int kr = it >> 6; transpose_item<0>(a.cmp_w1 + (size_t)kr * 1024 * 128, 1024, 128, nullptr, W1T + (size_t)kr * 128 * 1024, scr, it & 63, 4, lane); }
          bf16* W2F = (bf16*)(ws + cfg::WS_W2F);
          for (int e = blockIdx.x * 512 + tid; e < 2 * 8 * 2 * 64 * 8; e += G * 512) { const int j = e & 7, ln = (e >> 3) & 63, cb = (e >> 9) & 1, ks = (e >> 10) & 7, kv = e >> 13;
              W2F[e] = (bf16)f2bf(a.cmp_w2[(size_t)kv * 128 * 64 + (16 * ks + 8 * (ln >> 5) + j) * 64 + 32 * cb + (ln & 31)]); }
          bf16* WTR = (bf16*)(ws + cfg::WS_WTRIL);
          for (int e = blockIdx.x * 512 + tid; e < 4 * 128 * 128; e += G * 512) { const int j = e & 127, i = (e >> 7) & 127; WTR[e] = (bf16)f2bf(j <= i ? a.gmlp_ws[e] : 0.f); }
          float* PB = (float*)(ws + cfg::WS_PB);
          for (int it = gw; it < 64; it += NGW) { const int kv = it >> 5, c = it & 31; float s0 = 0.f, s1 = 0.f;
#pragma unroll 8
              for (int i = 0; i < 64; ++i) { const int k = c * 64 + i; const float pv = a.cmp_pe[kv * 2048 + k]; s0 += pv * a.cmp_w1[((size_t)kv * 2048 + k) * 128 + lane]; s1 += pv * a.cmp_w1[((size_t)kv * 2048 + k) * 128 + 64 + lane]; }
              PB[(kv * 32 + c) * 128 + lane] = s0; PB[(kv * 32 + c) * 128 + 64 + lane] = s1; } }
        { bf16* CB = (bf16*)(ws + cfg::WS_CB); const int kvg = lane >> 4, d0 = (lane & 15) * 4;
          for (int r0 = gw * 4; r0 < cfg::DB * cfg::PAST; r0 += NGW * 4) { v4f v[4];
#pragma unroll
              for (int i = 0; i < 4; ++i) { const int r = r0 + i, b = r >> 14, pos = r & 16383; const int phys = a.page_table[b * cfg::NPAGES + (pos >> 7)];
                  v[i] = *(const v4f*)(a.cache_cmp + ((size_t)phys * 128 + (pos & 127)) * 256 + lane * 4); }
#pragma unroll
              for (int i = 0; i < 4; ++i) { const int r = r0 + i, b = r >> 14, pos = r & 16383; v2u o; o.x = pg8::cvt_pk_bf16(v[i].x, v[i].y); o.y = pg8::cvt_pk_bf16(v[i].z, v[i].w);
                  *(v2u*)(CB + (((size_t)((kvg >> 1) * 32 + b) * 2 + (kvg & 1)) * 16384 + pos) * 64 + d0) = o; } } }
    }
    }
    if (1 < a.ph_hi) xcd_barrier(bar);
    }

    #endif
#if (PHMASK >> 1) & 1
    if (a.ph_lo <= 1 && 1 < a.ph_hi) {
    for (int rep_ = 0; rep_ < (int)((REPMASK >> 1) & 1) + 1; ++rep_) {
    { LAS float* biasL = (LAS float*)(lds + cfg::BIAS_OFF); load_cmp_bias(a, biasL, tid);
      pg8::Gemm g{XB, W_in_t, cfg::MPAD, cfg::INP, 1024}; MixOrder S; S.s1.init(cfg::MPAD, cfg::INP, G, (int)blockIdx.x, XB, W_in_t, 1024); S.G = G; S.c = (int)blockIdx.x;
      S.CB = (const char*)(ws + cfg::WS_CB); S.W1T = (const char*)(ws + cfg::WS_W1T);
      pg8::EpiMix E{pg8::EpiIn{RSTD1, Qb, KVB, Ub, VG, SSV, GT, NSAG, a.out, (bf16*)(ws + cfg::WS_CBP)}, pg8::EpiP{(bf16*)(ws + cfg::WS_PS), (size_t)65536 * 256, biasL}};
      pg8::gemm_phase<pg8::EpiMix, MixOrder, true, true>(lds, g, S, E); }
    }
    if (2 < a.ph_hi) xcd_barrier(bar);
    }

    #endif
#if (PHMASK >> 2) & 1
    if (a.ph_lo <= 2 && 2 < a.ph_hi) {
    for (int rep_ = 0; rep_ < (int)((REPMASK >> 2) & 1) + 1; ++rep_) {
    {
        const bf16* W2F = (const bf16*)(ws + cfg::WS_W2F);
        if (blockIdx.x < 16) {
            const int kv = blockIdx.x >> 3, bg = blockIdx.x & 7; LAS float* biasL = (LAS float*)(lds + cfg::BIAS_OFF); load_cmp_bias(a, biasL, tid);
            bf16* PP = (bf16*)(ws + cfg::WS_PP);
            OneOrder S; S.u0.pm = bg; S.u0.pn = 0; S.u0.kind = 1 + kv; S.u0.a = (const char*)(ws + cfg::WS_CBP) + (size_t)(kv * 8 + bg) * 4096 * 64 * 2; S.u0.b = (const char*)(ws + cfg::WS_W1T) + (size_t)kv * 256 * 1024 * 2;
            pg8::Gemm g{nullptr, nullptr, 256, 256, 1024}; pg8::EpiP E{PP, (size_t)2048 * 256, biasL};
            pg8::gemm_phase<pg8::EpiP, OneOrder, false, true>(lds, g, S, E);
            asm volatile("s_waitcnt vmcnt(0)" ::: "memory"); __syncthreads();
            cmp_stage2_tile<bf16>(PP + ((size_t)kv * 2048 + bg * 256) * 256, 256, wave * 32, W2F + (size_t)kv * 8192, (bf16*)(ws + (kv ? cfg::WS_VCP : cfg::WS_KCP)) + (size_t)bg * 256 * 64, 255, lane);
        } else {
            const int gw2 = (blockIdx.x - 16) * NWAVES + wave, NGW2 = (G - 16) * NWAVES;
            for (int task = gw2; task < 2 * 64 * 32; task += NGW2) { const int kv = task >> 11, bg = (task >> 5) & 63, tl = task & 31;
                cmp_stage2_tile<float>((const bf16*)(ws + cfg::WS_PS) + ((size_t)kv * 65536 + bg * 1024) * 256, 1024, tl * 32, W2F + (size_t)kv * 8192, (float*)(ws + (kv ? cfg::WS_VCS : cfg::WS_KCS)) + (size_t)bg * 1024 * 64, 1023, lane); }
            for (int task = blockIdx.x - 16; task < 4 * 32 * 4; task += G - 16) cmx::unit(a, task >> 7, (task >> 2) & 31, task & 3, lds, tid);
        }
        for (int i = 512 + gw; i < 4 * 128 + cfg::DB; i += NGW) {
            const bool smp = i >= 512; const int row = smp ? cfg::MP + (i - 512) : (i >> 7) * 4096 + 3968 + (i & 127);
            float* dst = smp ? a.out + cfg::OFF_V_S + (size_t)(i - 512) * 512 : a.out + cfg::OFF_V_P + (size_t)i * 512;
            const float rs = rstd_v(SSV, row); float vn[8]; load8(VG + (size_t)row * 512 + lane * 8, vn);
#pragma unroll
            for (int j = 0; j < 8; ++j) vn[j] = vn[j] * rs * a.gmlp_norm[lane * 8 + j];
            *(v4f*)(dst + lane * 8) = (v4f){vn[0], vn[1], vn[2], vn[3]}; *(v4f*)(dst + lane * 8 + 4) = (v4f){vn[4], vn[5], vn[6], vn[7]};
            if (smp) { const int gi = lane >> 4; const float w00 = a.gmlp_ws[(size_t)gi * 128 * 128], bs = a.gmlp_bs[gi * 128]; float uu[8]; load8(Ub + (size_t)row * 512 + lane * 8, uu);
                v4u o; o.x = pk2(uu[0] * (w00 * vn[0] + bs), uu[1] * (w00 * vn[1] + bs)); o.y = pk2(uu[2] * (w00 * vn[2] + bs), uu[3] * (w00 * vn[3] + bs));
                o.z = pk2(uu[4] * (w00 * vn[4] + bs), uu[5] * (w00 * vn[5] + bs)); o.w = pk2(uu[6] * (w00 * vn[6] + bs), uu[7] * (w00 * vn[7] + bs));
                *(v4u*)(CM + (size_t)row * 512 + lane * 8) = o; }
        }
    }
    }
    if (3 < a.ph_hi) xcd_barrier(bar);
    }

    #endif
#if (PHMASK >> 3) & 1
    if (a.ph_lo <= 3 && 3 < a.ph_hi) {
    for (int rep_ = 0; rep_ < (int)((REPMASK >> 3) & 1) + 1; ++rep_) {
    {
        gu32* qctr = (gu32*)(ws + cfg::WS_CTL) + 8192 + 64 * rep_; volatile LAS int* qslot = (volatile LAS int*)(lds + cfg::MISC_OFF + 64);
        for (;;) {
            if (tid == 0) qslot[0] = (int)__hip_atomic_fetch_add(qctr, 1u, __ATOMIC_RELAXED, __HIP_MEMORY_SCOPE_AGENT);
            LDS_WAIT(); __syncthreads();
            const int item = qslot[0];
            __syncthreads();
            if (item >= 64 + 512) break;
            if (item < 64) dec::sample_unit(a, item >> 1, item & 1, lds, tid);
            else { const int idx = item - 64, bgi = idx & 7; att::prompt_unit(a, bgi >> 1, bgi & 1, 63 - (idx >> 3), lds, tid); }
        }
    }
    }
    if (4 < a.ph_hi) xcd_barrier(bar);
    }

    #endif
#if (PHMASK >> 4) & 1
    if (a.ph_lo <= 4 && 4 < a.ph_hi) {
    for (int rep_ = 0; rep_ < (int)((REPMASK >> 4) & 1) + 1; ++rep_) {
    { pg8::StaticOrder S;
      { S.init(cfg::MPAD, 1024, G, (int)blockIdx.x, ONSA, W_pa_t, 512); pg8::Gemm g{ONSA, W_pa_t, cfg::MPAD, 1024, 512}; pg8::EpiPA E{GT, Tb}; pg8::gemm_phase<pg8::EpiPA, pg8::StaticOrder, true, true>(lds, g, S, E); }
      asm volatile("s_waitcnt vmcnt(0)" ::: "memory"); __syncthreads();
      { S.init(cfg::MPAD, 1024, G, (int)blockIdx.x, CM, W_pb_t, 512); pg8::Gemm g{CM, W_pb_t, cfg::MPAD, 1024, 512}; pg8::EpiPB E{GT, Tb, MIX}; pg8::gemm_phase<pg8::EpiPB, pg8::StaticOrder, true, true>(lds, g, S, E); } }
    }
    if (5 < a.ph_hi) xcd_barrier(bar);
    }

    #endif
#if (PHMASK >> 5) & 1
    if (a.ph_lo <= 5 && 5 < a.ph_hi) {
    for (int rep_ = 0; rep_ < (int)((REPMASK >> 5) & 1) + 1; ++rep_) {
    { pg8::Gemm g{MIX, W_out_t, cfg::MPAD, 1024, 1024}; pg8::StaticOrder S; S.init(cfg::MPAD, 1024, G, (int)blockIdx.x, MIX, W_out_t, 1024);
      pg8::EpiOut E{a.x_prompt, a.x_sample, X1F, X1B, SS2}; pg8::gemm_phase<pg8::EpiOut, pg8::StaticOrder, true, true>(lds, g, S, E); }
    }
    if (6 < a.ph_hi) xcd_barrier(bar);
    }

    #endif
#if (PHMASK >> 6) & 1
    if (a.ph_lo <= 6 && 6 < a.ph_hi) {
    for (int rep_ = 0; rep_ < (int)((REPMASK >> 6) & 1) + 1; ++rep_) {
    { pg8::Gemm g{X1B, W_up_t, cfg::MPAD, cfg::UPN, 1024}; pg8::StaticOrder S; S.init(cfg::MPAD, cfg::UPN, G, (int)blockIdx.x, X1B, W_up_t, 1024);
      pg8::EpiUp E{SS2, AB, a.out}; pg8::gemm_phase<pg8::EpiUp, pg8::StaticOrder, true, true>(lds, g, S, E); }
    }
    if (7 < a.ph_hi) xcd_barrier(bar);
    }

    #endif
#if (PHMASK >> 7) & 1
    if (a.ph_lo <= 7 && 7 < a.ph_hi) {
    for (int rep_ = 0; rep_ < (int)((REPMASK >> 7) & 1) + 1; ++rep_) {
    {
        constexpr int FV = cfg::DFF / 8;
        for (size_t i = (size_t)blockIdx.x * 512 + tid; i < (size_t)cfg::MPAD * FV; i += (size_t)G * 512) {
            const int row = (int)(i / FV), f = (int)(i % FV) * 8;
            float a0[8], a1[8], a2[8], bb[8], c[8];
            load8(AB + (size_t)row * cfg::UPN + f, a2); load8(AB + (size_t)row * cfg::UPN + cfg::DFF + f, bb);
            if (row < cfg::MP) { const int t = row & 4095;
                if (t >= 1) load8(AB + (size_t)(row - 1) * cfg::UPN + f, a1); else {
#pragma unroll
                    for (int j = 0; j < 8; ++j) a1[j] = 0.f; }
                if (t >= 2) load8(AB + (size_t)(row - 2) * cfg::UPN + f, a0); else {
#pragma unroll
                    for (int j = 0; j < 8; ++j) a0[j] = 0.f; } }
            else if (row < cfg::MROWS) { const float* sp = a.state_conv + (size_t)(row - cfg::MP) * 2 * cfg::DFF + f; load8(sp, a0); load8(sp + cfg::DFF, a1); }
            else {
#pragma unroll
                for (int j = 0; j < 8; ++j) { a0[j] = 0.f; a1[j] = 0.f; } }
            float w0[8], w1[8], w2[8], cb[8]; load8(a.conv_w + f, w0); load8(a.conv_w + cfg::DFF + f, w1); load8(a.conv_w + 2 * cfg::DFF + f, w2); load8(a.conv_b + f, cb);
#pragma unroll
            for (int j = 0; j < 8; ++j) c[j] = gelu_tanh(cb[j] + a0[j] * w0[j] + a1[j] * w1[j] + a2[j] * w2[j]) * bb[j];
            v4u o; o.x = pk2(c[0], c[1]); o.y = pk2(c[2], c[3]); o.z = pk2(c[4], c[5]); o.w = pk2(c[6], c[7]);
            *(v4u*)(ACT + (size_t)row * cfg::DFF + f) = o;
        }
    }
    }
    if (8 < a.ph_hi) xcd_barrier(bar);
    }

    #endif
#if (PHMASK >> 8) & 1
    if (a.ph_lo <= 8 && 8 < a.ph_hi) {
    for (int rep_ = 0; rep_ < (int)((REPMASK >> 8) & 1) + 1; ++rep_) {
    { pg8::Gemm g{ACT, W_dn_t, cfg::MPAD, 1024, cfg::DFF}; pg8::StaticOrder S; S.init(cfg::MPAD, 1024, G, (int)blockIdx.x, ACT, W_dn_t, cfg::DFF);
      pg8::EpiDown E{X1F, a.out, SS3}; pg8::gemm_phase<pg8::EpiDown, pg8::StaticOrder, true, true>(lds, g, S, E); }
    }
    if (9 < a.ph_hi) xcd_barrier(bar);
    }

    #endif
#if (PHMASK >> 9) & 1
    if (a.ph_lo <= 9 && 9 < a.ph_hi) {
    for (int rep_ = 0; rep_ < (int)((REPMASK >> 9) & 1) + 1; ++rep_) {
#ifdef DUMP
    for (int m = gw; m < cfg::MROWS; m += NGW) { float* yr = a.out + (size_t)m * 1024;
        if (DUMP == 4) continue;
#pragma unroll
        for (int j = 0; j < 4; ++j) { const int c = j * 256 + lane * 4; v4f v;
            if (DUMP == 1) { v.x = bf2f(MIX[(size_t)m * 1024 + c]); v.y = bf2f(MIX[(size_t)m * 1024 + c + 1]); v.z = bf2f(MIX[(size_t)m * 1024 + c + 2]); v.w = bf2f(MIX[(size_t)m * 1024 + c + 3]); }
            else if (DUMP == 2) v = *(const v4f*)(X1F + (size_t)m * 1024 + c);
            else if (DUMP == 3) { v.x = bf2f(ACT[(size_t)m * 2816 + c]); v.y = bf2f(ACT[(size_t)m * 2816 + c + 1]); v.z = bf2f(ACT[(size_t)m * 2816 + c + 2]); v.w = bf2f(ACT[(size_t)m * 2816 + c + 3]); }
            else { v.x = bf2f(AB[(size_t)m * 5632 + c]); v.y = bf2f(AB[(size_t)m * 5632 + c + 1]); v.z = bf2f(AB[(size_t)m * 5632 + c + 2]); v.w = bf2f(AB[(size_t)m * 5632 + c + 3]); }
            *(v4f*)(yr + c) = v; } }
#else
    for (int m = gw; m < cfg::MROWS; m += NGW) { const float rs = rstd16(SS3, m); float* yr = a.out + (size_t)m * 1024;
#pragma unroll
        for (int j = 0; j < 4; ++j) { const v4f v = *(const v4f*)(yr + j * 256 + lane * 4), gn = *(const v4f*)(a.norm_final + j * 256 + lane * 4); *(v4f*)(yr + j * 256 + lane * 4) = v * rs * gn; } }
#endif
    }
    }
#endif
}

extern "C" void kernel_launch(void* const* d_in, const int* in_sizes, int n_in, void* d_out, int out_size, void* d_ws, size_t ws_size, hipStream_t stream) {
    static int grid = 0;
    if (grid == 0) {
        if (n_in != 25 || in_sizes[0] != cfg::MP * 1024 || (size_t)out_size != cfg::OUT_TOTAL || ws_size < cfg::WS_END) {
            fprintf(stderr, "kernel_launch: unexpected shapes (n_in %d, in0 %d, out %d, ws %zu); nothing launched\n", n_in, n_in > 0 ? in_sizes[0] : -1, out_size, ws_size); grid = -1; return; }
        int dev = 0, cus = 0, per_cu = 0;
        if (hipGetDevice(&dev) != hipSuccess || hipDeviceGetAttribute(&cus, hipDeviceAttributeMultiprocessorCount, dev) != hipSuccess) { grid = -1; return; }
        if (hipFuncSetAttribute((const void*)nsa_hybrid_fwd, hipFuncAttributeMaxDynamicSharedMemorySize, cfg::LDS_BYTES) != hipSuccess) { fprintf(stderr, "kernel_launch: hipFuncSetAttribute failed\n"); grid = -1; return; }
        if (hipOccupancyMaxActiveBlocksPerMultiprocessor(&per_cu, (const void*)nsa_hybrid_fwd, NWAVES * 64, cfg::LDS_BYTES) != hipSuccess || per_cu < 1)
            fprintf(stderr, "kernel_launch: note: occupancy query reports %d workgroups per CU\n", per_cu);
        (void)hipGetLastError();
        grid = cus;
    }
    if (grid < 0) return;
    if (hipMemsetAsync((char*)d_ws + cfg::WS_CTL, 0, cfg::CTL_ZERO_BYTES, stream) != hipSuccess) return;
    Args a{};
    a.x_prompt = (const float*)d_in[0]; a.x_sample = (const float*)d_in[1]; a.cache_cmp = (const float*)d_in[2]; a.cache_slc = (const float*)d_in[3]; a.cache_win = (const float*)d_in[4];
    a.state_conv = (const float*)d_in[5]; a.page_table = (const int*)d_in[6]; a.norm_mix = (const float*)d_in[7]; a.w_in = (const float*)d_in[8]; a.cmp_pe = (const float*)d_in[9];
    a.cmp_w1 = (const float*)d_in[10]; a.cmp_b1 = (const float*)d_in[11]; a.cmp_w2 = (const float*)d_in[12]; a.gmlp_norm = (const float*)d_in[13]; a.gmlp_ws = (const float*)d_in[14];
    a.gmlp_bs = (const float*)d_in[15]; a.w_proj_a = (const float*)d_in[16]; a.w_proj_b = (const float*)d_in[17]; a.w_out = (const float*)d_in[18]; a.norm_ffn = (const float*)d_in[19];
    a.w_up = (const float*)d_in[20]; a.conv_w = (const float*)d_in[21]; a.conv_b = (const float*)d_in[22]; a.w_down = (const float*)d_in[23]; a.norm_final = (const float*)d_in[24];
    a.out = (float*)d_out; a.ws = (unsigned char*)d_ws;
    for (int li = 0; li < MK_N_LAUNCHES; ++li) {
        a.ph_lo = (MK_N_LAUNCHES == 1) ? 0 : li; a.ph_hi = (MK_N_LAUNCHES == 1) ? 10 : li + 1;
        hipLaunchKernelGGL(nsa_hybrid_fwd, dim3(grid), dim3(NWAVES * 64), cfg::LDS_BYTES, stream, a);
        const hipError_t le = hipPeekAtLastError();
        if (le != hipSuccess) { fprintf(stderr, "kernel_launch: launch failed: %s\n", hipGetErrorName(le)); break; }
    }
}
```

```cpp
#include <hip/hip_runtime.h>
#include <cstdio>
#include <cstdint>

namespace cfg {
constexpr int DM = 1024, BATCH = 4, SEQ = 4096, MP = BATCH * SEQ, DB = 32, MROWS = MP + DB, MPAD = 16640;
constexpr int PAST = 16384, PAGE = 128, NPAGES = PAST / PAGE;
constexpr int NH = 8, HD = 64, NKV = 2;
constexpr int INC = 4376, INP = 4608;
constexpr int GW = 512, DFF = 2816, UPN = 2 * DFF;
constexpr float EPS = 1e-6f, NEGF = -1e30f, L2E = 1.4426950408889634f;
constexpr size_t OFF_YP = 0, OFF_YS = 16777216, OFF_CMP_P = 16809984, OFF_SLC_P = 21004288, OFF_WIN_P = 25198592, OFF_V_P = 25722880, OFF_CONV_P = 25985024,
                 OFF_CMP_S = 26007552, OFF_SLC_S = 26015744, OFF_WIN_S = 26023936, OFF_V_S = 30218240, OFF_CONV_S = 30234624, OUT_TOTAL = 30414848;
constexpr size_t MiB = 1u << 20;
constexpr size_t WS_CTL = 0, CTL_ZERO_BYTES = 1 * MiB;
constexpr size_t WS_WIN_T = 2 * MiB, WS_WPA_T = 12 * MiB, WS_WPB_T = 13 * MiB, WS_WOUT_T = 14 * MiB, WS_WUP_T = 16 * MiB, WS_WDN_T = 28 * MiB;
constexpr size_t WS_RSTD1 = 34 * MiB, WS_SSV = 35 * MiB, WS_SS2 = 36 * MiB, WS_SS3 = 38 * MiB, WS_NSAG = 40 * MiB, WS_KCP = 43 * MiB, WS_VCP = 44 * MiB;
constexpr size_t WS_KCS = 48 * MiB, WS_VCS = 64 * MiB;
constexpr size_t WS_XB = 80 * MiB, WS_Q = 113 * MiB, WS_KVB = 130 * MiB, WS_U = 155 * MiB, WS_VG = 172 * MiB, WS_GT = 189 * MiB, WS_ONSA = 254 * MiB, WS_CM = 271 * MiB;
constexpr size_t WS_T = 288 * MiB, WS_MIX = 353 * MiB, WS_X1F = 386 * MiB, WS_X1B = 451 * MiB, WS_AB = 484 * MiB, WS_ACT = 663 * MiB;
constexpr size_t WS_W1T = 45 * MiB, WS_W2F = 46 * MiB, WS_PB = 46 * MiB + 512 * 1024, WS_WTRIL = 47 * MiB;
constexpr size_t WS_CB = 753 * MiB, WS_CBP = 1009 * MiB, WS_PS = 1017 * MiB, WS_PP = 1081 * MiB, WS_END = 1083 * MiB;
constexpr int CW_BAR = 4096;
constexpr int RING_BYTES = 131072, LDSCTL_OFF = RING_BYTES, MISC_OFF = LDSCTL_OFF + 320, BIAS_OFF = LDSCTL_OFF + 1024, LDS_BYTES = 147456;
}

#define GAS __attribute__((address_space(1)))
#define LAS __attribute__((address_space(3)))
#define DI __device__ __forceinline__
typedef unsigned short bf16;
typedef GAS unsigned gu32;
typedef unsigned v4u __attribute__((ext_vector_type(4)));
typedef unsigned v2u __attribute__((ext_vector_type(2)));
typedef float v4f __attribute__((ext_vector_type(4)));

struct Args {
    const float* x_prompt; const float* x_sample; const float* cache_cmp; const float* cache_slc; const float* cache_win; const float* state_conv;
    const int* page_table; const float* norm_mix; const float* w_in; const float* cmp_pe; const float* cmp_w1; const float* cmp_b1; const float* cmp_w2;
    const float* gmlp_norm; const float* gmlp_ws; const float* gmlp_bs; const float* w_proj_a; const float* w_proj_b; const float* w_out; const float* norm_ffn;
    const float* w_up; const float* conv_w; const float* conv_b; const float* w_down; const float* norm_final;
    float* out; unsigned char* ws;
    int ph_lo, ph_hi;
};

DI float bf2f(bf16 b) { return __uint_as_float(((unsigned)b) << 16); }
DI unsigned f2bf(float f) { unsigned u = __float_as_uint(f); return (u + 0x7fffu + ((u >> 16) & 1u)) >> 16; }
DI unsigned pk2(float lo, float hi) { return f2bf(lo) | (f2bf(hi) << 16); }
DI float fast_sigmoid(float x) { return __builtin_amdgcn_rcpf(1.0f + __builtin_amdgcn_exp2f(-1.4426950408889634f * x)); }
DI float gelu_tanh(float x) { const float u = x * (1.0f + 0.044715f * x * x); return x * __builtin_amdgcn_rcpf(1.0f + __builtin_amdgcn_exp2f(-2.302208198f * u)); }
DI float wave_sum(float v) {
#pragma unroll
    for (int o = 1; o < 64; o <<= 1) v += __shfl_xor(v, o);
    return v;
}
DI float wave_max(float v) {
#pragma unroll
    for (int o = 1; o < 64; o <<= 1) v = fmaxf(v, __shfl_xor(v, o));
    return v;
}
namespace pg8 {
#define PG8_LAS __attribute__((address_space(3)))
typedef unsigned short bf16_t;
typedef short bf16x8 __attribute__((ext_vector_type(8)));
typedef float f32x4 __attribute__((ext_vector_type(4)));
typedef unsigned u32x4 __attribute__((ext_vector_type(4)));
constexpr int BM = 256, BK = 64, HALF = 128, HTB = HALF * BK * 2  , STAGE_BYTES = 8 * HTB, NXCD = 8, WGM = 8;

__host__ __device__ __forceinline__ int lds_byte(int r, int c) { const int st = (r >> 4) * 2 + (c >> 5), rr = r & 15, cc = c & 31, ob = rr * 64 + cc * 2; return st * 1024 + (ob ^ (((ob >> 9) & 1) << 5)); }
__host__ __device__ __forceinline__ void stage_rc(int b, int& R, int& C) { const int st = b / 1024, sb = b % 1024, swz = sb ^ (((sb >> 9) & 1) << 5); R = (st >> 1) * 16 + swz / 64; C = (st & 1) * 32 + (swz % 64) / 2; }
__host__ __device__ __forceinline__ int perm32(int rho) { const int n = rho >> 4, i = rho & 15; return 8 * (i >> 2) + 4 * n + (i & 3); }

struct Unit { int pm, pn, kind; const char* a; const char* b; };
struct Gemm { const bf16_t* A; const bf16_t* Bt; int M, N, K, lda, ldb; };

struct StaticOrder {
    int nM, nN, nwg, G, c; const char* A; const char* Bt; size_t tstep;
    __host__ __device__ void init(int M, int N, int G_, int c_, const void* A_ = nullptr, const void* Bt_ = nullptr, int K_ = 0) { nM = M / BM; nN = N / BM; nwg = nM * nN; G = G_; c = c_; A = (const char*)A_; Bt = (const char*)Bt_; tstep = (size_t)BM * K_ * 2; }
    __host__ __device__ bool next(int i, Unit& u) const {
        const long L = (long)i * G + c; if (L >= nwg) return false;
        return unit_of((int)L, u);
    }
    __host__ __device__ bool unit_of(int L, Unit& u) const {
        int wgid = L; { const int q = nwg / NXCD, r = nwg % NXCD, xcd = wgid % NXCD, off = wgid / NXCD; wgid = (xcd < r ? xcd * (q + 1) : r * (q + 1) + (xcd - r) * q) + off; }
        const int nig = WGM * nN, gid = wgid / nig, fm = gid * WGM, gsz = (nM - fm) < WGM ? (nM - fm) : WGM;
        u.pm = fm + ((wgid % nig) % gsz); u.pn = (wgid % nig) / gsz; u.kind = 0; u.a = A + (size_t)u.pm * tstep; u.b = Bt + (size_t)u.pn * tstep; return true;
    }
    __device__ __forceinline__ void a_ready(const Unit&) const {}
    __device__ __forceinline__ void done(const Unit&) const {}
};

typedef float f32x2c_t __attribute__((ext_vector_type(2))); typedef __bf16 bf16x2c_t __attribute__((ext_vector_type(2)));
__device__ __forceinline__ unsigned cvt_pk_bf16(float lo, float hi) { f32x2c_t v = {lo, hi}; bf16x2c_t b = __builtin_convertvector(v, bf16x2c_t); return __builtin_bit_cast(unsigned, b); }
typedef unsigned u32x2 __attribute__((ext_vector_type(2)));
__device__ __forceinline__ u32x4 pack8(const f32x4& v0, const f32x4& v1) { u32x4 w; w.x = cvt_pk_bf16(v0[0], v0[1]); w.y = cvt_pk_bf16(v0[2], v0[3]); w.z = cvt_pk_bf16(v1[0], v1[1]); w.w = cvt_pk_bf16(v1[2], v1[3]); return w; }
__device__ __forceinline__ f32x4 sig4(const f32x4& v) { return (f32x4){fast_sigmoid(v[0]), fast_sigmoid(v[1]), fast_sigmoid(v[2]), fast_sigmoid(v[3])}; }
__device__ __forceinline__ f32x4 gelu4(const f32x4& v) { return (f32x4){gelu_tanh(v[0]), gelu_tanh(v[1]), gelu_tanh(v[2]), gelu_tanh(v[3])}; }
__device__ __forceinline__ float sq4(const f32x4& v) { return (v[0] * v[0] + v[1] * v[1]) + (v[2] * v[2] + v[3] * v[3]); }

struct EpiIn {
    static constexpr bool PERM = true, AFTER_DRAIN = false, KEEP = false;
    const float* rstd; bf16_t* Q; bf16_t* KVB; bf16_t* U; bf16_t* VG; float* SSV; bf16_t* GT; float* NSAG; float* out; bf16_t* CBP;
    __device__ __forceinline__ void operator()(const f32x4 (&acc)[2][2][4][2], const Unit& u, int wr, int wc, int fr, int fq) const {
        const int row0 = u.pm * BM + wr * 64 + fr, cl0 = wc * 32 + 8 * fq, pn = u.pn;
#pragma unroll
        for (int ai = 0; ai < 2; ++ai)
#pragma unroll
            for (int m = 0; m < 4; ++m) {
                const int row = row0 + ai * HALF + m * 16; const float rs = rstd[row];
                if (pn < 2) {
                    const float s = rs * 0.125f;
#pragma unroll
                    for (int bj = 0; bj < 2; ++bj) *(u32x4*)(Q + (size_t)row * 512 + pn * 256 + bj * HALF + cl0) = pack8(acc[ai][bj][m][0] * s, acc[ai][bj][m][1] * s);
                } else if (pn < 5) {
                    float* dst = nullptr;
                    if (pn == 2) dst = row < cfg::MP ? out + cfg::OFF_CMP_P + (size_t)row * 256 : (row < cfg::MROWS ? out + cfg::OFF_CMP_S + (size_t)(row - cfg::MP) * 256 : nullptr);
                    else if (pn == 3) dst = row < cfg::MP ? out + cfg::OFF_SLC_P + (size_t)row * 256 : (row < cfg::MROWS ? out + cfg::OFF_SLC_S + (size_t)(row - cfg::MP) * 256 : nullptr);
                    else { if (row < cfg::MP) { const int t = row & 4095, b = row >> 12; if (t >= 3584) dst = out + cfg::OFF_WIN_P + (size_t)(b * 512 + (t - 3584)) * 256; }
                           else if (row < cfg::MROWS) dst = out + cfg::OFF_WIN_S + ((size_t)(row - cfg::MP) * 512 + 511) * 256; }
#pragma unroll
                    for (int bj = 0; bj < 2; ++bj) { const f32x4 v0 = acc[ai][bj][m][0] * rs, v1 = acc[ai][bj][m][1] * rs; const int cl = bj * HALF + cl0;
                        const u32x4 pk = pack8(v0, v1); *(u32x4*)(KVB + (size_t)row * 768 + (pn - 2) * 256 + cl) = pk;
                        if (pn == 2 && row < cfg::MP) *(u32x4*)(CBP + ((size_t)((bj * 4 + (row >> 12)) * 2 + (cl0 >> 6)) * 4096 + (row & 4095)) * 64 + (cl0 & 63)) = pk;
                        if (dst) { *(f32x4*)(dst + cl) = v0; *(f32x4*)(dst + cl + 4) = v1; } }
                } else if (pn < 7) {
#pragma unroll
                    for (int bj = 0; bj < 2; ++bj) *(u32x4*)(U + (size_t)row * 512 + (pn - 5) * 256 + bj * HALF + cl0) = pack8(gelu4(acc[ai][bj][m][0] * rs), gelu4(acc[ai][bj][m][1] * rs));
                } else if (pn < 9) {
                    float ss = 0.f;
#pragma unroll
                    for (int bj = 0; bj < 2; ++bj) { const f32x4 v0 = gelu4(acc[ai][bj][m][0] * rs), v1 = gelu4(acc[ai][bj][m][1] * rs); ss += sq4(v0) + sq4(v1);
                        *(u32x4*)(VG + (size_t)row * 512 + (pn - 7) * 256 + bj * HALF + cl0) = pack8(v0, v1); }
                    ss += __shfl_xor(ss, 16); ss += __shfl_xor(ss, 32);
                    if (fq == 0) SSV[(size_t)row * 8 + (pn - 7) * 4 + wc] = ss;
                } else if (pn < 17) {
#pragma unroll
                    for (int bj = 0; bj < 2; ++bj) *(u32x4*)(GT + (size_t)row * 2048 + (pn - 9) * 256 + bj * HALF + cl0) = pack8(sig4(acc[ai][bj][m][0] * rs), sig4(acc[ai][bj][m][1] * rs));
                } else {
                    if (wc == 0 && fq < 3) { float* d = NSAG + (size_t)row * 32 + 8 * fq; *(f32x4*)d = sig4(acc[ai][0][m][0] * rs); *(f32x4*)(d + 4) = sig4(acc[ai][0][m][1] * rs); }
                }
            }
    }
};
struct EpiP {
    static constexpr bool PERM = true, AFTER_DRAIN = false, KEEP = false;
    bf16_t* P; size_t kv_stride; const PG8_LAS float* biasL;
    __device__ __forceinline__ void operator()(const f32x4 (&acc)[2][2][4][2], const Unit& u, int wr, int wc, int fr, int fq) const {
        const int kv = u.kind - 1, row0 = u.pm * BM + wr * 64 + fr, cl0 = wc * 32 + 8 * fq;
        const f32x4 b0 = *(const PG8_LAS f32x4*)(biasL + kv * 128 + cl0), b1 = *(const PG8_LAS f32x4*)(biasL + kv * 128 + cl0 + 4);
        bf16_t* Pk = P + (size_t)kv * kv_stride;
#pragma unroll
        for (int ai = 0; ai < 2; ++ai)
#pragma unroll
            for (int m = 0; m < 4; ++m) { bf16_t* pr = Pk + (size_t)(row0 + ai * HALF + m * 16) * 256 + cl0;
                *(u32x4*)pr = pack8(acc[ai][0][m][0] + b0, acc[ai][0][m][1] + b1); *(u32x4*)(pr + HALF) = pack8(acc[ai][1][m][0], acc[ai][1][m][1]); }
    }
};
struct EpiMix {
    static constexpr bool PERM = true, AFTER_DRAIN = false, KEEP = false;
    EpiIn in; EpiP p;
    __device__ __forceinline__ void operator()(const f32x4 (&acc)[2][2][4][2], const Unit& u, int wr, int wc, int fr, int fq) const { if (u.kind == 0) in(acc, u, wr, wc, fr, fq); else p(acc, u, wr, wc, fr, fq); }
};
__device__ __forceinline__ void unpack8(const u32x4& g, f32x4& lo, f32x4& hi) {
    lo = (f32x4){__uint_as_float(g.x << 16), __uint_as_float(g.x & 0xffff0000u), __uint_as_float(g.y << 16), __uint_as_float(g.y & 0xffff0000u)};
    hi = (f32x4){__uint_as_float(g.z << 16), __uint_as_float(g.z & 0xffff0000u), __uint_as_float(g.w << 16), __uint_as_float(g.w & 0xffff0000u)};
}
struct EpiMixAB {
    static constexpr bool PERM = true, AFTER_DRAIN = false, KEEP = true;
    const bf16_t* GT; bf16_t* MIX;
    __device__ __forceinline__ bool keep(const Unit& u) const { return u.kind == 0; }
    __device__ __forceinline__ void operator()(f32x4 (&acc)[2][2][4][2], const Unit& u, int wr, int wc, int fr, int fq) const {
        const int row0 = u.pm * BM + wr * 64 + fr, col0 = u.pn * BM + wc * 32 + 8 * fq;
        if (u.kind == 0) {
#pragma unroll
            for (int ai = 0; ai < 2; ++ai)
#pragma unroll
                for (int m = 0; m < 4; ++m) { const bf16_t* gp = GT + (size_t)(row0 + ai * HALF + m * 16) * 2048 + col0;
#pragma unroll
                    for (int bj = 0; bj < 2; ++bj) { f32x4 a0, a1, b0, b1; unpack8(*(const u32x4*)(gp + bj * HALF), a0, a1); unpack8(*(const u32x4*)(gp + 1024 + bj * HALF), b0, b1);
#pragma unroll
                        for (int i = 0; i < 4; ++i) { acc[ai][bj][m][0][i] *= a0[i] * __builtin_amdgcn_rcpf(b0[i]); acc[ai][bj][m][1][i] *= a1[i] * __builtin_amdgcn_rcpf(b1[i]); } } }
        } else {
#pragma unroll
            for (int ai = 0; ai < 2; ++ai)
#pragma unroll
                for (int m = 0; m < 4; ++m) { const int row = row0 + ai * HALF + m * 16;
#pragma unroll
                    for (int bj = 0; bj < 2; ++bj) { const int col = col0 + bj * HALF; f32x4 b0, b1; unpack8(*(const u32x4*)(GT + (size_t)row * 2048 + 1024 + col), b0, b1);
                        *(u32x4*)(MIX + (size_t)row * 1024 + col) = pack8(acc[ai][bj][m][0] * b0, acc[ai][bj][m][1] * b1); } }
        }
    }
};
struct EpiOut {
    static constexpr bool PERM = true, AFTER_DRAIN = false, KEEP = false;
    const float* xp; const float* xs; float* X1F; bf16_t* X1B; float* SS2;
    __device__ __forceinline__ void operator()(const f32x4 (&acc)[2][2][4][2], const Unit& u, int wr, int wc, int fr, int fq) const {
        const int row0 = u.pm * BM + wr * 64 + fr, col0 = u.pn * BM + wc * 32 + 8 * fq;
#pragma unroll
        for (int ai = 0; ai < 2; ++ai)
#pragma unroll
            for (int m = 0; m < 4; ++m) { const int row = row0 + ai * HALF + m * 16;
                const float* xr = row < cfg::MP ? xp + (size_t)row * 1024 : (row < cfg::MROWS ? xs + (size_t)(row - cfg::MP) * 1024 : nullptr);
                float ss = 0.f;
#pragma unroll
                for (int bj = 0; bj < 2; ++bj) { const int col = col0 + bj * HALF;
                    f32x4 x0 = (f32x4){0.f, 0.f, 0.f, 0.f}, x1 = x0; if (xr) { x0 = *(const f32x4*)(xr + col); x1 = *(const f32x4*)(xr + col + 4); }
                    x0 = x0 + acc[ai][bj][m][0]; x1 = x1 + acc[ai][bj][m][1]; ss += sq4(x0) + sq4(x1);
                    float* d = X1F + (size_t)row * 1024 + col; *(f32x4*)d = x0; *(f32x4*)(d + 4) = x1;
                    *(u32x4*)(X1B + (size_t)row * 1024 + col) = pack8(x0, x1); }
                ss += __shfl_xor(ss, 16); ss += __shfl_xor(ss, 32);
                if (fq == 0) SS2[(size_t)row * 16 + u.pn * 4 + wc] = ss; }
    }
};
struct EpiUp {
    static constexpr bool PERM = true, AFTER_DRAIN = false, KEEP = false;
    const float* SS2; bf16_t* AB; float* out;
    __device__ __forceinline__ void operator()(const f32x4 (&acc)[2][2][4][2], const Unit& u, int wr, int wc, int fr, int fq) const {
        const int row0 = u.pm * BM + wr * 64 + fr, col0 = u.pn * BM + wc * 32 + 8 * fq;
#pragma unroll
        for (int ai = 0; ai < 2; ++ai)
#pragma unroll
            for (int m = 0; m < 4; ++m) { const int row = row0 + ai * HALF + m * 16;
                const f32x4* sp = (const f32x4*)(SS2 + (size_t)row * 16); const f32x4 s0 = sp[0], s1 = sp[1], s2 = sp[2], s3 = sp[3];
                const float ssum = ((s0[0] + s0[1]) + (s0[2] + s0[3])) + ((s1[0] + s1[1]) + (s1[2] + s1[3])) + ((s2[0] + s2[1]) + (s2[2] + s2[3])) + ((s3[0] + s3[1]) + (s3[2] + s3[3]));
                const float rs = 1.0f / sqrtf(ssum * (1.0f / 1024.0f) + cfg::EPS);
                float* dst = nullptr;
                if (u.pn < 11) { if (row < cfg::MP) { const int t = row & 4095, b = row >> 12; if (t >= 4094) dst = out + cfg::OFF_CONV_P + (size_t)(b * 2 + (t - 4094)) * 2816; }
                                 else if (row < cfg::MROWS) dst = out + cfg::OFF_CONV_S + ((size_t)(row - cfg::MP) * 2 + 1) * 2816; }
#pragma unroll
                for (int bj = 0; bj < 2; ++bj) { const int col = col0 + bj * HALF; const f32x4 v0 = acc[ai][bj][m][0] * rs, v1 = acc[ai][bj][m][1] * rs;
                    *(u32x4*)(AB + (size_t)row * 5632 + col) = pack8(v0, v1);
                    if (dst) { *(f32x4*)(dst + col) = v0; *(f32x4*)(dst + col + 4) = v1; } } }
    }
};
struct EpiDown {
    static constexpr bool PERM = true, AFTER_DRAIN = false, KEEP = false;
    const float* X1F; float* out; float* SS3;
    __device__ __forceinline__ void operator()(const f32x4 (&acc)[2][2][4][2], const Unit& u, int wr, int wc, int fr, int fq) const {
        const int row0 = u.pm * BM + wr * 64 + fr, col0 = u.pn * BM + wc * 32 + 8 * fq;
#pragma unroll
        for (int ai = 0; ai < 2; ++ai)
#pragma unroll
            for (int m = 0; m < 4; ++m) { const int row = row0 + ai * HALF + m * 16; float ss = 0.f;
#pragma unroll
                for (int bj = 0; bj < 2; ++bj) { const int col = col0 + bj * HALF; const float* xr = X1F + (size_t)row * 1024 + col;
                    const f32x4 x0 = *(const f32x4*)xr + acc[ai][bj][m][0], x1 = *(const f32x4*)(xr + 4) + acc[ai][bj][m][1]; ss += sq4(x0) + sq4(x1);
                    if (row < cfg::MROWS) { float* d = out + (size_t)row * 1024 + col; *(f32x4*)d = x0; *(f32x4*)(d + 4) = x1; } }
                ss += __shfl_xor(ss, 16); ss += __shfl_xor(ss, 32);
                if (fq == 0) SS3[(size_t)row * 16 + u.pn * 4 + wc] = ss; }
    }
};
template <class Epi, class Sched, bool ALIGN_EPI = false, bool SP2 = false>
__device__ __forceinline__ void gemm_phase(PG8_LAS unsigned char* lds, const Gemm g, const Sched& S, const Epi& E) {
    const int tid = threadIdx.x, wid = __builtin_amdgcn_readfirstlane(tid >> 6), lane = tid & 63, wr = wid >> 2, wc = wid & 3, fr = lane & 15, fq = lane >> 4;
    const int K = g.K, nt = K / BK;
    unsigned voffA[2], voffB[2];
#pragma unroll
    for (int i = 0; i < 2; ++i) { int R, C; stage_rc(tid * 16 + i * 8192, R, C); const int Rb = Epi::PERM ? ((R & ~31) + perm32(R & 31)) : R;
        voffA[i] = (unsigned)(R * g.lda + C) * 2u; voffB[i] = (unsigned)(Rb * g.ldb + C) * 2u; }
    const size_t kstep = (size_t)(BK * 2);
    const size_t hstepA = (size_t)HALF * g.lda * 2, hstepB = (size_t)HALF * g.ldb * 2;
    const unsigned ldsw = (unsigned)wid * 1024u;
    const int aoff = lds_byte(wr * 64 + fr, fq * 8), boff = lds_byte(wc * 32 + fr, fq * 8);
#define PG8_SA(b, h) (((b) * 2 + (h)) * HTB)
#define PG8_SB(b, h) ((4 + (b) * 2 + (h)) * HTB)
#define PG8_STAGE(bufoff, gbase, voff) do { _Pragma("unroll") for (int _i = 0; _i < 2; ++_i) \
        __builtin_amdgcn_global_load_lds((const unsigned*)((const char*)(gbase) + (voff)[_i]), (PG8_LAS unsigned*)(lds + (bufoff) + ldsw + _i * 8192), 16, 0, 0); } while (0)
#define PG8_LDA(dst, b, h) do { _Pragma("unroll") for (int m = 0; m < 4; ++m) _Pragma("unroll") for (int k = 0; k < 2; ++k) dst[m][k] = *(const PG8_LAS bf16x8*)(lds + PG8_SA(b, h) + aoff + m * 2048 + k * 1024); } while (0)
#define PG8_LDB(dst, b, h) do { _Pragma("unroll") for (int n = 0; n < 2; ++n) _Pragma("unroll") for (int k = 0; k < 2; ++k) dst[n][k] = *(const PG8_LAS bf16x8*)(lds + PG8_SB(b, h) + boff + n * 2048 + k * 1024); } while (0)
#define PG8_MMA(ai, bj, At, Bt) do { __builtin_amdgcn_s_setprio(1); _Pragma("unroll") for (int m = 0; m < 4; ++m) _Pragma("unroll") for (int n = 0; n < 2; ++n) _Pragma("unroll") for (int k = 0; k < 2; ++k) \
        acc[ai][bj][m][n] = __builtin_amdgcn_mfma_f32_16x16x32_bf16(Bt[n][k], At[m][k], acc[ai][bj][m][n], 0, 0, 0); __builtin_amdgcn_s_setprio(0); } while (0)
#define PG8_WAIT_V(n) asm volatile("s_waitcnt vmcnt(" #n ")" ::: "memory")
#define PG8_WAIT_L(n) asm volatile("s_waitcnt lgkmcnt(" #n ")" ::: "memory")
#define PG8_BAR __builtin_amdgcn_s_barrier()
#define PG8_SCHED __builtin_amdgcn_sched_barrier(0)
    Unit cur, nxt; int ui = 0;
    if (!S.next(0, cur)) return;
    f32x4 acc[2][2][4][2];
#pragma unroll
    for (int a = 0; a < 2; ++a)
#pragma unroll
        for (int b = 0; b < 2; ++b)
#pragma unroll
            for (int m = 0; m < 4; ++m)
#pragma unroll
                for (int n = 0; n < 2; ++n) acc[a][b][m][n] = (f32x4){0.f, 0.f, 0.f, 0.f};
    bf16x8 At[4][2], B0[2][2], B1[2][2];
    const char* cA = cur.a; const char* cB = cur.b;
    S.a_ready(cur);
    if constexpr (SP2) {
        PG8_STAGE(PG8_SB(0, 0), cB, voffB); PG8_STAGE(PG8_SB(0, 1), cB + hstepB, voffB); PG8_STAGE(PG8_SA(0, 0), cA, voffA); PG8_STAGE(PG8_SA(0, 1), cA + hstepA, voffA);
        if (wr == 1) PG8_BAR;
        PG8_WAIT_V(2); PG8_BAR;
        PG8_STAGE(PG8_SB(1, 0), cB + kstep, voffB); PG8_STAGE(PG8_SA(1, 0), cA + kstep, voffA); PG8_STAGE(PG8_SB(1, 1), cB + hstepB + kstep, voffB);
        PG8_WAIT_V(6); PG8_BAR;
    } else {
        PG8_STAGE(PG8_SB(0, 0), cB, voffB); PG8_STAGE(PG8_SA(0, 0), cA, voffA); PG8_STAGE(PG8_SB(0, 1), cB + hstepB, voffB); PG8_STAGE(PG8_SA(0, 1), cA + hstepA, voffA);
        if (wr == 1) PG8_BAR;
        PG8_WAIT_V(4); PG8_BAR;
        PG8_STAGE(PG8_SB(1, 0), cB + kstep, voffB); PG8_STAGE(PG8_SA(1, 0), cA + kstep, voffA); PG8_STAGE(PG8_SB(1, 1), cB + hstepB + kstep, voffB);
        PG8_WAIT_V(6); PG8_BAR;
    }
    for (;;) {
        const bool has_next = S.next(ui + 1, nxt);
        const char* nA = has_next ? nxt.a : cA; const char* nB = has_next ? nxt.b : cB;
        for (int t = 0; t < nt; t += 2) {
            const bool last = (t == nt - 2);
            const char* a1 = cA + (size_t)(t + 1) * kstep;
            const char* a2 = last ? nA : cA + (size_t)(t + 2) * kstep; const char* b2 = last ? nB : cB + (size_t)(t + 2) * kstep;
            const char* a3 = a2 + kstep; const char* b3 = b2 + kstep;
            if (last && has_next) S.a_ready(nxt);
            if constexpr (SP2) {
            PG8_LDB(B0, 0, 0); PG8_LDB(B1, 0, 1); PG8_SCHED; PG8_LDA(At, 0, 0); PG8_STAGE(PG8_SA(1, 1), a1 + hstepA, voffA);
            PG8_WAIT_V(8); PG8_WAIT_L(0); PG8_BAR; PG8_MMA(0, 0, At, B0); PG8_MMA(0, 1, At, B1); PG8_BAR; PG8_SCHED;
            PG8_LDA(At, 0, 1); PG8_STAGE(PG8_SB(0, 0), b2, voffB); PG8_STAGE(PG8_SB(0, 1), b2 + hstepB, voffB); PG8_STAGE(PG8_SA(0, 0), a2, voffA);
            PG8_WAIT_V(8); PG8_WAIT_L(0); PG8_BAR; PG8_MMA(1, 0, At, B0); PG8_MMA(1, 1, At, B1); PG8_BAR; PG8_SCHED;
            PG8_LDB(B0, 1, 0); PG8_LDB(B1, 1, 1); PG8_SCHED; PG8_LDA(At, 1, 0); PG8_STAGE(PG8_SA(0, 1), a2 + hstepA, voffA);
            PG8_WAIT_V(8); PG8_WAIT_L(0); PG8_BAR; PG8_MMA(0, 0, At, B0); PG8_MMA(0, 1, At, B1); PG8_BAR; PG8_SCHED;
            PG8_LDA(At, 1, 1); PG8_STAGE(PG8_SB(1, 0), b3, voffB); PG8_STAGE(PG8_SB(1, 1), b3 + hstepB, voffB); PG8_STAGE(PG8_SA(1, 0), a3, voffA);
            PG8_WAIT_V(8); PG8_WAIT_L(0); PG8_BAR; PG8_MMA(1, 0, At, B0); PG8_MMA(1, 1, At, B1); PG8_BAR; PG8_SCHED;
            } else {
            PG8_LDB(B0, 0, 0); PG8_SCHED; PG8_LDA(At, 0, 0); PG8_STAGE(PG8_SA(1, 1), a1 + hstepA, voffA);
            PG8_WAIT_L(8); PG8_BAR; PG8_WAIT_L(0); PG8_MMA(0, 0, At, B0); PG8_BAR; PG8_SCHED;
            PG8_LDB(B1, 0, 1); PG8_STAGE(PG8_SB(0, 0), b2, voffB);
            PG8_BAR; PG8_WAIT_L(0); PG8_MMA(0, 1, At, B1); PG8_BAR;
            PG8_LDA(At, 0, 1); PG8_STAGE(PG8_SA(0, 0), a2, voffA);
            PG8_BAR; PG8_WAIT_L(0); PG8_MMA(1, 0, At, B0); PG8_BAR; PG8_SCHED;
            PG8_STAGE(PG8_SB(0, 1), b2 + hstepB, voffB);
            PG8_WAIT_V(6); PG8_BAR; PG8_MMA(1, 1, At, B1); PG8_BAR;
            PG8_LDB(B0, 1, 0); PG8_SCHED; PG8_LDA(At, 1, 0); PG8_STAGE(PG8_SA(0, 1), a2 + hstepA, voffA);
            PG8_WAIT_L(8); PG8_BAR; PG8_WAIT_L(0); PG8_MMA(0, 0, At, B0); PG8_BAR; PG8_SCHED;
            PG8_LDB(B1, 1, 1); PG8_STAGE(PG8_SB(1, 0), b3, voffB);
            PG8_BAR; PG8_WAIT_L(0); PG8_MMA(0, 1, At, B1); PG8_BAR;
            PG8_LDA(At, 1, 1); PG8_STAGE(PG8_SA(1, 0), a3, voffA);
            PG8_BAR; PG8_WAIT_L(0); PG8_MMA(1, 0, At, B0); PG8_BAR; PG8_SCHED;
            PG8_STAGE(PG8_SB(1, 1), b3 + hstepB, voffB);
            PG8_WAIT_V(6); PG8_BAR; PG8_MMA(1, 1, At, B1); PG8_BAR;
            }
        }
        if constexpr (ALIGN_EPI) { if (wr == 0) PG8_BAR; }
        if constexpr (!Epi::AFTER_DRAIN) { E(acc, cur, wr, wc, fr, fq); S.done(cur); }
        if (!has_next) break;
        bool keep = false; if constexpr (Epi::KEEP) keep = E.keep(cur);
        if (!keep) {
#pragma unroll
        for (int a = 0; a < 2; ++a)
#pragma unroll
            for (int b = 0; b < 2; ++b)
#pragma unroll
                for (int m = 0; m < 4; ++m)
#pragma unroll
                    for (int n = 0; n < 2; ++n) acc[a][b][m][n] = (f32x4){0.f, 0.f, 0.f, 0.f};
        }
        cur = nxt; cA = nA; cB = nB; ++ui;
        if constexpr (ALIGN_EPI) { if (wr == 1) PG8_BAR; }
    }
    PG8_WAIT_V(0);
    if constexpr (!ALIGN_EPI) { if (wr == 0) PG8_BAR; }
    PG8_BAR;
    if constexpr (Epi::AFTER_DRAIN) { E.fused(acc, cur, wr, wc, fr, fq, lds, wid, lane); S.done(cur); }
#undef PG8_SA
#undef PG8_SB
#undef PG8_STAGE
#undef PG8_LDA
#undef PG8_LDB
#undef PG8_MMA
#undef PG8_WAIT_V
#undef PG8_WAIT_L
#undef PG8_BAR
#undef PG8_SCHED
}
}
#define XB_TMO      128
#define XB_XCNT(j)  (256  + 64 * (j))
#define XB_XSUB(j)  (1280 + 64 * (j))
#define XB_XGEN(j)  (2304 + 64 * (j))
#define XB_TOP      3328
#define XB_TOPGEN   3392
#define XCD_BAR_WORDS 3456
#define XB_SPIN_CAP (1u << 22)

__device__ __forceinline__ unsigned xb_ld(unsigned* p)              { return __hip_atomic_load(p, __ATOMIC_RELAXED, __HIP_MEMORY_SCOPE_AGENT); }
__device__ __forceinline__ unsigned xb_add(unsigned* p, unsigned v) { return __hip_atomic_fetch_add(p, v, __ATOMIC_RELAXED, __HIP_MEMORY_SCOPE_AGENT); }
__device__ __forceinline__ unsigned xb_xcc_id() { return (unsigned)__builtin_amdgcn_s_getreg((3 << 11) | 20) & 0xFu; }
#define XB_SPIN(cond, bar) do { unsigned _sp = 0; while (cond) { __builtin_amdgcn_s_sleep(1); \
    if ((++_sp & 255u) == 0u) { if (xb_ld(&(bar)[XB_TMO])) break; if (_sp > XB_SPIN_CAP) { atomicAdd(&(bar)[XB_TMO], 1u); break; } } } } while (0)

struct XcdBarrier {
    unsigned* bar; unsigned x;
    volatile LAS unsigned* st;
};

__device__ __forceinline__ XcdBarrier xcd_barrier_post(unsigned* bar, volatile LAS unsigned* st) {
    XcdBarrier b; b.bar = bar; b.x = xb_xcc_id(); b.st = st;
    if (threadIdx.x == 0) (void)xb_add(&bar[XB_XCNT(b.x)], 1u);
    return b;
}
__device__ __forceinline__ void xcd_barrier_complete(unsigned* bar, unsigned x, unsigned& nloc, unsigned& nx) {
    const unsigned G = gridDim.x * gridDim.y * gridDim.z;
    unsigned sum, cnt, mine, sp = 0u;
    for (;;) {
        sum = 0u; cnt = 0u; mine = 0u;
#pragma unroll
        for (unsigned j = 0; j < 16; ++j) { const unsigned c = xb_ld(&bar[XB_XCNT(j)]); sum += c; cnt += (c > 0u) ? 1u : 0u; mine = (j == x) ? c : mine; }
        if (sum == G) break;
        __builtin_amdgcn_s_sleep(1);
        if ((++sp & 255u) == 0u) { if (xb_ld(&bar[XB_TMO])) break; if (sp > XB_SPIN_CAP) { atomicAdd(&bar[XB_TMO], 1u); break; } }
    }
    nloc = mine > 0u ? mine : 1u; nx = cnt > 0u ? cnt : 1u;
}

__device__ __forceinline__ void xcd_barrier(const XcdBarrier& b) {
    asm volatile("s_waitcnt vmcnt(0)" ::: "memory");
    __syncthreads();
    if (threadIdx.x == 0) {
        unsigned* bar = b.bar;
        __builtin_amdgcn_s_waitcnt(0);
        unsigned nloc = b.st[0], nx = b.st[1];
        if (nloc == 0u) { xcd_barrier_complete(bar, b.x, nloc, nx); b.st[0] = nloc; b.st[1] = nx; }
        const unsigned old = xb_add(&bar[XB_XSUB(b.x)], 1u);
        const unsigned gen = old / nloc;
        if (old + 1u == (gen + 1u) * nloc) {
            __builtin_amdgcn_fence(__ATOMIC_RELEASE, "agent");
            asm volatile("s_waitcnt vmcnt(0)" ::: "memory");
            const unsigned og = xb_add(&bar[XB_TOP], 1u);
            const unsigned tg = og / nx;
            if (og + 1u == (tg + 1u) * nx) xb_add(&bar[XB_TOPGEN], 1u);
            else XB_SPIN(xb_ld(&bar[XB_TOPGEN]) == tg, bar);
            __builtin_amdgcn_fence(__ATOMIC_ACQUIRE, "agent");
            xb_add(&bar[XB_XGEN(b.x)], 1u);
            asm volatile("s_waitcnt vmcnt(0)" ::: "memory");
        } else {
            XB_SPIN(xb_ld(&bar[XB_XGEN(b.x)]) == gen, bar);
            __builtin_amdgcn_fence(__ATOMIC_ACQUIRE, "agent");
            asm volatile("s_waitcnt vmcnt(0)" ::: "memory");
        }
    }
    __syncthreads();
}
constexpr int NWAVES = 8;
#ifndef MK_N_LAUNCHES
#define MK_N_LAUNCHES 1
#endif
#ifndef REPMASK
#define REPMASK 0
#endif
#ifndef PHMASK
#define PHMASK 0x3ff
#endif
#define LDS_WAIT() asm volatile("s_waitcnt lgkmcnt(0)" ::: "memory")

template <int MAPK> DI int colmap(int n, int N) {
    if (MAPK == 0) return n < N ? n : -1;
    if (n < 1280) return n;
    if (n < 2304) return n + 24;
    if (n < 4352) return n + 24;
    if (n < 4376) return n - 4352 + 1280;
    return -1;
}
template <int MAPK> DI void transpose_item(const float* W, int K, int N, const float* kscale, bf16* WT, LAS float* scr, int item, int nblk, int lane) {
    const int kb = item / nblk, nb = item % nblk, k0 = 64 * kb, n0 = 32 * nb;
    const int sc = colmap<MAPK>(n0 + (lane & 31), N);
#pragma unroll 8
    for (int i = 0; i < 32; ++i) { const int kk = 2 * i + (lane >> 5); float v = 0.f; if (sc >= 0) { v = W[(size_t)(k0 + kk) * N + sc]; if (kscale) v *= kscale[k0 + kk]; } scr[kk * 33 + (lane & 31)] = v; }
    LDS_WAIT();
    const int c = lane & 7;
#pragma unroll
    for (int j = 0; j < 4; ++j) { const int n = (lane >> 3) + 8 * j; const LAS float* s = scr + (8 * c) * 33 + n;
        v4u o; o.x = pk2(s[0 * 33], s[1 * 33]); o.y = pk2(s[2 * 33], s[3 * 33]); o.z = pk2(s[4 * 33], s[5 * 33]); o.w = pk2(s[6 * 33], s[7 * 33]);
        *(v4u*)(WT + (size_t)(n0 + n) * K + k0 + 8 * c) = o; }
    LDS_WAIT();
}

DI void load8(const float* p, float (&x)[8]) { const v4f a = *(const v4f*)p, b = *(const v4f*)(p + 4); x[0] = a.x; x[1] = a.y; x[2] = a.z; x[3] = a.w; x[4] = b.x; x[5] = b.y; x[6] = b.z; x[7] = b.w; }
DI void load8(const bf16* p, float (&x)[8]) { const v4u a = *(const v4u*)p; x[0] = __uint_as_float(a.x << 16); x[1] = __uint_as_float(a.x & 0xffff0000u); x[2] = __uint_as_float(a.y << 16); x[3] = __uint_as_float(a.y & 0xffff0000u);
    x[4] = __uint_as_float(a.z << 16); x[5] = __uint_as_float(a.z & 0xffff0000u); x[6] = __uint_as_float(a.w << 16); x[7] = __uint_as_float(a.w & 0xffff0000u); }
DI float load1(const float* p) { return *p; }
DI float load1(const bf16* p) { return bf2f(*p); }

typedef short s16x8 __attribute__((ext_vector_type(8)));
typedef float f32x16 __attribute__((ext_vector_type(16)));
template <typename OT> DI void cmp_stage2_tile(const bf16* Pg, int nseg, int n0, const bf16* W2Fkv, OT* OUTg, int ncmp, int lane) {
    const int r32 = lane & 31, hi = lane >> 5, ra = n0 + r32, rb = ra + 1 < nseg ? ra + 1 : nseg - 1;
    f32x16 acc0, acc1;
#pragma unroll
    for (int i = 0; i < 16; ++i) { acc0[i] = 0.f; acc1[i] = 0.f; }
#pragma unroll
    for (int ks = 0; ks < 8; ++ks) {
        float p0[8], p1[8]; load8(Pg + (size_t)ra * 256 + 16 * ks + 8 * hi, p0); load8(Pg + (size_t)rb * 256 + 128 + 16 * ks + 8 * hi, p1);
        v4u av; av.x = pg8::cvt_pk_bf16(gelu_tanh(p0[0] + p1[0]), gelu_tanh(p0[1] + p1[1])); av.y = pg8::cvt_pk_bf16(gelu_tanh(p0[2] + p1[2]), gelu_tanh(p0[3] + p1[3]));
        av.z = pg8::cvt_pk_bf16(gelu_tanh(p0[4] + p1[4]), gelu_tanh(p0[5] + p1[5])); av.w = pg8::cvt_pk_bf16(gelu_tanh(p0[6] + p1[6]), gelu_tanh(p0[7] + p1[7]));
        const v4u b0 = *(const v4u*)(W2Fkv + ((size_t)(ks * 2 + 0) * 64 + lane) * 8), b1 = *(const v4u*)(W2Fkv + ((size_t)(ks * 2 + 1) * 64 + lane) * 8);
        acc0 = __builtin_amdgcn_mfma_f32_32x32x16_bf16(__builtin_bit_cast(s16x8, av), __builtin_bit_cast(s16x8, b0), acc0, 0, 0, 0);
        acc1 = __builtin_amdgcn_mfma_f32_32x32x16_bf16(__builtin_bit_cast(s16x8, av), __builtin_bit_cast(s16x8, b1), acc1, 0, 0, 0);
    }
#pragma unroll
    for (int r = 0; r < 16; ++r) { const int row = n0 + (r & 3) + 8 * (r >> 2) + 4 * hi; if (row < ncmp) { if (sizeof(OT) == 4) { OUTg[(size_t)row * 64 + r32] = (OT)acc0[r]; OUTg[(size_t)row * 64 + 32 + r32] = (OT)acc1[r]; } else { OUTg[(size_t)row * 64 + r32] = (OT)f2bf(acc0[r]); OUTg[(size_t)row * 64 + 32 + r32] = (OT)f2bf(acc1[r]); } } }
}
DI void load_cmp_bias(const Args& a, LAS float* biasL, int tid) {
    if (tid < 256) { const float* PB = (const float*)(a.ws + cfg::WS_PB); const int kv = tid >> 7, h = tid & 127; float s = a.cmp_b1[kv * 128 + h];
#pragma unroll 8
        for (int c = 0; c < 32; ++c) s += PB[(kv * 32 + c) * 128 + h];
        biasL[tid] = s; }
    LDS_WAIT(); __syncthreads();
}
struct MixOrder {
    pg8::StaticOrder s1; int G, c; const char* CB; const char* W1T;
    __device__ bool next(int i, pg8::Unit& u) const {
        long L = (long)i * G + c; if (L < s1.nwg) return s1.unit_of((int)L, u);
        L -= s1.nwg; if (L >= 512) return false;
        const int kv = (int)(L >> 8), rest = (int)(L & 255);
        u.pm = rest; u.pn = 0; u.kind = 1 + kv; u.a = CB + (((size_t)(kv * 64 + (rest >> 2)) * 16384 + (size_t)(rest & 3) * 4096) * 64) * 2; u.b = W1T + (size_t)kv * 256 * 1024 * 2; return true;
    }
    __device__ __forceinline__ void a_ready(const pg8::Unit&) const {}
    __device__ __forceinline__ void done(const pg8::Unit&) const {}
};
struct PairOrder {
    pg8::StaticOrder s1;
    __device__ bool next(int i, pg8::Unit& u) const { if (!s1.next(i >> 1, u)) return false; u.kind = i & 1; u.a += (i & 1) * 1024; u.b += (i & 1) * 1024; return true; }
    __device__ __forceinline__ void a_ready(const pg8::Unit&) const {}
    __device__ __forceinline__ void done(const pg8::Unit&) const {}
};
struct OneOrder {
    pg8::Unit u0;
    __device__ bool next(int i, pg8::Unit& u) const { if (i) return false; u = u0; return true; }
    __device__ __forceinline__ void a_ready(const pg8::Unit&) const {}
    __device__ __forceinline__ void done(const pg8::Unit&) const {}
};
template <typename KT> DI void score4(float (&s)[4], const KT* kptr, bool valid, const LAS float* qs) {
    float a0 = 0.f, a1 = 0.f, a2 = 0.f, a3 = 0.f;
#pragma unroll
    for (int c = 0; c < 8; ++c) { float k[8]; load8(kptr + 8 * c, k); asm volatile("" : "+v"(a0), "+v"(a1), "+v"(a2), "+v"(a3) :: "memory");
#pragma unroll
        for (int j = 0; j < 8; ++j) { const int d = 8 * c + j; a0 += k[j] * qs[d]; a1 += k[j] * qs[64 + d]; a2 += k[j] * qs[128 + d]; a3 += k[j] * qs[192 + d]; } }
    s[0] = valid ? a0 : cfg::NEGF; s[1] = valid ? a1 : cfg::NEGF; s[2] = valid ? a2 : cfg::NEGF; s[3] = valid ? a3 : cfg::NEGF;
}
namespace dec {
constexpr int L_QS = 0, L_S = 1024, L_RED = L_S + 4 * 1024 * 4, L_OS = L_RED + 512, L_IC = L_OS + 8 * 4 * 64 * 4, L_SC = L_IC + 1056 * 4, L_LIST = L_SC + 272 * 4, L_O = L_LIST + 128, L_END = L_O + 3 * 256 * 4;
static_assert(L_END <= cfg::RING_BYTES, "decode attention LDS map");
struct KeyCmp { const float* kc; const float* vc; DI bool valid(int k) const { return k < 1023; } DI const float* kp(int k) const { return kc + (size_t)(k < 1023 ? k : 1022) * 64; } DI const float* vp(int k) const { return vc + (size_t)(k < 1023 ? k : 1022) * 64; } };
struct KeyWin { const float* cw; const float* nw; DI bool valid(int k) const { return k < 513; } DI const float* kp(int k) const { return k < 512 ? cw + (size_t)k * 256 : nw; } DI const float* vp(int k) const { return kp(k) + 128; } };
struct KeySlc { const float* cs; const int* pt; const LAS int* list; const float* ns; int g;
    DI bool valid(int k) const { return list[k >> 6] < 256 || (k & 63) == 0; }
    DI const float* kp(int k) const { const int blk = list[k >> 6]; if (blk >= 256) return ns; const int phys = pt[blk >> 1]; return cs + (((size_t)phys * 128 + (blk & 1) * 64 + (k & 63)) * 4 + g) * 64; }
    DI const float* vp(int k) const { return kp(k) + 128; } };
template <int NK, bool IMP, class KM> DI void attend(const KM& km, LAS char* L, int slot, int tid) {
    const int lane = tid & 63, wave = __builtin_amdgcn_readfirstlane(tid >> 6);
    const LAS float* qs = (const LAS float*)(L + L_QS); LAS float* sb = (LAS float*)(L + L_S); LAS float* red = (LAS float*)(L + L_RED); LAS float* os = (LAS float*)(L + L_OS); LAS float* ic = (LAS float*)(L + L_IC);
    float s[NK][4]; bool ok[NK]; float mx[4] = {cfg::NEGF, cfg::NEGF, cfg::NEGF, cfg::NEGF};
#pragma unroll
    for (int i = 0; i < NK; ++i) { const int k = tid + 512 * i; ok[i] = km.valid(k); score4<float>(s[i], km.kp(k), ok[i], qs);
#pragma unroll
        for (int r = 0; r < 4; ++r) mx[r] = fmaxf(mx[r], s[i][r]); }
#pragma unroll
    for (int r = 0; r < 4; ++r) { mx[r] = wave_max(mx[r]); if (lane == 0) red[wave * 4 + r] = mx[r]; }
    LDS_WAIT(); __syncthreads();
    float sm[4];
#pragma unroll
    for (int r = 0; r < 4; ++r) { float m = red[r];
#pragma unroll
        for (int w = 1; w < 8; ++w) m = fmaxf(m, red[w * 4 + r]);
        mx[r] = m; sm[r] = 0.f; }
#pragma unroll
    for (int i = 0; i < NK; ++i)
#pragma unroll
        for (int r = 0; r < 4; ++r) { s[i][r] = ok[i] ? __builtin_amdgcn_exp2f((s[i][r] - mx[r]) * cfg::L2E) : 0.f; sm[r] += s[i][r]; }
#pragma unroll
    for (int r = 0; r < 4; ++r) { sm[r] = wave_sum(sm[r]); if (lane == 0) red[32 + wave * 4 + r] = sm[r]; }
    LDS_WAIT(); __syncthreads();
#pragma unroll
    for (int r = 0; r < 4; ++r) { float t = red[32 + r];
#pragma unroll
        for (int w = 1; w < 8; ++w) t += red[32 + w * 4 + r];
        sm[r] = t > 0.f ? 1.0f / t : 0.f; }
#pragma unroll
    for (int i = 0; i < NK; ++i) { const int k = tid + 512 * i; float isum = 0.f;
#pragma unroll
        for (int r = 0; r < 4; ++r) { const float p = s[i][r] * sm[r]; sb[r * 1024 + k] = p; isum += p; }
        if (IMP) ic[k] = isum; }
    LDS_WAIT(); __syncthreads();
    constexpr int KW = NK * 64; float o0 = 0.f, o1 = 0.f, o2 = 0.f, o3 = 0.f;
#pragma unroll 8
    for (int kk = 0; kk < KW; ++kk) { const int k = wave * KW + kk; const float v = km.vp(k)[lane];
        o0 += sb[k] * v; o1 += sb[1024 + k] * v; o2 += sb[2048 + k] * v; o3 += sb[3072 + k] * v; }
    os[(wave * 4 + 0) * 64 + lane] = o0; os[(wave * 4 + 1) * 64 + lane] = o1; os[(wave * 4 + 2) * 64 + lane] = o2; os[(wave * 4 + 3) * 64 + lane] = o3;
    LDS_WAIT(); __syncthreads();
    if (tid < 256) { float t = 0.f;
#pragma unroll
        for (int w = 0; w < 8; ++w) t += os[w * 256 + tid];
        ((LAS float*)(L + L_O))[slot * 256 + tid] = t; }
    LDS_WAIT(); __syncthreads();
}
DI void sample_unit(const Args& a, int b, int g, LAS unsigned char* lds_raw, int tid) {
    LAS char* L = (LAS char*)lds_raw; const int row = cfg::MP + b;
    LAS float* qs = (LAS float*)(L + L_QS); LAS float* ic = (LAS float*)(L + L_IC); LAS float* sc = (LAS float*)(L + L_SC); LAS int* list = (LAS int*)(L + L_LIST);
    const bf16* Q = (const bf16*)(a.ws + cfg::WS_Q);
    if (tid < 256) qs[tid] = bf2f(Q[(size_t)row * 512 + g * 256 + tid]);
    for (int i = tid; i < 1056; i += 512) ic[i] = 0.f;
    LDS_WAIT(); __syncthreads();
    { KeyCmp km{(const float*)(a.ws + cfg::WS_KCS) + (size_t)(b * 2 + g) * 1024 * 64, (const float*)(a.ws + cfg::WS_VCS) + (size_t)(b * 2 + g) * 1024 * 64}; attend<2, true>(km, L, 0, tid); }
    if (tid < 257) { const int j = tid; float imp = 0.f;
#pragma unroll
        for (int mm = -1; mm < 4; ++mm) { const int idx = 4 * j + mm; if (idx >= 0 && idx < 1023) imp += ic[idx]; }
        sc[j] = imp + ((j == 0 || j >= 255) ? 1e6f : 0.f); }
    LDS_WAIT(); __syncthreads();
    { const int j = tid < 257 ? tid : 256; const float my = sc[j]; int rank = 0;
#pragma unroll 8
      for (int k = 0; k < 257; ++k) { const float o = sc[k]; rank += (o > my || (o == my && k < j)) ? 1 : 0; }
      __syncthreads();
      if (tid < 257 && rank < 16) list[rank] = j; }
    LDS_WAIT(); __syncthreads();
    { KeySlc km{a.cache_slc, a.page_table + b * cfg::NPAGES, list, a.out + cfg::OFF_SLC_S + (size_t)(b * 4 + g) * 64, g}; attend<2, false>(km, L, 1, tid); }
    { KeyWin km{a.cache_win + ((size_t)b * 512 * 4 + g) * 64, a.out + cfg::OFF_WIN_S + (((size_t)b * 512 + 511) * 4 + g) * 64}; attend<2, false>(km, L, 2, tid); }
    if (tid < 256) { const int r = tid >> 6, h = g * 4 + r; const float* ng = (const float*)(a.ws + cfg::WS_NSAG) + (size_t)row * 32 + h * 3; const LAS float* O = (const LAS float*)(L + L_O);
        ((bf16*)(a.ws + cfg::WS_ONSA))[(size_t)row * 1024 + h * 64 + (tid & 63)] = (bf16)f2bf(ng[0] * O[tid] + ng[1] * O[256 + tid] + ng[2] * O[512 + tid]); }
    LDS_WAIT(); __syncthreads();
}
}

DI float rstd_v(const float* SSV, int row) { const v4f a = *(const v4f*)(SSV + (size_t)row * 8), b = *(const v4f*)(SSV + (size_t)row * 8 + 4);
    return 1.0f / sqrtf((((a.x + a.y) + (a.z + a.w)) + ((b.x + b.y) + (b.z + b.w))) * (1.0f / 512.0f) + cfg::EPS); }
DI float rstd16(const float* SS, int row) { const v4f* p = (const v4f*)(SS + (size_t)row * 16); const v4f s0 = p[0], s1 = p[1], s2 = p[2], s3 = p[3];
    const float t = ((s0.x + s0.y) + (s0.z + s0.w)) + ((s1.x + s1.y) + (s1.z + s1.w)) + ((s2.x + s2.y) + (s2.z + s2.w)) + ((s3.x + s3.y) + (s3.z + s3.w));
    return 1.0f / sqrtf(t * (1.0f / 1024.0f) + cfg::EPS); }

namespace att {
constexpr int KP = 144;
constexpr int TILE_B = 64 * KP;
constexpr int BUF_B = 2 * TILE_B;
constexpr int W_OFF = 2 * BUF_B;
constexpr int W_IC = 0, W_SC = 8192, W_TAB = 10240, W_MSK = 10496, W_BYTES = 10560;
static_assert(W_OFF + 8 * W_BYTES <= cfg::RING_BYTES, "attention LDS map");
constexpr float NEG_S = -2e30f, M_INIT = -1e30f;
typedef short s16x4 __attribute__((ext_vector_type(4)));

DI float pl32_max(float v) { const auto rr = __builtin_amdgcn_permlane32_swap(__float_as_uint(v), __float_as_uint(v), false, false); return fmaxf(__uint_as_float(rr[0]), __uint_as_float(rr[1])); }
DI float pl32_sum(float v) { const auto rr = __builtin_amdgcn_permlane32_swap(__float_as_uint(v), __float_as_uint(v), false, false); return __uint_as_float(rr[0]) + __uint_as_float(rr[1]); }
DI float quad_sum(float v) {
    v += __int_as_float(__builtin_amdgcn_mov_dpp(__float_as_int(v), 0xB1, 0xf, 0xf, true));
    v += __int_as_float(__builtin_amdgcn_mov_dpp(__float_as_int(v), 0x4E, 0xf, 0xf, true));
    return v;
}
DI s16x4 lds_tr(const LAS char* p) { return __builtin_bit_cast(s16x4, __builtin_amdgcn_ds_read_tr16_b64_v4i16((LAS s16x4*)p)); }

DI void tile_fetch(v4u& kr, v4u& vr, const bf16* kg, const bf16* vg, size_t rowstride, int tid) {
    const size_t off = (size_t)(tid >> 3) * rowstride + (tid & 7) * 8; kr = *(const v4u*)(kg + off); vr = *(const v4u*)(vg + off);
}
DI void tile_store(LAS char* buf, const v4u& kr, const v4u& vr, int tid) {
    LAS char* p = buf + (tid >> 3) * KP + (tid & 7) * 16; *(LAS v4u*)p = kr; *(LAS v4u*)(p + TILE_B) = vr;
}
DI void qk_tile(f32x16& s0, f32x16& s1, const LAS char* Kt, const s16x8 (&qf)[4], int r32, int hi) {
#pragma unroll
    for (int i = 0; i < 16; ++i) { s0[i] = 0.f; s1[i] = 0.f; }
#pragma unroll
    for (int d0 = 0; d0 < 4; ++d0) {
        const s16x8 a0 = *(const LAS s16x8*)(Kt + r32 * KP + (2 * d0 + hi) * 16), a1 = *(const LAS s16x8*)(Kt + (32 + r32) * KP + (2 * d0 + hi) * 16);
        s0 = __builtin_amdgcn_mfma_f32_32x32x16_bf16(a0, qf[d0], s0, 0, 0, 0); s1 = __builtin_amdgcn_mfma_f32_32x32x16_bf16(a1, qf[d0], s1, 0, 0, 0);
    }
}
DI void pv_tile(f32x16 (&o)[2], const LAS char* Vt, const unsigned (&pk)[16], int lane) {
    const int hi = lane >> 5, gq = (lane >> 4) & 1, qq = (lane & 15) >> 2, pp = lane & 3;
    const LAS char* vb = Vt + (4 * hi + qq) * KP + (16 * gq + 4 * pp) * 2;
#pragma unroll
    for (int ks = 0; ks < 4; ++ks) {
        v4u av; av.x = pk[4 * ks]; av.y = pk[4 * ks + 1]; av.z = pk[4 * ks + 2]; av.w = pk[4 * ks + 3];
#pragma unroll
        for (int db = 0; db < 2; ++db) {
            const s16x4 lo = lds_tr(vb + (16 * ks) * KP + db * 64), hh = lds_tr(vb + (16 * ks + 8) * KP + db * 64);
            const s16x8 bv = (s16x8){lo[0], lo[1], lo[2], lo[3], hh[0], hh[1], hh[2], hh[3]};
            o[db] = __builtin_amdgcn_mfma_f32_32x32x16_bf16(__builtin_bit_cast(s16x8, av), bv, o[db], 0, 0, 0);
        }
    }
}
DI void tab_publish(LAS float* tab, float v, int r32, int hi) { if (hi == 0) tab[r32] = v; LDS_WAIT(); }
DI float crowf(const LAS float* tab, int reg, int hi) { return tab[(reg & 3) + 8 * (reg >> 2) + 4 * hi]; }

struct Ctx {
    int b, g, qt, tid, lane, wave, r32, hi, tq;
    LAS char* lds; LAS float* ic; LAS float* sc; LAS float* tab; LAS unsigned* msk;
};

template <int MODE> DI void run_tiles(const Ctx& c, const s16x8 (&qf)[4], int j_lo, int j_hi, const bf16* kg, const bf16* vg, size_t rowstride,
                                      float& m, float& l, f32x16 (&o)[2], float linv, int vis, unsigned msk_lo, unsigned msk_hi) {
    v4u kr, vr; tile_fetch(kr, vr, kg + (size_t)j_lo * 64 * rowstride, vg + (size_t)j_lo * 64 * rowstride, rowstride, c.tid);
    tile_store(c.lds, kr, vr, c.tid);
    LDS_WAIT(); __syncthreads();
    for (int j = j_lo; j <= j_hi; ++j) {
        const int cur = (j - j_lo) & 1; const LAS char* Kt = c.lds + cur * BUF_B; const LAS char* Vt = Kt + TILE_B;
        if (j < j_hi) tile_fetch(kr, vr, kg + (size_t)(j + 1) * 64 * rowstride, vg + (size_t)(j + 1) * 64 * rowstride, rowstride, c.tid);
        int lo = 0, hi_ = 63; bool need_mask;
        if (MODE <= 1) { hi_ = vis - 64 * j; need_mask = true; }
        else if (MODE == 2) { const bool sel = ((j < 32 ? msk_lo >> j : msk_hi >> (j - 32)) & 1u) != 0u; if (j == c.qt) hi_ = c.tq; if (!sel) hi_ = -1; need_mask = __any(hi_ != 63) != 0; }
        else { if (j == c.qt) hi_ = c.tq; else if (j == c.qt - 8) lo = c.tq; need_mask = (j == c.qt) || (j == c.qt - 8); }
        f32x16 s0, s1; qk_tile(s0, s1, Kt, qf, c.r32, c.hi);
        if (need_mask) { const int l4 = lo - 4 * c.hi, h4 = hi_ - 4 * c.hi;
#pragma unroll
            for (int r = 0; r < 16; ++r) { const int k0 = (r & 3) + 8 * (r >> 2); s0[r] = (k0 >= l4 && k0 <= h4) ? s0[r] : NEG_S; s1[r] = (k0 + 32 >= l4 && k0 + 32 <= h4) ? s1[r] : NEG_S; } }
        unsigned pk[16];
        if (MODE == 1) {
            const float mL = m * cfg::L2E;
#pragma unroll
            for (int r = 0; r < 16; ++r) { s0[r] = __builtin_amdgcn_exp2f(__builtin_fmaf(s0[r], cfg::L2E, -mL)) * linv; s1[r] = __builtin_amdgcn_exp2f(__builtin_fmaf(s1[r], cfg::L2E, -mL)) * linv; }
#pragma unroll
            for (int r = 0; r < 16; ++r) { const float a0 = quad_sum(s0[r]), a1 = quad_sum(s1[r]); const int key = 64 * j + (r & 3) + 8 * (r >> 2) + 4 * c.hi;
                if ((c.r32 & 3) == 0) { c.ic[(c.r32 >> 2) * 256 + key] = a0; c.ic[(c.r32 >> 2) * 256 + key + 32] = a1; } }
        } else {
            float mt = fmaxf(s0[0], s1[0]);
#pragma unroll
            for (int r = 1; r < 16; ++r) mt = fmaxf(mt, fmaxf(s0[r], s1[r]));
            mt = pl32_max(mt);
            const float mn = fmaxf(m, mt);
            if (__any(mn > m)) { const float al = __builtin_amdgcn_exp2f((m - mn) * cfg::L2E); l *= al; m = mn;
                if (MODE >= 2) { tab_publish(c.tab, al, c.r32, c.hi);
#pragma unroll
                    for (int r = 0; r < 16; ++r) { const float f = crowf(c.tab, r, c.hi); o[0][r] *= f; o[1][r] *= f; } } }
            const float mL = m * cfg::L2E; float ls = 0.f;
#pragma unroll
            for (int r = 0; r < 16; ++r) { s0[r] = __builtin_amdgcn_exp2f(__builtin_fmaf(s0[r], cfg::L2E, -mL)); s1[r] = __builtin_amdgcn_exp2f(__builtin_fmaf(s1[r], cfg::L2E, -mL)); ls += s0[r] + s1[r]; }
            l += ls;
        }
        if (MODE >= 1) {
#pragma unroll
            for (int i = 0; i < 8; ++i) { pk[i] = pg8::cvt_pk_bf16(s0[2 * i], s0[2 * i + 1]); pk[8 + i] = pg8::cvt_pk_bf16(s1[2 * i], s1[2 * i + 1]); }
            pv_tile(o, Vt, pk, c.lane);
        }
        if (j < j_hi) tile_store(c.lds + (cur ^ 1) * BUF_B, kr, vr, c.tid);
        LDS_WAIT(); __syncthreads();
    }
}

template <bool FIRST> DI void merge_branch(const Ctx& c, LAS float* accl, const f32x16 (&o)[2], float fac) {
    tab_publish(c.tab, fac, c.r32, c.hi);
#pragma unroll
    for (int r = 0; r < 16; ++r) { const int q = (r & 3) + 8 * (r >> 2) + 4 * c.hi; const float f = c.tab[q]; LAS float* p = accl + q * 64 + c.r32;
        if (FIRST) { p[0] = o[0][r] * f; p[32] = o[1][r] * f; } else { p[0] += o[0][r] * f; p[32] += o[1][r] * f; } }
}
DI void prompt_unit(const Args& a, int b, int g, int qt, LAS unsigned char* lds_raw, int tid) {
    Ctx c; c.b = b; c.g = g; c.qt = qt; c.tid = tid; c.lane = tid & 63; c.wave = __builtin_amdgcn_readfirstlane(tid >> 6); c.r32 = c.lane & 31; c.hi = c.lane >> 5; c.tq = 8 * c.wave + (c.r32 >> 2);
    c.lds = (LAS char*)lds_raw; LAS char* wreg = c.lds + W_OFF + c.wave * W_BYTES;
    c.ic = (LAS float*)(wreg + W_IC); c.sc = (LAS float*)(wreg + W_SC); c.tab = (LAS float*)(wreg + W_TAB); c.msk = (LAS unsigned*)(wreg + W_MSK);
    const int t0 = 64 * qt, t = t0 + c.tq, rh = c.r32 & 3, row = b * 4096 + t, head = g * 4 + rh;
    const bf16* Q = (const bf16*)(a.ws + cfg::WS_Q); const bf16* KVB = (const bf16*)(a.ws + cfg::WS_KVB);
    const bf16* KC = (const bf16*)(a.ws + cfg::WS_KCP) + (size_t)(b * 2 + g) * 256 * 64; const bf16* VC = (const bf16*)(a.ws + cfg::WS_VCP) + (size_t)(b * 2 + g) * 256 * 64;
#pragma unroll
    for (int i = 0; i < 32; ++i) c.ic[i * 64 + c.lane] = 0.f;
    s16x8 qf[4];
#pragma unroll
    for (int d0 = 0; d0 < 4; ++d0) qf[d0] = *(const s16x8*)(Q + (size_t)row * 512 + head * 64 + 16 * d0 + 8 * c.hi);
    const float* ng = (const float*)(a.ws + cfg::WS_NSAG) + (size_t)row * 32 + head * 3; const float g_cmp = ng[0], g_slc = ng[1], g_win = ng[2];
    f32x16 o[2];
#pragma unroll
    for (int i = 0; i < 16; ++i) { o[0][i] = 0.f; o[1][i] = 0.f; }
    LDS_WAIT();
    const int vis = t >= 31 ? (t - 31) >> 4 : -1;
    { const int vmax = (t0 + 63 - 31) >> 4; int ntc = (vmax + 64) >> 6; ntc = ntc > 4 ? 4 : ntc;
      float m = M_INIT, l = 0.f;
      run_tiles<0>(c, qf, 0, ntc - 1, KC, VC, 64, m, l, o, 0.f, vis, 0u, 0u);
      const float lt = pl32_sum(l); const float linv = lt > 0.f ? 1.0f / lt : 0.f;
      run_tiles<1>(c, qf, 0, ntc - 1, KC, VC, 64, m, l, o, linv, vis, 0u, 0u); }
    unsigned msk_lo, msk_hi;
    { const int tl = c.lane >> 3, sub = c.lane & 7; const LAS float* icr = c.ic + tl * 256; float my[8];
#pragma unroll
      for (int e = 0; e < 8; ++e) { const int j = sub * 8 + e; float imp = 0.f;
#pragma unroll
          for (int mm = -1; mm < 4; ++mm) { const int idx = 4 * j + mm; if (idx >= 0 && idx < 255) imp += icr[idx]; }
          const bool valid = j <= qt, forced = (j == 0) || (j == qt) || (j == qt - 1);
          my[e] = valid ? imp + (forced ? 1e6f : 0.f) : cfg::NEGF; c.sc[tl * 64 + j] = my[e]; }
      LDS_WAIT();
      int rank[8];
#pragma unroll
      for (int e = 0; e < 8; ++e) rank[e] = 0;
      for (int k4 = 0; k4 < 16; ++k4) { const v4f ov = *(const LAS v4f*)(c.sc + tl * 64 + 4 * k4);
#pragma unroll
          for (int kk = 0; kk < 4; ++kk) { const float ovk = ov[kk]; const int k = 4 * k4 + kk;
#pragma unroll
              for (int e = 0; e < 8; ++e) rank[e] += (ovk > my[e] || (ovk == my[e] && k < sub * 8 + e)) ? 1 : 0; } }
      unsigned bits = 0u;
#pragma unroll
      for (int e = 0; e < 8; ++e) bits |= ((sub * 8 + e) <= qt && rank[e] < 16) ? (1u << e) : 0u;
      unsigned lo32 = sub < 4 ? bits << (8 * sub) : 0u, hi32 = sub >= 4 ? bits << (8 * (sub - 4)) : 0u;
#pragma unroll
      for (int x = 1; x < 8; x <<= 1) { lo32 |= (unsigned)__shfl_xor((int)lo32, x); hi32 |= (unsigned)__shfl_xor((int)hi32, x); }
      if (sub == 0) { c.msk[2 * tl] = lo32; c.msk[2 * tl + 1] = hi32; }
      LDS_WAIT();
      msk_lo = c.msk[2 * (c.r32 >> 2)]; msk_hi = c.msk[2 * (c.r32 >> 2) + 1]; }
    LAS float* accl = c.ic;
    merge_branch<true>(c, accl, o, g_cmp);
    {
#pragma unroll
      for (int i = 0; i < 16; ++i) { o[0][i] = 0.f; o[1][i] = 0.f; }
      float m = M_INIT, l = 0.f; const bf16* kg = KVB + (size_t)b * 4096 * 768 + 256 + g * 64;
      run_tiles<2>(c, qf, 0, qt, kg, kg + 128, 768, m, l, o, 0.f, 0, msk_lo, msk_hi);
      const float lt = pl32_sum(l); merge_branch<false>(c, accl, o, lt > 0.f ? g_slc / lt : 0.f); }
    {
#pragma unroll
      for (int i = 0; i < 16; ++i) { o[0][i] = 0.f; o[1][i] = 0.f; }
      float m = M_INIT, l = 0.f; const bf16* kg = KVB + (size_t)b * 4096 * 768 + 512 + g * 64;
      run_tiles<3>(c, qf, qt > 8 ? qt - 8 : 0, qt, kg, kg + 128, 768, m, l, o, 0.f, 0, 0u, 0u);
      const float lt = pl32_sum(l); merge_branch<false>(c, accl, o, lt > 0.f ? g_win / lt : 0.f); }
    LDS_WAIT();
    bf16* O = (bf16*)(a.ws + cfg::WS_ONSA);
#pragma unroll
    for (int r = 0; r < 16; ++r) { const int q = (r & 3) + 8 * (r >> 2) + 4 * c.hi; const size_t orow = (size_t)(b * 4096 + t0 + 8 * c.wave + (q >> 2)) * 1024 + (g * 4 + (q & 3)) * 64;
        O[orow + c.r32] = (bf16)f2bf(accl[q * 64 + c.r32]); O[orow + 32 + c.r32] = (bf16)f2bf(accl[q * 64 + 32 + c.r32]); }
    LDS_WAIT();
}
}
namespace cmx {
constexpr int VP = 272;
DI void unit(const Args& a, int b, int c, int gi, LAS unsigned char* lds_raw, int tid) {
    LAS char* L = (LAS char*)lds_raw; const int lane = tid & 63, wave = __builtin_amdgcn_readfirstlane(tid >> 6);
    const bf16* VG = (const bf16*)(a.ws + cfg::WS_VG); const bf16* U = (const bf16*)(a.ws + cfg::WS_U); const float* SSV = (const float*)(a.ws + cfg::WS_SSV); bf16* CM = (bf16*)(a.ws + cfg::WS_ONSA);
    const bf16* Wt = (const bf16*)(a.ws + cfg::WS_WTRIL) + (size_t)gi * 128 * 128; const int rbase = b * 4096 + c * 128;
#pragma unroll
    for (int k = 0; k < 4; ++k) { const int p = tid + 512 * k, j = p >> 4, ch = p & 15, row = rbase + j; const float rs = rstd_v(SSV, row);
        float v[8], gn[8]; load8(VG + (size_t)row * 512 + gi * 128 + ch * 8, v); load8(a.gmlp_norm + gi * 128 + ch * 8, gn);
#pragma unroll
        for (int e = 0; e < 8; ++e) v[e] = v[e] * rs * gn[e];
        if (c == 31) { float* d = a.out + cfg::OFF_V_P + ((size_t)(b * 128 + j)) * 512 + gi * 128 + ch * 8; *(v4f*)d = (v4f){v[0], v[1], v[2], v[3]}; *(v4f*)(d + 4) = (v4f){v[4], v[5], v[6], v[7]}; }
        v4u o; o.x = pg8::cvt_pk_bf16(v[0], v[1]); o.y = pg8::cvt_pk_bf16(v[2], v[3]); o.z = pg8::cvt_pk_bf16(v[4], v[5]); o.w = pg8::cvt_pk_bf16(v[6], v[7]);
        *(LAS v4u*)(L + j * VP + ch * 16) = o; }
    LDS_WAIT(); __syncthreads();
    const int ib = wave & 3, chh = wave >> 2, r32 = lane & 31, hi = lane >> 5, gq = (lane >> 4) & 1, qq = (lane & 15) >> 2, pp = lane & 3;
    f32x16 acc[2];
#pragma unroll
    for (int i = 0; i < 16; ++i) { acc[0][i] = 0.f; acc[1][i] = 0.f; }
    const bf16* wrow = Wt + (size_t)(32 * ib + r32) * 128 + 4 * hi; const LAS char* vb = L + (4 * hi + qq) * VP + (64 * chh + 16 * gq + 4 * pp) * 2;
    for (int ks = 0; ks < 2 * ib + 2; ++ks) {
        const v2u a0 = *(const v2u*)(wrow + 16 * ks), a1 = *(const v2u*)(wrow + 16 * ks + 8);
        const v4u av = (v4u){a0.x, a0.y, a1.x, a1.y};
#pragma unroll
        for (int cb = 0; cb < 2; ++cb) { const att::s16x4 lo = att::lds_tr(vb + (16 * ks) * VP + cb * 64), hh = att::lds_tr(vb + (16 * ks + 8) * VP + cb * 64);
            const s16x8 bv = (s16x8){lo[0], lo[1], lo[2], lo[3], hh[0], hh[1], hh[2], hh[3]};
            acc[cb] = __builtin_amdgcn_mfma_f32_32x32x16_bf16(__builtin_bit_cast(s16x8, av), bv, acc[cb], 0, 0, 0); }
    }
#pragma unroll
    for (int r = 0; r < 16; ++r) { const int i = 32 * ib + (r & 3) + 8 * (r >> 2) + 4 * hi; const float bs = a.gmlp_bs[gi * 128 + i]; const size_t off = (size_t)(rbase + i) * 512 + gi * 128 + 64 * chh + r32, offc = (size_t)(rbase + i) * 1024 + 512 + gi * 128 + 64 * chh + r32;
        CM[offc] = (bf16)f2bf(bf2f(U[off]) * (acc[0][r] + bs)); CM[offc + 32] = (bf16)f2bf(bf2f(U[off + 32]) * (acc[1][r] + bs)); }
    LDS_WAIT(); __syncthreads();
}
}


namespace thin {
template <int KS> DI v4f gemm(const bf16* A, int lda, const bf16* Bt, int ldb, int cbk, LAS unsigned char* lds_raw, int tid) {
    const int lane = tid & 63, wave = __builtin_amdgcn_readfirstlane(tid >> 6), r32 = lane & 31, hi = lane >> 5, k0 = wave * KS * 16 + 8 * hi;
    const bf16* ap = A + (size_t)r32 * lda + k0; const bf16* bp0 = Bt + (size_t)(64 * cbk + r32) * ldb + k0; const bf16* bp1 = bp0 + (size_t)32 * ldb;
    f32x16 acc0, acc1;
#pragma unroll
    for (int i = 0; i < 16; ++i) { acc0[i] = 0.f; acc1[i] = 0.f; }
#pragma unroll
    for (int ks = 0; ks < KS; ++ks) { const s16x8 av = *(const s16x8*)(ap + 16 * ks), b0 = *(const s16x8*)(bp0 + 16 * ks), b1 = *(const s16x8*)(bp1 + 16 * ks);
        acc0 = __builtin_amdgcn_mfma_f32_32x32x16_bf16(av, b0, acc0, 0, 0, 0); acc1 = __builtin_amdgcn_mfma_f32_32x32x16_bf16(av, b1, acc1, 0, 0, 0); }
    LAS float* Lf = (LAS float*)lds_raw;
#pragma unroll
    for (int r = 0; r < 16; ++r) { const int row = (r & 3) + 8 * (r >> 2) + 4 * hi; Lf[(wave * 32 + row) * 64 + r32] = acc0[r]; Lf[(wave * 32 + row) * 64 + 32 + r32] = acc1[r]; }
    LDS_WAIT(); __syncthreads();
    v4f t = *(const LAS v4f*)(Lf + (tid >> 4) * 64 + 4 * (tid & 15));
#pragma unroll
    for (int w = 1; w < 8; ++w) t += *(const LAS v4f*)(Lf + (w * 32 + (tid >> 4)) * 64 + 4 * (tid & 15));
    LDS_WAIT(); __syncthreads();
    return t;
}
DI float sum16(float v) { v += __shfl_xor(v, 1); v += __shfl_xor(v, 2); v += __shfl_xor(v, 4); v += __shfl_xor(v, 8); return v; }
}

__global__ void __launch_bounds__(NWAVES * 64, 2) nsa_hybrid_fwd(Args a) {
    extern __shared__ __attribute__((aligned(16))) unsigned char lds_raw[];
    LAS unsigned char* lds = (LAS unsigned char*)lds_raw;
    const int tid = threadIdx.x, lane = tid & 63, wave = __builtin_amdgcn_readfirstlane(tid >> 6);
    const int G = gridDim.x, gw = blockIdx.x * NWAVES + wave, NGW = G * NWAVES;
    unsigned char* ws = a.ws;
    for (int u = tid; u < (cfg::LDS_BYTES - cfg::LDSCTL_OFF) / 4; u += NWAVES * 64) ((LAS unsigned*)(lds + cfg::LDSCTL_OFF))[u] = 0u;
    __syncthreads();
    volatile LAS unsigned* MISC = (volatile LAS unsigned*)(lds + cfg::MISC_OFF);
    XcdBarrier bar = xcd_barrier_post((unsigned*)(ws + cfg::WS_CTL) + cfg::CW_BAR, MISC + 8);

    bf16* W_in_t = (bf16*)(ws + cfg::WS_WIN_T); bf16* W_pa_t = (bf16*)(ws + cfg::WS_WPA_T); bf16* W_pb_t = (bf16*)(ws + cfg::WS_WPB_T); bf16* W_out_t = (bf16*)(ws + cfg::WS_WOUT_T);
    bf16* W_up_t = (bf16*)(ws + cfg::WS_WUP_T); bf16* W_dn_t = (bf16*)(ws + cfg::WS_WDN_T);
    float* RSTD1 = (float*)(ws + cfg::WS_RSTD1); float* SSV = (float*)(ws + cfg::WS_SSV); float* SS2 = (float*)(ws + cfg::WS_SS2); float* SS3 = (float*)(ws + cfg::WS_SS3); float* NSAG = (float*)(ws + cfg::WS_NSAG);
    bf16* XB = (bf16*)(ws + cfg::WS_XB); bf16* Qb = (bf16*)(ws + cfg::WS_Q); bf16* KVB = (bf16*)(ws + cfg::WS_KVB); bf16* Ub = (bf16*)(ws + cfg::WS_U); bf16* VG = (bf16*)(ws + cfg::WS_VG); bf16* GT = (bf16*)(ws + cfg::WS_GT);
    bf16* OC = (bf16*)(ws + cfg::WS_ONSA);     bf16* MIX = (bf16*)(ws + cfg::WS_MIX);
    float* X1F = (float*)(ws + cfg::WS_X1F); bf16* X1B = (bf16*)(ws + cfg::WS_X1B); bf16* AB = (bf16*)(ws + cfg::WS_AB); bf16* ACT = (bf16*)(ws + cfg::WS_ACT);

    #if (PHMASK >> 0) & 1
    if (a.ph_lo <= 0 && 0 < a.ph_hi) {
    for (int rep_ = 0; rep_ < (int)((REPMASK >> 0) & 1) + 1; ++rep_) {
    {
        LAS float* scr = (LAS float*)(lds + wave * 16384);
        constexpr int I_IN = 16 * (cfg::INP / 32), I_PA = 8 * 32, I_PB = 8 * 32, I_OUT = 16 * 32, I_UP = 16 * (cfg::UPN / 32), I_DN = (cfg::DFF / 64) * 32;
        constexpr int NITEMS = I_IN + I_PA + I_PB + I_OUT + I_UP + I_DN;
        for (int it = gw; it < NITEMS; it += NGW) { int r = it;
            if (r < I_IN) { transpose_item<1>(a.w_in, 1024, cfg::INC, a.norm_mix, W_in_t, scr, r, cfg::INP / 32, lane); continue; } r -= I_IN;
            if (r < I_PA) { transpose_item<0>(a.w_proj_a, 1024, 1024, nullptr, W_pa_t, scr, r, 32, lane); continue; } r -= I_PA;
            if (r < I_PB) { transpose_item<0>(a.w_proj_b, 1024, 1024, nullptr, W_pa_t + 512, scr, r, 32, lane); continue; } r -= I_PB;
            if (r < I_OUT) { transpose_item<0>(a.w_out, 1024, 1024, nullptr, W_out_t, scr, r, 32, lane); continue; } r -= I_OUT;
            if (r < I_UP) { transpose_item<0>(a.w_up, 1024, cfg::UPN, a.norm_ffn, W_up_t, scr, r, cfg::UPN / 32, lane); continue; } r -= I_UP;
            transpose_item<0>(a.w_down, cfg::DFF, 1024, nullptr, W_dn_t, scr, r, 32, lane); }
        for (int m = gw; m < cfg::MPAD; m += NGW) {
            const float* xr = m < cfg::MP ? a.x_prompt + (size_t)m * 1024 : (m < cfg::MROWS ? a.x_sample + (size_t)(m - cfg::MP) * 1024 : nullptr);
            v4f v[4]; float s = 0.f;
#pragma unroll
            for (int j = 0; j < 4; ++j) { v[j] = xr ? *(const v4f*)(xr + j * 256 + lane * 4) : (v4f){0.f, 0.f, 0.f, 0.f}; s += (v[j].x * v[j].x + v[j].y * v[j].y) + (v[j].z * v[j].z + v[j].w * v[j].w); }
            s = wave_sum(s);
            if (lane == 0) RSTD1[m] = xr ? 1.0f / sqrtf(s * (1.0f / 1024.0f) + cfg::EPS) : 0.f;
#pragma unroll
            for (int j = 0; j < 4; ++j) { v2u o; o.x = pk2(v[j].x, v[j].y); o.y = pk2(v[j].z, v[j].w); *(v2u*)(XB + (size_t)m * 1024 + j * 256 + lane * 4) = o; }
            if (m >= cfg::MROWS) {
                v4u z = (v4u){0u, 0u, 0u, 0u}; *(v4u*)(X1B + (size_t)m * 1024 + lane * 8) = z; *(v4u*)(X1B + (size_t)m * 1024 + 512 + lane * 8) = z; if (lane < 16) SS2[(size_t)m * 16 + lane] = 0.f; }
        }
        { const size_t n4 = (size_t)cfg::DB * 511 * 64;
          for (size_t i = (size_t)blockIdx.x * 512 + tid; i < n4; i += (size_t)G * 512) { const size_t bb = i / (511 * 64), rem = i % (511 * 64);
              ((v4f*)(a.out + cfg::OFF_WIN_S))[bb * 512 * 64 + rem] = ((const v4f*)a.cache_win)[bb * 512 * 64 + 64 + rem]; }
          for (int i = blockIdx.x * 512 + tid; i < cfg::DB * cfg::DFF; i += G * 512) { const int bb = i / cfg::DFF, f = i % cfg::DFF; a.out[cfg::OFF_CONV_S + (size_t)bb * 2 * cfg::DFF + f] = a.state_conv[(size_t)bb * 2 * cfg::DFF + cfg::DFF + f]; } }
        { bf16* W1T = (bf16*)(ws + cfg::WS_W1T);
          for (int it = gw; it < 4 * 64; it += NGW) { const int kr = it >> 6; transpose_item<0>(a.cmp_w1 + (size_t)kr * 1024 * 128, 1024, 128, nullptr, W1T + (size_t)kr * 128 * 1024, scr, it & 63, 4, lane); }
          bf16* W2F = (bf16*)(ws + cfg::WS_W2F);
          for (int e = blockIdx.x * 512 + tid; e < 2 * 8 * 2 * 64 * 8; e += G * 512) { const int j = e & 7, ln = (e >> 3) & 63, cb = (e >> 9) & 1, ks = (e >> 10) & 7, kv = e >> 13;
              W2F[e] = (bf16)f2bf(a.cmp_w2[(size_t)kv * 128 * 64 + (16 * ks + 8 * (ln >> 5) + j) * 64 + 32 * cb + (ln & 31)]); }
          bf16* WTR = (bf16*)(ws + cfg::WS_WTRIL);
          for (int e = blockIdx.x * 512 + tid; e < 4 * 128 * 128; e += G * 512) { const int j = e & 127, i = (e >> 7) & 127; WTR[e] = (bf16)f2bf(j <= i ? a.gmlp_ws[e] : 0.f); }
          float* PB = (float*)(ws + cfg::WS_PB);
          for (int it = gw; it < 64; it += NGW) { const int kv = it >> 5, c = it & 31; float s0 = 0.f, s1 = 0.f;
#pragma unroll 8
              for (int i = 0; i < 64; ++i) { const int k = c * 64 + i; const float pv = a.cmp_pe[kv * 2048 + k]; s0 += pv * a.cmp_w1[((size_t)kv * 2048 + k) * 128 + lane]; s1 += pv * a.cmp_w1[((size_t)kv * 2048 + k) * 128 + 64 + lane]; }
              PB[(kv * 32 + c) * 128 + lane] = s0; PB[(kv * 32 + c) * 128 + 64 + lane] = s1; } }
        { bf16* CB = (bf16*)(ws + cfg::WS_CB); const int kvg = lane >> 4, d0 = (lane & 15) * 4;
          for (int r0 = gw * 4; r0 < cfg::DB * cfg::PAST; r0 += NGW * 4) { v4f v[4];
#pragma unroll
              for (int i = 0; i < 4; ++i) { const int r = r0 + i, b = r >> 14, pos = r & 16383; const int phys = a.page_table[b * cfg::NPAGES + (pos >> 7)];
                  v[i] = *(const v4f*)(a.cache_cmp + ((size_t)phys * 128 + (pos & 127)) * 256 + lane * 4); }
#pragma unroll
              for (int i = 0; i < 4; ++i) { const int r = r0 + i, b = r >> 14, pos = r & 16383; v2u o; o.x = pg8::cvt_pk_bf16(v[i].x, v[i].y); o.y = pg8::cvt_pk_bf16(v[i].z, v[i].w);
                  *(v2u*)(CB + (((size_t)((kvg >> 1) * 32 + b) * 2 + (kvg & 1)) * 16384 + pos) * 64 + d0) = o; } } }
    }
    }
    if (1 < a.ph_hi) xcd_barrier(bar);
    }

    #endif
#if (PHMASK >> 1) & 1
    if (a.ph_lo <= 1 && 1 < a.ph_hi) {
    for (int rep_ = 0; rep_ < (int)((REPMASK >> 1) & 1) + 1; ++rep_) {
    { LAS float* biasL = (LAS float*)(lds + cfg::BIAS_OFF); load_cmp_bias(a, biasL, tid);
      pg8::Gemm g{XB, W_in_t, cfg::MPAD, cfg::INP, 1024, 1024, 1024}; MixOrder S; S.s1.init(cfg::MPAD, cfg::INP, G, (int)blockIdx.x, XB, W_in_t, 1024); S.G = G; S.c = (int)blockIdx.x;
      S.CB = (const char*)(ws + cfg::WS_CB); S.W1T = (const char*)(ws + cfg::WS_W1T);
      pg8::EpiMix E{pg8::EpiIn{RSTD1, Qb, KVB, Ub, VG, SSV, GT, NSAG, a.out, (bf16*)(ws + cfg::WS_CBP)}, pg8::EpiP{(bf16*)(ws + cfg::WS_PS), (size_t)65536 * 256, biasL}};
      pg8::gemm_phase<pg8::EpiMix, MixOrder, true, true>(lds, g, S, E); }
    }
    if (2 < a.ph_hi) xcd_barrier(bar);
    }

    #endif
#if (PHMASK >> 2) & 1
    if (a.ph_lo <= 2 && 2 < a.ph_hi) {
    for (int rep_ = 0; rep_ < (int)((REPMASK >> 2) & 1) + 1; ++rep_) {
    {
        const bf16* W2F = (const bf16*)(ws + cfg::WS_W2F);
        if (blockIdx.x < 16) {
            const int kv = blockIdx.x >> 3, bg = blockIdx.x & 7; LAS float* biasL = (LAS float*)(lds + cfg::BIAS_OFF); load_cmp_bias(a, biasL, tid);
            bf16* PP = (bf16*)(ws + cfg::WS_PP);
            OneOrder S; S.u0.pm = bg; S.u0.pn = 0; S.u0.kind = 1 + kv; S.u0.a = (const char*)(ws + cfg::WS_CBP) + (size_t)(kv * 8 + bg) * 4096 * 64 * 2; S.u0.b = (const char*)(ws + cfg::WS_W1T) + (size_t)kv * 256 * 1024 * 2;
            pg8::Gemm g{nullptr, nullptr, 256, 256, 1024, 1024, 1024}; pg8::EpiP E{PP, (size_t)2048 * 256, biasL};
            pg8::gemm_phase<pg8::EpiP, OneOrder, false, true>(lds, g, S, E);
            asm volatile("s_waitcnt vmcnt(0)" ::: "memory"); __syncthreads();
            cmp_stage2_tile<bf16>(PP + ((size_t)kv * 2048 + bg * 256) * 256, 256, wave * 32, W2F + (size_t)kv * 8192, (bf16*)(ws + (kv ? cfg::WS_VCP : cfg::WS_KCP)) + (size_t)bg * 256 * 64, 255, lane);
        } else {
            const int gw2 = (blockIdx.x - 16) * NWAVES + wave, NGW2 = (G - 16) * NWAVES;
            for (int task = gw2; task < 2 * 64 * 32; task += NGW2) { const int kv = task >> 11, bg = (task >> 5) & 63, tl = task & 31;
                cmp_stage2_tile<float>((const bf16*)(ws + cfg::WS_PS) + ((size_t)kv * 65536 + bg * 1024) * 256, 1024, tl * 32, W2F + (size_t)kv * 8192, (float*)(ws + (kv ? cfg::WS_VCS : cfg::WS_KCS)) + (size_t)bg * 1024 * 64, 1023, lane); }
            for (int task = blockIdx.x - 16; task < 4 * 32 * 4; task += G - 16) cmx::unit(a, task >> 7, (task >> 2) & 31, task & 3, lds, tid);
        }
        for (int i = 512 + gw; i < 4 * 128 + cfg::DB; i += NGW) {
            const bool smp = i >= 512; const int row = smp ? cfg::MP + (i - 512) : (i >> 7) * 4096 + 3968 + (i & 127);
            float* dst = smp ? a.out + cfg::OFF_V_S + (size_t)(i - 512) * 512 : a.out + cfg::OFF_V_P + (size_t)i * 512;
            const float rs = rstd_v(SSV, row); float vn[8]; load8(VG + (size_t)row * 512 + lane * 8, vn);
#pragma unroll
            for (int j = 0; j < 8; ++j) vn[j] = vn[j] * rs * a.gmlp_norm[lane * 8 + j];
            *(v4f*)(dst + lane * 8) = (v4f){vn[0], vn[1], vn[2], vn[3]}; *(v4f*)(dst + lane * 8 + 4) = (v4f){vn[4], vn[5], vn[6], vn[7]};
            if (smp) { const int gi = lane >> 4; const float w00 = a.gmlp_ws[(size_t)gi * 128 * 128], bs = a.gmlp_bs[gi * 128]; float uu[8]; load8(Ub + (size_t)row * 512 + lane * 8, uu);
                v4u o; o.x = pk2(uu[0] * (w00 * vn[0] + bs), uu[1] * (w00 * vn[1] + bs)); o.y = pk2(uu[2] * (w00 * vn[2] + bs), uu[3] * (w00 * vn[3] + bs));
                o.z = pk2(uu[4] * (w00 * vn[4] + bs), uu[5] * (w00 * vn[5] + bs)); o.w = pk2(uu[6] * (w00 * vn[6] + bs), uu[7] * (w00 * vn[7] + bs));
                *(v4u*)(OC + (size_t)row * 1024 + 512 + lane * 8) = o; }
        }
    }
    }
    if (3 < a.ph_hi) xcd_barrier(bar);
    }

    #endif
#if (PHMASK >> 3) & 1
    if (a.ph_lo <= 3 && 3 < a.ph_hi) {
    for (int rep_ = 0; rep_ < (int)((REPMASK >> 3) & 1) + 1; ++rep_) {
    {
        gu32* qctr = (gu32*)(ws + cfg::WS_CTL) + 8192 + 64 * rep_; volatile LAS int* qslot = (volatile LAS int*)(lds + cfg::MISC_OFF + 64);
        for (;;) {
            if (tid == 0) qslot[0] = (int)__hip_atomic_fetch_add(qctr, 1u, __ATOMIC_RELAXED, __HIP_MEMORY_SCOPE_AGENT);
            LDS_WAIT(); __syncthreads();
            const int item = qslot[0];
            __syncthreads();
            if (item >= 64 + 512) break;
            if (item < 64) dec::sample_unit(a, item >> 1, item & 1, lds, tid);
            else { const int idx = item - 64, bgi = idx & 7; att::prompt_unit(a, bgi >> 1, bgi & 1, 63 - (idx >> 3), lds, tid); }
        }
    }
    }
    if (4 < a.ph_hi) xcd_barrier(bar);
    }

    #endif
#if (PHMASK >> 4) & 1
    if (a.ph_lo <= 4 && 4 < a.ph_hi) {
    for (int rep_ = 0; rep_ < (int)((REPMASK >> 4) & 1) + 1; ++rep_) {
    if (blockIdx.x < 16) {
        const int cbk = blockIdx.x, row = cfg::MP + (tid >> 4), col = 64 * cbk + 4 * (tid & 15);
        const v4f ya = thin::gemm<4>(OC + (size_t)cfg::MP * 1024, 1024, W_pa_t, 1024, cbk, lds, tid), yb = thin::gemm<4>(OC + (size_t)cfg::MP * 1024 + 512, 1024, W_pa_t + 512, 1024, cbk, lds, tid);
        const v2u ga = *(const v2u*)(GT + (size_t)row * 2048 + col), gb = *(const v2u*)(GT + (size_t)row * 2048 + 1024 + col);
        const v4f g0 = (v4f){__uint_as_float(ga.x << 16), __uint_as_float(ga.x & 0xffff0000u), __uint_as_float(ga.y << 16), __uint_as_float(ga.y & 0xffff0000u)};
        const v4f g1 = (v4f){__uint_as_float(gb.x << 16), __uint_as_float(gb.x & 0xffff0000u), __uint_as_float(gb.y << 16), __uint_as_float(gb.y & 0xffff0000u)};
        const v4f mx = g0 * ya + g1 * yb; v2u o; o.x = pg8::cvt_pk_bf16(mx.x, mx.y); o.y = pg8::cvt_pk_bf16(mx.z, mx.w); *(v2u*)(MIX + (size_t)row * 1024 + col) = o; }
    { PairOrder S; S.s1.init(cfg::MP, 1024, G, (int)blockIdx.x, OC, W_pa_t, 1024); pg8::Gemm g{OC, W_pa_t, cfg::MP, 1024, 512, 1024, 1024}; pg8::EpiMixAB E{GT, MIX};
      pg8::gemm_phase<pg8::EpiMixAB, PairOrder, true, true>(lds, g, S, E); }
    }
    if (5 < a.ph_hi) xcd_barrier(bar);
    }

    #endif
#if (PHMASK >> 5) & 1
    if (a.ph_lo <= 5 && 5 < a.ph_hi) {
    for (int rep_ = 0; rep_ < (int)((REPMASK >> 5) & 1) + 1; ++rep_) {
    if (blockIdx.x < 16) {
        const int cbk = blockIdx.x, r = tid >> 4, row = cfg::MP + r, col = 64 * cbk + 4 * (tid & 15);
        const v4f y = thin::gemm<8>(MIX + (size_t)cfg::MP * 1024, 1024, W_out_t, 1024, cbk, lds, tid);
        const v4f x1 = *(const v4f*)(a.x_sample + (size_t)r * 1024 + col) + y; *(v4f*)(X1F + (size_t)row * 1024 + col) = x1;
        v2u o; o.x = pg8::cvt_pk_bf16(x1.x, x1.y); o.y = pg8::cvt_pk_bf16(x1.z, x1.w); *(v2u*)(X1B + (size_t)row * 1024 + col) = o;
        const float ss = thin::sum16((x1.x * x1.x + x1.y * x1.y) + (x1.z * x1.z + x1.w * x1.w)); if ((tid & 15) == 0) SS2[(size_t)row * 16 + cbk] = ss; }
    { pg8::Gemm g{MIX, W_out_t, cfg::MP, 1024, 1024, 1024, 1024}; pg8::StaticOrder S; S.init(cfg::MP, 1024, G, (int)blockIdx.x, MIX, W_out_t, 1024);
      pg8::EpiOut E{a.x_prompt, a.x_sample, X1F, X1B, SS2}; pg8::gemm_phase<pg8::EpiOut, pg8::StaticOrder, true, true>(lds, g, S, E); }
    }
    if (6 < a.ph_hi) xcd_barrier(bar);
    }

    #endif
#if (PHMASK >> 6) & 1
    if (a.ph_lo <= 6 && 6 < a.ph_hi) {
    for (int rep_ = 0; rep_ < (int)((REPMASK >> 6) & 1) + 1; ++rep_) {
    { pg8::Gemm g{X1B, W_up_t, cfg::MPAD, cfg::UPN, 1024, 1024, 1024}; pg8::StaticOrder S; S.init(cfg::MPAD, cfg::UPN, G, (int)blockIdx.x, X1B, W_up_t, 1024);
      pg8::EpiUp E{SS2, AB, a.out}; pg8::gemm_phase<pg8::EpiUp, pg8::StaticOrder, true, true>(lds, g, S, E); }
    }
    if (7 < a.ph_hi) xcd_barrier(bar);
    }

    #endif
#if (PHMASK >> 7) & 1
    if (a.ph_lo <= 7 && 7 < a.ph_hi) {
    for (int rep_ = 0; rep_ < (int)((REPMASK >> 7) & 1) + 1; ++rep_) {
    {
        constexpr int FV = cfg::DFF / 8;
        for (size_t i = (size_t)blockIdx.x * 512 + tid; i < (size_t)cfg::MPAD * FV; i += (size_t)G * 512) {
            const int row = (int)(i / FV), f = (int)(i % FV) * 8;
            float a0[8], a1[8], a2[8], bb[8], c[8];
            load8(AB + (size_t)row * cfg::UPN + f, a2); load8(AB + (size_t)row * cfg::UPN + cfg::DFF + f, bb);
            if (row < cfg::MP) { const int t = row & 4095;
                if (t >= 1) load8(AB + (size_t)(row - 1) * cfg::UPN + f, a1); else {
#pragma unroll
                    for (int j = 0; j < 8; ++j) a1[j] = 0.f; }
                if (t >= 2) load8(AB + (size_t)(row - 2) * cfg::UPN + f, a0); else {
#pragma unroll
                    for (int j = 0; j < 8; ++j) a0[j] = 0.f; } }
            else if (row < cfg::MROWS) { const float* sp = a.state_conv + (size_t)(row - cfg::MP) * 2 * cfg::DFF + f; load8(sp, a0); load8(sp + cfg::DFF, a1); }
            else {
#pragma unroll
                for (int j = 0; j < 8; ++j) { a0[j] = 0.f; a1[j] = 0.f; } }
            float w0[8], w1[8], w2[8], cb[8]; load8(a.conv_w + f, w0); load8(a.conv_w + cfg::DFF + f, w1); load8(a.conv_w + 2 * cfg::DFF + f, w2); load8(a.conv_b + f, cb);
#pragma unroll
            for (int j = 0; j < 8; ++j) c[j] = gelu_tanh(cb[j] + a0[j] * w0[j] + a1[j] * w1[j] + a2[j] * w2[j]) * bb[j];
            v4u o; o.x = pk2(c[0], c[1]); o.y = pk2(c[2], c[3]); o.z = pk2(c[4], c[5]); o.w = pk2(c[6], c[7]);
            *(v4u*)(ACT + (size_t)row * cfg::DFF + f) = o;
        }
    }
    }
    if (8 < a.ph_hi) xcd_barrier(bar);
    }

    #endif
#if (PHMASK >> 8) & 1
    if (a.ph_lo <= 8 && 8 < a.ph_hi) {
    for (int rep_ = 0; rep_ < (int)((REPMASK >> 8) & 1) + 1; ++rep_) {
    if (blockIdx.x < 16) {
        const int cbk = blockIdx.x, r = tid >> 4, row = cfg::MP + r, col = 64 * cbk + 4 * (tid & 15);
        const v4f y = thin::gemm<22>(ACT + (size_t)cfg::MP * cfg::DFF, cfg::DFF, W_dn_t, cfg::DFF, cbk, lds, tid);
        const v4f x2 = *(const v4f*)(X1F + (size_t)row * 1024 + col) + y; *(v4f*)(a.out + (size_t)row * 1024 + col) = x2;
        const float ss = thin::sum16((x2.x * x2.x + x2.y * x2.y) + (x2.z * x2.z + x2.w * x2.w)); if ((tid & 15) == 0) SS3[(size_t)row * 16 + cbk] = ss; }
    { pg8::Gemm g{ACT, W_dn_t, cfg::MP, 1024, cfg::DFF, cfg::DFF, cfg::DFF}; pg8::StaticOrder S; S.init(cfg::MP, 1024, G, (int)blockIdx.x, ACT, W_dn_t, cfg::DFF);
      pg8::EpiDown E{X1F, a.out, SS3}; pg8::gemm_phase<pg8::EpiDown, pg8::StaticOrder, true, true>(lds, g, S, E); }
    }
    if (9 < a.ph_hi) xcd_barrier(bar);
    }

    #endif
#if (PHMASK >> 9) & 1
    if (a.ph_lo <= 9 && 9 < a.ph_hi) {
    for (int rep_ = 0; rep_ < (int)((REPMASK >> 9) & 1) + 1; ++rep_) {
#ifdef DUMP
    for (int m = gw; m < cfg::MROWS; m += NGW) { float* yr = a.out + (size_t)m * 1024;
        if (DUMP == 4) continue;
#pragma unroll
        for (int j = 0; j < 4; ++j) { const int c = j * 256 + lane * 4; v4f v;
            if (DUMP == 1) { v.x = bf2f(MIX[(size_t)m * 1024 + c]); v.y = bf2f(MIX[(size_t)m * 1024 + c + 1]); v.z = bf2f(MIX[(size_t)m * 1024 + c + 2]); v.w = bf2f(MIX[(size_t)m * 1024 + c + 3]); }
            else if (DUMP == 2) v = *(const v4f*)(X1F + (size_t)m * 1024 + c);
            else if (DUMP == 3) { v.x = bf2f(ACT[(size_t)m * 2816 + c]); v.y = bf2f(ACT[(size_t)m * 2816 + c + 1]); v.z = bf2f(ACT[(size_t)m * 2816 + c + 2]); v.w = bf2f(ACT[(size_t)m * 2816 + c + 3]); }
            else { v.x = bf2f(AB[(size_t)m * 5632 + c]); v.y = bf2f(AB[(size_t)m * 5632 + c + 1]); v.z = bf2f(AB[(size_t)m * 5632 + c + 2]); v.w = bf2f(AB[(size_t)m * 5632 + c + 3]); }
            *(v4f*)(yr + c) = v; } }
#else
    for (int m = gw; m < cfg::MROWS; m += NGW) { const float rs = rstd16(SS3, m); float* yr = a.out + (size_t)m * 1024;
#pragma unroll
        for (int j = 0; j < 4; ++j) { const v4f v = *(const v4f*)(yr + j * 256 + lane * 4), gn = *(const v4f*)(a.norm_final + j * 256 + lane * 4); *(v4f*)(yr + j * 256 + lane * 4) = v * rs * gn; } }
#endif
    }
    }
#endif
}

extern "C" void kernel_launch(void* const* d_in, const int* in_sizes, int n_in, void* d_out, int out_size, void* d_ws, size_t ws_size, hipStream_t stream) {
    static int grid = 0;
    if (grid == 0) {
        if (n_in != 25 || in_sizes[0] != cfg::MP * 1024 || (size_t)out_size != cfg::OUT_TOTAL || ws_size < cfg::WS_END) {
            fprintf(stderr, "kernel_launch: unexpected shapes (n_in %d, in0 %d, out %d, ws %zu); nothing launched\n", n_in, n_in > 0 ? in_sizes[0] : -1, out_size, ws_size); grid = -1; return; }
        int dev = 0, cus = 0, per_cu = 0;
        if (hipGetDevice(&dev) != hipSuccess || hipDeviceGetAttribute(&cus, hipDeviceAttributeMultiprocessorCount, dev) != hipSuccess) { grid = -1; return; }
        if (hipFuncSetAttribute((const void*)nsa_hybrid_fwd, hipFuncAttributeMaxDynamicSharedMemorySize, cfg::LDS_BYTES) != hipSuccess) { fprintf(stderr, "kernel_launch: hipFuncSetAttribute failed\n"); grid = -1; return; }
        if (hipOccupancyMaxActiveBlocksPerMultiprocessor(&per_cu, (const void*)nsa_hybrid_fwd, NWAVES * 64, cfg::LDS_BYTES) != hipSuccess || per_cu < 1)
            fprintf(stderr, "kernel_launch: note: occupancy query reports %d workgroups per CU\n", per_cu);
        (void)hipGetLastError();
        grid = cus;
    }
    if (grid < 0) return;
    if (hipMemsetAsync((char*)d_ws + cfg::WS_CTL, 0, cfg::CTL_ZERO_BYTES, stream) != hipSuccess) return;
    Args a{};
    a.x_prompt = (const float*)d_in[0]; a.x_sample = (const float*)d_in[1]; a.cache_cmp = (const float*)d_in[2]; a.cache_slc = (const float*)d_in[3]; a.cache_win = (const float*)d_in[4];
    a.state_conv = (const float*)d_in[5]; a.page_table = (const int*)d_in[6]; a.norm_mix = (const float*)d_in[7]; a.w_in = (const float*)d_in[8]; a.cmp_pe = (const float*)d_in[9];
    a.cmp_w1 = (const float*)d_in[10]; a.cmp_b1 = (const float*)d_in[11]; a.cmp_w2 = (const float*)d_in[12]; a.gmlp_norm = (const float*)d_in[13]; a.gmlp_ws = (const float*)d_in[14];
    a.gmlp_bs = (const float*)d_in[15]; a.w_proj_a = (const float*)d_in[16]; a.w_proj_b = (const float*)d_in[17]; a.w_out = (const float*)d_in[18]; a.norm_ffn = (const float*)d_in[19];
    a.w_up = (const float*)d_in[20]; a.conv_w = (const float*)d_in[21]; a.conv_b = (const float*)d_in[22]; a.w_down = (const float*)d_in[23]; a.norm_final = (const float*)d_in[24];
    a.out = (float*)d_out; a.ws = (unsigned char*)d_ws;
    for (int li = 0; li < MK_N_LAUNCHES; ++li) {
        a.ph_lo = (MK_N_LAUNCHES == 1) ? 0 : li; a.ph_hi = (MK_N_LAUNCHES == 1) ? 10 : li + 1;
        hipLaunchKernelGGL(nsa_hybrid_fwd, dim3(grid), dim3(NWAVES * 64), cfg::LDS_BYTES, stream, a);
        const hipError_t le = hipPeekAtLastError();
        if (le != hipSuccess) { fprintf(stderr, "kernel_launch: launch failed: %s\n", hipGetErrorName(le)); break; }
    }
}
```

```cpp
#include <hip/hip_runtime.h>
#include <cstdio>
#include <cstdint>

namespace cfg {
constexpr int DM = 1024, BATCH = 4, SEQ = 4096, MP = BATCH * SEQ, DB = 32, MROWS = MP + DB, MPAD = 16640;
constexpr int PAST = 16384, PAGE = 128, NPAGES = PAST / PAGE;
constexpr int NH = 8, HD = 64, NKV = 2;
constexpr int INC = 4376, INP = 4608;
constexpr int GW = 512, DFF = 2816, UPN = 2 * DFF;
constexpr float EPS = 1e-6f, NEGF = -1e30f, L2E = 1.4426950408889634f;
constexpr size_t OFF_YP = 0, OFF_YS = 16777216, OFF_CMP_P = 16809984, OFF_SLC_P = 21004288, OFF_WIN_P = 25198592, OFF_V_P = 25722880, OFF_CONV_P = 25985024,
                 OFF_CMP_S = 26007552, OFF_SLC_S = 26015744, OFF_WIN_S = 26023936, OFF_V_S = 30218240, OFF_CONV_S = 30234624, OUT_TOTAL = 30414848;
constexpr size_t MiB = 1u << 20;
constexpr size_t WS_CTL = 0, CTL_ZERO_BYTES = 1 * MiB;
constexpr size_t WS_WIN_T = 2 * MiB, WS_WPA_T = 12 * MiB, WS_WPB_T = 13 * MiB, WS_WOUT_T = 14 * MiB, WS_WUP_T = 16 * MiB, WS_WDN_T = 28 * MiB;
constexpr size_t WS_RSTD1 = 34 * MiB, WS_SSV = 35 * MiB, WS_SS2 = 36 * MiB, WS_SS3 = 38 * MiB, WS_NSAG = 40 * MiB, WS_KCP = 43 * MiB, WS_VCP = 44 * MiB;
constexpr size_t WS_KCS = 48 * MiB, WS_VCS = 64 * MiB;
constexpr size_t WS_XB = 80 * MiB, WS_Q = 113 * MiB, WS_KVB = 130 * MiB, WS_U = 155 * MiB, WS_VG = 172 * MiB, WS_GT = 189 * MiB, WS_ONSA = 254 * MiB, WS_CM = 271 * MiB;
constexpr size_t WS_T = 288 * MiB, WS_MIX = 353 * MiB, WS_X1F = 386 * MiB, WS_X1B = 451 * MiB, WS_AB = 484 * MiB, WS_ACT = 663 * MiB;
constexpr size_t WS_W1T = 45 * MiB, WS_W2F = 46 * MiB, WS_PB = 46 * MiB + 512 * 1024, WS_WTRIL = 47 * MiB;
constexpr size_t WS_CB = 753 * MiB, WS_CBP = 1009 * MiB, WS_PS = 1017 * MiB, WS_PP = 1081 * MiB, WS_END = 1083 * MiB;
constexpr int CW_BAR = 4096;
constexpr int RING_BYTES = 131072, LDSCTL_OFF = RING_BYTES, MISC_OFF = LDSCTL_OFF + 320, BIAS_OFF = LDSCTL_OFF + 1024, LDS_BYTES = 147456;
}

#define GAS __attribute__((address_space(1)))
#define LAS __attribute__((address_space(3)))
#define DI __device__ __forceinline__
typedef unsigned short bf16;
typedef GAS unsigned gu32;
typedef unsigned v4u __attribute__((ext_vector_type(4)));
typedef unsigned v2u __attribute__((ext_vector_type(2)));
typedef float v4f __attribute__((ext_vector_type(4)));

struct Args {
    const float* x_prompt; const float* x_sample; const float* cache_cmp; const float* cache_slc; const float* cache_win; const float* state_conv;
    const int* page_table; const float* norm_mix; const float* w_in; const float* cmp_pe; const float* cmp_w1; const float* cmp_b1; const float* cmp_w2;
    const float* gmlp_norm; const float* gmlp_ws; const float* gmlp_bs; const float* w_proj_a; const float* w_proj_b; const float* w_out; const float* norm_ffn;
    const float* w_up; const float* conv_w; const float* conv_b; const float* w_down; const float* norm_final;
    float* out; unsigned char* ws;
    int ph_lo, ph_hi;
};

DI float bf2f(bf16 b) { return __uint_as_float(((unsigned)b) << 16); }
DI unsigned f2bf(float f) { unsigned u = __float_as_uint(f); return (u + 0x7fffu + ((u >> 16) & 1u)) >> 16; }
DI unsigned pk2(float lo, float hi) { return f2bf(lo) | (f2bf(hi) << 16); }
DI float fast_sigmoid(float x) { return __builtin_amdgcn_rcpf(1.0f + __builtin_amdgcn_exp2f(-1.4426950408889634f * x)); }
DI float gelu_tanh(float x) { const float u = x * (1.0f + 0.044715f * x * x); return x * __builtin_amdgcn_rcpf(1.0f + __builtin_amdgcn_exp2f(-2.302208198f * u)); }
DI float wave_sum(float v) {
#pragma unroll
    for (int o = 1; o < 64; o <<= 1) v += __shfl_xor(v, o);
    return v;
}
DI float wave_max(float v) {
#pragma unroll
    for (int o = 1; o < 64; o <<= 1) v = fmaxf(v, __shfl_xor(v, o));
    return v;
}
namespace pg8 {
#define PG8_LAS __attribute__((address_space(3)))
typedef unsigned short bf16_t;
typedef short bf16x8 __attribute__((ext_vector_type(8)));
typedef float f32x4 __attribute__((ext_vector_type(4)));
typedef unsigned u32x4 __attribute__((ext_vector_type(4)));
constexpr int BM = 256, BK = 64, HALF = 128, HTB = HALF * BK * 2  , STAGE_BYTES = 8 * HTB, NXCD = 8, WGM = 8;

__host__ __device__ __forceinline__ int lds_byte(int r, int c) { const int st = (r >> 4) * 2 + (c >> 5), rr = r & 15, cc = c & 31, ob = rr * 64 + cc * 2; return st * 1024 + (ob ^ (((ob >> 9) & 1) << 5)); }
__host__ __device__ __forceinline__ void stage_rc(int b, int& R, int& C) { const int st = b / 1024, sb = b % 1024, swz = sb ^ (((sb >> 9) & 1) << 5); R = (st >> 1) * 16 + swz / 64; C = (st & 1) * 32 + (swz % 64) / 2; }
__host__ __device__ __forceinline__ int perm32(int rho) { const int n = rho >> 4, i = rho & 15; return 8 * (i >> 2) + 4 * n + (i & 3); }

struct Unit { int pm, pn, kind; const char* a; const char* b; };
struct Gemm { const bf16_t* A; const bf16_t* Bt; int M, N, K, lda, ldb; };

struct StaticOrder {
    int nM, nN, nwg, G, c; const char* A; const char* Bt; size_t tstep;
    __host__ __device__ __forceinline__ void init(int M, int N, int G_, int c_, const void* A_ = nullptr, const void* Bt_ = nullptr, int K_ = 0) { nM = M / BM; nN = N / BM; nwg = nM * nN; G = G_; c = c_; A = (const char*)A_; Bt = (const char*)Bt_; tstep = (size_t)BM * K_ * 2; }
    __host__ __device__ __forceinline__ bool next(int i, Unit& u) const {
        const long L = (long)i * G + c; if (L >= nwg) return false;
        return unit_of((int)L, u);
    }
    __host__ __device__ __forceinline__ bool unit_of(int L, Unit& u) const {
        int wgid = L; { const int q = nwg / NXCD, r = nwg % NXCD, xcd = wgid % NXCD, off = wgid / NXCD; wgid = (xcd < r ? xcd * (q + 1) : r * (q + 1) + (xcd - r) * q) + off; }
        const int nig = WGM * nN, gid = wgid / nig, fm = gid * WGM, gsz = (nM - fm) < WGM ? (nM - fm) : WGM;
        u.pm = fm + ((wgid % nig) % gsz); u.pn = (wgid % nig) / gsz; u.kind = 0; u.a = A + (size_t)u.pm * tstep; u.b = Bt + (size_t)u.pn * tstep; return true;
    }
    __device__ __forceinline__ void a_ready(const Unit&) const {}
    __device__ __forceinline__ void done(const Unit&) const {}
};

typedef float f32x2c_t __attribute__((ext_vector_type(2))); typedef __bf16 bf16x2c_t __attribute__((ext_vector_type(2)));
__device__ __forceinline__ unsigned cvt_pk_bf16(float lo, float hi) { f32x2c_t v = {lo, hi}; bf16x2c_t b = __builtin_convertvector(v, bf16x2c_t); return __builtin_bit_cast(unsigned, b); }
typedef unsigned u32x2 __attribute__((ext_vector_type(2)));
__device__ __forceinline__ u32x4 pack8(const f32x4& v0, const f32x4& v1) { u32x4 w; w.x = cvt_pk_bf16(v0[0], v0[1]); w.y = cvt_pk_bf16(v0[2], v0[3]); w.z = cvt_pk_bf16(v1[0], v1[1]); w.w = cvt_pk_bf16(v1[2], v1[3]); return w; }
__device__ __forceinline__ f32x4 sig4(const f32x4& v) { return (f32x4){fast_sigmoid(v[0]), fast_sigmoid(v[1]), fast_sigmoid(v[2]), fast_sigmoid(v[3])}; }
__device__ __forceinline__ f32x4 gelu4(const f32x4& v) { return (f32x4){gelu_tanh(v[0]), gelu_tanh(v[1]), gelu_tanh(v[2]), gelu_tanh(v[3])}; }
__device__ __forceinline__ float sq4(const f32x4& v) { return (v[0] * v[0] + v[1] * v[1]) + (v[2] * v[2] + v[3] * v[3]); }

struct EpiIn {
    static constexpr bool PERM = true, AFTER_DRAIN = false, KEEP = false, APERM = false;
    const float* rstd; bf16_t* Q; bf16_t* KVB; bf16_t* U; bf16_t* VG; float* SSV; bf16_t* GT; float* NSAG; float* out; bf16_t* CBP;
    __device__ __forceinline__ void operator()(const f32x4 (&acc)[2][2][4][2], const Unit& u, int wr, int wc, int fr, int fq) const {
        const int row0 = u.pm * BM + wr * 64 + fr, cl0 = wc * 32 + 8 * fq, pn = u.pn;
#pragma unroll
        for (int ai = 0; ai < 2; ++ai)
#pragma unroll
            for (int m = 0; m < 4; ++m) {
                const int row = row0 + ai * HALF + m * 16; const float rs = rstd[row];
                if (pn < 2) {
                    const float s = rs * 0.125f;
#pragma unroll
                    for (int bj = 0; bj < 2; ++bj) *(u32x4*)(Q + (size_t)row * 512 + pn * 256 + bj * HALF + cl0) = pack8(acc[ai][bj][m][0] * s, acc[ai][bj][m][1] * s);
                } else if (pn < 5) {
                    float* dst = nullptr;
                    if (pn == 2) dst = row < cfg::MP ? out + cfg::OFF_CMP_P + (size_t)row * 256 : (row < cfg::MROWS ? out + cfg::OFF_CMP_S + (size_t)(row - cfg::MP) * 256 : nullptr);
                    else if (pn == 3) dst = row < cfg::MP ? out + cfg::OFF_SLC_P + (size_t)row * 256 : (row < cfg::MROWS ? out + cfg::OFF_SLC_S + (size_t)(row - cfg::MP) * 256 : nullptr);
                    else { if (row < cfg::MP) { const int t = row & 4095, b = row >> 12; if (t >= 3584) dst = out + cfg::OFF_WIN_P + (size_t)(b * 512 + (t - 3584)) * 256; }
                           else if (row < cfg::MROWS) dst = out + cfg::OFF_WIN_S + ((size_t)(row - cfg::MP) * 512 + 511) * 256; }
#pragma unroll
                    for (int bj = 0; bj < 2; ++bj) { const f32x4 v0 = acc[ai][bj][m][0] * rs, v1 = acc[ai][bj][m][1] * rs; const int cl = bj * HALF + cl0;
                        const u32x4 pk = pack8(v0, v1); *(u32x4*)(KVB + (size_t)row * 768 + (pn - 2) * 256 + cl) = pk;
                        if (pn == 2 && row < cfg::MP) *(u32x4*)(CBP + ((size_t)((bj * 4 + (row >> 12)) * 2 + (cl0 >> 6)) * 4096 + (row & 4095)) * 64 + (cl0 & 63)) = pk;
                        if (dst) { *(f32x4*)(dst + cl) = v0; *(f32x4*)(dst + cl + 4) = v1; } }
                } else if (pn < 7) {
#pragma unroll
                    for (int bj = 0; bj < 2; ++bj) *(u32x4*)(U + (size_t)row * 512 + (pn - 5) * 256 + bj * HALF + cl0) = pack8(gelu4(acc[ai][bj][m][0] * rs), gelu4(acc[ai][bj][m][1] * rs));
                } else if (pn < 9) {
                    float ss = 0.f;
#pragma unroll
                    for (int bj = 0; bj < 2; ++bj) { const f32x4 v0 = gelu4(acc[ai][bj][m][0] * rs), v1 = gelu4(acc[ai][bj][m][1] * rs); ss += sq4(v0) + sq4(v1);
                        *(u32x4*)(VG + (size_t)row * 512 + (pn - 7) * 256 + bj * HALF + cl0) = pack8(v0, v1); }
                    ss += __shfl_xor(ss, 16); ss += __shfl_xor(ss, 32);
                    if (fq == 0) SSV[(size_t)row * 8 + (pn - 7) * 4 + wc] = ss;
                } else if (pn < 17) {
#pragma unroll
                    for (int bj = 0; bj < 2; ++bj) *(u32x4*)(GT + (size_t)row * 2048 + (pn - 9) * 256 + bj * HALF + cl0) = pack8(sig4(acc[ai][bj][m][0] * rs), sig4(acc[ai][bj][m][1] * rs));
                } else {
                    if (wc == 0 && fq < 3) { float* d = NSAG + (size_t)row * 32 + 8 * fq; *(f32x4*)d = sig4(acc[ai][0][m][0] * rs); *(f32x4*)(d + 4) = sig4(acc[ai][0][m][1] * rs); }
                }
            }
    }
};
struct EpiP {
    static constexpr bool PERM = true, AFTER_DRAIN = false, KEEP = false, APERM = false;
    bf16_t* P; size_t kv_stride; const PG8_LAS float* biasL;
    __device__ __forceinline__ void operator()(const f32x4 (&acc)[2][2][4][2], const Unit& u, int wr, int wc, int fr, int fq) const {
        const int kv = u.kind - 1, row0 = u.pm * BM + wr * 64 + fr, cl0 = wc * 32 + 8 * fq;
        const f32x4 b0 = *(const PG8_LAS f32x4*)(biasL + kv * 128 + cl0), b1 = *(const PG8_LAS f32x4*)(biasL + kv * 128 + cl0 + 4);
        bf16_t* Pk = P + (size_t)kv * kv_stride;
#pragma unroll
        for (int ai = 0; ai < 2; ++ai)
#pragma unroll
            for (int m = 0; m < 4; ++m) { bf16_t* pr = Pk + (size_t)(row0 + ai * HALF + m * 16) * 256 + cl0;
                *(u32x4*)pr = pack8(acc[ai][0][m][0] + b0, acc[ai][0][m][1] + b1); *(u32x4*)(pr + HALF) = pack8(acc[ai][1][m][0], acc[ai][1][m][1]); }
    }
};
struct EpiMix {
    static constexpr bool PERM = true, AFTER_DRAIN = false, KEEP = false, APERM = false;
    EpiIn in; EpiP p;
    __device__ __forceinline__ void operator()(const f32x4 (&acc)[2][2][4][2], const Unit& u, int wr, int wc, int fr, int fq) const { if (u.kind == 0) in(acc, u, wr, wc, fr, fq); else p(acc, u, wr, wc, fr, fq); }
};
__device__ __forceinline__ void unpack8(const u32x4& g, f32x4& lo, f32x4& hi) {
    lo = (f32x4){__uint_as_float(g.x << 16), __uint_as_float(g.x & 0xffff0000u), __uint_as_float(g.y << 16), __uint_as_float(g.y & 0xffff0000u)};
    hi = (f32x4){__uint_as_float(g.z << 16), __uint_as_float(g.z & 0xffff0000u), __uint_as_float(g.w << 16), __uint_as_float(g.w & 0xffff0000u)};
}
struct EpiMixAB {
    static constexpr bool PERM = true, AFTER_DRAIN = false, KEEP = true, APERM = false;
    const bf16_t* GT; bf16_t* MIX;
    __device__ __forceinline__ bool keep(const Unit& u) const { return u.kind == 0; }
    __device__ __forceinline__ void operator()(f32x4 (&acc)[2][2][4][2], const Unit& u, int wr, int wc, int fr, int fq) const {
        const int row0 = u.pm * BM + wr * 64 + fr, col0 = u.pn * BM + wc * 32 + 8 * fq;
        if (u.kind == 0) {
#pragma unroll
            for (int ai = 0; ai < 2; ++ai)
#pragma unroll
                for (int m = 0; m < 4; ++m) { const bf16_t* gp = GT + (size_t)(row0 + ai * HALF + m * 16) * 2048 + col0;
#pragma unroll
                    for (int bj = 0; bj < 2; ++bj) { f32x4 a0, a1, b0, b1; unpack8(*(const u32x4*)(gp + bj * HALF), a0, a1); unpack8(*(const u32x4*)(gp + 1024 + bj * HALF), b0, b1);
#pragma unroll
                        for (int i = 0; i < 4; ++i) { acc[ai][bj][m][0][i] *= a0[i] * __builtin_amdgcn_rcpf(b0[i]); acc[ai][bj][m][1][i] *= a1[i] * __builtin_amdgcn_rcpf(b1[i]); } } }
        } else {
#pragma unroll
            for (int ai = 0; ai < 2; ++ai)
#pragma unroll
                for (int m = 0; m < 4; ++m) { const int row = row0 + ai * HALF + m * 16;
#pragma unroll
                    for (int bj = 0; bj < 2; ++bj) { const int col = col0 + bj * HALF; f32x4 b0, b1; unpack8(*(const u32x4*)(GT + (size_t)row * 2048 + 1024 + col), b0, b1);
                        *(u32x4*)(MIX + (size_t)row * 1024 + col) = pack8(acc[ai][bj][m][0] * b0, acc[ai][bj][m][1] * b1); } }
        }
    }
};
struct EpiOut {
    static constexpr bool PERM = true, AFTER_DRAIN = false, KEEP = false, APERM = false;
    const float* xp; const float* xs; float* X1F; bf16_t* X1B; float* SS2;
    __device__ __forceinline__ void operator()(const f32x4 (&acc)[2][2][4][2], const Unit& u, int wr, int wc, int fr, int fq) const {
        const int row0 = u.pm * BM + wr * 64 + fr, col0 = u.pn * BM + wc * 32 + 8 * fq;
#pragma unroll
        for (int ai = 0; ai < 2; ++ai)
#pragma unroll
            for (int m = 0; m < 4; ++m) { const int row = row0 + ai * HALF + m * 16;
                const float* xr = row < cfg::MP ? xp + (size_t)row * 1024 : (row < cfg::MROWS ? xs + (size_t)(row - cfg::MP) * 1024 : nullptr);
                float ss = 0.f;
#pragma unroll
                for (int bj = 0; bj < 2; ++bj) { const int col = col0 + bj * HALF;
                    f32x4 x0 = (f32x4){0.f, 0.f, 0.f, 0.f}, x1 = x0; if (xr) { x0 = *(const f32x4*)(xr + col); x1 = *(const f32x4*)(xr + col + 4); }
                    x0 = x0 + acc[ai][bj][m][0]; x1 = x1 + acc[ai][bj][m][1]; ss += sq4(x0) + sq4(x1);
                    float* d = X1F + (size_t)row * 1024 + col; *(f32x4*)d = x0; *(f32x4*)(d + 4) = x1;
                    *(u32x4*)(X1B + (size_t)row * 1024 + col) = pack8(x0, x1); }
                ss += __shfl_xor(ss, 16); ss += __shfl_xor(ss, 32);
                if (fq == 0) SS2[(size_t)row * 16 + u.pn * 4 + wc] = ss; }
    }
};
__device__ __forceinline__ float dpp_shr1(float v) { return __int_as_float(__builtin_amdgcn_update_dpp(0, __float_as_int(v), 0x111, 0xf, 0xf, true)); }
struct EpiUpConv {
    static constexpr bool PERM = true, AFTER_DRAIN = false, KEEP = false, APERM = true;
    const PG8_LAS float* rsl; bf16_t* ACT; float* out; const float* conv_w; const float* conv_b; const float* state_conv; float* HALO; float* RAW;
    __device__ __forceinline__ void operator()(const f32x4 (&acc)[2][2][4][2], const Unit& u, int wr, int wc, int fr, int fq) const {
        const int pm = u.pm, f0 = u.pn * 128 + wc * 32 + 8 * fq, tok0 = 128 * wr + 8 * fr, row0 = pm * BM + tok0;
        const f32x4 rsa = *(const PG8_LAS f32x4*)(rsl + u.kind * 256 + tok0), rsb = *(const PG8_LAS f32x4*)(rsl + u.kind * 256 + tok0 + 4);
        const float rs[8] = {rsa[0], rsa[1], rsa[2], rsa[3], rsb[0], rsb[1], rsb[2], rsb[3]};
#pragma unroll
        for (int n = 0; n < 2; ++n) { const int f = f0 + 4 * n;
            const f32x4 w0 = *(const f32x4*)(conv_w + f), w1 = *(const f32x4*)(conv_w + cfg::DFF + f), w2 = *(const f32x4*)(conv_w + 2 * cfg::DFF + f), cb = *(const f32x4*)(conv_b + f);
            if (pm < 64) {
                const f32x4 a7 = acc[1][0][3][n] * rs[7], a6 = acc[1][0][2][n] * rs[6]; f32x4 am1, am2;
#pragma unroll
                for (int i = 0; i < 4; ++i) { am1[i] = dpp_shr1(a7[i]); am2[i] = dpp_shr1(a6[i]); }
#pragma unroll
                for (int e = 0; e < 8; ++e) { const f32x4 ae = acc[e >> 2][0][e & 3][n] * rs[e], be = acc[e >> 2][1][e & 3][n] * rs[e];
                    const f32x4 act = gelu4(cb + w0 * am2 + w1 * am1 + w2 * ae) * be;
                    if (!(fr == 0 && e < 2)) { u32x2 o; o.x = cvt_pk_bf16(act[0], act[1]); o.y = cvt_pk_bf16(act[2], act[3]); *(u32x2*)(ACT + (size_t)(row0 + e) * cfg::DFF + f) = o; }
                    if (e < 2 && fr == 0) { int fz = f; asm volatile("" : "+v"(fz));
                        float* rw = RAW + (size_t)(((pm * 2 + wr) * 2 + e) * 2) * cfg::DFF + fz; *(f32x4*)rw = ae; *(f32x4*)(rw + cfg::DFF) = be; }
                    if (e >= 6 && fr == 15) { int fz = f; asm volatile("" : "+v"(fz)); *(f32x4*)(HALO + (size_t)((pm * 2 + wr) * 2 + (e - 6)) * cfg::DFF + fz) = ae;
                        if ((pm & 15) == 15 && wr == 1) *(f32x4*)(out + cfg::OFF_CONV_P + (size_t)((pm >> 4) * 2 + (e - 6)) * cfg::DFF + fz) = ae; }
                    am2 = am1; am1 = ae; }
            } else if (tok0 < cfg::DB) {
#pragma unroll
                for (int e = 0; e < 8; ++e) { const int bs = tok0 + e; const float* sp = state_conv + (size_t)bs * 2 * cfg::DFF + f; const f32x4 s0 = *(const f32x4*)sp, s1 = *(const f32x4*)(sp + cfg::DFF);
                    const f32x4 ae = acc[e >> 2][0][e & 3][n] * rs[e], be = acc[e >> 2][1][e & 3][n] * rs[e];
                    const f32x4 act = gelu4(cb + w0 * s0 + w1 * s1 + w2 * ae) * be;
                    u32x2 o; o.x = cvt_pk_bf16(act[0], act[1]); o.y = cvt_pk_bf16(act[2], act[3]); *(u32x2*)(ACT + (size_t)(row0 + e) * cfg::DFF + f) = o;
                    *(f32x4*)(out + cfg::OFF_CONV_S + ((size_t)bs * 2 + 1) * cfg::DFF + f) = ae; }
            }
        }
    }
};
struct EpiDown {
    static constexpr bool PERM = true, AFTER_DRAIN = false, KEEP = false, APERM = false;
    const float* X1F; float* out; float* SS3;
    __device__ __forceinline__ void operator()(const f32x4 (&acc)[2][2][4][2], const Unit& u, int wr, int wc, int fr, int fq) const {
        const int row0 = u.pm * BM + wr * 64 + fr, col0 = u.pn * BM + wc * 32 + 8 * fq;
#pragma unroll
        for (int ai = 0; ai < 2; ++ai)
#pragma unroll
            for (int m = 0; m < 4; ++m) { const int row = row0 + ai * HALF + m * 16; float ss = 0.f;
#pragma unroll
                for (int bj = 0; bj < 2; ++bj) { const int col = col0 + bj * HALF; const float* xr = X1F + (size_t)row * 1024 + col;
                    const f32x4 x0 = *(const f32x4*)xr + acc[ai][bj][m][0], x1 = *(const f32x4*)(xr + 4) + acc[ai][bj][m][1]; ss += sq4(x0) + sq4(x1);
                    if (row < cfg::MROWS) { float* d = out + (size_t)row * 1024 + col; *(f32x4*)d = x0; *(f32x4*)(d + 4) = x1; } }
                ss += __shfl_xor(ss, 16); ss += __shfl_xor(ss, 32);
                if (fq == 0) SS3[(size_t)row * 16 + u.pn * 4 + wc] = ss; }
    }
};
template <class Epi, class Sched, bool ALIGN_EPI = false, bool SP2 = false>
__device__ __forceinline__ void gemm_phase(PG8_LAS unsigned char* lds, const Gemm g, const Sched& S, const Epi& E) {
    const int tid = threadIdx.x, wid = __builtin_amdgcn_readfirstlane(tid >> 6), lane = tid & 63, wr = wid >> 2, wc = wid & 3, fr = lane & 15, fq = lane >> 4;
    const int K = g.K, nt = K / BK;
    unsigned voffA[2], voffB[2];
#pragma unroll
    for (int i = 0; i < 2; ++i) { int R, C; stage_rc(tid * 16 + i * 8192, R, C); const int Rb = Epi::PERM ? ((R & ~31) + perm32(R & 31)) : R;
        const int Ra = Epi::APERM ? (128 * (R >> 6) + 8 * (R & 15) + ((R >> 4) & 3)) : R;
        voffA[i] = (unsigned)(Ra * g.lda + C) * 2u; voffB[i] = (unsigned)(Rb * g.ldb + C) * 2u; }
    const size_t kstep = (size_t)(BK * 2);
    const size_t hstepA = (size_t)(Epi::APERM ? 4 : HALF) * g.lda * 2, hstepB = (size_t)HALF * g.ldb * 2;
    const unsigned ldsw = (unsigned)wid * 1024u;
    const int aoff = lds_byte(wr * 64 + fr, fq * 8), boff = lds_byte(wc * 32 + fr, fq * 8);
#define PG8_SA(b, h) (((b) * 2 + (h)) * HTB)
#define PG8_SB(b, h) ((4 + (b) * 2 + (h)) * HTB)
#define PG8_STAGE(bufoff, gbase, voff) do { _Pragma("unroll") for (int _i = 0; _i < 2; ++_i) \
        __builtin_amdgcn_global_load_lds((const unsigned*)((const char*)(gbase) + (voff)[_i]), (PG8_LAS unsigned*)(lds + (bufoff) + ldsw + _i * 8192), 16, 0, 0); } while (0)
#define PG8_LDA(dst, b, h) do { _Pragma("unroll") for (int m = 0; m < 4; ++m) _Pragma("unroll") for (int k = 0; k < 2; ++k) dst[m][k] = *(const PG8_LAS bf16x8*)(lds + PG8_SA(b, h) + aoff + m * 2048 + k * 1024); } while (0)
#define PG8_LDB(dst, b, h) do { _Pragma("unroll") for (int n = 0; n < 2; ++n) _Pragma("unroll") for (int k = 0; k < 2; ++k) dst[n][k] = *(const PG8_LAS bf16x8*)(lds + PG8_SB(b, h) + boff + n * 2048 + k * 1024); } while (0)
#define PG8_MMA(ai, bj, At, Bt) do { __builtin_amdgcn_s_setprio(1); _Pragma("unroll") for (int m = 0; m < 4; ++m) _Pragma("unroll") for (int n = 0; n < 2; ++n) _Pragma("unroll") for (int k = 0; k < 2; ++k) \
        acc[ai][bj][m][n] = __builtin_amdgcn_mfma_f32_16x16x32_bf16(Bt[n][k], At[m][k], acc[ai][bj][m][n], 0, 0, 0); __builtin_amdgcn_s_setprio(0); } while (0)
#define PG8_WAIT_V(n) asm volatile("s_waitcnt vmcnt(" #n ")" ::: "memory")
#define PG8_WAIT_L(n) asm volatile("s_waitcnt lgkmcnt(" #n ")" ::: "memory")
#define PG8_BAR __builtin_amdgcn_s_barrier()
#define PG8_SCHED __builtin_amdgcn_sched_barrier(0)
    Unit cur, nxt; int ui = 0;
    if (!S.next(0, cur)) return;
    f32x4 acc[2][2][4][2];
#pragma unroll
    for (int a = 0; a < 2; ++a)
#pragma unroll
        for (int b = 0; b < 2; ++b)
#pragma unroll
            for (int m = 0; m < 4; ++m)
#pragma unroll
                for (int n = 0; n < 2; ++n) acc[a][b][m][n] = (f32x4){0.f, 0.f, 0.f, 0.f};
    bf16x8 At[4][2], B0[2][2], B1[2][2];
    const char* cA = cur.a; const char* cB = cur.b;
    S.a_ready(cur);
    if constexpr (SP2) {
        PG8_STAGE(PG8_SB(0, 0), cB, voffB); PG8_STAGE(PG8_SB(0, 1), cB + hstepB, voffB); PG8_STAGE(PG8_SA(0, 0), cA, voffA); PG8_STAGE(PG8_SA(0, 1), cA + hstepA, voffA);
        if (wr == 1) PG8_BAR;
        PG8_WAIT_V(2); PG8_BAR;
        PG8_STAGE(PG8_SB(1, 0), cB + kstep, voffB); PG8_STAGE(PG8_SA(1, 0), cA + kstep, voffA); PG8_STAGE(PG8_SB(1, 1), cB + hstepB + kstep, voffB);
        PG8_WAIT_V(6); PG8_BAR;
    } else {
        PG8_STAGE(PG8_SB(0, 0), cB, voffB); PG8_STAGE(PG8_SA(0, 0), cA, voffA); PG8_STAGE(PG8_SB(0, 1), cB + hstepB, voffB); PG8_STAGE(PG8_SA(0, 1), cA + hstepA, voffA);
        if (wr == 1) PG8_BAR;
        PG8_WAIT_V(4); PG8_BAR;
        PG8_STAGE(PG8_SB(1, 0), cB + kstep, voffB); PG8_STAGE(PG8_SA(1, 0), cA + kstep, voffA); PG8_STAGE(PG8_SB(1, 1), cB + hstepB + kstep, voffB);
        PG8_WAIT_V(6); PG8_BAR;
    }
    for (;;) {
        const bool has_next = S.next(ui + 1, nxt);
        const char* nA = has_next ? nxt.a : cA; const char* nB = has_next ? nxt.b : cB;
        for (int t = 0; t < nt; t += 2) {
            const bool last = (t == nt - 2);
            const char* a1 = cA + (size_t)(t + 1) * kstep;
            const char* a2 = last ? nA : cA + (size_t)(t + 2) * kstep; const char* b2 = last ? nB : cB + (size_t)(t + 2) * kstep;
            const char* a3 = a2 + kstep; const char* b3 = b2 + kstep;
            if (last && has_next) S.a_ready(nxt);
            if constexpr (SP2) {
            PG8_LDB(B0, 0, 0); PG8_LDB(B1, 0, 1); PG8_SCHED; PG8_LDA(At, 0, 0); PG8_STAGE(PG8_SA(1, 1), a1 + hstepA, voffA);
            PG8_WAIT_V(8); PG8_WAIT_L(0); PG8_BAR; PG8_MMA(0, 0, At, B0); PG8_MMA(0, 1, At, B1); PG8_BAR; PG8_SCHED;
            PG8_LDA(At, 0, 1); PG8_STAGE(PG8_SB(0, 0), b2, voffB); PG8_STAGE(PG8_SB(0, 1), b2 + hstepB, voffB); PG8_STAGE(PG8_SA(0, 0), a2, voffA);
            PG8_WAIT_V(8); PG8_WAIT_L(0); PG8_BAR; PG8_MMA(1, 0, At, B0); PG8_MMA(1, 1, At, B1); PG8_BAR; PG8_SCHED;
            PG8_LDB(B0, 1, 0); PG8_LDB(B1, 1, 1); PG8_SCHED; PG8_LDA(At, 1, 0); PG8_STAGE(PG8_SA(0, 1), a2 + hstepA, voffA);
            PG8_WAIT_V(8); PG8_WAIT_L(0); PG8_BAR; PG8_MMA(0, 0, At, B0); PG8_MMA(0, 1, At, B1); PG8_BAR; PG8_SCHED;
            PG8_LDA(At, 1, 1); PG8_STAGE(PG8_SB(1, 0), b3, voffB); PG8_STAGE(PG8_SB(1, 1), b3 + hstepB, voffB); PG8_STAGE(PG8_SA(1, 0), a3, voffA);
            PG8_WAIT_V(8); PG8_WAIT_L(0); PG8_BAR; PG8_MMA(1, 0, At, B0); PG8_MMA(1, 1, At, B1); PG8_BAR; PG8_SCHED;
            } else {
            PG8_LDB(B0, 0, 0); PG8_SCHED; PG8_LDA(At, 0, 0); PG8_STAGE(PG8_SA(1, 1), a1 + hstepA, voffA);
            PG8_WAIT_L(8); PG8_BAR; PG8_WAIT_L(0); PG8_MMA(0, 0, At, B0); PG8_BAR; PG8_SCHED;
            PG8_LDB(B1, 0, 1); PG8_STAGE(PG8_SB(0, 0), b2, voffB);
            PG8_BAR; PG8_WAIT_L(0); PG8_MMA(0, 1, At, B1); PG8_BAR;
            PG8_LDA(At, 0, 1); PG8_STAGE(PG8_SA(0, 0), a2, voffA);
            PG8_BAR; PG8_WAIT_L(0); PG8_MMA(1, 0, At, B0); PG8_BAR; PG8_SCHED;
            PG8_STAGE(PG8_SB(0, 1), b2 + hstepB, voffB);
            PG8_WAIT_V(6); PG8_BAR; PG8_MMA(1, 1, At, B1); PG8_BAR;
            PG8_LDB(B0, 1, 0); PG8_SCHED; PG8_LDA(At, 1, 0); PG8_STAGE(PG8_SA(0, 1), a2 + hstepA, voffA);
            PG8_WAIT_L(8); PG8_BAR; PG8_WAIT_L(0); PG8_MMA(0, 0, At, B0); PG8_BAR; PG8_SCHED;
            PG8_LDB(B1, 1, 1); PG8_STAGE(PG8_SB(1, 0), b3, voffB);
            PG8_BAR; PG8_WAIT_L(0); PG8_MMA(0, 1, At, B1); PG8_BAR;
            PG8_LDA(At, 1, 1); PG8_STAGE(PG8_SA(1, 0), a3, voffA);
            PG8_BAR; PG8_WAIT_L(0); PG8_MMA(1, 0, At, B0); PG8_BAR; PG8_SCHED;
            PG8_STAGE(PG8_SB(1, 1), b3 + hstepB, voffB);
            PG8_WAIT_V(6); PG8_BAR; PG8_MMA(1, 1, At, B1); PG8_BAR;
            }
        }
        if constexpr (ALIGN_EPI) { if (wr == 0) PG8_BAR; }
        if constexpr (!Epi::AFTER_DRAIN) { E(acc, cur, wr, wc, fr, fq); S.done(cur); }
        if (!has_next) break;
        bool keep = false; if constexpr (Epi::KEEP) keep = E.keep(cur);
        if (!keep) {
#pragma unroll
        for (int a = 0; a < 2; ++a)
#pragma unroll
            for (int b = 0; b < 2; ++b)
#pragma unroll
                for (int m = 0; m < 4; ++m)
#pragma unroll
                    for (int n = 0; n < 2; ++n) acc[a][b][m][n] = (f32x4){0.f, 0.f, 0.f, 0.f};
        }
        cur = nxt; cA = nA; cB = nB; ++ui;
        if constexpr (ALIGN_EPI) { if (wr == 1) PG8_BAR; }
    }
    PG8_WAIT_V(0);
    if constexpr (!ALIGN_EPI) { if (wr == 0) PG8_BAR; }
    PG8_BAR;
    if constexpr (Epi::AFTER_DRAIN) { E.fused(acc, cur, wr, wc, fr, fq, lds, wid, lane); S.done(cur); }
#undef PG8_SA
#undef PG8_SB
#undef PG8_STAGE
#undef PG8_LDA
#undef PG8_LDB
#undef PG8_MMA
#undef PG8_WAIT_V
#undef PG8_WAIT_L
#undef PG8_BAR
#undef PG8_SCHED
}
}
#define XB_TMO      128
#define XB_XCNT(j)  (256  + 64 * (j))
#define XB_XSUB(j)  (1280 + 64 * (j))
#define XB_XGEN(j)  (2304 + 64 * (j))
#define XB_TOP      3328
#define XB_TOPGEN   3392
#define XCD_BAR_WORDS 3456
#define XB_SPIN_CAP (1u << 22)

__device__ __forceinline__ unsigned xb_ld(unsigned* p)              { return __hip_atomic_load(p, __ATOMIC_RELAXED, __HIP_MEMORY_SCOPE_AGENT); }
__device__ __forceinline__ unsigned xb_add(unsigned* p, unsigned v) { return __hip_atomic_fetch_add(p, v, __ATOMIC_RELAXED, __HIP_MEMORY_SCOPE_AGENT); }
__device__ __forceinline__ unsigned xb_xcc_id() { return (unsigned)__builtin_amdgcn_s_getreg((3 << 11) | 20) & 0xFu; }
#define XB_SPIN(cond, bar) do { unsigned _sp = 0; while (cond) { __builtin_amdgcn_s_sleep(1); \
    if ((++_sp & 255u) == 0u) { if (xb_ld(&(bar)[XB_TMO])) break; if (_sp > XB_SPIN_CAP) { atomicAdd(&(bar)[XB_TMO], 1u); break; } } } } while (0)

struct XcdBarrier {
    unsigned* bar; unsigned x;
    volatile LAS unsigned* st;
};

__device__ __forceinline__ XcdBarrier xcd_barrier_post(unsigned* bar, volatile LAS unsigned* st) {
    XcdBarrier b; b.bar = bar; b.x = xb_xcc_id(); b.st = st;
    if (threadIdx.x == 0) (void)xb_add(&bar[XB_XCNT(b.x)], 1u);
    return b;
}
__device__ __forceinline__ void xcd_barrier_complete(unsigned* bar, unsigned x, unsigned& nloc, unsigned& nx) {
    const unsigned G = gridDim.x * gridDim.y * gridDim.z;
    unsigned sum, cnt, mine, sp = 0u;
    for (;;) {
        sum = 0u; cnt = 0u; mine = 0u;
#pragma unroll
        for (unsigned j = 0; j < 16; ++j) { const unsigned c = xb_ld(&bar[XB_XCNT(j)]); sum += c; cnt += (c > 0u) ? 1u : 0u; mine = (j == x) ? c : mine; }
        if (sum == G) break;
        __builtin_amdgcn_s_sleep(1);
        if ((++sp & 255u) == 0u) { if (xb_ld(&bar[XB_TMO])) break; if (sp > XB_SPIN_CAP) { atomicAdd(&bar[XB_TMO], 1u); break; } }
    }
    nloc = mine > 0u ? mine : 1u; nx = cnt > 0u ? cnt : 1u;
}

__device__ __forceinline__ void xcd_barrier(const XcdBarrier& b) {
    asm volatile("s_waitcnt vmcnt(0)" ::: "memory");
    __syncthreads();
    if (threadIdx.x == 0) {
        unsigned* bar = b.bar;
        __builtin_amdgcn_s_waitcnt(0);
        unsigned nloc = b.st[0], nx = b.st[1];
        if (nloc == 0u) { xcd_barrier_complete(bar, b.x, nloc, nx); b.st[0] = nloc; b.st[1] = nx; }
        const unsigned old = xb_add(&bar[XB_XSUB(b.x)], 1u);
        const unsigned gen = old / nloc;
        if (old + 1u == (gen + 1u) * nloc) {
            __builtin_amdgcn_fence(__ATOMIC_RELEASE, "agent");
            asm volatile("s_waitcnt vmcnt(0)" ::: "memory");
            const unsigned og = xb_add(&bar[XB_TOP], 1u);
            const unsigned tg = og / nx;
            if (og + 1u == (tg + 1u) * nx) xb_add(&bar[XB_TOPGEN], 1u);
            else XB_SPIN(xb_ld(&bar[XB_TOPGEN]) == tg, bar);
            __builtin_amdgcn_fence(__ATOMIC_ACQUIRE, "agent");
            xb_add(&bar[XB_XGEN(b.x)], 1u);
            asm volatile("s_waitcnt vmcnt(0)" ::: "memory");
        } else {
            XB_SPIN(xb_ld(&bar[XB_XGEN(b.x)]) == gen, bar);
            __builtin_amdgcn_fence(__ATOMIC_ACQUIRE, "agent");
            asm volatile("s_waitcnt vmcnt(0)" ::: "memory");
        }
    }
    __syncthreads();
}
constexpr int NWAVES = 8;
#ifndef MK_N_LAUNCHES
#define MK_N_LAUNCHES 1
#endif
#ifndef REPMASK
#define REPMASK 0
#endif
#ifndef PHMASK
#define PHMASK 0x3ff
#endif
#define LDS_WAIT() asm volatile("s_waitcnt lgkmcnt(0)" ::: "memory")

template <int MAPK> DI int colmap(int n, int N) {
    if (MAPK == 0) return n < N ? n : -1;
    if (MAPK == 2) { const int w = n & 255; return w < 128 ? (n >> 8) * 128 + w : cfg::DFF + (n >> 8) * 128 + (w - 128); }
    if (n < 1280) return n;
    if (n < 2304) return n + 24;
    if (n < 4352) return n + 24;
    if (n < 4376) return n - 4352 + 1280;
    return -1;
}
template <int MAPK> DI void transpose_item(const float* W, int K, int N, const float* kscale, bf16* WT, LAS float* scr, int item, int nblk, int lane) {
    const int kb = item / nblk, nb = item % nblk, k0 = 64 * kb, n0 = 32 * nb;
    const int sc = colmap<MAPK>(n0 + (lane & 31), N);
    float tv[32];
#pragma unroll
    for (int i = 0; i < 32; ++i) { const int kk = 2 * i + (lane >> 5); tv[i] = sc >= 0 ? W[(size_t)(k0 + kk) * N + sc] : 0.f; }
#pragma unroll
    for (int i = 0; i < 32; ++i) { const int kk = 2 * i + (lane >> 5); float v = tv[i]; if (kscale) v *= kscale[k0 + kk]; scr[kk * 33 + (lane & 31)] = v; }
    LDS_WAIT();
    const int c = lane & 7;
#pragma unroll
    for (int j = 0; j < 4; ++j) { const int n = (lane >> 3) + 8 * j; const LAS float* s = scr + (8 * c) * 33 + n;
        v4u o; o.x = pk2(s[0 * 33], s[1 * 33]); o.y = pk2(s[2 * 33], s[3 * 33]); o.z = pk2(s[4 * 33], s[5 * 33]); o.w = pk2(s[6 * 33], s[7 * 33]);
        *(v4u*)(WT + (size_t)(n0 + n) * K + k0 + 8 * c) = o; }
    LDS_WAIT();
}

DI void load8(const float* p, float (&x)[8]) { const v4f a = *(const v4f*)p, b = *(const v4f*)(p + 4); x[0] = a.x; x[1] = a.y; x[2] = a.z; x[3] = a.w; x[4] = b.x; x[5] = b.y; x[6] = b.z; x[7] = b.w; }
DI void load8(const bf16* p, float (&x)[8]) { const v4u a = *(const v4u*)p; x[0] = __uint_as_float(a.x << 16); x[1] = __uint_as_float(a.x & 0xffff0000u); x[2] = __uint_as_float(a.y << 16); x[3] = __uint_as_float(a.y & 0xffff0000u);
    x[4] = __uint_as_float(a.z << 16); x[5] = __uint_as_float(a.z & 0xffff0000u); x[6] = __uint_as_float(a.w << 16); x[7] = __uint_as_float(a.w & 0xffff0000u); }
DI float load1(const float* p) { return *p; }
DI float load1(const bf16* p) { return bf2f(*p); }

typedef short s16x8 __attribute__((ext_vector_type(8)));
typedef float f32x16 __attribute__((ext_vector_type(16)));
template <typename OT> DI void cmp_stage2_tile(const bf16* Pg, int nseg, int n0, const bf16* W2Fkv, OT* OUTg, int ncmp, int lane) {
    const int r32 = lane & 31, hi = lane >> 5, ra = n0 + r32, rb = ra + 1 < nseg ? ra + 1 : nseg - 1;
    f32x16 acc0, acc1;
#pragma unroll
    for (int i = 0; i < 16; ++i) { acc0[i] = 0.f; acc1[i] = 0.f; }
#pragma unroll
    for (int ks = 0; ks < 8; ++ks) {
        float p0[8], p1[8]; load8(Pg + (size_t)ra * 256 + 16 * ks + 8 * hi, p0); load8(Pg + (size_t)rb * 256 + 128 + 16 * ks + 8 * hi, p1);
        v4u av; av.x = pg8::cvt_pk_bf16(gelu_tanh(p0[0] + p1[0]), gelu_tanh(p0[1] + p1[1])); av.y = pg8::cvt_pk_bf16(gelu_tanh(p0[2] + p1[2]), gelu_tanh(p0[3] + p1[3]));
        av.z = pg8::cvt_pk_bf16(gelu_tanh(p0[4] + p1[4]), gelu_tanh(p0[5] + p1[5])); av.w = pg8::cvt_pk_bf16(gelu_tanh(p0[6] + p1[6]), gelu_tanh(p0[7] + p1[7]));
        const v4u b0 = *(const v4u*)(W2Fkv + ((size_t)(ks * 2 + 0) * 64 + lane) * 8), b1 = *(const v4u*)(W2Fkv + ((size_t)(ks * 2 + 1) * 64 + lane) * 8);
        acc0 = __builtin_amdgcn_mfma_f32_32x32x16_bf16(__builtin_bit_cast(s16x8, av), __builtin_bit_cast(s16x8, b0), acc0, 0, 0, 0);
        acc1 = __builtin_amdgcn_mfma_f32_32x32x16_bf16(__builtin_bit_cast(s16x8, av), __builtin_bit_cast(s16x8, b1), acc1, 0, 0, 0);
    }
#pragma unroll
    for (int r = 0; r < 16; ++r) { const int row = n0 + (r & 3) + 8 * (r >> 2) + 4 * hi; if (row < ncmp) { if (sizeof(OT) == 4) { OUTg[(size_t)row * 64 + r32] = (OT)acc0[r]; OUTg[(size_t)row * 64 + 32 + r32] = (OT)acc1[r]; } else { OUTg[(size_t)row * 64 + r32] = (OT)f2bf(acc0[r]); OUTg[(size_t)row * 64 + 32 + r32] = (OT)f2bf(acc1[r]); } } }
}
DI void load_cmp_bias(const Args& a, LAS float* biasL, int tid) {
    if (tid < 256) { const float* PB = (const float*)(a.ws + cfg::WS_PB); const int kv = tid >> 7, h = tid & 127; float s = a.cmp_b1[kv * 128 + h];
#pragma unroll 8
        for (int c = 0; c < 32; ++c) s += PB[(kv * 32 + c) * 128 + h];
        biasL[tid] = s; }
    LDS_WAIT(); __syncthreads();
}
struct MixOrder {
    pg8::StaticOrder s1; int G, c; const char* CB; const char* W1T;
    __device__ __forceinline__ bool next(int i, pg8::Unit& u) const {
        long L = (long)i * G + c; if (L < s1.nwg) return s1.unit_of((int)L, u);
        L -= s1.nwg; if (L >= 512) return false;
        const int kv = (int)(L >> 8), rest = (int)(L & 255);
        u.pm = rest; u.pn = 0; u.kind = 1 + kv; u.a = CB + (((size_t)(kv * 64 + (rest >> 2)) * 16384 + (size_t)(rest & 3) * 4096) * 64) * 2; u.b = W1T + (size_t)kv * 256 * 1024 * 2; return true;
    }
    __device__ __forceinline__ void a_ready(const pg8::Unit&) const {}
    __device__ __forceinline__ void done(const pg8::Unit&) const {}
};
struct PairOrder {
    pg8::StaticOrder s1;
    __device__ __forceinline__ bool next(int i, pg8::Unit& u) const { if (!s1.next(i >> 1, u)) return false; u.kind = i & 1; u.a += (i & 1) * 1024; u.b += (i & 1) * 1024; return true; }
    __device__ __forceinline__ void a_ready(const pg8::Unit&) const {}
    __device__ __forceinline__ void done(const pg8::Unit&) const {}
};
struct OrdOrder {
    pg8::StaticOrder s1;
    __device__ __forceinline__ bool next(int i, pg8::Unit& u) const { if (!s1.next(i, u)) return false; u.kind = i; return true; }
    __device__ __forceinline__ void a_ready(const pg8::Unit&) const {}
    __device__ __forceinline__ void done(const pg8::Unit&) const {}
};
struct OneOrder {
    pg8::Unit u0;
    __device__ __forceinline__ bool next(int i, pg8::Unit& u) const { if (i) return false; u = u0; return true; }
    __device__ __forceinline__ void a_ready(const pg8::Unit&) const {}
    __device__ __forceinline__ void done(const pg8::Unit&) const {}
};
template <typename KT> DI void score4(float (&s)[4], const KT* kptr, bool valid, const LAS float* qs) {
    float a0 = 0.f, a1 = 0.f, a2 = 0.f, a3 = 0.f;
#pragma unroll
    for (int c = 0; c < 8; ++c) { float k[8]; load8(kptr + 8 * c, k); asm volatile("" : "+v"(a0), "+v"(a1), "+v"(a2), "+v"(a3) :: "memory");
#pragma unroll
        for (int j = 0; j < 8; ++j) { const int d = 8 * c + j; a0 += k[j] * qs[d]; a1 += k[j] * qs[64 + d]; a2 += k[j] * qs[128 + d]; a3 += k[j] * qs[192 + d]; } }
    s[0] = valid ? a0 : cfg::NEGF; s[1] = valid ? a1 : cfg::NEGF; s[2] = valid ? a2 : cfg::NEGF; s[3] = valid ? a3 : cfg::NEGF;
}
namespace dec {
constexpr int L_QS = 0, L_S = 1024, L_RED = L_S + 4 * 1024 * 4, L_OS = L_RED + 512, L_IC = L_OS + 8 * 4 * 64 * 4, L_SC = L_IC + 1056 * 4, L_LIST = L_SC + 272 * 4, L_O = L_LIST + 128, L_END = L_O + 3 * 256 * 4;
static_assert(L_END <= cfg::RING_BYTES, "decode attention LDS map");
struct KeyCmp { const float* kc; const float* vc; DI bool valid(int k) const { return k < 1023; } DI const float* kp(int k) const { return kc + (size_t)(k < 1023 ? k : 1022) * 64; } DI const float* vp(int k) const { return vc + (size_t)(k < 1023 ? k : 1022) * 64; } };
struct KeyWin { const float* cw; const float* nw; DI bool valid(int k) const { return k < 513; } DI const float* kp(int k) const { return k < 512 ? cw + (size_t)k * 256 : nw; } DI const float* vp(int k) const { return kp(k) + 128; } };
struct KeySlc { const float* cs; const int* pt; const LAS int* list; const float* ns; int g;
    DI bool valid(int k) const { return list[k >> 6] < 256 || (k & 63) == 0; }
    DI const float* kp(int k) const { const int blk = list[k >> 6]; if (blk >= 256) return ns; const int phys = pt[blk >> 1]; return cs + (((size_t)phys * 128 + (blk & 1) * 64 + (k & 63)) * 4 + g) * 64; }
    DI const float* vp(int k) const { return kp(k) + 128; } };
template <int NK, bool IMP, class KM> DI void attend(const KM& km, LAS char* L, int slot, int tid) {
    const int lane = tid & 63, wave = __builtin_amdgcn_readfirstlane(tid >> 6);
    const LAS float* qs = (const LAS float*)(L + L_QS); LAS float* sb = (LAS float*)(L + L_S); LAS float* red = (LAS float*)(L + L_RED); LAS float* os = (LAS float*)(L + L_OS); LAS float* ic = (LAS float*)(L + L_IC);
    float s[NK][4]; bool ok[NK]; float mx[4] = {cfg::NEGF, cfg::NEGF, cfg::NEGF, cfg::NEGF};
#pragma unroll
    for (int i = 0; i < NK; ++i) { const int k = tid + 512 * i; ok[i] = km.valid(k); score4<float>(s[i], km.kp(k), ok[i], qs);
#pragma unroll
        for (int r = 0; r < 4; ++r) mx[r] = fmaxf(mx[r], s[i][r]); }
#pragma unroll
    for (int r = 0; r < 4; ++r) { mx[r] = wave_max(mx[r]); if (lane == 0) red[wave * 4 + r] = mx[r]; }
    LDS_WAIT(); __syncthreads();
    float sm[4];
#pragma unroll
    for (int r = 0; r < 4; ++r) { float m = red[r];
#pragma unroll
        for (int w = 1; w < 8; ++w) m = fmaxf(m, red[w * 4 + r]);
        mx[r] = m; sm[r] = 0.f; }
#pragma unroll
    for (int i = 0; i < NK; ++i)
#pragma unroll
        for (int r = 0; r < 4; ++r) { s[i][r] = ok[i] ? __builtin_amdgcn_exp2f((s[i][r] - mx[r]) * cfg::L2E) : 0.f; sm[r] += s[i][r]; }
#pragma unroll
    for (int r = 0; r < 4; ++r) { sm[r] = wave_sum(sm[r]); if (lane == 0) red[32 + wave * 4 + r] = sm[r]; }
    LDS_WAIT(); __syncthreads();
#pragma unroll
    for (int r = 0; r < 4; ++r) { float t = red[32 + r];
#pragma unroll
        for (int w = 1; w < 8; ++w) t += red[32 + w * 4 + r];
        sm[r] = t > 0.f ? 1.0f / t : 0.f; }
#pragma unroll
    for (int i = 0; i < NK; ++i) { const int k = tid + 512 * i; float isum = 0.f;
#pragma unroll
        for (int r = 0; r < 4; ++r) { const float p = s[i][r] * sm[r]; sb[r * 1024 + k] = p; isum += p; }
        if (IMP) ic[k] = isum; }
    LDS_WAIT(); __syncthreads();
    constexpr int KW = NK * 64; float o0 = 0.f, o1 = 0.f, o2 = 0.f, o3 = 0.f;
#pragma unroll 8
    for (int kk = 0; kk < KW; ++kk) { const int k = wave * KW + kk; const float v = km.vp(k)[lane];
        o0 += sb[k] * v; o1 += sb[1024 + k] * v; o2 += sb[2048 + k] * v; o3 += sb[3072 + k] * v; }
    os[(wave * 4 + 0) * 64 + lane] = o0; os[(wave * 4 + 1) * 64 + lane] = o1; os[(wave * 4 + 2) * 64 + lane] = o2; os[(wave * 4 + 3) * 64 + lane] = o3;
    LDS_WAIT(); __syncthreads();
    if (tid < 256) { float t = 0.f;
#pragma unroll
        for (int w = 0; w < 8; ++w) t += os[w * 256 + tid];
        ((LAS float*)(L + L_O))[slot * 256 + tid] = t; }
    LDS_WAIT(); __syncthreads();
}
DI void sample_unit(const Args& a, int b, int g, LAS unsigned char* lds_raw, int tid) {
    LAS char* L = (LAS char*)lds_raw; const int row = cfg::MP + b;
    LAS float* qs = (LAS float*)(L + L_QS); LAS float* ic = (LAS float*)(L + L_IC); LAS float* sc = (LAS float*)(L + L_SC); LAS int* list = (LAS int*)(L + L_LIST);
    const bf16* Q = (const bf16*)(a.ws + cfg::WS_Q);
    if (tid < 256) qs[tid] = bf2f(Q[(size_t)row * 512 + g * 256 + tid]);
    for (int i = tid; i < 1056; i += 512) ic[i] = 0.f;
    LDS_WAIT(); __syncthreads();
    { KeyCmp km{(const float*)(a.ws + cfg::WS_KCS) + (size_t)(b * 2 + g) * 1024 * 64, (const float*)(a.ws + cfg::WS_VCS) + (size_t)(b * 2 + g) * 1024 * 64}; attend<2, true>(km, L, 0, tid); }
    if (tid < 257) { const int j = tid; float imp = 0.f;
#pragma unroll
        for (int mm = -1; mm < 4; ++mm) { const int idx = 4 * j + mm; if (idx >= 0 && idx < 1023) imp += ic[idx]; }
        sc[j] = imp + ((j == 0 || j >= 255) ? 1e6f : 0.f); }
    LDS_WAIT(); __syncthreads();
    { const int j = tid < 257 ? tid : 256; const float my = sc[j]; int rank = 0;
#pragma unroll 8
      for (int k = 0; k < 257; ++k) { const float o = sc[k]; rank += (o > my || (o == my && k < j)) ? 1 : 0; }
      __syncthreads();
      if (tid < 257 && rank < 16) list[rank] = j; }
    LDS_WAIT(); __syncthreads();
    { KeySlc km{a.cache_slc, a.page_table + b * cfg::NPAGES, list, a.out + cfg::OFF_SLC_S + (size_t)(b * 4 + g) * 64, g}; attend<2, false>(km, L, 1, tid); }
    { KeyWin km{a.cache_win + ((size_t)b * 512 * 4 + g) * 64, a.out + cfg::OFF_WIN_S + (((size_t)b * 512 + 511) * 4 + g) * 64}; attend<2, false>(km, L, 2, tid); }
    if (tid < 256) { const int r = tid >> 6, h = g * 4 + r; const float* ng = (const float*)(a.ws + cfg::WS_NSAG) + (size_t)row * 32 + h * 3; const LAS float* O = (const LAS float*)(L + L_O);
        ((bf16*)(a.ws + cfg::WS_ONSA))[(size_t)row * 1024 + h * 64 + (tid & 63)] = (bf16)f2bf(ng[0] * O[tid] + ng[1] * O[256 + tid] + ng[2] * O[512 + tid]); }
    LDS_WAIT(); __syncthreads();
}
}

DI float rstd_v(const float* SSV, int row) { const v4f a = *(const v4f*)(SSV + (size_t)row * 8), b = *(const v4f*)(SSV + (size_t)row * 8 + 4);
    return 1.0f / sqrtf((((a.x + a.y) + (a.z + a.w)) + ((b.x + b.y) + (b.z + b.w))) * (1.0f / 512.0f) + cfg::EPS); }
DI float rstd16(const float* SS, int row) { const v4f* p = (const v4f*)(SS + (size_t)row * 16); const v4f s0 = p[0], s1 = p[1], s2 = p[2], s3 = p[3];
    const float t = ((s0.x + s0.y) + (s0.z + s0.w)) + ((s1.x + s1.y) + (s1.z + s1.w)) + ((s2.x + s2.y) + (s2.z + s2.w)) + ((s3.x + s3.y) + (s3.z + s3.w));
    return 1.0f / sqrtf(t * (1.0f / 1024.0f) + cfg::EPS); }

namespace att {
constexpr int KP = 144;
constexpr int TILE_B = 64 * KP;
constexpr int BUF_B = 2 * TILE_B;
constexpr int W_OFF = 2 * BUF_B;
constexpr int W_IC = 0, W_SC = 8192, W_TAB = 10240, W_MSK = 10496, W_BYTES = 10560;
static_assert(W_OFF + 8 * W_BYTES <= cfg::RING_BYTES, "attention LDS map");
constexpr float NEG_S = -2e30f, M_INIT = -1e30f;
typedef short s16x4 __attribute__((ext_vector_type(4)));

DI float pl32_max(float v) { const auto rr = __builtin_amdgcn_permlane32_swap(__float_as_uint(v), __float_as_uint(v), false, false); return fmaxf(__uint_as_float(rr[0]), __uint_as_float(rr[1])); }
DI float pl32_sum(float v) { const auto rr = __builtin_amdgcn_permlane32_swap(__float_as_uint(v), __float_as_uint(v), false, false); return __uint_as_float(rr[0]) + __uint_as_float(rr[1]); }
DI float quad_sum(float v) {
    v += __int_as_float(__builtin_amdgcn_mov_dpp(__float_as_int(v), 0xB1, 0xf, 0xf, true));
    v += __int_as_float(__builtin_amdgcn_mov_dpp(__float_as_int(v), 0x4E, 0xf, 0xf, true));
    return v;
}
DI s16x4 lds_tr(const LAS char* p) { return __builtin_bit_cast(s16x4, __builtin_amdgcn_ds_read_tr16_b64_v4i16((LAS s16x4*)p)); }

DI void tile_fetch(v4u& kr, v4u& vr, const bf16* kg, const bf16* vg, size_t rowstride, int tid) {
    const size_t off = (size_t)(tid >> 3) * rowstride + (tid & 7) * 8; kr = *(const v4u*)(kg + off); vr = *(const v4u*)(vg + off);
}
DI void tile_store(LAS char* buf, const v4u& kr, const v4u& vr, int tid) {
    LAS char* p = buf + (tid >> 3) * KP + (tid & 7) * 16; *(LAS v4u*)p = kr; *(LAS v4u*)(p + TILE_B) = vr;
}
DI void qk_tile(f32x16& s0, f32x16& s1, const LAS char* Kt, const s16x8 (&qf)[4], int r32, int hi) {
#pragma unroll
    for (int i = 0; i < 16; ++i) { s0[i] = 0.f; s1[i] = 0.f; }
#pragma unroll
    for (int d0 = 0; d0 < 4; ++d0) {
        const s16x8 a0 = *(const LAS s16x8*)(Kt + r32 * KP + (2 * d0 + hi) * 16), a1 = *(const LAS s16x8*)(Kt + (32 + r32) * KP + (2 * d0 + hi) * 16);
        s0 = __builtin_amdgcn_mfma_f32_32x32x16_bf16(a0, qf[d0], s0, 0, 0, 0); s1 = __builtin_amdgcn_mfma_f32_32x32x16_bf16(a1, qf[d0], s1, 0, 0, 0);
    }
}
DI void pv_tile(f32x16 (&o)[2], const LAS char* Vt, const unsigned (&pk)[16], int lane) {
    const int hi = lane >> 5, gq = (lane >> 4) & 1, qq = (lane & 15) >> 2, pp = lane & 3;
    const LAS char* vb = Vt + (4 * hi + qq) * KP + (16 * gq + 4 * pp) * 2;
#pragma unroll
    for (int ks = 0; ks < 4; ++ks) {
        v4u av; av.x = pk[4 * ks]; av.y = pk[4 * ks + 1]; av.z = pk[4 * ks + 2]; av.w = pk[4 * ks + 3];
#pragma unroll
        for (int db = 0; db < 2; ++db) {
            const s16x4 lo = lds_tr(vb + (16 * ks) * KP + db * 64), hh = lds_tr(vb + (16 * ks + 8) * KP + db * 64);
            const s16x8 bv = (s16x8){lo[0], lo[1], lo[2], lo[3], hh[0], hh[1], hh[2], hh[3]};
            o[db] = __builtin_amdgcn_mfma_f32_32x32x16_bf16(__builtin_bit_cast(s16x8, av), bv, o[db], 0, 0, 0);
        }
    }
}
DI void tab_publish(LAS float* tab, float v, int r32, int hi) { if (hi == 0) tab[r32] = v; LDS_WAIT(); }
DI float crowf(const LAS float* tab, int reg, int hi) { return tab[(reg & 3) + 8 * (reg >> 2) + 4 * hi]; }

struct Ctx {
    int b, g, qt, tid, lane, wave, r32, hi, tq;
    LAS char* lds; LAS float* ic; LAS float* sc; LAS float* tab; LAS unsigned* msk;
};

DI void lds_barrier() { asm volatile("s_waitcnt lgkmcnt(0)\n\ts_barrier" ::: "memory"); }

template <int MODE> DI void tile_compute(const Ctx& c, const s16x8 (&qf)[4], int j, const LAS char* Kt, const LAS char* Vt, float& m, float& l, f32x16 (&o)[2], float linv, int vis, unsigned msk_lo, unsigned msk_hi) {
    int lo = 0, hi_ = 63; bool need_mask, lane_on = true;
    if (MODE <= 1) { hi_ = vis - 64 * j; need_mask = true; }
    else if (MODE == 2) { lane_on = ((j < 32 ? msk_lo >> j : msk_hi >> (j - 32)) & 1u) != 0u; if (!__any(lane_on)) return;
        if (j == c.qt) { hi_ = lane_on ? c.tq : -1; need_mask = true; lane_on = true; } else need_mask = false; }
    else { if (j == c.qt) hi_ = c.tq; else if (j == c.qt - 8) lo = c.tq; need_mask = (j == c.qt) || (j == c.qt - 8); }
    f32x16 s0, s1; qk_tile(s0, s1, Kt, qf, c.r32, c.hi);
    if (need_mask) { const int l4 = lo - 4 * c.hi, h4 = hi_ - 4 * c.hi;
#pragma unroll
        for (int r = 0; r < 16; ++r) { const int k0 = (r & 3) + 8 * (r >> 2); s0[r] = (k0 >= l4 && k0 <= h4) ? s0[r] : NEG_S; s1[r] = (k0 + 32 >= l4 && k0 + 32 <= h4) ? s1[r] : NEG_S; } }
    unsigned pk[16];
    if (MODE == 1) {
        const float mL = m * cfg::L2E;
#pragma unroll
        for (int r = 0; r < 16; ++r) { s0[r] = __builtin_amdgcn_exp2f(__builtin_fmaf(s0[r], cfg::L2E, -mL)) * linv; s1[r] = __builtin_amdgcn_exp2f(__builtin_fmaf(s1[r], cfg::L2E, -mL)) * linv; }
#pragma unroll
        for (int r = 0; r < 16; ++r) { const float a0 = quad_sum(s0[r]), a1 = quad_sum(s1[r]); const int key = 64 * j + (r & 3) + 8 * (r >> 2) + 4 * c.hi;
            if ((c.r32 & 3) == 0) { c.ic[(c.r32 >> 2) * 256 + key] = a0; c.ic[(c.r32 >> 2) * 256 + key + 32] = a1; } }
    } else {
        float mt = __builtin_fmaxf(s0[0], s1[0]);
#pragma unroll
        for (int r = 1; r < 16; ++r) mt = __builtin_fmaxf(__builtin_fmaxf(mt, s0[r]), s1[r]);
        if (MODE == 2) mt = lane_on ? mt : NEG_S;
        mt = pl32_max(mt);
        const float mn = fmaxf(m, mt);
        if (__any(mn > m)) { const float al = __builtin_amdgcn_exp2f((m - mn) * cfg::L2E); l *= al; m = mn;
            if (MODE >= 2) { tab_publish(c.tab, al, c.r32, c.hi);
#pragma unroll
                for (int r = 0; r < 16; ++r) { const float f = crowf(c.tab, r, c.hi); o[0][r] *= f; o[1][r] *= f; } } }
        const float mL = m * cfg::L2E; float ls = 0.f;
#pragma unroll
        for (int r = 0; r < 16; ++r) { s0[r] = __builtin_amdgcn_exp2f(__builtin_fmaf(s0[r], cfg::L2E, -mL)); s1[r] = __builtin_amdgcn_exp2f(__builtin_fmaf(s1[r], cfg::L2E, -mL)); ls += s0[r] + s1[r]; }
        if (MODE == 2) ls = lane_on ? ls : 0.f;
        l += ls;
    }
    if (MODE >= 1) {
#pragma unroll
        for (int i = 0; i < 8; ++i) { pk[i] = pg8::cvt_pk_bf16(s0[2 * i], s0[2 * i + 1]); pk[8 + i] = pg8::cvt_pk_bf16(s1[2 * i], s1[2 * i + 1]); }
        if (MODE == 2) {
#pragma unroll
            for (int i = 0; i < 16; ++i) pk[i] = lane_on ? pk[i] : 0u; }
        pv_tile(o, Vt, pk, c.lane);
    }
}
template <int MODE> DI void run_tiles(const Ctx& c, const s16x8 (&qf)[4], int j_lo, int j_hi, const bf16* kg, const bf16* vg, size_t rowstride,
                                      float& m, float& l, f32x16 (&o)[2], float linv, int vis, unsigned msk_lo, unsigned msk_hi) {
    v4u kr0, vr0, kr1, vr1; const size_t ts = (size_t)64 * rowstride;
    tile_fetch(kr0, vr0, kg + (size_t)j_lo * ts, vg + (size_t)j_lo * ts, rowstride, c.tid);
    if (j_lo + 1 <= j_hi) tile_fetch(kr1, vr1, kg + (size_t)(j_lo + 1) * ts, vg + (size_t)(j_lo + 1) * ts, rowstride, c.tid);
    tile_store(c.lds, kr0, vr0, c.tid);
    lds_barrier();
    for (int j = j_lo; j <= j_hi; j += 2) {
        if (j + 2 <= j_hi) tile_fetch(kr0, vr0, kg + (size_t)(j + 2) * ts, vg + (size_t)(j + 2) * ts, rowstride, c.tid);
        tile_compute<MODE>(c, qf, j, c.lds, c.lds + TILE_B, m, l, o, linv, vis, msk_lo, msk_hi);
        if (j + 1 <= j_hi) tile_store(c.lds + BUF_B, kr1, vr1, c.tid);
        lds_barrier();
        if (j + 1 > j_hi) break;
        if (j + 3 <= j_hi) tile_fetch(kr1, vr1, kg + (size_t)(j + 3) * ts, vg + (size_t)(j + 3) * ts, rowstride, c.tid);
        tile_compute<MODE>(c, qf, j + 1, c.lds + BUF_B, c.lds + BUF_B + TILE_B, m, l, o, linv, vis, msk_lo, msk_hi);
        if (j + 2 <= j_hi) tile_store(c.lds, kr0, vr0, c.tid);
        lds_barrier();
    }
}

template <bool FIRST> DI void merge_branch(const Ctx& c, LAS float* accl, const f32x16 (&o)[2], float fac) {
    tab_publish(c.tab, fac, c.r32, c.hi);
#pragma unroll
    for (int r = 0; r < 16; ++r) { const int q = (r & 3) + 8 * (r >> 2) + 4 * c.hi; const float f = c.tab[q]; LAS float* p = accl + q * 64 + c.r32;
        if (FIRST) { p[0] = o[0][r] * f; p[32] = o[1][r] * f; } else { p[0] += o[0][r] * f; p[32] += o[1][r] * f; } }
}
DI void prompt_unit(const Args& a, int b, int g, int qt, LAS unsigned char* lds_raw, int tid) {
    Ctx c; c.b = b; c.g = g; c.qt = qt; c.tid = tid; c.lane = tid & 63; c.wave = __builtin_amdgcn_readfirstlane(tid >> 6); c.r32 = c.lane & 31; c.hi = c.lane >> 5; c.tq = 8 * c.wave + (c.r32 >> 2);
    c.lds = (LAS char*)lds_raw; LAS char* wreg = c.lds + W_OFF + c.wave * W_BYTES;
    c.ic = (LAS float*)(wreg + W_IC); c.sc = (LAS float*)(wreg + W_SC); c.tab = (LAS float*)(wreg + W_TAB); c.msk = (LAS unsigned*)(wreg + W_MSK);
    const int t0 = 64 * qt, t = t0 + c.tq, rh = c.r32 & 3, row = b * 4096 + t, head = g * 4 + rh;
    const bf16* Q = (const bf16*)(a.ws + cfg::WS_Q); const bf16* KVB = (const bf16*)(a.ws + cfg::WS_KVB);
    const bf16* KC = (const bf16*)(a.ws + cfg::WS_KCP) + (size_t)(b * 2 + g) * 256 * 64; const bf16* VC = (const bf16*)(a.ws + cfg::WS_VCP) + (size_t)(b * 2 + g) * 256 * 64;
#pragma unroll
    for (int i = 0; i < 32; ++i) c.ic[i * 64 + c.lane] = 0.f;
    s16x8 qf[4];
#pragma unroll
    for (int d0 = 0; d0 < 4; ++d0) qf[d0] = *(const s16x8*)(Q + (size_t)row * 512 + head * 64 + 16 * d0 + 8 * c.hi);
    const float* ng = (const float*)(a.ws + cfg::WS_NSAG) + (size_t)row * 32 + head * 3; const float g_cmp = ng[0], g_slc = ng[1], g_win = ng[2];
    f32x16 o[2];
#pragma unroll
    for (int i = 0; i < 16; ++i) { o[0][i] = 0.f; o[1][i] = 0.f; }
    LDS_WAIT();
    const int vis = t >= 31 ? (t - 31) >> 4 : -1;
    { const int vmax = (t0 + 63 - 31) >> 4; int ntc = (vmax + 64) >> 6; ntc = ntc > 4 ? 4 : ntc;
      float m = M_INIT, l = 0.f;
      run_tiles<0>(c, qf, 0, ntc - 1, KC, VC, 64, m, l, o, 0.f, vis, 0u, 0u);
      const float lt = pl32_sum(l); const float linv = lt > 0.f ? 1.0f / lt : 0.f;
      run_tiles<1>(c, qf, 0, ntc - 1, KC, VC, 64, m, l, o, linv, vis, 0u, 0u); }
    unsigned msk_lo, msk_hi;
    { const int tl = c.lane >> 3, sub = c.lane & 7; const LAS float* icr = c.ic + tl * 256; float my[8];
#pragma unroll
      for (int e = 0; e < 8; ++e) { const int j = sub * 8 + e; float imp = 0.f;
#pragma unroll
          for (int mm = -1; mm < 4; ++mm) { const int idx = 4 * j + mm; if (idx >= 0 && idx < 255) imp += icr[idx]; }
          const bool valid = j <= qt, forced = (j == 0) || (j == qt) || (j == qt - 1);
          my[e] = valid ? imp + (forced ? 1e6f : 0.f) : cfg::NEGF; c.sc[tl * 64 + j] = my[e]; }
      LDS_WAIT();
      int rank[8];
#pragma unroll
      for (int e = 0; e < 8; ++e) rank[e] = 0;
      for (int k4 = 0; k4 < 16; ++k4) { const v4f ov = *(const LAS v4f*)(c.sc + tl * 64 + 4 * k4);
#pragma unroll
          for (int kk = 0; kk < 4; ++kk) { const float ovk = ov[kk]; const int k = 4 * k4 + kk;
#pragma unroll
              for (int e = 0; e < 8; ++e) rank[e] += (ovk > my[e] || (ovk == my[e] && k < sub * 8 + e)) ? 1 : 0; } }
      unsigned bits = 0u;
#pragma unroll
      for (int e = 0; e < 8; ++e) bits |= ((sub * 8 + e) <= qt && rank[e] < 16) ? (1u << e) : 0u;
      unsigned lo32 = sub < 4 ? bits << (8 * sub) : 0u, hi32 = sub >= 4 ? bits << (8 * (sub - 4)) : 0u;
#pragma unroll
      for (int x = 1; x < 8; x <<= 1) { lo32 |= (unsigned)__shfl_xor((int)lo32, x); hi32 |= (unsigned)__shfl_xor((int)hi32, x); }
      if (sub == 0) { c.msk[2 * tl] = lo32; c.msk[2 * tl + 1] = hi32; }
      LDS_WAIT();
      msk_lo = c.msk[2 * (c.r32 >> 2)]; msk_hi = c.msk[2 * (c.r32 >> 2) + 1]; }
    LAS float* accl = c.ic;
    merge_branch<true>(c, accl, o, g_cmp);
    {
#pragma unroll
      for (int i = 0; i < 16; ++i) { o[0][i] = 0.f; o[1][i] = 0.f; }
      float m = M_INIT, l = 0.f; const bf16* kg = KVB + (size_t)b * 4096 * 768 + 256 + g * 64;
      run_tiles<2>(c, qf, 0, qt, kg, kg + 128, 768, m, l, o, 0.f, 0, msk_lo, msk_hi);
      const float lt = pl32_sum(l); merge_branch<false>(c, accl, o, lt > 0.f ? g_slc / lt : 0.f); }
    {
#pragma unroll
      for (int i = 0; i < 16; ++i) { o[0][i] = 0.f; o[1][i] = 0.f; }
      float m = M_INIT, l = 0.f; const bf16* kg = KVB + (size_t)b * 4096 * 768 + 512 + g * 64;
      run_tiles<3>(c, qf, qt > 8 ? qt - 8 : 0, qt, kg, kg + 128, 768, m, l, o, 0.f, 0, 0u, 0u);
      const float lt = pl32_sum(l); merge_branch<false>(c, accl, o, lt > 0.f ? g_win / lt : 0.f); }
    LDS_WAIT();
    bf16* O = (bf16*)(a.ws + cfg::WS_ONSA);
#pragma unroll
    for (int r = 0; r < 16; ++r) { const int q = (r & 3) + 8 * (r >> 2) + 4 * c.hi; const size_t orow = (size_t)(b * 4096 + t0 + 8 * c.wave + (q >> 2)) * 1024 + (g * 4 + (q & 3)) * 64;
        O[orow + c.r32] = (bf16)f2bf(accl[q * 64 + c.r32]); O[orow + 32 + c.r32] = (bf16)f2bf(accl[q * 64 + 32 + c.r32]); }
    LDS_WAIT();
}
}
namespace cmx {
constexpr int VP = 272;
DI void unit(const Args& a, int b, int c, int gi, LAS unsigned char* lds_raw, int tid) {
    LAS char* L = (LAS char*)lds_raw; const int lane = tid & 63, wave = __builtin_amdgcn_readfirstlane(tid >> 6);
    const bf16* VG = (const bf16*)(a.ws + cfg::WS_VG); const bf16* U = (const bf16*)(a.ws + cfg::WS_U); const float* SSV = (const float*)(a.ws + cfg::WS_SSV); bf16* CM = (bf16*)(a.ws + cfg::WS_ONSA);
    const bf16* Wt = (const bf16*)(a.ws + cfg::WS_WTRIL) + (size_t)gi * 128 * 128; const int rbase = b * 4096 + c * 128;
#pragma unroll
    for (int k = 0; k < 4; ++k) { const int p = tid + 512 * k, j = p >> 4, ch = p & 15, row = rbase + j; const float rs = rstd_v(SSV, row);
        float v[8], gn[8]; load8(VG + (size_t)row * 512 + gi * 128 + ch * 8, v); load8(a.gmlp_norm + gi * 128 + ch * 8, gn);
#pragma unroll
        for (int e = 0; e < 8; ++e) v[e] = v[e] * rs * gn[e];
        if (c == 31) { float* d = a.out + cfg::OFF_V_P + ((size_t)(b * 128 + j)) * 512 + gi * 128 + ch * 8; *(v4f*)d = (v4f){v[0], v[1], v[2], v[3]}; *(v4f*)(d + 4) = (v4f){v[4], v[5], v[6], v[7]}; }
        v4u o; o.x = pg8::cvt_pk_bf16(v[0], v[1]); o.y = pg8::cvt_pk_bf16(v[2], v[3]); o.z = pg8::cvt_pk_bf16(v[4], v[5]); o.w = pg8::cvt_pk_bf16(v[6], v[7]);
        *(LAS v4u*)(L + j * VP + ch * 16) = o; }
    LDS_WAIT(); __syncthreads();
    const int ib = wave & 3, chh = wave >> 2, r32 = lane & 31, hi = lane >> 5, gq = (lane >> 4) & 1, qq = (lane & 15) >> 2, pp = lane & 3;
    f32x16 acc[2];
#pragma unroll
    for (int i = 0; i < 16; ++i) { acc[0][i] = 0.f; acc[1][i] = 0.f; }
    const bf16* wrow = Wt + (size_t)(32 * ib + r32) * 128 + 4 * hi; const LAS char* vb = L + (4 * hi + qq) * VP + (64 * chh + 16 * gq + 4 * pp) * 2;
    for (int ks = 0; ks < 2 * ib + 2; ++ks) {
        const v2u a0 = *(const v2u*)(wrow + 16 * ks), a1 = *(const v2u*)(wrow + 16 * ks + 8);
        const v4u av = (v4u){a0.x, a0.y, a1.x, a1.y};
#pragma unroll
        for (int cb = 0; cb < 2; ++cb) { const att::s16x4 lo = att::lds_tr(vb + (16 * ks) * VP + cb * 64), hh = att::lds_tr(vb + (16 * ks + 8) * VP + cb * 64);
            const s16x8 bv = (s16x8){lo[0], lo[1], lo[2], lo[3], hh[0], hh[1], hh[2], hh[3]};
            acc[cb] = __builtin_amdgcn_mfma_f32_32x32x16_bf16(__builtin_bit_cast(s16x8, av), bv, acc[cb], 0, 0, 0); }
    }
#pragma unroll
    for (int r = 0; r < 16; ++r) { const int i = 32 * ib + (r & 3) + 8 * (r >> 2) + 4 * hi; const float bs = a.gmlp_bs[gi * 128 + i]; const size_t off = (size_t)(rbase + i) * 512 + gi * 128 + 64 * chh + r32, offc = (size_t)(rbase + i) * 1024 + 512 + gi * 128 + 64 * chh + r32;
        CM[offc] = (bf16)f2bf(bf2f(U[off]) * (acc[0][r] + bs)); CM[offc + 32] = (bf16)f2bf(bf2f(U[off + 32]) * (acc[1][r] + bs)); }
    LDS_WAIT(); __syncthreads();
}
}


namespace thin {
template <int KS> DI v4f gemm(const bf16* A, int lda, const bf16* Bt, int ldb, int cbk, LAS unsigned char* lds_raw, int tid) {
    const int lane = tid & 63, wave = __builtin_amdgcn_readfirstlane(tid >> 6), r32 = lane & 31, hi = lane >> 5, k0 = wave * KS * 16 + 8 * hi;
    const bf16* ap = A + (size_t)r32 * lda + k0; const bf16* bp0 = Bt + (size_t)(64 * cbk + r32) * ldb + k0; const bf16* bp1 = bp0 + (size_t)32 * ldb;
    f32x16 acc0, acc1;
#pragma unroll
    for (int i = 0; i < 16; ++i) { acc0[i] = 0.f; acc1[i] = 0.f; }
#pragma unroll
    for (int ks = 0; ks < KS; ++ks) { const s16x8 av = *(const s16x8*)(ap + 16 * ks), b0 = *(const s16x8*)(bp0 + 16 * ks), b1 = *(const s16x8*)(bp1 + 16 * ks);
        acc0 = __builtin_amdgcn_mfma_f32_32x32x16_bf16(av, b0, acc0, 0, 0, 0); acc1 = __builtin_amdgcn_mfma_f32_32x32x16_bf16(av, b1, acc1, 0, 0, 0); }
    LAS float* Lf = (LAS float*)lds_raw;
#pragma unroll
    for (int r = 0; r < 16; ++r) { const int row = (r & 3) + 8 * (r >> 2) + 4 * hi; Lf[(wave * 32 + row) * 64 + r32] = acc0[r]; Lf[(wave * 32 + row) * 64 + 32 + r32] = acc1[r]; }
    LDS_WAIT(); __syncthreads();
    v4f t = *(const LAS v4f*)(Lf + (tid >> 4) * 64 + 4 * (tid & 15));
#pragma unroll
    for (int w = 1; w < 8; ++w) t += *(const LAS v4f*)(Lf + (w * 32 + (tid >> 4)) * 64 + 4 * (tid & 15));
    LDS_WAIT(); __syncthreads();
    return t;
}
DI float sum16(float v) { v += __shfl_xor(v, 1); v += __shfl_xor(v, 2); v += __shfl_xor(v, 4); v += __shfl_xor(v, 8); return v; }
}

#define W_in_t ((bf16*)(ws + cfg::WS_WIN_T))
#define W_pa_t ((bf16*)(ws + cfg::WS_WPA_T))
#define W_pb_t ((bf16*)(ws + cfg::WS_WPB_T))
#define W_out_t ((bf16*)(ws + cfg::WS_WOUT_T))
#define W_up_t ((bf16*)(ws + cfg::WS_WUP_T))
#define W_dn_t ((bf16*)(ws + cfg::WS_WDN_T))
#define RSTD1 ((float*)(ws + cfg::WS_RSTD1))
#define SSV ((float*)(ws + cfg::WS_SSV))
#define SS2 ((float*)(ws + cfg::WS_SS2))
#define SS3 ((float*)(ws + cfg::WS_SS3))
#define NSAG ((float*)(ws + cfg::WS_NSAG))
#define XB ((bf16*)(ws + cfg::WS_XB))
#define Qb ((bf16*)(ws + cfg::WS_Q))
#define KVB ((bf16*)(ws + cfg::WS_KVB))
#define Ub ((bf16*)(ws + cfg::WS_U))
#define VG ((bf16*)(ws + cfg::WS_VG))
#define GT ((bf16*)(ws + cfg::WS_GT))
#define OC ((bf16*)(ws + cfg::WS_ONSA))
#define MIX ((bf16*)(ws + cfg::WS_MIX))
#define X1F ((float*)(ws + cfg::WS_X1F))
#define X1B ((bf16*)(ws + cfg::WS_X1B))
#define AB ((bf16*)(ws + cfg::WS_AB))
#define ACT ((bf16*)(ws + cfg::WS_ACT))
__global__ void __launch_bounds__(NWAVES * 64, 2) nsa_hybrid_fwd(Args a) {
    extern __shared__ __attribute__((aligned(16))) unsigned char lds_raw[];
    LAS unsigned char* lds = (LAS unsigned char*)lds_raw;
    const int tid = threadIdx.x, lane = tid & 63, wave = __builtin_amdgcn_readfirstlane(tid >> 6);
    const int G = gridDim.x, gw = blockIdx.x * NWAVES + wave, NGW = G * NWAVES;
    unsigned char* ws = a.ws;
    for (int u = tid; u < (cfg::LDS_BYTES - cfg::LDSCTL_OFF) / 4; u += NWAVES * 64) ((LAS unsigned*)(lds + cfg::LDSCTL_OFF))[u] = 0u;
    __syncthreads();
    volatile LAS unsigned* MISC = (volatile LAS unsigned*)(lds + cfg::MISC_OFF);
    XcdBarrier bar = xcd_barrier_post((unsigned*)(ws + cfg::WS_CTL) + cfg::CW_BAR, MISC + 8);


    #if (PHMASK >> 0) & 1
    if (a.ph_lo <= 0 && 0 < a.ph_hi) {
    for (int rep_ = 0; rep_ < (int)((REPMASK >> 0) & 1) + 1; ++rep_) {
    unsigned char* ws = a.ws; asm volatile("" : "+s"(ws)); int tid = threadIdx.x; asm volatile("" : "+v"(tid)); const int lane = tid & 63;
    {
        LAS float* scr = (LAS float*)(lds + wave * 16384);
        constexpr int I_IN = 16 * (cfg::INP / 32), I_PA = 8 * 32, I_PB = 8 * 32, I_OUT = 16 * 32, I_UP = 16 * (cfg::UPN / 32), I_DN = (cfg::DFF / 64) * 32;
        constexpr int NITEMS = I_IN + I_PA + I_PB + I_OUT + I_UP + I_DN;
        for (int it = gw; it < NITEMS; it += NGW) { int r = it;
            if (r < I_IN) { transpose_item<1>(a.w_in, 1024, cfg::INC, a.norm_mix, W_in_t, scr, r, cfg::INP / 32, lane); continue; } r -= I_IN;
            if (r < I_PA) { transpose_item<0>(a.w_proj_a, 1024, 1024, nullptr, W_pa_t, scr, r, 32, lane); continue; } r -= I_PA;
            if (r < I_PB) { transpose_item<0>(a.w_proj_b, 1024, 1024, nullptr, W_pa_t + 512, scr, r, 32, lane); continue; } r -= I_PB;
            if (r < I_OUT) { transpose_item<0>(a.w_out, 1024, 1024, nullptr, W_out_t, scr, r, 32, lane); continue; } r -= I_OUT;
            if (r < I_UP) { transpose_item<2>(a.w_up, 1024, cfg::UPN, a.norm_ffn, W_up_t, scr, r, cfg::UPN / 32, lane); continue; } r -= I_UP;
            transpose_item<0>(a.w_down, cfg::DFF, 1024, nullptr, W_dn_t, scr, r, 32, lane); }
        for (int m = gw; m < cfg::MPAD; m += NGW) {
            const float* xr = m < cfg::MP ? a.x_prompt + (size_t)m * 1024 : (m < cfg::MROWS ? a.x_sample + (size_t)(m - cfg::MP) * 1024 : nullptr);
            v4f v[4]; float s = 0.f;
#pragma unroll
            for (int j = 0; j < 4; ++j) { v[j] = xr ? *(const v4f*)(xr + j * 256 + lane * 4) : (v4f){0.f, 0.f, 0.f, 0.f}; s += (v[j].x * v[j].x + v[j].y * v[j].y) + (v[j].z * v[j].z + v[j].w * v[j].w); }
            s = wave_sum(s);
            if (lane == 0) RSTD1[m] = xr ? 1.0f / sqrtf(s * (1.0f / 1024.0f) + cfg::EPS) : 0.f;
#pragma unroll
            for (int j = 0; j < 4; ++j) { v2u o; o.x = pk2(v[j].x, v[j].y); o.y = pk2(v[j].z, v[j].w); *(v2u*)(XB + (size_t)m * 1024 + j * 256 + lane * 4) = o; }
            if (m >= cfg::MROWS) {
                v4u z = (v4u){0u, 0u, 0u, 0u}; *(v4u*)(X1B + (size_t)m * 1024 + lane * 8) = z; *(v4u*)(X1B + (size_t)m * 1024 + 512 + lane * 8) = z; if (lane < 16) SS2[(size_t)m * 16 + lane] = 0.f; }
        }
        { const size_t n4 = (size_t)cfg::DB * 511 * 64;
          for (size_t i = (size_t)blockIdx.x * 512 + tid; i < n4; i += (size_t)G * 512) { const size_t bb = i / (511 * 64), rem = i % (511 * 64);
              ((v4f*)(a.out + cfg::OFF_WIN_S))[bb * 512 * 64 + rem] = ((const v4f*)a.cache_win)[bb * 512 * 64 + 64 + rem]; }
          for (int i = blockIdx.x * 512 + tid; i < cfg::DB * cfg::DFF; i += G * 512) { const int bb = i / cfg::DFF, f = i % cfg::DFF; a.out[cfg::OFF_CONV_S + (size_t)bb * 2 * cfg::DFF + f] = a.state_conv[(size_t)bb * 2 * cfg::DFF + cfg::DFF + f]; } }
        { bf16* W1T = (bf16*)(ws + cfg::WS_W1T);
          for (int it = gw; it < 4 * 64; it += NGW) { const int kr = it >> 6; transpose_item<0>(a.cmp_w1 + (size_t)kr * 1024 * 128, 1024, 128, nullptr, W1T + (size_t)kr * 128 * 1024, scr, it & 63, 4, lane); }
          bf16* W2F = (bf16*)(ws + cfg::WS_W2F);
          for (int e = blockIdx.x * 512 + tid; e < 2 * 8 * 2 * 64 * 8; e += G * 512) { const int j = e & 7, ln = (e >> 3) & 63, cb = (e >> 9) & 1, ks = (e >> 10) & 7, kv = e >> 13;
              W2F[e] = (bf16)f2bf(a.cmp_w2[(size_t)kv * 128 * 64 + (16 * ks + 8 * (ln >> 5) + j) * 64 + 32 * cb + (ln & 31)]); }
          bf16* WTR = (bf16*)(ws + cfg::WS_WTRIL);
          for (int e = blockIdx.x * 512 + tid; e < 4 * 128 * 128; e += G * 512) { const int j = e & 127, i = (e >> 7) & 127; WTR[e] = (bf16)f2bf(j <= i ? a.gmlp_ws[e] : 0.f); }
          float* PB = (float*)(ws + cfg::WS_PB);
          for (int it = gw; it < 64; it += NGW) { const int kv = it >> 5, c = it & 31; float s0 = 0.f, s1 = 0.f;
#pragma unroll 8
              for (int i = 0; i < 64; ++i) { const int k = c * 64 + i; const float pv = a.cmp_pe[kv * 2048 + k]; s0 += pv * a.cmp_w1[((size_t)kv * 2048 + k) * 128 + lane]; s1 += pv * a.cmp_w1[((size_t)kv * 2048 + k) * 128 + 64 + lane]; }
              PB[(kv * 32 + c) * 128 + lane] = s0; PB[(kv * 32 + c) * 128 + 64 + lane] = s1; } }
        { bf16* CB = (bf16*)(ws + cfg::WS_CB); const int kvg = lane >> 4, d0 = (lane & 15) * 4;
          for (int r0 = gw * 8; r0 < cfg::DB * cfg::PAST; r0 += NGW * 8) { v4f v[8];
#pragma unroll
              for (int i = 0; i < 8; ++i) { const int r = r0 + i, b = r >> 14, pos = r & 16383; const int phys = a.page_table[b * cfg::NPAGES + (pos >> 7)];
                  v[i] = *(const v4f*)(a.cache_cmp + ((size_t)phys * 128 + (pos & 127)) * 256 + lane * 4); }
#pragma unroll
              for (int i = 0; i < 8; ++i) { const int r = r0 + i, b = r >> 14, pos = r & 16383; v2u o; o.x = pg8::cvt_pk_bf16(v[i].x, v[i].y); o.y = pg8::cvt_pk_bf16(v[i].z, v[i].w);
                  *(v2u*)(CB + (((size_t)((kvg >> 1) * 32 + b) * 2 + (kvg & 1)) * 16384 + pos) * 64 + d0) = o; } } }
    }
    }
    if (1 < a.ph_hi) xcd_barrier(bar);
    }

    #endif
#if (PHMASK >> 1) & 1
    if (a.ph_lo <= 1 && 1 < a.ph_hi) {
    for (int rep_ = 0; rep_ < (int)((REPMASK >> 1) & 1) + 1; ++rep_) {
    unsigned char* ws = a.ws; asm volatile("" : "+s"(ws)); int tid = threadIdx.x; asm volatile("" : "+v"(tid)); const int lane = tid & 63;
    { LAS float* biasL = (LAS float*)(lds + cfg::BIAS_OFF); load_cmp_bias(a, biasL, tid);
      pg8::Gemm g{XB, W_in_t, cfg::MPAD, cfg::INP, 1024, 1024, 1024}; MixOrder S; S.s1.init(cfg::MPAD, cfg::INP, G, (int)blockIdx.x, XB, W_in_t, 1024); S.G = G; S.c = (int)blockIdx.x;
      S.CB = (const char*)(ws + cfg::WS_CB); S.W1T = (const char*)(ws + cfg::WS_W1T);
      pg8::EpiMix E{pg8::EpiIn{RSTD1, Qb, KVB, Ub, VG, SSV, GT, NSAG, a.out, (bf16*)(ws + cfg::WS_CBP)}, pg8::EpiP{(bf16*)(ws + cfg::WS_PS), (size_t)65536 * 256, biasL}};
      pg8::gemm_phase<pg8::EpiMix, MixOrder, true, true>(lds, g, S, E); }
    }
    if (2 < a.ph_hi) xcd_barrier(bar);
    }

    #endif
#if (PHMASK >> 2) & 1
    if (a.ph_lo <= 2 && 2 < a.ph_hi) {
    for (int rep_ = 0; rep_ < (int)((REPMASK >> 2) & 1) + 1; ++rep_) {
    unsigned char* ws = a.ws; asm volatile("" : "+s"(ws)); int tid = threadIdx.x; asm volatile("" : "+v"(tid)); const int lane = tid & 63;
    {
        const bf16* W2F = (const bf16*)(ws + cfg::WS_W2F);
        if (blockIdx.x < 16) {
            const int kv = blockIdx.x >> 3, bg = blockIdx.x & 7; LAS float* biasL = (LAS float*)(lds + cfg::BIAS_OFF); load_cmp_bias(a, biasL, tid);
            bf16* PP = (bf16*)(ws + cfg::WS_PP);
            OneOrder S; S.u0.pm = bg; S.u0.pn = 0; S.u0.kind = 1 + kv; S.u0.a = (const char*)(ws + cfg::WS_CBP) + (size_t)(kv * 8 + bg) * 4096 * 64 * 2; S.u0.b = (const char*)(ws + cfg::WS_W1T) + (size_t)kv * 256 * 1024 * 2;
            pg8::Gemm g{nullptr, nullptr, 256, 256, 1024, 1024, 1024}; pg8::EpiP E{PP, (size_t)2048 * 256, biasL};
            pg8::gemm_phase<pg8::EpiP, OneOrder, false, true>(lds, g, S, E);
            asm volatile("s_waitcnt vmcnt(0)" ::: "memory"); __syncthreads();
            cmp_stage2_tile<bf16>(PP + ((size_t)kv * 2048 + bg * 256) * 256, 256, wave * 32, W2F + (size_t)kv * 8192, (bf16*)(ws + (kv ? cfg::WS_VCP : cfg::WS_KCP)) + (size_t)bg * 256 * 64, 255, lane);
        } else {
            const int gw2 = (blockIdx.x - 16) * NWAVES + wave, NGW2 = (G - 16) * NWAVES;
            for (int task = gw2; task < 2 * 64 * 32; task += NGW2) { const int kv = task >> 11, bg = (task >> 5) & 63, tl = task & 31;
                cmp_stage2_tile<float>((const bf16*)(ws + cfg::WS_PS) + ((size_t)kv * 65536 + bg * 1024) * 256, 1024, tl * 32, W2F + (size_t)kv * 8192, (float*)(ws + (kv ? cfg::WS_VCS : cfg::WS_KCS)) + (size_t)bg * 1024 * 64, 1023, lane); }
            for (int task = blockIdx.x - 16; task < 4 * 32 * 4; task += G - 16) cmx::unit(a, task >> 7, (task >> 2) & 31, task & 3, lds, tid);
        }
        for (int i = 512 + gw; i < 4 * 128 + cfg::DB; i += NGW) {
            const bool smp = i >= 512; const int row = smp ? cfg::MP + (i - 512) : (i >> 7) * 4096 + 3968 + (i & 127);
            float* dst = smp ? a.out + cfg::OFF_V_S + (size_t)(i - 512) * 512 : a.out + cfg::OFF_V_P + (size_t)i * 512;
            const float rs = rstd_v(SSV, row); float vn[8]; load8(VG + (size_t)row * 512 + lane * 8, vn);
#pragma unroll
            for (int j = 0; j < 8; ++j) vn[j] = vn[j] * rs * a.gmlp_norm[lane * 8 + j];
            *(v4f*)(dst + lane * 8) = (v4f){vn[0], vn[1], vn[2], vn[3]}; *(v4f*)(dst + lane * 8 + 4) = (v4f){vn[4], vn[5], vn[6], vn[7]};
            if (smp) { const int gi = lane >> 4; const float w00 = a.gmlp_ws[(size_t)gi * 128 * 128], bs = a.gmlp_bs[gi * 128]; float uu[8]; load8(Ub + (size_t)row * 512 + lane * 8, uu);
                v4u o; o.x = pk2(uu[0] * (w00 * vn[0] + bs), uu[1] * (w00 * vn[1] + bs)); o.y = pk2(uu[2] * (w00 * vn[2] + bs), uu[3] * (w00 * vn[3] + bs));
                o.z = pk2(uu[4] * (w00 * vn[4] + bs), uu[5] * (w00 * vn[5] + bs)); o.w = pk2(uu[6] * (w00 * vn[6] + bs), uu[7] * (w00 * vn[7] + bs));
                *(v4u*)(OC + (size_t)row * 1024 + 512 + lane * 8) = o; }
        }
    }
    }
    if (3 < a.ph_hi) xcd_barrier(bar);
    }

    #endif
#if (PHMASK >> 3) & 1
    if (a.ph_lo <= 3 && 3 < a.ph_hi) {
    for (int rep_ = 0; rep_ < (int)((REPMASK >> 3) & 1) + 1; ++rep_) {
    unsigned char* ws = a.ws; asm volatile("" : "+s"(ws)); int tid = threadIdx.x; asm volatile("" : "+v"(tid)); const int lane = tid & 63;
    {
        gu32* qctr = (gu32*)(ws + cfg::WS_CTL) + 8192 + 64 * rep_; volatile LAS int* qslot = (volatile LAS int*)(lds + cfg::MISC_OFF + 64);
        for (;;) {
            if (tid == 0) qslot[0] = (int)__hip_atomic_fetch_add(qctr, 1u, __ATOMIC_RELAXED, __HIP_MEMORY_SCOPE_AGENT);
            LDS_WAIT(); __syncthreads();
            const int item = qslot[0];
            __syncthreads();
            if (item >= 64 + 512) break;
            if (item < 64) dec::sample_unit(a, item >> 1, item & 1, lds, tid);
            else { const int idx = item - 64, bgi = idx & 7; att::prompt_unit(a, bgi >> 1, bgi & 1, 63 - (idx >> 3), lds, tid); }
        }
    }
    }
    if (4 < a.ph_hi) xcd_barrier(bar);
    }

    #endif
#if (PHMASK >> 4) & 1
    if (a.ph_lo <= 4 && 4 < a.ph_hi) {
    for (int rep_ = 0; rep_ < (int)((REPMASK >> 4) & 1) + 1; ++rep_) {
    unsigned char* ws = a.ws; asm volatile("" : "+s"(ws)); int tid = threadIdx.x; asm volatile("" : "+v"(tid)); const int lane = tid & 63;
    if (blockIdx.x < 16) {
        const int cbk = blockIdx.x, row = cfg::MP + (tid >> 4), col = 64 * cbk + 4 * (tid & 15);
        const v4f ya = thin::gemm<4>(OC + (size_t)cfg::MP * 1024, 1024, W_pa_t, 1024, cbk, lds, tid), yb = thin::gemm<4>(OC + (size_t)cfg::MP * 1024 + 512, 1024, W_pa_t + 512, 1024, cbk, lds, tid);
        const v2u ga = *(const v2u*)(GT + (size_t)row * 2048 + col), gb = *(const v2u*)(GT + (size_t)row * 2048 + 1024 + col);
        const v4f g0 = (v4f){__uint_as_float(ga.x << 16), __uint_as_float(ga.x & 0xffff0000u), __uint_as_float(ga.y << 16), __uint_as_float(ga.y & 0xffff0000u)};
        const v4f g1 = (v4f){__uint_as_float(gb.x << 16), __uint_as_float(gb.x & 0xffff0000u), __uint_as_float(gb.y << 16), __uint_as_float(gb.y & 0xffff0000u)};
        const v4f mx = g0 * ya + g1 * yb; v2u o; o.x = pg8::cvt_pk_bf16(mx.x, mx.y); o.y = pg8::cvt_pk_bf16(mx.z, mx.w); *(v2u*)(MIX + (size_t)row * 1024 + col) = o; }
    { PairOrder S; S.s1.init(cfg::MP, 1024, G, (int)blockIdx.x, OC, W_pa_t, 1024); pg8::Gemm g{OC, W_pa_t, cfg::MP, 1024, 512, 1024, 1024}; pg8::EpiMixAB E{GT, MIX};
      pg8::gemm_phase<pg8::EpiMixAB, PairOrder, true, true>(lds, g, S, E); }
    }
    if (5 < a.ph_hi) xcd_barrier(bar);
    }

    #endif
#if (PHMASK >> 5) & 1
    if (a.ph_lo <= 5 && 5 < a.ph_hi) {
    for (int rep_ = 0; rep_ < (int)((REPMASK >> 5) & 1) + 1; ++rep_) {
    unsigned char* ws = a.ws; asm volatile("" : "+s"(ws)); int tid = threadIdx.x; asm volatile("" : "+v"(tid)); const int lane = tid & 63;
    if (blockIdx.x < 16) {
        const int cbk = blockIdx.x, r = tid >> 4, row = cfg::MP + r, col = 64 * cbk + 4 * (tid & 15);
        const v4f y = thin::gemm<8>(MIX + (size_t)cfg::MP * 1024, 1024, W_out_t, 1024, cbk, lds, tid);
        const v4f x1 = *(const v4f*)(a.x_sample + (size_t)r * 1024 + col) + y; *(v4f*)(X1F + (size_t)row * 1024 + col) = x1;
        v2u o; o.x = pg8::cvt_pk_bf16(x1.x, x1.y); o.y = pg8::cvt_pk_bf16(x1.z, x1.w); *(v2u*)(X1B + (size_t)row * 1024 + col) = o;
        const float ss = thin::sum16((x1.x * x1.x + x1.y * x1.y) + (x1.z * x1.z + x1.w * x1.w)); if ((tid & 15) == 0) SS2[(size_t)row * 16 + cbk] = ss; }
    { pg8::Gemm g{MIX, W_out_t, cfg::MP, 1024, 1024, 1024, 1024}; pg8::StaticOrder S; S.init(cfg::MP, 1024, G, (int)blockIdx.x, MIX, W_out_t, 1024);
      pg8::EpiOut E{a.x_prompt, a.x_sample, X1F, X1B, SS2}; pg8::gemm_phase<pg8::EpiOut, pg8::StaticOrder, true, true>(lds, g, S, E); }
    }
    if (6 < a.ph_hi) xcd_barrier(bar);
    }

    #endif
#if (PHMASK >> 6) & 1
    if (a.ph_lo <= 6 && 6 < a.ph_hi) {
    for (int rep_ = 0; rep_ < (int)((REPMASK >> 6) & 1) + 1; ++rep_) {
    unsigned char* ws = a.ws; asm volatile("" : "+s"(ws)); int tid = threadIdx.x; asm volatile("" : "+v"(tid)); const int lane = tid & 63;
    { pg8::Gemm g{X1B, W_up_t, cfg::MPAD, cfg::UPN, 1024, 1024, 1024}; OrdOrder S; S.s1.init(cfg::MPAD, cfg::UPN, G, (int)blockIdx.x, X1B, W_up_t, 1024);
      LAS float* rsl = (LAS float*)(lds + cfg::BIAS_OFF); { pg8::Unit u; for (int ui = 0; ui < 14 && S.next(ui, u); ++ui) if (tid < 256) rsl[ui * 256 + tid] = rstd16(SS2, u.pm * 256 + tid); }
      LDS_WAIT(); __syncthreads();
      pg8::EpiUpConv E{rsl, ACT, a.out, a.conv_w, a.conv_b, a.state_conv, (float*)(ws + cfg::WS_AB), (float*)(ws + cfg::WS_AB + 4 * cfg::MiB)}; pg8::gemm_phase<pg8::EpiUpConv, OrdOrder, true, true>(lds, g, S, E); }
    }
    if (7 < a.ph_hi) xcd_barrier(bar);
    }

    #endif
#if (PHMASK >> 7) & 1
    if (a.ph_lo <= 7 && 7 < a.ph_hi) {
    for (int rep_ = 0; rep_ < (int)((REPMASK >> 7) & 1) + 1; ++rep_) {
    unsigned char* ws = a.ws; asm volatile("" : "+s"(ws)); int tid = threadIdx.x; asm volatile("" : "+v"(tid)); const int lane = tid & 63;
    }
    }

    #endif
#if (PHMASK >> 8) & 1
    if (a.ph_lo <= 8 && 8 < a.ph_hi) {
    for (int rep_ = 0; rep_ < (int)((REPMASK >> 8) & 1) + 1; ++rep_) {
    unsigned char* ws = a.ws; asm volatile("" : "+s"(ws)); int tid = threadIdx.x; asm volatile("" : "+v"(tid)); const int lane = tid & 63;
    if (blockIdx.x < 16) {
        const int cbk = blockIdx.x, r = tid >> 4, row = cfg::MP + r, col = 64 * cbk + 4 * (tid & 15);
        const v4f y = thin::gemm<22>(ACT + (size_t)cfg::MP * cfg::DFF, cfg::DFF, W_dn_t, cfg::DFF, cbk, lds, tid);
        const v4f x2 = *(const v4f*)(X1F + (size_t)row * 1024 + col) + y; *(v4f*)(a.out + (size_t)row * 1024 + col) = x2;
        const float ss = thin::sum16((x2.x * x2.x + x2.y * x2.y) + (x2.z * x2.z + x2.w * x2.w)); if ((tid & 15) == 0) SS3[(size_t)row * 16 + cbk] = ss; }
    { pg8::Gemm g{ACT, W_dn_t, cfg::MP, 1024, cfg::DFF, cfg::DFF, cfg::DFF}; pg8::StaticOrder S; S.init(cfg::MP, 1024, G, (int)blockIdx.x, ACT, W_dn_t, cfg::DFF);
      { const float* HALO = (const float*)(ws + cfg::WS_AB); const float* RAW = (const float*)(ws + cfg::WS_AB + 4 * cfg::MiB); pg8::Unit u;
        for (int ui = 0; S.next(ui, u); ++ui) { const int pm = u.pm;
            for (int i = tid; i < 4 * (cfg::DFF / 4); i += NWAVES * 64) { const int f = (i % (cfg::DFF / 4)) * 4, we = i / (cfg::DFF / 4), wh = we >> 1, e = we & 1;
                const float* rw = RAW + (size_t)((pm * 2 + wh) * 2) * 2 * cfg::DFF + f; const v4f a0 = *(const v4f*)rw, b0 = *(const v4f*)(rw + cfg::DFF), a1 = *(const v4f*)(rw + 2 * cfg::DFF), b1 = *(const v4f*)(rw + 3 * cfg::DFF);
                v4f h6 = (v4f){0.f, 0.f, 0.f, 0.f}, h7 = h6;
                if (wh == 1 || (pm & 15) != 0) { const float* hl = HALO + (size_t)(((wh ? pm : pm - 1) * 2 + (wh ? 0 : 1)) * 2) * cfg::DFF + f; h6 = *(const v4f*)hl; h7 = *(const v4f*)(hl + cfg::DFF); }
                const v4f w0 = *(const v4f*)(a.conv_w + f), w1 = *(const v4f*)(a.conv_w + cfg::DFF + f), w2 = *(const v4f*)(a.conv_w + 2 * cfg::DFF + f), cb = *(const v4f*)(a.conv_b + f);
                const v4f c = e ? cb + w0 * h7 + w1 * a0 + w2 * a1 : cb + w0 * h6 + w1 * h7 + w2 * a0, bb = e ? b1 : b0;
                v2u o; o.x = pg8::cvt_pk_bf16(gelu_tanh(c.x) * bb.x, gelu_tanh(c.y) * bb.y); o.y = pg8::cvt_pk_bf16(gelu_tanh(c.z) * bb.z, gelu_tanh(c.w) * bb.w);
                *(v2u*)(ACT + (size_t)(pm * 256 + 128 * wh + e) * cfg::DFF + f) = o; } }
        asm volatile("s_waitcnt vmcnt(0)" ::: "memory"); __syncthreads(); }
      pg8::EpiDown E{X1F, a.out, SS3}; pg8::gemm_phase<pg8::EpiDown, pg8::StaticOrder, true, true>(lds, g, S, E); }
    }
    if (9 < a.ph_hi) xcd_barrier(bar);
    }

    #endif
#if (PHMASK >> 9) & 1
    if (a.ph_lo <= 9 && 9 < a.ph_hi) {
    for (int rep_ = 0; rep_ < (int)((REPMASK >> 9) & 1) + 1; ++rep_) {
    unsigned char* ws = a.ws; asm volatile("" : "+s"(ws)); int tid = threadIdx.x; asm volatile("" : "+v"(tid)); const int lane = tid & 63;
#ifdef DUMP
    for (int m = gw; m < cfg::MROWS; m += NGW) { float* yr = a.out + (size_t)m * 1024;
        if (DUMP == 4) continue;
#pragma unroll
        for (int j = 0; j < 4; ++j) { const int c = j * 256 + lane * 4; v4f v;
            if (DUMP == 1) { v.x = bf2f(MIX[(size_t)m * 1024 + c]); v.y = bf2f(MIX[(size_t)m * 1024 + c + 1]); v.z = bf2f(MIX[(size_t)m * 1024 + c + 2]); v.w = bf2f(MIX[(size_t)m * 1024 + c + 3]); }
            else if (DUMP == 2) v = *(const v4f*)(X1F + (size_t)m * 1024 + c);
            else if (DUMP == 3) { v.x = bf2f(ACT[(size_t)m * 2816 + c]); v.y = bf2f(ACT[(size_t)m * 2816 + c + 1]); v.z = bf2f(ACT[(size_t)m * 2816 + c + 2]); v.w = bf2f(ACT[(size_t)m * 2816 + c + 3]); }
            else { v.x = bf2f(AB[(size_t)m * 5632 + c]); v.y = bf2f(AB[(size_t)m * 5632 + c + 1]); v.z = bf2f(AB[(size_t)m * 5632 + c + 2]); v.w = bf2f(AB[(size_t)m * 5632 + c + 3]); }
            *(v4f*)(yr + c) = v; } }
#else
    for (int m = gw; m < cfg::MROWS; m += NGW) { const float rs = rstd16(SS3, m); float* yr = a.out + (size_t)m * 1024;
#pragma unroll
        for (int j = 0; j < 4; ++j) { const v4f v = *(const v4f*)(yr + j * 256 + lane * 4), gn = *(const v4f*)(a.norm_final + j * 256 + lane * 4); *(v4f*)(yr + j * 256 + lane * 4) = v * rs * gn; } }
#endif
    }
    }
#endif
}

extern "C" void kernel_launch(void* const* d_in, const int* in_sizes, int n_in, void* d_out, int out_size, void* d_ws, size_t ws_size, hipStream_t stream) {
    static int grid = 0;
    if (grid == 0) {
        if (n_in != 25 || in_sizes[0] != cfg::MP * 1024 || (size_t)out_size != cfg::OUT_TOTAL || ws_size < cfg::WS_END) {
            fprintf(stderr, "kernel_launch: unexpected shapes (n_in %d, in0 %d, out %d, ws %zu); nothing launched\n", n_in, n_in > 0 ? in_sizes[0] : -1, out_size, ws_size); grid = -1; return; }
        int dev = 0, cus = 0, per_cu = 0;
        if (hipGetDevice(&dev) != hipSuccess || hipDeviceGetAttribute(&cus, hipDeviceAttributeMultiprocessorCount, dev) != hipSuccess) { grid = -1; return; }
        if (hipFuncSetAttribute((const void*)nsa_hybrid_fwd, hipFuncAttributeMaxDynamicSharedMemorySize, cfg::LDS_BYTES) != hipSuccess) { fprintf(stderr, "kernel_launch: hipFuncSetAttribute failed\n"); grid = -1; return; }
        if (hipOccupancyMaxActiveBlocksPerMultiprocessor(&per_cu, (const void*)nsa_hybrid_fwd, NWAVES * 64, cfg::LDS_BYTES) != hipSuccess || per_cu < 1)
            fprintf(stderr, "kernel_launch: note: occupancy query reports %d workgroups per CU\n", per_cu);
        (void)hipGetLastError();
        grid = cus;
    }
    if (grid < 0) return;
    if (hipMemsetAsync((char*)d_ws + cfg::WS_CTL, 0, cfg::CTL_ZERO_BYTES, stream) != hipSuccess) return;
    Args a{};
    a.x_prompt = (const float*)d_in[0]; a.x_sample = (const float*)d_in[1]; a.cache_cmp = (const float*)d_in[2]; a.cache_slc = (const float*)d_in[3]; a.cache_win = (const float*)d_in[4];
    a.state_conv = (const float*)d_in[5]; a.page_table = (const int*)d_in[6]; a.norm_mix = (const float*)d_in[7]; a.w_in = (const float*)d_in[8]; a.cmp_pe = (const float*)d_in[9];
    a.cmp_w1 = (const float*)d_in[10]; a.cmp_b1 = (const float*)d_in[11]; a.cmp_w2 = (const float*)d_in[12]; a.gmlp_norm = (const float*)d_in[13]; a.gmlp_ws = (const float*)d_in[14];
    a.gmlp_bs = (const float*)d_in[15]; a.w_proj_a = (const float*)d_in[16]; a.w_proj_b = (const float*)d_in[17]; a.w_out = (const float*)d_in[18]; a.norm_ffn = (const float*)d_in[19];
    a.w_up = (const float*)d_in[20]; a.conv_w = (const float*)d_in[21]; a.conv_b = (const float*)d_in[22]; a.w_down = (const float*)d_in[23]; a.norm_final = (const float*)d_in[24];
    a.out = (float*)d_out; a.ws = (unsigned char*)d_ws;
    for (int li = 0; li < MK_N_LAUNCHES; ++li) {
        a.ph_lo = (MK_N_LAUNCHES == 1) ? 0 : li; a.ph_hi = (MK_N_LAUNCHES == 1) ? 10 : li + 1;
        hipLaunchKernelGGL(nsa_hybrid_fwd, dim3(grid), dim3(NWAVES * 64), cfg::LDS_BYTES, stream, a);
        const hipError_t le = hipPeekAtLastError();
        if (le != hipSuccess) { fprintf(stderr, "kernel_launch: launch failed: %s\n", hipGetErrorName(le)); break; }
    }
}
```

```cpp
#include <hip/hip_runtime.h>
#include <cstdio>
#include <cstdint>

namespace cfg {
constexpr int DM = 1024, BATCH = 4, SEQ = 4096, MP = BATCH * SEQ, DB = 32, MROWS = MP + DB, MPAD = 16640;
constexpr int PAST = 16384, PAGE = 128, NPAGES = PAST / PAGE;
constexpr int NH = 8, HD = 64, NKV = 2;
constexpr int INC = 4376, INP = 4608;
constexpr int GW = 512, DFF = 2816, UPN = 2 * DFF;
constexpr float EPS = 1e-6f, NEGF = -1e30f, L2E = 1.4426950408889634f;
constexpr size_t OFF_YP = 0, OFF_YS = 16777216, OFF_CMP_P = 16809984, OFF_SLC_P = 21004288, OFF_WIN_P = 25198592, OFF_V_P = 25722880, OFF_CONV_P = 25985024,
                 OFF_CMP_S = 26007552, OFF_SLC_S = 26015744, OFF_WIN_S = 26023936, OFF_V_S = 30218240, OFF_CONV_S = 30234624, OUT_TOTAL = 30414848;
constexpr size_t MiB = 1u << 20;
constexpr size_t WS_CTL = 0, CTL_ZERO_BYTES = 1 * MiB;
constexpr size_t WS_WIN_T = 2 * MiB, WS_WPA_T = 12 * MiB, WS_WPB_T = 13 * MiB, WS_WOUT_T = 14 * MiB, WS_WUP_T = 16 * MiB, WS_WDN_T = 28 * MiB;
constexpr size_t WS_RSTD1 = 34 * MiB, WS_SSV = 35 * MiB, WS_SS2 = 36 * MiB, WS_SS3 = 38 * MiB, WS_NSAG = 40 * MiB, WS_KCP = 43 * MiB, WS_VCP = 44 * MiB;
constexpr size_t WS_KCS = 48 * MiB, WS_VCS = 64 * MiB;
constexpr size_t WS_XB = 80 * MiB, WS_Q = 113 * MiB, WS_KVB = 130 * MiB, WS_U = 155 * MiB, WS_VG = 172 * MiB, WS_GT = 189 * MiB, WS_ONSA = 254 * MiB, WS_CM = 271 * MiB;
constexpr size_t WS_T = 288 * MiB, WS_MIX = 353 * MiB, WS_X1F = 386 * MiB, WS_X1B = 451 * MiB, WS_AB = 484 * MiB, WS_ACT = 663 * MiB;
constexpr size_t WS_W1T = 45 * MiB, WS_W2F = 46 * MiB, WS_PB = 46 * MiB + 512 * 1024, WS_WTRIL = 47 * MiB;
constexpr size_t WS_CB = 753 * MiB, WS_CBP = 1009 * MiB, WS_PS = 1017 * MiB, WS_PP = 1081 * MiB, WS_END = 1083 * MiB;
constexpr int CW_BAR = 4096;
constexpr int RING_BYTES = 131072, LDSCTL_OFF = RING_BYTES, MISC_OFF = LDSCTL_OFF + 320, BIAS_OFF = LDSCTL_OFF + 1024, LDS_BYTES = 147456;
}

#define GAS __attribute__((address_space(1)))
#define LAS __attribute__((address_space(3)))
#define DI __device__ __forceinline__
typedef unsigned short bf16;
typedef GAS unsigned gu32;
typedef unsigned v4u __attribute__((ext_vector_type(4)));
typedef unsigned v2u __attribute__((ext_vector_type(2)));
typedef float v4f __attribute__((ext_vector_type(4)));

struct Args {
    const float* x_prompt; const float* x_sample; const float* cache_cmp; const float* cache_slc; const float* cache_win; const float* state_conv;
    const int* page_table; const float* norm_mix; const float* w_in; const float* cmp_pe; const float* cmp_w1; const float* cmp_b1; const float* cmp_w2;
    const float* gmlp_norm; const float* gmlp_ws; const float* gmlp_bs; const float* w_proj_a; const float* w_proj_b; const float* w_out; const float* norm_ffn;
    const float* w_up; const float* conv_w; const float* conv_b; const float* w_down; const float* norm_final;
    float* out; unsigned char* ws;
    int ph_lo, ph_hi;
};

DI float bf2f(bf16 b) { return __uint_as_float(((unsigned)b) << 16); }
DI unsigned f2bf(float f) { unsigned u = __float_as_uint(f); return (u + 0x7fffu + ((u >> 16) & 1u)) >> 16; }
DI unsigned pk2(float lo, float hi) { return f2bf(lo) | (f2bf(hi) << 16); }
DI float fast_sigmoid(float x) { return __builtin_amdgcn_rcpf(1.0f + __builtin_amdgcn_exp2f(-1.4426950408889634f * x)); }
DI float gelu_tanh(float x) { const float u = x * (1.0f + 0.044715f * x * x); return x * __builtin_amdgcn_rcpf(1.0f + __builtin_amdgcn_exp2f(-2.302208198f * u)); }
DI float wave_sum(float v) {
#pragma unroll
    for (int o = 1; o < 64; o <<= 1) v += __shfl_xor(v, o);
    return v;
}
DI float wave_max(float v) {
#pragma unroll
    for (int o = 1; o < 64; o <<= 1) v = fmaxf(v, __shfl_xor(v, o));
    return v;
}
namespace pg8 {
#define PG8_LAS __attribute__((address_space(3)))
typedef unsigned short bf16_t;
typedef short bf16x8 __attribute__((ext_vector_type(8)));
typedef float f32x4 __attribute__((ext_vector_type(4)));
typedef unsigned u32x4 __attribute__((ext_vector_type(4)));
constexpr int BM = 256, BK = 64, HALF = 128, HTB = HALF * BK * 2  , STAGE_BYTES = 8 * HTB, NXCD = 8, WGM = 8;

__host__ __device__ __forceinline__ int lds_byte(int r, int c) { const int st = (r >> 4) * 2 + (c >> 5), rr = r & 15, cc = c & 31, ob = rr * 64 + cc * 2; return st * 1024 + (ob ^ (((ob >> 9) & 1) << 5)); }
__host__ __device__ __forceinline__ void stage_rc(int b, int& R, int& C) { const int st = b / 1024, sb = b % 1024, swz = sb ^ (((sb >> 9) & 1) << 5); R = (st >> 1) * 16 + swz / 64; C = (st & 1) * 32 + (swz % 64) / 2; }
__host__ __device__ __forceinline__ int perm32(int rho) { const int n = rho >> 4, i = rho & 15; return 8 * (i >> 2) + 4 * n + (i & 3); }

struct Unit { int pm, pn, kind; const char* a; const char* b; };
struct Gemm { const bf16_t* A; const bf16_t* Bt; int M, N, K, lda, ldb; };

struct StaticOrder {
    int nM, nN, nwg, G, c; const char* A; const char* Bt; size_t tstep;
    __host__ __device__ __forceinline__ void init(int M, int N, int G_, int c_, const void* A_ = nullptr, const void* Bt_ = nullptr, int K_ = 0) { nM = M / BM; nN = N / BM; nwg = nM * nN; G = G_; c = c_; A = (const char*)A_; Bt = (const char*)Bt_; tstep = (size_t)BM * K_ * 2; }
    __host__ __device__ __forceinline__ bool next(int i, Unit& u) const {
        const long L = (long)i * G + c; if (L >= nwg) return false;
        return unit_of((int)L, u);
    }
    __host__ __device__ __forceinline__ bool unit_of(int L, Unit& u) const {
        int wgid = L; { const int q = nwg / NXCD, r = nwg % NXCD, xcd = wgid % NXCD, off = wgid / NXCD; wgid = (xcd < r ? xcd * (q + 1) : r * (q + 1) + (xcd - r) * q) + off; }
        const int nig = WGM * nN, gid = wgid / nig, fm = gid * WGM, gsz = (nM - fm) < WGM ? (nM - fm) : WGM;
        u.pm = fm + ((wgid % nig) % gsz); u.pn = (wgid % nig) / gsz; u.kind = 0; u.a = A + (size_t)u.pm * tstep; u.b = Bt + (size_t)u.pn * tstep; return true;
    }
    __device__ __forceinline__ void a_ready(const Unit&) const {}
    __device__ __forceinline__ void done(const Unit&) const {}
};

typedef float f32x2c_t __attribute__((ext_vector_type(2))); typedef __bf16 bf16x2c_t __attribute__((ext_vector_type(2)));
__device__ __forceinline__ unsigned cvt_pk_bf16(float lo, float hi) { f32x2c_t v = {lo, hi}; bf16x2c_t b = __builtin_convertvector(v, bf16x2c_t); return __builtin_bit_cast(unsigned, b); }
typedef unsigned u32x2 __attribute__((ext_vector_type(2)));
__device__ __forceinline__ u32x4 pack8(const f32x4& v0, const f32x4& v1) { u32x4 w; w.x = cvt_pk_bf16(v0[0], v0[1]); w.y = cvt_pk_bf16(v0[2], v0[3]); w.z = cvt_pk_bf16(v1[0], v1[1]); w.w = cvt_pk_bf16(v1[2], v1[3]); return w; }
__device__ __forceinline__ f32x4 sig4(const f32x4& v) { return (f32x4){fast_sigmoid(v[0]), fast_sigmoid(v[1]), fast_sigmoid(v[2]), fast_sigmoid(v[3])}; }
__device__ __forceinline__ f32x4 gelu4(const f32x4& v) { return (f32x4){gelu_tanh(v[0]), gelu_tanh(v[1]), gelu_tanh(v[2]), gelu_tanh(v[3])}; }
__device__ __forceinline__ float sq4(const f32x4& v) { return (v[0] * v[0] + v[1] * v[1]) + (v[2] * v[2] + v[3] * v[3]); }

struct EpiIn {
    static constexpr bool PERM = true, AFTER_DRAIN = false, KEEP = false, APERM = false;
    const float* rstd; bf16_t* Q; bf16_t* KVB; bf16_t* U; bf16_t* VG; float* SSV; bf16_t* GT; float* NSAG; float* out; bf16_t* CBP;
    __device__ __forceinline__ void operator()(const f32x4 (&acc)[2][2][4][2], const Unit& u, int wr, int wc, int fr, int fq) const {
        const int row0 = u.pm * BM + wr * 64 + fr, cl0 = wc * 32 + 8 * fq, pn = u.pn;
#pragma unroll
        for (int ai = 0; ai < 2; ++ai)
#pragma unroll
            for (int m = 0; m < 4; ++m) {
                const int row = row0 + ai * HALF + m * 16; const float rs = rstd[row];
                if (pn < 2) {
                    const float s = rs * 0.125f;
#pragma unroll
                    for (int bj = 0; bj < 2; ++bj) *(u32x4*)(Q + (size_t)row * 512 + pn * 256 + bj * HALF + cl0) = pack8(acc[ai][bj][m][0] * s, acc[ai][bj][m][1] * s);
                } else if (pn < 5) {
                    float* dst = nullptr;
                    if (pn == 2) dst = row < cfg::MP ? out + cfg::OFF_CMP_P + (size_t)row * 256 : (row < cfg::MROWS ? out + cfg::OFF_CMP_S + (size_t)(row - cfg::MP) * 256 : nullptr);
                    else if (pn == 3) dst = row < cfg::MP ? out + cfg::OFF_SLC_P + (size_t)row * 256 : (row < cfg::MROWS ? out + cfg::OFF_SLC_S + (size_t)(row - cfg::MP) * 256 : nullptr);
                    else { if (row < cfg::MP) { const int t = row & 4095, b = row >> 12; if (t >= 3584) dst = out + cfg::OFF_WIN_P + (size_t)(b * 512 + (t - 3584)) * 256; }
                           else if (row < cfg::MROWS) dst = out + cfg::OFF_WIN_S + ((size_t)(row - cfg::MP) * 512 + 511) * 256; }
#pragma unroll
                    for (int bj = 0; bj < 2; ++bj) { const f32x4 v0 = acc[ai][bj][m][0] * rs, v1 = acc[ai][bj][m][1] * rs; const int cl = bj * HALF + cl0;
                        const u32x4 pk = pack8(v0, v1); *(u32x4*)(KVB + (size_t)row * 768 + (pn - 2) * 256 + cl) = pk;
                        if (pn == 2 && row < cfg::MP) *(u32x4*)(CBP + ((size_t)((bj * 4 + (row >> 12)) * 2 + (cl0 >> 6)) * 4096 + (row & 4095)) * 64 + (cl0 & 63)) = pk;
                        if (dst) { *(f32x4*)(dst + cl) = v0; *(f32x4*)(dst + cl + 4) = v1; } }
                } else if (pn < 7) {
#pragma unroll
                    for (int bj = 0; bj < 2; ++bj) *(u32x4*)(U + (size_t)row * 512 + (pn - 5) * 256 + bj * HALF + cl0) = pack8(gelu4(acc[ai][bj][m][0] * rs), gelu4(acc[ai][bj][m][1] * rs));
                } else if (pn < 9) {
                    float ss = 0.f;
#pragma unroll
                    for (int bj = 0; bj < 2; ++bj) { const f32x4 v0 = gelu4(acc[ai][bj][m][0] * rs), v1 = gelu4(acc[ai][bj][m][1] * rs); ss += sq4(v0) + sq4(v1);
                        *(u32x4*)(VG + (size_t)row * 512 + (pn - 7) * 256 + bj * HALF + cl0) = pack8(v0, v1); }
                    ss += __shfl_xor(ss, 16); ss += __shfl_xor(ss, 32);
                    if (fq == 0) SSV[(size_t)row * 8 + (pn - 7) * 4 + wc] = ss;
                } else if (pn < 17) {
#pragma unroll
                    for (int bj = 0; bj < 2; ++bj) *(u32x4*)(GT + (size_t)row * 2048 + (pn - 9) * 256 + bj * HALF + cl0) = pack8(sig4(acc[ai][bj][m][0] * rs), sig4(acc[ai][bj][m][1] * rs));
                } else {
                    if (wc == 0 && fq < 3) { float* d = NSAG + (size_t)row * 32 + 8 * fq; *(f32x4*)d = sig4(acc[ai][0][m][0] * rs); *(f32x4*)(d + 4) = sig4(acc[ai][0][m][1] * rs); }
                }
            }
    }
};
struct EpiP {
    static constexpr bool PERM = true, AFTER_DRAIN = false, KEEP = false, APERM = false;
    bf16_t* P; size_t kv_stride; const PG8_LAS float* biasL;
    __device__ __forceinline__ void operator()(const f32x4 (&acc)[2][2][4][2], const Unit& u, int wr, int wc, int fr, int fq) const {
        const int kv = u.kind - 1, row0 = u.pm * BM + wr * 64 + fr, cl0 = wc * 32 + 8 * fq;
        const f32x4 b0 = *(const PG8_LAS f32x4*)(biasL + kv * 128 + cl0), b1 = *(const PG8_LAS f32x4*)(biasL + kv * 128 + cl0 + 4);
        bf16_t* Pk = P + (size_t)kv * kv_stride;
#pragma unroll
        for (int ai = 0; ai < 2; ++ai)
#pragma unroll
            for (int m = 0; m < 4; ++m) { bf16_t* pr = Pk + (size_t)(row0 + ai * HALF + m * 16) * 256 + cl0;
                *(u32x4*)pr = pack8(acc[ai][0][m][0] + b0, acc[ai][0][m][1] + b1); *(u32x4*)(pr + HALF) = pack8(acc[ai][1][m][0], acc[ai][1][m][1]); }
    }
};
struct EpiMix {
    static constexpr bool PERM = true, AFTER_DRAIN = false, KEEP = false, APERM = false;
    EpiIn in; EpiP p;
    __device__ __forceinline__ void operator()(const f32x4 (&acc)[2][2][4][2], const Unit& u, int wr, int wc, int fr, int fq) const { if (u.kind == 0) in(acc, u, wr, wc, fr, fq); else p(acc, u, wr, wc, fr, fq); }
};
__device__ __forceinline__ void unpack8(const u32x4& g, f32x4& lo, f32x4& hi) {
    lo = (f32x4){__uint_as_float(g.x << 16), __uint_as_float(g.x & 0xffff0000u), __uint_as_float(g.y << 16), __uint_as_float(g.y & 0xffff0000u)};
    hi = (f32x4){__uint_as_float(g.z << 16), __uint_as_float(g.z & 0xffff0000u), __uint_as_float(g.w << 16), __uint_as_float(g.w & 0xffff0000u)};
}
struct EpiMixAB {
    static constexpr bool PERM = true, AFTER_DRAIN = false, KEEP = true, APERM = false;
    const bf16_t* GT; bf16_t* MIX;
    __device__ __forceinline__ bool keep(const Unit& u) const { return u.kind == 0; }
    __device__ __forceinline__ void operator()(f32x4 (&acc)[2][2][4][2], const Unit& u, int wr, int wc, int fr, int fq) const {
        const int row0 = u.pm * BM + wr * 64 + fr, col0 = u.pn * BM + wc * 32 + 8 * fq;
        if (u.kind == 0) {
#pragma unroll
            for (int ai = 0; ai < 2; ++ai)
#pragma unroll
                for (int m = 0; m < 4; ++m) { const bf16_t* gp = GT + (size_t)(row0 + ai * HALF + m * 16) * 2048 + col0;
#pragma unroll
                    for (int bj = 0; bj < 2; ++bj) { f32x4 a0, a1, b0, b1; unpack8(*(const u32x4*)(gp + bj * HALF), a0, a1); unpack8(*(const u32x4*)(gp + 1024 + bj * HALF), b0, b1);
#pragma unroll
                        for (int i = 0; i < 4; ++i) { acc[ai][bj][m][0][i] *= a0[i] * __builtin_amdgcn_rcpf(b0[i]); acc[ai][bj][m][1][i] *= a1[i] * __builtin_amdgcn_rcpf(b1[i]); } } }
        } else {
#pragma unroll
            for (int ai = 0; ai < 2; ++ai)
#pragma unroll
                for (int m = 0; m < 4; ++m) { const int row = row0 + ai * HALF + m * 16;
#pragma unroll
                    for (int bj = 0; bj < 2; ++bj) { const int col = col0 + bj * HALF; f32x4 b0, b1; unpack8(*(const u32x4*)(GT + (size_t)row * 2048 + 1024 + col), b0, b1);
                        *(u32x4*)(MIX + (size_t)row * 1024 + col) = pack8(acc[ai][bj][m][0] * b0, acc[ai][bj][m][1] * b1); } }
        }
    }
};
struct EpiOut {
    static constexpr bool PERM = true, AFTER_DRAIN = false, KEEP = false, APERM = false;
    const float* xp; const float* xs; float* X1F; bf16_t* X1B; float* SS2;
    __device__ __forceinline__ void operator()(const f32x4 (&acc)[2][2][4][2], const Unit& u, int wr, int wc, int fr, int fq) const {
        const int row0 = u.pm * BM + wr * 64 + fr, col0 = u.pn * BM + wc * 32 + 8 * fq;
#pragma unroll
        for (int ai = 0; ai < 2; ++ai)
#pragma unroll
            for (int m = 0; m < 4; ++m) { const int row = row0 + ai * HALF + m * 16;
                const float* xr = row < cfg::MP ? xp + (size_t)row * 1024 : (row < cfg::MROWS ? xs + (size_t)(row - cfg::MP) * 1024 : nullptr);
                float ss = 0.f;
#pragma unroll
                for (int bj = 0; bj < 2; ++bj) { const int col = col0 + bj * HALF;
                    f32x4 x0 = (f32x4){0.f, 0.f, 0.f, 0.f}, x1 = x0; if (xr) { x0 = *(const f32x4*)(xr + col); x1 = *(const f32x4*)(xr + col + 4); }
                    x0 = x0 + acc[ai][bj][m][0]; x1 = x1 + acc[ai][bj][m][1]; ss += sq4(x0) + sq4(x1);
                    float* d = X1F + (size_t)row * 1024 + col; *(f32x4*)d = x0; *(f32x4*)(d + 4) = x1;
                    *(u32x4*)(X1B + (size_t)row * 1024 + col) = pack8(x0, x1); }
                ss += __shfl_xor(ss, 16); ss += __shfl_xor(ss, 32);
                if (fq == 0) SS2[(size_t)row * 16 + u.pn * 4 + wc] = ss; }
    }
};
__device__ __forceinline__ float dpp_shr1(float v) { return __int_as_float(__builtin_amdgcn_update_dpp(0, __float_as_int(v), 0x111, 0xf, 0xf, true)); }
struct EpiUpConv {
    static constexpr bool PERM = true, AFTER_DRAIN = false, KEEP = false, APERM = true;
    const PG8_LAS float* rsl; bf16_t* ACT; float* out; const float* conv_w; const float* conv_b; const float* state_conv; float* HALO; float* RAW;
    __device__ __forceinline__ void operator()(const f32x4 (&acc)[2][2][4][2], const Unit& u, int wr, int wc, int fr, int fq) const {
        const int pm = u.pm, f0 = u.pn * 128 + wc * 32 + 8 * fq, tok0 = 128 * wr + 8 * fr, row0 = pm * BM + tok0;
        const f32x4 rsa = *(const PG8_LAS f32x4*)(rsl + u.kind * 256 + tok0), rsb = *(const PG8_LAS f32x4*)(rsl + u.kind * 256 + tok0 + 4);
        const float rs[8] = {rsa[0], rsa[1], rsa[2], rsa[3], rsb[0], rsb[1], rsb[2], rsb[3]};
#pragma unroll
        for (int n = 0; n < 2; ++n) { const int f = f0 + 4 * n;
            const f32x4 w0 = *(const f32x4*)(conv_w + f), w1 = *(const f32x4*)(conv_w + cfg::DFF + f), w2 = *(const f32x4*)(conv_w + 2 * cfg::DFF + f), cb = *(const f32x4*)(conv_b + f);
            if (pm < 64) {
                const f32x4 a7 = acc[1][0][3][n] * rs[7], a6 = acc[1][0][2][n] * rs[6]; f32x4 am1, am2;
#pragma unroll
                for (int i = 0; i < 4; ++i) { am1[i] = dpp_shr1(a7[i]); am2[i] = dpp_shr1(a6[i]); }
#pragma unroll
                for (int e = 0; e < 8; ++e) { const f32x4 ae = acc[e >> 2][0][e & 3][n] * rs[e], be = acc[e >> 2][1][e & 3][n] * rs[e];
                    const f32x4 act = gelu4(cb + w0 * am2 + w1 * am1 + w2 * ae) * be;
                    if (!(fr == 0 && e < 2)) { u32x2 o; o.x = cvt_pk_bf16(act[0], act[1]); o.y = cvt_pk_bf16(act[2], act[3]); *(u32x2*)(ACT + (size_t)(row0 + e) * cfg::DFF + f) = o; }
                    if (e < 2 && fr == 0) { int fz = f; asm volatile("" : "+v"(fz));
                        float* rw = RAW + (size_t)(((pm * 2 + wr) * 2 + e) * 2) * cfg::DFF + fz; *(f32x4*)rw = ae; *(f32x4*)(rw + cfg::DFF) = be; }
                    if (e >= 6 && fr == 15) { int fz = f; asm volatile("" : "+v"(fz)); *(f32x4*)(HALO + (size_t)((pm * 2 + wr) * 2 + (e - 6)) * cfg::DFF + fz) = ae;
                        if ((pm & 15) == 15 && wr == 1) *(f32x4*)(out + cfg::OFF_CONV_P + (size_t)((pm >> 4) * 2 + (e - 6)) * cfg::DFF + fz) = ae; }
                    am2 = am1; am1 = ae; }
            } else if (tok0 < cfg::DB) {
#pragma unroll
                for (int e = 0; e < 8; ++e) { const int bs = tok0 + e; const float* sp = state_conv + (size_t)bs * 2 * cfg::DFF + f; const f32x4 s0 = *(const f32x4*)sp, s1 = *(const f32x4*)(sp + cfg::DFF);
                    const f32x4 ae = acc[e >> 2][0][e & 3][n] * rs[e], be = acc[e >> 2][1][e & 3][n] * rs[e];
                    const f32x4 act = gelu4(cb + w0 * s0 + w1 * s1 + w2 * ae) * be;
                    u32x2 o; o.x = cvt_pk_bf16(act[0], act[1]); o.y = cvt_pk_bf16(act[2], act[3]); *(u32x2*)(ACT + (size_t)(row0 + e) * cfg::DFF + f) = o;
                    *(f32x4*)(out + cfg::OFF_CONV_S + ((size_t)bs * 2 + 1) * cfg::DFF + f) = ae; }
            }
        }
    }
};
struct EpiDown {
    static constexpr bool PERM = true, AFTER_DRAIN = false, KEEP = false, APERM = false;
    const float* X1F; float* out; float* SS3;
    __device__ __forceinline__ void operator()(const f32x4 (&acc)[2][2][4][2], const Unit& u, int wr, int wc, int fr, int fq) const {
        const int row0 = u.pm * BM + wr * 64 + fr, col0 = u.pn * BM + wc * 32 + 8 * fq;
#pragma unroll
        for (int ai = 0; ai < 2; ++ai)
#pragma unroll
            for (int m = 0; m < 4; ++m) { const int row = row0 + ai * HALF + m * 16; float ss = 0.f;
#pragma unroll
                for (int bj = 0; bj < 2; ++bj) { const int col = col0 + bj * HALF; const float* xr = X1F + (size_t)row * 1024 + col;
                    const f32x4 x0 = *(const f32x4*)xr + acc[ai][bj][m][0], x1 = *(const f32x4*)(xr + 4) + acc[ai][bj][m][1]; ss += sq4(x0) + sq4(x1);
                    if (row < cfg::MROWS) { float* d = out + (size_t)row * 1024 + col; *(f32x4*)d = x0; *(f32x4*)(d + 4) = x1; } }
                ss += __shfl_xor(ss, 16); ss += __shfl_xor(ss, 32);
                if (fq == 0) SS3[(size_t)row * 16 + u.pn * 4 + wc] = ss; }
    }
};
template <class Epi, class Sched, bool ALIGN_EPI = false, bool SP2 = false>
__device__ __forceinline__ void gemm_phase(PG8_LAS unsigned char* lds, const Gemm g, const Sched& S, const Epi& E, int wave_id) {
    int lane_v; asm volatile("v_mbcnt_lo_u32_b32 %0, -1, 0\n\tv_mbcnt_hi_u32_b32 %0, -1, %0" : "=v"(lane_v));
    const int wid = wave_id, lane = lane_v, tid = wid * 64 + lane,     wr = wid >> 2, wc = wid & 3, fr = lane & 15, fq = lane >> 4;
    const int K = g.K, nt = K / BK;
    unsigned voffA[2], voffB[2];
#pragma unroll
    for (int i = 0; i < 2; ++i) { int R, C; stage_rc(tid * 16 + i * 8192, R, C); const int Rb = Epi::PERM ? ((R & ~31) + perm32(R & 31)) : R;
        const int Ra = Epi::APERM ? (128 * (R >> 6) + 8 * (R & 15) + ((R >> 4) & 3)) : R;
        voffA[i] = (unsigned)(Ra * g.lda + C) * 2u; voffB[i] = (unsigned)(Rb * g.ldb + C) * 2u; }
    const size_t kstep = (size_t)(BK * 2);
    const size_t hstepA = (size_t)(Epi::APERM ? 4 : HALF) * g.lda * 2, hstepB = (size_t)HALF * g.ldb * 2;
    const unsigned ldsw = (unsigned)wid * 1024u;
    const int aoff = lds_byte(wr * 64 + fr, fq * 8), boff = lds_byte(wc * 32 + fr, fq * 8);
#define PG8_SA(b, h) (((b) * 2 + (h)) * HTB)
#define PG8_SB(b, h) ((4 + (b) * 2 + (h)) * HTB)
#define PG8_STAGE(bufoff, gbase, voff) do { _Pragma("unroll") for (int _i = 0; _i < 2; ++_i) \
        __builtin_amdgcn_global_load_lds((const unsigned*)((const char*)(gbase) + (voff)[_i]), (PG8_LAS unsigned*)(lds + (bufoff) + ldsw + _i * 8192), 16, 0, 0); } while (0)
#define PG8_LDA(dst, b, h) do { _Pragma("unroll") for (int m = 0; m < 4; ++m) _Pragma("unroll") for (int k = 0; k < 2; ++k) dst[m][k] = *(const PG8_LAS bf16x8*)(lds + PG8_SA(b, h) + aoff + m * 2048 + k * 1024); } while (0)
#define PG8_LDB(dst, b, h) do { _Pragma("unroll") for (int n = 0; n < 2; ++n) _Pragma("unroll") for (int k = 0; k < 2; ++k) dst[n][k] = *(const PG8_LAS bf16x8*)(lds + PG8_SB(b, h) + boff + n * 2048 + k * 1024); } while (0)
#define PG8_MMA(ai, bj, At, Bt) do { __builtin_amdgcn_s_setprio(1); _Pragma("unroll") for (int m = 0; m < 4; ++m) _Pragma("unroll") for (int n = 0; n < 2; ++n) _Pragma("unroll") for (int k = 0; k < 2; ++k) \
        acc[ai][bj][m][n] = __builtin_amdgcn_mfma_f32_16x16x32_bf16(Bt[n][k], At[m][k], acc[ai][bj][m][n], 0, 0, 0); __builtin_amdgcn_s_setprio(0); } while (0)
#define PG8_WAIT_V(n) asm volatile("s_waitcnt vmcnt(" #n ")" ::: "memory")
#define PG8_WAIT_L(n) asm volatile("s_waitcnt lgkmcnt(" #n ")" ::: "memory")
#define PG8_BAR __builtin_amdgcn_s_barrier()
#define PG8_SCHED __builtin_amdgcn_sched_barrier(0)
    Unit cur, nxt; int ui = 0;
    if (!S.next(0, cur)) return;
    f32x4 acc[2][2][4][2];
#pragma unroll
    for (int a = 0; a < 2; ++a)
#pragma unroll
        for (int b = 0; b < 2; ++b)
#pragma unroll
            for (int m = 0; m < 4; ++m)
#pragma unroll
                for (int n = 0; n < 2; ++n) acc[a][b][m][n] = (f32x4){0.f, 0.f, 0.f, 0.f};
    bf16x8 At[4][2], B0[2][2], B1[2][2];
    const char* cA = cur.a; const char* cB = cur.b;
    S.a_ready(cur);
    if constexpr (SP2) {
        PG8_STAGE(PG8_SB(0, 0), cB, voffB); PG8_STAGE(PG8_SB(0, 1), cB + hstepB, voffB); PG8_STAGE(PG8_SA(0, 0), cA, voffA); PG8_STAGE(PG8_SA(0, 1), cA + hstepA, voffA);
        if (wr == 1) PG8_BAR;
        PG8_WAIT_V(2); PG8_BAR;
        PG8_STAGE(PG8_SB(1, 0), cB + kstep, voffB); PG8_STAGE(PG8_SA(1, 0), cA + kstep, voffA); PG8_STAGE(PG8_SB(1, 1), cB + hstepB + kstep, voffB);
        PG8_WAIT_V(6); PG8_BAR;
    } else {
        PG8_STAGE(PG8_SB(0, 0), cB, voffB); PG8_STAGE(PG8_SA(0, 0), cA, voffA); PG8_STAGE(PG8_SB(0, 1), cB + hstepB, voffB); PG8_STAGE(PG8_SA(0, 1), cA + hstepA, voffA);
        if (wr == 1) PG8_BAR;
        PG8_WAIT_V(4); PG8_BAR;
        PG8_STAGE(PG8_SB(1, 0), cB + kstep, voffB); PG8_STAGE(PG8_SA(1, 0), cA + kstep, voffA); PG8_STAGE(PG8_SB(1, 1), cB + hstepB + kstep, voffB);
        PG8_WAIT_V(6); PG8_BAR;
    }
    for (;;) {
        const bool has_next = S.next(ui + 1, nxt);
        const char* nA = has_next ? nxt.a : cA; const char* nB = has_next ? nxt.b : cB;
        for (int t = 0; t < nt; t += 2) {
            const bool last = (t == nt - 2);
            const char* a1 = cA + (size_t)(t + 1) * kstep;
            const char* a2 = last ? nA : cA + (size_t)(t + 2) * kstep; const char* b2 = last ? nB : cB + (size_t)(t + 2) * kstep;
            const char* a3 = a2 + kstep; const char* b3 = b2 + kstep;
            if (last && has_next) S.a_ready(nxt);
            if constexpr (SP2) {
            PG8_LDB(B0, 0, 0); PG8_LDB(B1, 0, 1); PG8_SCHED; PG8_LDA(At, 0, 0); PG8_STAGE(PG8_SA(1, 1), a1 + hstepA, voffA);
            PG8_WAIT_V(8); PG8_WAIT_L(0); PG8_BAR; PG8_MMA(0, 0, At, B0); PG8_MMA(0, 1, At, B1); PG8_BAR; PG8_SCHED;
            PG8_LDA(At, 0, 1); PG8_STAGE(PG8_SB(0, 0), b2, voffB); PG8_STAGE(PG8_SB(0, 1), b2 + hstepB, voffB); PG8_STAGE(PG8_SA(0, 0), a2, voffA);
            PG8_WAIT_V(8); PG8_WAIT_L(0); PG8_BAR; PG8_MMA(1, 0, At, B0); PG8_MMA(1, 1, At, B1); PG8_BAR; PG8_SCHED;
            PG8_LDB(B0, 1, 0); PG8_LDB(B1, 1, 1); PG8_SCHED; PG8_LDA(At, 1, 0); PG8_STAGE(PG8_SA(0, 1), a2 + hstepA, voffA);
            PG8_WAIT_V(8); PG8_WAIT_L(0); PG8_BAR; PG8_MMA(0, 0, At, B0); PG8_MMA(0, 1, At, B1); PG8_BAR; PG8_SCHED;
            PG8_LDA(At, 1, 1); PG8_STAGE(PG8_SB(1, 0), b3, voffB); PG8_STAGE(PG8_SB(1, 1), b3 + hstepB, voffB); PG8_STAGE(PG8_SA(1, 0), a3, voffA);
            PG8_WAIT_V(8); PG8_WAIT_L(0); PG8_BAR; PG8_MMA(1, 0, At, B0); PG8_MMA(1, 1, At, B1); PG8_BAR; PG8_SCHED;
            } else {
            PG8_LDB(B0, 0, 0); PG8_SCHED; PG8_LDA(At, 0, 0); PG8_STAGE(PG8_SA(1, 1), a1 + hstepA, voffA);
            PG8_WAIT_L(8); PG8_BAR; PG8_WAIT_L(0); PG8_MMA(0, 0, At, B0); PG8_BAR; PG8_SCHED;
            PG8_LDB(B1, 0, 1); PG8_STAGE(PG8_SB(0, 0), b2, voffB);
            PG8_BAR; PG8_WAIT_L(0); PG8_MMA(0, 1, At, B1); PG8_BAR;
            PG8_LDA(At, 0, 1); PG8_STAGE(PG8_SA(0, 0), a2, voffA);
            PG8_BAR; PG8_WAIT_L(0); PG8_MMA(1, 0, At, B0); PG8_BAR; PG8_SCHED;
            PG8_STAGE(PG8_SB(0, 1), b2 + hstepB, voffB);
            PG8_WAIT_V(6); PG8_BAR; PG8_MMA(1, 1, At, B1); PG8_BAR;
            PG8_LDB(B0, 1, 0); PG8_SCHED; PG8_LDA(At, 1, 0); PG8_STAGE(PG8_SA(0, 1), a2 + hstepA, voffA);
            PG8_WAIT_L(8); PG8_BAR; PG8_WAIT_L(0); PG8_MMA(0, 0, At, B0); PG8_BAR; PG8_SCHED;
            PG8_LDB(B1, 1, 1); PG8_STAGE(PG8_SB(1, 0), b3, voffB);
            PG8_BAR; PG8_WAIT_L(0); PG8_MMA(0, 1, At, B1); PG8_BAR;
            PG8_LDA(At, 1, 1); PG8_STAGE(PG8_SA(1, 0), a3, voffA);
            PG8_BAR; PG8_WAIT_L(0); PG8_MMA(1, 0, At, B0); PG8_BAR; PG8_SCHED;
            PG8_STAGE(PG8_SB(1, 1), b3 + hstepB, voffB);
            PG8_WAIT_V(6); PG8_BAR; PG8_MMA(1, 1, At, B1); PG8_BAR;
            }
        }
        if constexpr (ALIGN_EPI) { if (wr == 0) PG8_BAR; }
        if constexpr (!Epi::AFTER_DRAIN) { int fr_ = fr, fq_ = fq; asm volatile("" : "+v"(fr_), "+v"(fq_));
            E(acc, cur, wr, wc, fr_, fq_); S.done(cur); }
        if (!has_next) break;
        bool keep = false; if constexpr (Epi::KEEP) keep = E.keep(cur);
        if (!keep) {
#pragma unroll
        for (int a = 0; a < 2; ++a)
#pragma unroll
            for (int b = 0; b < 2; ++b)
#pragma unroll
                for (int m = 0; m < 4; ++m)
#pragma unroll
                    for (int n = 0; n < 2; ++n) acc[a][b][m][n] = (f32x4){0.f, 0.f, 0.f, 0.f};
        }
        cur = nxt; cA = nA; cB = nB; ++ui;
        if constexpr (ALIGN_EPI) { if (wr == 1) PG8_BAR; }
    }
    PG8_WAIT_V(0);
    if constexpr (!ALIGN_EPI) { if (wr == 0) PG8_BAR; }
    PG8_BAR;
    if constexpr (Epi::AFTER_DRAIN) { E.fused(acc, cur, wr, wc, fr, fq, lds, wid, lane); S.done(cur); }
#undef PG8_SA
#undef PG8_SB
#undef PG8_STAGE
#undef PG8_LDA
#undef PG8_LDB
#undef PG8_MMA
#undef PG8_WAIT_V
#undef PG8_WAIT_L
#undef PG8_BAR
#undef PG8_SCHED
}
}
#define XB_TMO      128
#define XB_XCNT(j)  (256  + 64 * (j))
#define XB_XSUB(j)  (1280 + 64 * (j))
#define XB_XGEN(j)  (2304 + 64 * (j))
#define XB_TOP      3328
#define XB_TOPGEN   3392
#define XCD_BAR_WORDS 3456
#define XB_SPIN_CAP (1u << 22)

__device__ __forceinline__ unsigned xb_ld(unsigned* p)              { return __hip_atomic_load(p, __ATOMIC_RELAXED, __HIP_MEMORY_SCOPE_AGENT); }
__device__ __forceinline__ unsigned xb_add(unsigned* p, unsigned v) { return __hip_atomic_fetch_add(p, v, __ATOMIC_RELAXED, __HIP_MEMORY_SCOPE_AGENT); }
__device__ __forceinline__ unsigned xb_xcc_id() { return (unsigned)__builtin_amdgcn_s_getreg((3 << 11) | 20) & 0xFu; }
#define XB_SPIN(cond, bar) do { unsigned _sp = 0; while (cond) { __builtin_amdgcn_s_sleep(1); \
    if ((++_sp & 255u) == 0u) { if (xb_ld(&(bar)[XB_TMO])) break; if (_sp > XB_SPIN_CAP) { atomicAdd(&(bar)[XB_TMO], 1u); break; } } } } while (0)

struct XcdBarrier {
    unsigned* bar; unsigned x; int wv;
    volatile LAS unsigned* st;
};

__device__ __forceinline__ bool xb_thread0(int wv) { unsigned l; asm volatile("v_mbcnt_lo_u32_b32 %0, -1, 0\n\tv_mbcnt_hi_u32_b32 %0, -1, %0" : "=v"(l)); return wv == 0 && l == 0u; }
__device__ __forceinline__ XcdBarrier xcd_barrier_post(unsigned* bar, volatile LAS unsigned* st, int wv) {
    XcdBarrier b; b.bar = bar; b.x = xb_xcc_id(); b.st = st; b.wv = wv;
    if (xb_thread0(wv)) (void)xb_add(&bar[XB_XCNT(b.x)], 1u);
    return b;
}
__device__ __forceinline__ void xcd_barrier_complete(unsigned* bar, unsigned x, unsigned& nloc, unsigned& nx) {
    const unsigned G = gridDim.x * gridDim.y * gridDim.z;
    unsigned sum, cnt, mine, sp = 0u;
    for (;;) {
        sum = 0u; cnt = 0u; mine = 0u;
#pragma unroll
        for (unsigned j = 0; j < 16; ++j) { const unsigned c = xb_ld(&bar[XB_XCNT(j)]); sum += c; cnt += (c > 0u) ? 1u : 0u; mine = (j == x) ? c : mine; }
        if (sum == G) break;
        __builtin_amdgcn_s_sleep(1);
        if ((++sp & 255u) == 0u) { if (xb_ld(&bar[XB_TMO])) break; if (sp > XB_SPIN_CAP) { atomicAdd(&bar[XB_TMO], 1u); break; } }
    }
    nloc = mine > 0u ? mine : 1u; nx = cnt > 0u ? cnt : 1u;
}

__device__ __forceinline__ void xcd_barrier(const XcdBarrier& b) {
    asm volatile("s_waitcnt vmcnt(0)" ::: "memory");
    __syncthreads();
    if (xb_thread0(b.wv)) {
        unsigned* bar = b.bar;
        __builtin_amdgcn_s_waitcnt(0);
        unsigned nloc = b.st[0], nx = b.st[1];
        if (nloc == 0u) { xcd_barrier_complete(bar, b.x, nloc, nx); b.st[0] = nloc; b.st[1] = nx; }
        const unsigned old = xb_add(&bar[XB_XSUB(b.x)], 1u);
        const unsigned gen = old / nloc;
        if (old + 1u == (gen + 1u) * nloc) {
            __builtin_amdgcn_fence(__ATOMIC_RELEASE, "agent");
            asm volatile("s_waitcnt vmcnt(0)" ::: "memory");
            const unsigned og = xb_add(&bar[XB_TOP], 1u);
            const unsigned tg = og / nx;
            if (og + 1u == (tg + 1u) * nx) xb_add(&bar[XB_TOPGEN], 1u);
            else XB_SPIN(xb_ld(&bar[XB_TOPGEN]) == tg, bar);
            __builtin_amdgcn_fence(__ATOMIC_ACQUIRE, "agent");
            xb_add(&bar[XB_XGEN(b.x)], 1u);
            asm volatile("s_waitcnt vmcnt(0)" ::: "memory");
        } else {
            XB_SPIN(xb_ld(&bar[XB_XGEN(b.x)]) == gen, bar);
            __builtin_amdgcn_fence(__ATOMIC_ACQUIRE, "agent");
            asm volatile("s_waitcnt vmcnt(0)" ::: "memory");
        }
    }
    __syncthreads();
}
constexpr int NWAVES = 8;
#ifndef MK_N_LAUNCHES
#define MK_N_LAUNCHES 1
#endif
#ifndef PROBE_PH
#define PROBE_PH -1
#endif
#ifndef BARX
#define BARX 0
#endif
#ifndef REPMASK
#define REPMASK 0
#endif
#ifndef PHMASK
#define PHMASK 0x3ff
#endif
#define LDS_WAIT() asm volatile("s_waitcnt lgkmcnt(0)" ::: "memory")

template <int MAPK> DI int colmap(int n, int N) {
    if (MAPK == 0) return n < N ? n : -1;
    if (MAPK == 2) { const int w = n & 255; return w < 128 ? (n >> 8) * 128 + w : cfg::DFF + (n >> 8) * 128 + (w - 128); }
    if (n < 1280) return n;
    if (n < 2304) return n + 24;
    if (n < 4352) return n + 24;
    if (n < 4376) return n - 4352 + 1280;
    return -1;
}
template <int MAPK> DI void transpose_item(const float* W, int K, int N, const float* kscale, bf16* WT, LAS float* scr, int item, int nblk, int lane) {
    const int kb = item / nblk, nb = item % nblk, k0 = 64 * kb, n0 = 32 * nb;
    const int sc = colmap<MAPK>(n0 + (lane & 31), N);
    float tv[32];
#pragma unroll
    for (int i = 0; i < 32; ++i) { const int kk = 2 * i + (lane >> 5); tv[i] = sc >= 0 ? W[(size_t)(k0 + kk) * N + sc] : 0.f; }
#pragma unroll
    for (int i = 0; i < 32; ++i) { const int kk = 2 * i + (lane >> 5); float v = tv[i]; if (kscale) v *= kscale[k0 + kk]; scr[kk * 33 + (lane & 31)] = v; }
    LDS_WAIT();
    const int c = lane & 7;
#pragma unroll
    for (int j = 0; j < 4; ++j) { const int n = (lane >> 3) + 8 * j; const LAS float* s = scr + (8 * c) * 33 + n;
        v4u o; o.x = pk2(s[0 * 33], s[1 * 33]); o.y = pk2(s[2 * 33], s[3 * 33]); o.z = pk2(s[4 * 33], s[5 * 33]); o.w = pk2(s[6 * 33], s[7 * 33]);
        *(v4u*)(WT + (size_t)(n0 + n) * K + k0 + 8 * c) = o; }
    LDS_WAIT();
}

DI void load8(const float* p, float (&x)[8]) { const v4f a = *(const v4f*)p, b = *(const v4f*)(p + 4); x[0] = a.x; x[1] = a.y; x[2] = a.z; x[3] = a.w; x[4] = b.x; x[5] = b.y; x[6] = b.z; x[7] = b.w; }
DI void load8(const bf16* p, float (&x)[8]) { const v4u a = *(const v4u*)p; x[0] = __uint_as_float(a.x << 16); x[1] = __uint_as_float(a.x & 0xffff0000u); x[2] = __uint_as_float(a.y << 16); x[3] = __uint_as_float(a.y & 0xffff0000u);
    x[4] = __uint_as_float(a.z << 16); x[5] = __uint_as_float(a.z & 0xffff0000u); x[6] = __uint_as_float(a.w << 16); x[7] = __uint_as_float(a.w & 0xffff0000u); }
DI float load1(const float* p) { return *p; }
DI float load1(const bf16* p) { return bf2f(*p); }

typedef short s16x8 __attribute__((ext_vector_type(8)));
typedef float f32x16 __attribute__((ext_vector_type(16)));
template <typename OT> DI void cmp_stage2_tile(const bf16* Pg, int nseg, int n0, const bf16* W2Fkv, OT* OUTg, int ncmp, int lane) {
    const int r32 = lane & 31, hi = lane >> 5, ra = n0 + r32, rb = ra + 1 < nseg ? ra + 1 : nseg - 1;
    f32x16 acc0, acc1;
#pragma unroll
    for (int i = 0; i < 16; ++i) { acc0[i] = 0.f; acc1[i] = 0.f; }
#pragma unroll
    for (int ks = 0; ks < 8; ++ks) {
        float p0[8], p1[8]; load8(Pg + (size_t)ra * 256 + 16 * ks + 8 * hi, p0); load8(Pg + (size_t)rb * 256 + 128 + 16 * ks + 8 * hi, p1);
        v4u av; av.x = pg8::cvt_pk_bf16(gelu_tanh(p0[0] + p1[0]), gelu_tanh(p0[1] + p1[1])); av.y = pg8::cvt_pk_bf16(gelu_tanh(p0[2] + p1[2]), gelu_tanh(p0[3] + p1[3]));
        av.z = pg8::cvt_pk_bf16(gelu_tanh(p0[4] + p1[4]), gelu_tanh(p0[5] + p1[5])); av.w = pg8::cvt_pk_bf16(gelu_tanh(p0[6] + p1[6]), gelu_tanh(p0[7] + p1[7]));
        const v4u b0 = *(const v4u*)(W2Fkv + ((size_t)(ks * 2 + 0) * 64 + lane) * 8), b1 = *(const v4u*)(W2Fkv + ((size_t)(ks * 2 + 1) * 64 + lane) * 8);
        acc0 = __builtin_amdgcn_mfma_f32_32x32x16_bf16(__builtin_bit_cast(s16x8, av), __builtin_bit_cast(s16x8, b0), acc0, 0, 0, 0);
        acc1 = __builtin_amdgcn_mfma_f32_32x32x16_bf16(__builtin_bit_cast(s16x8, av), __builtin_bit_cast(s16x8, b1), acc1, 0, 0, 0);
    }
#pragma unroll
    for (int r = 0; r < 16; ++r) { const int row = n0 + (r & 3) + 8 * (r >> 2) + 4 * hi; if (row < ncmp) { if (sizeof(OT) == 4) { OUTg[(size_t)row * 64 + r32] = (OT)acc0[r]; OUTg[(size_t)row * 64 + 32 + r32] = (OT)acc1[r]; } else { OUTg[(size_t)row * 64 + r32] = (OT)f2bf(acc0[r]); OUTg[(size_t)row * 64 + 32 + r32] = (OT)f2bf(acc1[r]); } } }
}
DI void load_cmp_bias(const Args& a, LAS float* biasL, int tid) {
    if (tid < 256) { const float* PB = (const float*)(a.ws + cfg::WS_PB); const int kv = tid >> 7, h = tid & 127; float s = a.cmp_b1[kv * 128 + h];
#pragma unroll 8
        for (int c = 0; c < 32; ++c) s += PB[(kv * 32 + c) * 128 + h];
        biasL[tid] = s; }
    LDS_WAIT(); __syncthreads();
}
struct MixOrder {
    pg8::StaticOrder s1; int G, c; const char* CB; const char* W1T;
    __device__ __forceinline__ bool next(int i, pg8::Unit& u) const {
        long L = (long)i * G + c; if (L < s1.nwg) return s1.unit_of((int)L, u);
        L -= s1.nwg; if (L >= 512) return false;
        const int kv = (int)(L >> 8), rest = (int)(L & 255);
        u.pm = rest; u.pn = 0; u.kind = 1 + kv; u.a = CB + (((size_t)(kv * 64 + (rest >> 2)) * 16384 + (size_t)(rest & 3) * 4096) * 64) * 2; u.b = W1T + (size_t)kv * 256 * 1024 * 2; return true;
    }
    __device__ __forceinline__ void a_ready(const pg8::Unit&) const {}
    __device__ __forceinline__ void done(const pg8::Unit&) const {}
};
struct PairOrder {
    pg8::StaticOrder s1;
    __device__ __forceinline__ bool next(int i, pg8::Unit& u) const { if (!s1.next(i >> 1, u)) return false; u.kind = i & 1; u.a += (i & 1) * 1024; u.b += (i & 1) * 1024; return true; }
    __device__ __forceinline__ void a_ready(const pg8::Unit&) const {}
    __device__ __forceinline__ void done(const pg8::Unit&) const {}
};
struct OrdOrder {
    pg8::StaticOrder s1;
    __device__ __forceinline__ bool next(int i, pg8::Unit& u) const { if (!s1.next(i, u)) return false; u.kind = i; return true; }
    __device__ __forceinline__ void a_ready(const pg8::Unit&) const {}
    __device__ __forceinline__ void done(const pg8::Unit&) const {}
};
struct CmpOrder {
    int rest; const char* CB; const char* W1T;
    __device__ __forceinline__ bool next(int i, pg8::Unit& u) const { if (i >= 2) return false; u.pm = rest; u.pn = 0; u.kind = 1 + i;
        u.a = CB + (((size_t)(i * 64 + (rest >> 2)) * 16384 + (size_t)(rest & 3) * 4096) * 64) * 2; u.b = W1T + (size_t)i * 256 * 1024 * 2; return true; }
    __device__ __forceinline__ void a_ready(const pg8::Unit&) const {}
    __device__ __forceinline__ void done(const pg8::Unit&) const {}
};
struct OneOrder {
    pg8::Unit u0;
    __device__ __forceinline__ bool next(int i, pg8::Unit& u) const { if (i) return false; u = u0; return true; }
    __device__ __forceinline__ void a_ready(const pg8::Unit&) const {}
    __device__ __forceinline__ void done(const pg8::Unit&) const {}
};
template <typename KT> DI void score4(float (&s)[4], const KT* kptr, bool valid, const LAS float* qs) {
    float a0 = 0.f, a1 = 0.f, a2 = 0.f, a3 = 0.f;
#pragma unroll
    for (int c = 0; c < 8; ++c) { float k[8]; load8(kptr + 8 * c, k); asm volatile("" : "+v"(a0), "+v"(a1), "+v"(a2), "+v"(a3) :: "memory");
#pragma unroll
        for (int j = 0; j < 8; ++j) { const int d = 8 * c + j; a0 += k[j] * qs[d]; a1 += k[j] * qs[64 + d]; a2 += k[j] * qs[128 + d]; a3 += k[j] * qs[192 + d]; } }
    s[0] = valid ? a0 : cfg::NEGF; s[1] = valid ? a1 : cfg::NEGF; s[2] = valid ? a2 : cfg::NEGF; s[3] = valid ? a3 : cfg::NEGF;
}
namespace dec {
constexpr int L_QS = 0, L_S = 1024, L_RED = L_S + 4 * 1024 * 4, L_OS = L_RED + 512, L_IC = L_OS + 8 * 4 * 64 * 4, L_SC = L_IC + 1056 * 4, L_LIST = L_SC + 272 * 4, L_O = L_LIST + 128, L_END = L_O + 3 * 256 * 4;
static_assert(L_END <= cfg::RING_BYTES, "decode attention LDS map");
struct KeyCmp { const float* kc; const float* vc; DI bool valid(int k) const { return k < 1023; } DI const float* kbase(int) const { return kc; } DI const float* vbase(int) const { return vc; } DI int stride(int) const { return 64; } DI int first(int grp) const { return grp * 64; } };
struct KeyWin { const float* cw; const float* nw; DI bool valid(int k) const { return k < 513; } DI const float* kbase(int grp) const { return grp < 8 ? cw : nw; } DI const float* vbase(int grp) const { return kbase(grp) + 128; }
    DI int stride(int grp) const { return grp < 8 ? 256 : 0; } DI int first(int grp) const { return grp < 8 ? grp * 64 : 0; } };
struct KeySlc { const float* cs; const int* pt; const LAS int* list; const float* ns; int g;
    DI bool valid(int k) const { return list[k >> 6] < 256 || (k & 63) == 0; }
    DI const float* kbase(int grp) const { const int blk = list[grp]; if (blk >= 256) return ns; const int phys = pt[blk >> 1]; return cs + (((size_t)phys * 128 + (blk & 1) * 64) * 4 + g) * 64; }
    DI const float* vbase(int grp) const { return kbase(grp) + 128; } DI int stride(int grp) const { return list[grp] < 256 ? 256 : 0; } DI int first(int) const { return 0; } };
DI void score4_wide(float (&s)[4], const float* kptr, bool valid, const LAS float* qs) {
    float a0 = 0.f, a1 = 0.f, a2 = 0.f, a3 = 0.f;
#pragma unroll
    for (int h = 0; h < 2; ++h) {
        v4f kv[8];
#pragma unroll
        for (int c = 0; c < 8; ++c) kv[c] = *(const v4f*)(kptr + 32 * h + 4 * c);
        asm volatile("" : "+v"(a0), "+v"(a1), "+v"(a2), "+v"(a3) :: "memory");
#pragma unroll
        for (int c = 0; c < 8; ++c) { const int d = 32 * h + 4 * c; const v4f q0 = *(const LAS v4f*)(qs + d), q1 = *(const LAS v4f*)(qs + 64 + d), q2 = *(const LAS v4f*)(qs + 128 + d), q3 = *(const LAS v4f*)(qs + 192 + d);
            a0 += (kv[c].x * q0.x + kv[c].y * q0.y) + (kv[c].z * q0.z + kv[c].w * q0.w); a1 += (kv[c].x * q1.x + kv[c].y * q1.y) + (kv[c].z * q1.z + kv[c].w * q1.w);
            a2 += (kv[c].x * q2.x + kv[c].y * q2.y) + (kv[c].z * q2.z + kv[c].w * q2.w); a3 += (kv[c].x * q3.x + kv[c].y * q3.y) + (kv[c].z * q3.z + kv[c].w * q3.w); }
        asm volatile("" : "+v"(a0), "+v"(a1), "+v"(a2), "+v"(a3) :: "memory");
    }
    s[0] = valid ? a0 : cfg::NEGF; s[1] = valid ? a1 : cfg::NEGF; s[2] = valid ? a2 : cfg::NEGF; s[3] = valid ? a3 : cfg::NEGF;
}
template <int NK, bool IMP, class KM> DI void attend(const KM& km, LAS char* L, int slot, int tid) {
    const int lane = tid & 63, wave = __builtin_amdgcn_readfirstlane(tid >> 6);
    const LAS float* qs = (const LAS float*)(L + L_QS); LAS float* sb = (LAS float*)(L + L_S); LAS float* red = (LAS float*)(L + L_RED); LAS float* os = (LAS float*)(L + L_OS); LAS float* ic = (LAS float*)(L + L_IC);
    float s[NK][4]; bool ok[NK]; float mx[4] = {cfg::NEGF, cfg::NEGF, cfg::NEGF, cfg::NEGF};
#pragma unroll
    for (int i = 0; i < NK; ++i) { const int k = tid + 512 * i, grp = k >> 6; ok[i] = km.valid(k); score4_wide(s[i], km.kbase(grp) + (size_t)(km.first(grp) + (k & 63)) * km.stride(grp), ok[i], qs);
#pragma unroll
        for (int r = 0; r < 4; ++r) mx[r] = fmaxf(mx[r], s[i][r]); }
#pragma unroll
    for (int r = 0; r < 4; ++r) { mx[r] = wave_max(mx[r]); if (lane == 0) red[wave * 4 + r] = mx[r]; }
    LDS_WAIT(); __syncthreads();
    float sm[4];
#pragma unroll
    for (int r = 0; r < 4; ++r) { float m = red[r];
#pragma unroll
        for (int w = 1; w < 8; ++w) m = fmaxf(m, red[w * 4 + r]);
        mx[r] = m; sm[r] = 0.f; }
#pragma unroll
    for (int i = 0; i < NK; ++i)
#pragma unroll
        for (int r = 0; r < 4; ++r) { s[i][r] = ok[i] ? __builtin_amdgcn_exp2f((s[i][r] - mx[r]) * cfg::L2E) : 0.f; sm[r] += s[i][r]; }
#pragma unroll
    for (int r = 0; r < 4; ++r) { sm[r] = wave_sum(sm[r]); if (lane == 0) red[32 + wave * 4 + r] = sm[r]; }
    LDS_WAIT(); __syncthreads();
#pragma unroll
    for (int r = 0; r < 4; ++r) { float t = red[32 + r];
#pragma unroll
        for (int w = 1; w < 8; ++w) t += red[32 + w * 4 + r];
        sm[r] = t > 0.f ? 1.0f / t : 0.f; }
#pragma unroll
    for (int i = 0; i < NK; ++i) { const int k = tid + 512 * i; float isum = 0.f;
#pragma unroll
        for (int r = 0; r < 4; ++r) { const float p = s[i][r] * sm[r]; sb[r * 1024 + k] = p; isum += p; }
        if (IMP) ic[k] = isum; }
    LDS_WAIT(); __syncthreads();
    float o0 = 0.f, o1 = 0.f, o2 = 0.f, o3 = 0.f;
#pragma unroll
    for (int gi = 0; gi < NK; ++gi) { const int grp = wave * NK + gi, st = km.stride(grp); const float* vb = km.vbase(grp) + (size_t)km.first(grp) * st + lane; const int k0 = grp * 64;
#pragma unroll 8
        for (int kk = 0; kk < 64; ++kk) { const float v = vb[(size_t)kk * st]; const int k = k0 + kk;
            o0 += sb[k] * v; o1 += sb[1024 + k] * v; o2 += sb[2048 + k] * v; o3 += sb[3072 + k] * v; } }
    os[(wave * 4 + 0) * 64 + lane] = o0; os[(wave * 4 + 1) * 64 + lane] = o1; os[(wave * 4 + 2) * 64 + lane] = o2; os[(wave * 4 + 3) * 64 + lane] = o3;
    LDS_WAIT(); __syncthreads();
    if (tid < 256) { float t = 0.f;
#pragma unroll
        for (int w = 0; w < 8; ++w) t += os[w * 256 + tid];
        ((LAS float*)(L + L_O))[slot * 256 + tid] = t; }
    LDS_WAIT(); __syncthreads();
}
DI void sample_unit(const Args& a, int b, int g, LAS unsigned char* lds_raw, int tid) {
    LAS char* L = (LAS char*)lds_raw; const int row = cfg::MP + b;
    LAS float* qs = (LAS float*)(L + L_QS); LAS float* ic = (LAS float*)(L + L_IC); LAS float* sc = (LAS float*)(L + L_SC); LAS int* list = (LAS int*)(L + L_LIST);
    const bf16* Q = (const bf16*)(a.ws + cfg::WS_Q);
    if (tid < 256) qs[tid] = bf2f(Q[(size_t)row * 512 + g * 256 + tid]);
    for (int i = tid; i < 1056; i += 512) ic[i] = 0.f;
    LDS_WAIT(); __syncthreads();
    { KeyCmp km{(const float*)(a.ws + cfg::WS_KCS) + (size_t)(b * 2 + g) * 1024 * 64, (const float*)(a.ws + cfg::WS_VCS) + (size_t)(b * 2 + g) * 1024 * 64}; attend<2, true>(km, L, 0, tid); }
    if (tid < 257) { const int j = tid; float imp = 0.f;
#pragma unroll
        for (int mm = -1; mm < 4; ++mm) { const int idx = 4 * j + mm; if (idx >= 0 && idx < 1023) imp += ic[idx]; }
        sc[j] = imp + ((j == 0 || j >= 255) ? 1e6f : 0.f); }
    LDS_WAIT(); __syncthreads();
    { const int j = tid < 257 ? tid : 256; const float my = sc[j]; int rank = 0;
#pragma unroll 8
      for (int k = 0; k < 257; ++k) { const float o = sc[k]; rank += (o > my || (o == my && k < j)) ? 1 : 0; }
      __syncthreads();
      if (tid < 257 && rank < 16) list[rank] = j; }
    LDS_WAIT(); __syncthreads();
    { KeySlc km{a.cache_slc, a.page_table + b * cfg::NPAGES, list, a.out + cfg::OFF_SLC_S + (size_t)(b * 4 + g) * 64, g}; attend<2, false>(km, L, 1, tid); }
    { KeyWin km{a.cache_win + ((size_t)b * 512 * 4 + g) * 64, a.out + cfg::OFF_WIN_S + (((size_t)b * 512 + 511) * 4 + g) * 64}; attend<2, false>(km, L, 2, tid); }
    if (tid < 256) { const int r = tid >> 6, h = g * 4 + r; const float* ng = (const float*)(a.ws + cfg::WS_NSAG) + (size_t)row * 32 + h * 3; const LAS float* O = (const LAS float*)(L + L_O);
        ((bf16*)(a.ws + cfg::WS_ONSA))[(size_t)row * 1024 + h * 64 + (tid & 63)] = (bf16)f2bf(ng[0] * O[tid] + ng[1] * O[256 + tid] + ng[2] * O[512 + tid]); }
    LDS_WAIT(); __syncthreads();
}
}

DI float rstd_v(const float* SSV, int row) { const v4f a = *(const v4f*)(SSV + (size_t)row * 8), b = *(const v4f*)(SSV + (size_t)row * 8 + 4);
    return 1.0f / sqrtf((((a.x + a.y) + (a.z + a.w)) + ((b.x + b.y) + (b.z + b.w))) * (1.0f / 512.0f) + cfg::EPS); }
DI float rstd16(const float* SS, int row) { const v4f* p = (const v4f*)(SS + (size_t)row * 16); const v4f s0 = p[0], s1 = p[1], s2 = p[2], s3 = p[3];
    const float t = ((s0.x + s0.y) + (s0.z + s0.w)) + ((s1.x + s1.y) + (s1.z + s1.w)) + ((s2.x + s2.y) + (s2.z + s2.w)) + ((s3.x + s3.y) + (s3.z + s3.w));
    return 1.0f / sqrtf(t * (1.0f / 1024.0f) + cfg::EPS); }

#ifndef ATT_EXP
#define ATT_EXP 0
#endif
namespace att {
constexpr int KP = 144;
constexpr int TILE_B = 64 * KP;
constexpr int BUF_B = 2 * TILE_B;
constexpr int W_OFF = 2 * BUF_B;
constexpr int ICP = 260, SCP = 68;
constexpr int W_IC = 0, W_SC = 8320, W_TAB = W_SC + 8 * SCP * 4, W_MSK = W_TAB + 256, W_BYTES = W_MSK + 64;
static_assert(W_OFF + 8 * W_BYTES <= cfg::RING_BYTES, "attention LDS map");
constexpr float NEG_S = -2e30f, M_INIT = -1e30f;
typedef short s16x4 __attribute__((ext_vector_type(4)));

DI float pl32_max(float v) { const auto rr = __builtin_amdgcn_permlane32_swap(__float_as_uint(v), __float_as_uint(v), false, false); return fmaxf(__uint_as_float(rr[0]), __uint_as_float(rr[1])); }
DI float pl32_sum(float v) { const auto rr = __builtin_amdgcn_permlane32_swap(__float_as_uint(v), __float_as_uint(v), false, false); return __uint_as_float(rr[0]) + __uint_as_float(rr[1]); }
DI float quad_sum(float v) {
    v += __int_as_float(__builtin_amdgcn_mov_dpp(__float_as_int(v), 0xB1, 0xf, 0xf, true));
    v += __int_as_float(__builtin_amdgcn_mov_dpp(__float_as_int(v), 0x4E, 0xf, 0xf, true));
    return v;
}
DI s16x4 lds_tr(const LAS char* p) { return __builtin_bit_cast(s16x4, __builtin_amdgcn_ds_read_tr16_b64_v4i16((LAS s16x4*)p)); }

DI void tile_fetch(v4u& kr, v4u& vr, const bf16* kg, const bf16* vg, size_t rowstride, int tid) {
#if ATT_EXP == 7
    if (rowstride == 768) { kr = (v4u){0u,0u,0u,0u}; vr = kr; return; }
#endif
    const size_t off = (size_t)(tid >> 3) * rowstride + (tid & 7) * 8; kr = *(const v4u*)(kg + off); vr = *(const v4u*)(vg + off);
}
DI void tile_store(LAS char* buf, const v4u& kr, const v4u& vr, int tid) {
#if ATT_EXP == 7
    if (kr.x == 0u && kr.y == 0u && vr.x == 0u) return;
#endif
    LAS char* p = buf + (tid >> 3) * KP + (tid & 7) * 16; *(LAS v4u*)p = kr; *(LAS v4u*)(p + TILE_B) = vr;
}
DI void qk_tile(f32x16& s0, f32x16& s1, const LAS char* Kt, const s16x8 (&qf)[4], int r32, int hi) {
#pragma unroll
    for (int i = 0; i < 16; ++i) { s0[i] = 0.f; s1[i] = 0.f; }
#pragma unroll
    for (int d0 = 0; d0 < 4; ++d0) {
        const s16x8 a0 = *(const LAS s16x8*)(Kt + r32 * KP + (2 * d0 + hi) * 16), a1 = *(const LAS s16x8*)(Kt + (32 + r32) * KP + (2 * d0 + hi) * 16);
        s0 = __builtin_amdgcn_mfma_f32_32x32x16_bf16(a0, qf[d0], s0, 0, 0, 0); s1 = __builtin_amdgcn_mfma_f32_32x32x16_bf16(a1, qf[d0], s1, 0, 0, 0);
    }
}
DI void pv_tile(f32x16 (&o)[2], const LAS char* Vt, const unsigned (&pk)[16], int lane) {
    const int hi = lane >> 5, gq = (lane >> 4) & 1, qq = (lane & 15) >> 2, pp = lane & 3;
    const LAS char* vb = Vt + (4 * hi + qq) * KP + (16 * gq + 4 * pp) * 2;
#pragma unroll
    for (int ks = 0; ks < 4; ++ks) {
        v4u av; av.x = pk[4 * ks]; av.y = pk[4 * ks + 1]; av.z = pk[4 * ks + 2]; av.w = pk[4 * ks + 3];
#pragma unroll
        for (int db = 0; db < 2; ++db) {
            const s16x4 lo = lds_tr(vb + (16 * ks) * KP + db * 64), hh = lds_tr(vb + (16 * ks + 8) * KP + db * 64);
            const s16x8 bv = (s16x8){lo[0], lo[1], lo[2], lo[3], hh[0], hh[1], hh[2], hh[3]};
            o[db] = __builtin_amdgcn_mfma_f32_32x32x16_bf16(__builtin_bit_cast(s16x8, av), bv, o[db], 0, 0, 0);
        }
    }
}
DI void tab_publish(LAS float* tab, float v, int r32, int hi) { if (hi == 0) tab[r32] = v; LDS_WAIT(); }
DI float crowf(const LAS float* tab, int reg, int hi) { return tab[(reg & 3) + 8 * (reg >> 2) + 4 * hi]; }

struct Ctx {
    int b, g, qt, tid, lane, wave, r32, hi, tq;
    LAS char* lds; LAS float* ic; LAS float* sc; LAS float* tab; LAS unsigned* msk;
};

template <int MODE = 0> DI void lds_barrier() {
#if ATT_EXP == 8
    if (MODE >= 2) { asm volatile("s_waitcnt lgkmcnt(0)" ::: "memory"); return; }
#endif
    asm volatile("s_waitcnt lgkmcnt(0)\n\ts_barrier" ::: "memory"); }

template <int MODE> DI void tile_compute(const Ctx& c, const s16x8 (&qf)[4], int j, const LAS char* Kt, const LAS char* Vt, float& m, float& l, f32x16 (&o)[2], float linv, int vis, unsigned msk_lo, unsigned msk_hi) {
#if ATT_EXP == 1
    if (MODE >= 2) return;
#endif
    int lo = 0, hi_ = 63; bool need_mask, lane_on = true;
    if (MODE <= 1) { hi_ = vis - 64 * j; need_mask = true; }
    else if (MODE == 2) { lane_on = ((j < 32 ? msk_lo >> j : msk_hi >> (j - 32)) & 1u) != 0u; if (!__any(lane_on)) return;
        if (j == c.qt) { hi_ = lane_on ? c.tq : -1; need_mask = true; lane_on = true; } else need_mask = false; }
    else { if (j == c.qt) hi_ = c.tq; else if (j == c.qt - 8) lo = c.tq; need_mask = (j == c.qt) || (j == c.qt - 8); }
    f32x16 s0, s1; qk_tile(s0, s1, Kt, qf, c.r32, c.hi);
    if (need_mask) { const int l4 = lo - 4 * c.hi, h4 = hi_ - 4 * c.hi;
#pragma unroll
        for (int r = 0; r < 16; ++r) { const int k0 = (r & 3) + 8 * (r >> 2); s0[r] = (k0 >= l4 && k0 <= h4) ? s0[r] : NEG_S; s1[r] = (k0 + 32 >= l4 && k0 + 32 <= h4) ? s1[r] : NEG_S; } }
    unsigned pk[16];
    if (MODE == 1) {
        const float mL = m * cfg::L2E;
#pragma unroll
        for (int r = 0; r < 16; ++r) { s0[r] = __builtin_amdgcn_exp2f(__builtin_fmaf(s0[r], cfg::L2E, -mL)) * linv; s1[r] = __builtin_amdgcn_exp2f(__builtin_fmaf(s1[r], cfg::L2E, -mL)) * linv; }
#pragma unroll
        for (int r = 0; r < 16; ++r) { const float a0 = quad_sum(s0[r]), a1 = quad_sum(s1[r]); const int key = 64 * j + (r & 3) + 8 * (r >> 2) + 4 * c.hi;
            if ((c.r32 & 3) == 0) { c.ic[(c.r32 >> 2) * ICP + key] = a0; c.ic[(c.r32 >> 2) * ICP + key + 32] = a1; } }
    } else {
        float mt = __builtin_fmaxf(s0[0], s1[0]);
#pragma unroll
        for (int r = 1; r < 16; ++r) mt = __builtin_fmaxf(__builtin_fmaxf(mt, s0[r]), s1[r]);
        if (MODE == 2) mt = lane_on ? mt : NEG_S;
        mt = pl32_max(mt);
        const float mn = fmaxf(m, mt);
        if (__any(mn > m)) { const float al = __builtin_amdgcn_exp2f((m - mn) * cfg::L2E); l *= al; m = mn;
            if (MODE >= 2) { tab_publish(c.tab, al, c.r32, c.hi);
#pragma unroll
                for (int r = 0; r < 16; ++r) { const float f = crowf(c.tab, r, c.hi); o[0][r] *= f; o[1][r] *= f; } } }
        const float mL = m * cfg::L2E; float ls = 0.f;
#pragma unroll
#if ATT_EXP == 2
        for (int r = 0; r < 16; ++r) { s0[r] = __builtin_fmaf(s0[r], cfg::L2E, -mL); s1[r] = __builtin_fmaf(s1[r], cfg::L2E, -mL); ls += s0[r] + s1[r]; }
#else
        for (int r = 0; r < 16; ++r) { s0[r] = __builtin_amdgcn_exp2f(__builtin_fmaf(s0[r], cfg::L2E, -mL)); s1[r] = __builtin_amdgcn_exp2f(__builtin_fmaf(s1[r], cfg::L2E, -mL)); ls += s0[r] + s1[r]; }
#endif
        if (MODE == 2) ls = lane_on ? ls : 0.f;
        l += ls;
    }
    if (MODE >= 1) {
#pragma unroll
        for (int i = 0; i < 8; ++i) { pk[i] = pg8::cvt_pk_bf16(s0[2 * i], s0[2 * i + 1]); pk[8 + i] = pg8::cvt_pk_bf16(s1[2 * i], s1[2 * i + 1]); }
        if (MODE == 2) {
#pragma unroll
            for (int i = 0; i < 16; ++i) pk[i] = lane_on ? pk[i] : 0u; }
#if ATT_EXP != 3
        pv_tile(o, Vt, pk, c.lane);
#endif
    }
}
template <int MODE> DI void run_tiles(const Ctx& c, const s16x8 (&qf)[4], int j_lo, int j_hi, const bf16* kg, const bf16* vg, size_t rowstride,
                                      float& m, float& l, f32x16 (&o)[2], float linv, int vis, unsigned msk_lo, unsigned msk_hi) {
#if ATT_EXP == 4 || ATT_EXP == 5
    if (MODE >= 2) return;
#endif
    v4u kr0, vr0, kr1, vr1; const size_t ts = (size_t)64 * rowstride;
    tile_fetch(kr0, vr0, kg + (size_t)j_lo * ts, vg + (size_t)j_lo * ts, rowstride, c.tid);
    { const int jf = j_lo + 1 <= j_hi ? j_lo + 1 : j_hi; tile_fetch(kr1, vr1, kg + (size_t)jf * ts, vg + (size_t)jf * ts, rowstride, c.tid); }
    tile_store(c.lds, kr0, vr0, c.tid);
    lds_barrier();
    for (int j = j_lo; j <= j_hi; j += 2) {
        { const int jf = j + 2 <= j_hi ? j + 2 : j_hi; tile_fetch(kr0, vr0, kg + (size_t)jf * ts, vg + (size_t)jf * ts, rowstride, c.tid); }
        tile_compute<MODE>(c, qf, j, c.lds, c.lds + TILE_B, m, l, o, linv, vis, msk_lo, msk_hi);
        tile_store(c.lds + BUF_B, kr1, vr1, c.tid);
        lds_barrier<MODE>();
        if (j + 1 > j_hi) break;
        { const int jf = j + 3 <= j_hi ? j + 3 : j_hi; tile_fetch(kr1, vr1, kg + (size_t)jf * ts, vg + (size_t)jf * ts, rowstride, c.tid); }
        tile_compute<MODE>(c, qf, j + 1, c.lds + BUF_B, c.lds + BUF_B + TILE_B, m, l, o, linv, vis, msk_lo, msk_hi);
        tile_store(c.lds, kr0, vr0, c.tid);
        lds_barrier<MODE>();
    }
}

template <bool FIRST> DI void merge_branch(const Ctx& c, LAS float* accl, const f32x16 (&o)[2], float fac) {
    tab_publish(c.tab, fac, c.r32, c.hi);
#pragma unroll
    for (int r = 0; r < 16; ++r) { const int q = (r & 3) + 8 * (r >> 2) + 4 * c.hi; const float f = c.tab[q]; LAS float* p = accl + q * 64 + c.r32;
        if (FIRST) { p[0] = o[0][r] * f; p[32] = o[1][r] * f; } else { p[0] += o[0][r] * f; p[32] += o[1][r] * f; } }
}
DI void prompt_unit(const Args& a, int b, int g, int qt, LAS unsigned char* lds_raw, int tid) {
    Ctx c; c.b = b; c.g = g; c.qt = qt; c.tid = tid; c.lane = tid & 63; c.wave = __builtin_amdgcn_readfirstlane(tid >> 6); c.r32 = c.lane & 31; c.hi = c.lane >> 5; c.tq = 8 * c.wave + (c.r32 >> 2);
    c.lds = (LAS char*)lds_raw; LAS char* wreg = c.lds + W_OFF + c.wave * W_BYTES;
    c.ic = (LAS float*)(wreg + W_IC); c.sc = (LAS float*)(wreg + W_SC); c.tab = (LAS float*)(wreg + W_TAB); c.msk = (LAS unsigned*)(wreg + W_MSK);
    const int t0 = 64 * qt, t = t0 + c.tq, rh = c.r32 & 3, row = b * 4096 + t, head = g * 4 + rh;
    const bf16* Q = (const bf16*)(a.ws + cfg::WS_Q); const bf16* KVB = (const bf16*)(a.ws + cfg::WS_KVB);
    const bf16* KC = (const bf16*)(a.ws + cfg::WS_KCP) + (size_t)(b * 2 + g) * 256 * 64; const bf16* VC = (const bf16*)(a.ws + cfg::WS_VCP) + (size_t)(b * 2 + g) * 256 * 64;
#pragma unroll
    for (int i = 0; i < 33; ++i) if (i * 64 + c.lane < 8 * ICP) c.ic[i * 64 + c.lane] = 0.f;
    s16x8 qf[4];
#pragma unroll
    for (int d0 = 0; d0 < 4; ++d0) qf[d0] = *(const s16x8*)(Q + (size_t)row * 512 + head * 64 + 16 * d0 + 8 * c.hi);
    const float* ng = (const float*)(a.ws + cfg::WS_NSAG) + (size_t)row * 32 + head * 3; const float g_cmp = ng[0], g_slc = ng[1], g_win = ng[2];
    f32x16 o[2];
#pragma unroll
    for (int i = 0; i < 16; ++i) { o[0][i] = 0.f; o[1][i] = 0.f; }
    LDS_WAIT();
    const int vis = t >= 31 ? (t - 31) >> 4 : -1;
    { const int vmax = (t0 + 63 - 31) >> 4; int ntc = (vmax + 64) >> 6; ntc = ntc > 4 ? 4 : ntc;
      float m = M_INIT, l = 0.f;
#if ATT_EXP == 11
      { float m2 = M_INIT, l2 = 0.f; run_tiles<0>(c, qf, 0, ntc - 1, KC, VC, 64, m2, l2, o, 0.f, vis, 0u, 0u); const float lt2 = pl32_sum(l2); run_tiles<1>(c, qf, 0, ntc - 1, KC, VC, 64, m2, l2, o, lt2 > 0.f ? 1.0f / lt2 : 0.f, vis, 0u, 0u);
#pragma unroll
        for (int i = 0; i < 16; ++i) { o[0][i] = 0.f; o[1][i] = 0.f; } asm volatile("" : "+v"(m2)); }
#endif
      run_tiles<0>(c, qf, 0, ntc - 1, KC, VC, 64, m, l, o, 0.f, vis, 0u, 0u);
      const float lt = pl32_sum(l); const float linv = lt > 0.f ? 1.0f / lt : 0.f;
      run_tiles<1>(c, qf, 0, ntc - 1, KC, VC, 64, m, l, o, linv, vis, 0u, 0u); }
    unsigned msk_lo, msk_hi;
#if ATT_EXP == 12
    for (int rp = 0; rp < 2; ++rp)
#endif
    { const int tl = c.lane >> 3, sub = c.lane & 7; const LAS float* icr = c.ic + tl * ICP + 32 * sub; LAS int* keys = (LAS int*)c.sc + tl * SCP;
      const float prev = sub > 0 ? icr[-1] : 0.f; v4f qv[8];
#pragma unroll
      for (int e = 0; e < 8; ++e) qv[e] = *(const LAS v4f*)(icr + 4 * e);
      int my[8];
#pragma unroll
      for (int e = 0; e < 8; ++e) { const int j = sub * 8 + e; const float imp = (e > 0 ? qv[e - 1].w : prev) + ((qv[e].x + qv[e].y) + (qv[e].z + qv[e].w));
          const bool valid = j <= qt, forced = (j == 0) || (j == qt) || (j == qt - 1); const float score = valid ? imp + (forced ? 1e6f : 0.f) : cfg::NEGF;
          my[e] = (__float_as_int(score) & ~63) | (63 - j); keys[j] = my[e]; }
      LDS_WAIT();
      int rank[8];
#pragma unroll
      for (int e = 0; e < 8; ++e) rank[e] = 0;
      typedef int v4i __attribute__((ext_vector_type(4)));
#pragma unroll 4
      for (int k4 = 0; k4 < 16; ++k4) { const v4i ov = *(const LAS v4i*)(keys + 4 * k4);
#pragma unroll
          for (int kk = 0; kk < 4; ++kk)
#pragma unroll
              for (int e = 0; e < 8; ++e) rank[e] += (ov[kk] > my[e]) ? 1 : 0; }
      unsigned bits = 0u;
#pragma unroll
      for (int e = 0; e < 8; ++e) bits |= ((sub * 8 + e) <= qt && rank[e] < 16) ? (1u << e) : 0u;
      unsigned lo32 = sub < 4 ? bits << (8 * sub) : 0u, hi32 = sub >= 4 ? bits << (8 * (sub - 4)) : 0u;
#pragma unroll
      for (int x = 1; x < 8; x <<= 1) { lo32 |= (unsigned)__shfl_xor((int)lo32, x); hi32 |= (unsigned)__shfl_xor((int)hi32, x); }
      if (sub == 0) { c.msk[2 * tl] = lo32; c.msk[2 * tl + 1] = hi32; }
      LDS_WAIT();
      msk_lo = c.msk[2 * (c.r32 >> 2)]; msk_hi = c.msk[2 * (c.r32 >> 2) + 1]; }
    LAS float* accl = c.ic;
    merge_branch<true>(c, accl, o, g_cmp);
    {
#pragma unroll
      for (int i = 0; i < 16; ++i) { o[0][i] = 0.f; o[1][i] = 0.f; }
      float m = M_INIT, l = 0.f; const bf16* kg = KVB + (size_t)b * 4096 * 768 + 256 + g * 64;
      run_tiles<2>(c, qf, 0, qt, kg, kg + 128, 768, m, l, o, 0.f, 0, msk_lo, msk_hi);
#if ATT_EXP == 9
      m = M_INIT; l = 0.f;
#pragma unroll
      for (int i = 0; i < 16; ++i) { o[0][i] = 0.f; o[1][i] = 0.f; }
      asm volatile("" : "+v"(m), "+v"(l));
      run_tiles<2>(c, qf, 0, qt, kg, kg + 128, 768, m, l, o, 0.f, 0, msk_lo, msk_hi);
#endif
      const float lt = pl32_sum(l); merge_branch<false>(c, accl, o, lt > 0.f ? g_slc / lt : 0.f); }
    {
#pragma unroll
      for (int i = 0; i < 16; ++i) { o[0][i] = 0.f; o[1][i] = 0.f; }
      float m = M_INIT, l = 0.f; const bf16* kg = KVB + (size_t)b * 4096 * 768 + 512 + g * 64;
      run_tiles<3>(c, qf, qt > 8 ? qt - 8 : 0, qt, kg, kg + 128, 768, m, l, o, 0.f, 0, 0u, 0u);
#if ATT_EXP == 10
      m = M_INIT; l = 0.f;
#pragma unroll
      for (int i = 0; i < 16; ++i) { o[0][i] = 0.f; o[1][i] = 0.f; }
      asm volatile("" : "+v"(m), "+v"(l));
      run_tiles<3>(c, qf, qt > 8 ? qt - 8 : 0, qt, kg, kg + 128, 768, m, l, o, 0.f, 0, 0u, 0u);
#endif
      const float lt = pl32_sum(l); merge_branch<false>(c, accl, o, lt > 0.f ? g_win / lt : 0.f); }
    LDS_WAIT();
    bf16* O = (bf16*)(a.ws + cfg::WS_ONSA);
#pragma unroll
    for (int r = 0; r < 16; ++r) { const int q = (r & 3) + 8 * (r >> 2) + 4 * c.hi; const size_t orow = (size_t)(b * 4096 + t0 + 8 * c.wave + (q >> 2)) * 1024 + (g * 4 + (q & 3)) * 64;
        O[orow + c.r32] = (bf16)f2bf(accl[q * 64 + c.r32]); O[orow + 32 + c.r32] = (bf16)f2bf(accl[q * 64 + 32 + c.r32]); }
    LDS_WAIT();
}
}
namespace cmx {
constexpr int VP = 272;
DI void unit(const Args& a, int b, int c, int gi, LAS unsigned char* lds_raw, int tid) {
    LAS char* L = (LAS char*)lds_raw; const int lane = tid & 63, wave = __builtin_amdgcn_readfirstlane(tid >> 6);
    const bf16* VG = (const bf16*)(a.ws + cfg::WS_VG); const bf16* U = (const bf16*)(a.ws + cfg::WS_U); const float* SSV = (const float*)(a.ws + cfg::WS_SSV); bf16* CM = (bf16*)(a.ws + cfg::WS_ONSA);
    const bf16* Wt = (const bf16*)(a.ws + cfg::WS_WTRIL) + (size_t)gi * 128 * 128; const int rbase = b * 4096 + c * 128;
#pragma unroll
    for (int k = 0; k < 4; ++k) { const int p = tid + 512 * k, j = p >> 4, ch = p & 15, row = rbase + j; const float rs = rstd_v(SSV, row);
        float v[8], gn[8]; load8(VG + (size_t)row * 512 + gi * 128 + ch * 8, v); load8(a.gmlp_norm + gi * 128 + ch * 8, gn);
#pragma unroll
        for (int e = 0; e < 8; ++e) v[e] = v[e] * rs * gn[e];
        if (c == 31) { float* d = a.out + cfg::OFF_V_P + ((size_t)(b * 128 + j)) * 512 + gi * 128 + ch * 8; *(v4f*)d = (v4f){v[0], v[1], v[2], v[3]}; *(v4f*)(d + 4) = (v4f){v[4], v[5], v[6], v[7]}; }
        v4u o; o.x = pg8::cvt_pk_bf16(v[0], v[1]); o.y = pg8::cvt_pk_bf16(v[2], v[3]); o.z = pg8::cvt_pk_bf16(v[4], v[5]); o.w = pg8::cvt_pk_bf16(v[6], v[7]);
        *(LAS v4u*)(L + j * VP + ch * 16) = o; }
    LDS_WAIT(); __syncthreads();
    const int ib = wave & 3, chh = wave >> 2, r32 = lane & 31, hi = lane >> 5, gq = (lane >> 4) & 1, qq = (lane & 15) >> 2, pp = lane & 3;
    f32x16 acc[2];
#pragma unroll
    for (int i = 0; i < 16; ++i) { acc[0][i] = 0.f; acc[1][i] = 0.f; }
    const bf16* wrow = Wt + (size_t)(32 * ib + r32) * 128 + 4 * hi; const LAS char* vb = L + (4 * hi + qq) * VP + (64 * chh + 16 * gq + 4 * pp) * 2;
    for (int ks = 0; ks < 2 * ib + 2; ++ks) {
        const v2u a0 = *(const v2u*)(wrow + 16 * ks), a1 = *(const v2u*)(wrow + 16 * ks + 8);
        const v4u av = (v4u){a0.x, a0.y, a1.x, a1.y};
#pragma unroll
        for (int cb = 0; cb < 2; ++cb) { const att::s16x4 lo = att::lds_tr(vb + (16 * ks) * VP + cb * 64), hh = att::lds_tr(vb + (16 * ks + 8) * VP + cb * 64);
            const s16x8 bv = (s16x8){lo[0], lo[1], lo[2], lo[3], hh[0], hh[1], hh[2], hh[3]};
            acc[cb] = __builtin_amdgcn_mfma_f32_32x32x16_bf16(__builtin_bit_cast(s16x8, av), bv, acc[cb], 0, 0, 0); }
    }
#pragma unroll
    for (int r = 0; r < 16; ++r) { const int i = 32 * ib + (r & 3) + 8 * (r >> 2) + 4 * hi; const float bs = a.gmlp_bs[gi * 128 + i]; const size_t off = (size_t)(rbase + i) * 512 + gi * 128 + 64 * chh + r32, offc = (size_t)(rbase + i) * 1024 + 512 + gi * 128 + 64 * chh + r32;
        CM[offc] = (bf16)f2bf(bf2f(U[off]) * (acc[0][r] + bs)); CM[offc + 32] = (bf16)f2bf(bf2f(U[off + 32]) * (acc[1][r] + bs)); }
    LDS_WAIT(); __syncthreads();
}
}


namespace cmpx {
constexpr int TP = 80, A_OFF = 0, B_OFF = 256 * TP;
DI void unit(const Args& a, int rest, const bf16* W1T, bf16* PS, const LAS float* biasL, LAS unsigned char* lds_raw, int tid) {
    LAS char* L = (LAS char*)lds_raw; const int lane = tid & 63, wave = __builtin_amdgcn_readfirstlane(tid >> 6), r32 = lane & 31, hi = lane >> 5, rg = wave & 3, ch = wave >> 2;
    const int bgi = rest >> 2, b = bgi >> 1, g = bgi & 1, q = rest & 3, ar = tid >> 1, ah = tid & 1, seg = 256 * q + ar;
    const int phys = a.page_table[b * cfg::NPAGES + (seg >> 3)];
    const unsigned aoff0 = (((unsigned)phys * 128u + (unsigned)(seg & 7) * 16u) * 4u + (unsigned)g) * 64u + (unsigned)ah * 16u;
    LAS char* ast = L + A_OFF + ar * TP + ah * 32; LAS char* bst = L + B_OFF + ar * TP + ah * 32;
    const LAS char* afr = L + A_OFF + (64 * rg + r32) * TP + hi * 16; const LAS char* bfr = L + B_OFF + (128 * ch + r32) * TP + hi * 16;
    const float* cc = a.cache_cmp;
    for (int kv = 0; kv < 2; ++kv) {
        const unsigned aoff = aoff0 + kv * 128u, boff = ((unsigned)kv * 256u + (unsigned)ar) * 1024u + (unsigned)ah * 16u;
        f32x16 acc[2][4];
#pragma unroll
        for (int i = 0; i < 2; ++i)
#pragma unroll
            for (int j = 0; j < 4; ++j)
#pragma unroll
                for (int e = 0; e < 16; ++e) acc[i][j][e] = 0.f;
        v4f av[4]; v4u bv[2];
#pragma unroll
        for (int i = 0; i < 4; ++i) av[i] = *(const v4f*)(cc + aoff + 4 * i);
#pragma unroll
        for (int i = 0; i < 2; ++i) bv[i] = *(const v4u*)(W1T + boff + 8 * i);
        for (int c = 0; c < 32; ++c) {
            att::lds_barrier<0>();
#pragma unroll
            for (int i = 0; i < 2; ++i) { v4u o; o.x = pg8::cvt_pk_bf16(av[2 * i].x, av[2 * i].y); o.y = pg8::cvt_pk_bf16(av[2 * i].z, av[2 * i].w); o.z = pg8::cvt_pk_bf16(av[2 * i + 1].x, av[2 * i + 1].y); o.w = pg8::cvt_pk_bf16(av[2 * i + 1].z, av[2 * i + 1].w);
                *(LAS v4u*)(ast + 16 * i) = o; *(LAS v4u*)(bst + 16 * i) = bv[i]; }
            att::lds_barrier<0>();
            { const unsigned cn = c < 31 ? c + 1 : 31;
#pragma unroll
              for (int i = 0; i < 4; ++i) av[i] = *(const v4f*)(cc + aoff + (cn >> 1) * 256u + (cn & 1u) * 32u + 4 * i);
#pragma unroll
              for (int i = 0; i < 2; ++i) bv[i] = *(const v4u*)(W1T + boff + cn * 32u + 8 * i); }
#pragma unroll
            for (int ks = 0; ks < 2; ++ks) { asm volatile("" ::: "memory");
                const s16x8 a0 = *(const LAS s16x8*)(afr + ks * 32), a1 = *(const LAS s16x8*)(afr + 32 * TP + ks * 32);
#pragma unroll
                for (int cb = 0; cb < 4; ++cb) { const s16x8 bb = *(const LAS s16x8*)(bfr + cb * 32 * TP + ks * 32);
                    acc[0][cb] = __builtin_amdgcn_mfma_f32_32x32x16_bf16(a0, bb, acc[0][cb], 0, 0, 0); acc[1][cb] = __builtin_amdgcn_mfma_f32_32x32x16_bf16(a1, bb, acc[1][cb], 0, 0, 0); } }
        }
        bf16* Pk = PS + ((size_t)kv * 65536 + (size_t)rest * 256) * 256;
#pragma unroll
        for (int cb = 0; cb < 4; ++cb) { const int col = 128 * ch + 32 * cb + r32; const float bias = ch == 0 ? biasL[kv * 128 + col] : 0.f;
#pragma unroll
            for (int rb = 0; rb < 2; ++rb)
#pragma unroll
                for (int e = 0; e < 16; ++e) { const int row = 64 * rg + 32 * rb + (e & 3) + 8 * (e >> 2) + 4 * hi; Pk[(size_t)row * 256 + col] = (bf16)f2bf(acc[rb][cb][e] + bias); } }
    }
    att::lds_barrier<0>();
}
}
namespace thin {
template <int KS> DI v4f gemm(const bf16* A, int lda, const bf16* Bt, int ldb, int cbk, LAS unsigned char* lds_raw, int tid) {
    const int lane = tid & 63, wave = __builtin_amdgcn_readfirstlane(tid >> 6), r32 = lane & 31, hi = lane >> 5, k0 = wave * KS * 16 + 8 * hi;
    const bf16* ap = A + (size_t)r32 * lda + k0; const bf16* bp0 = Bt + (size_t)(64 * cbk + r32) * ldb + k0; const bf16* bp1 = bp0 + (size_t)32 * ldb;
    f32x16 acc0, acc1;
#pragma unroll
    for (int i = 0; i < 16; ++i) { acc0[i] = 0.f; acc1[i] = 0.f; }
#pragma unroll
    for (int ks = 0; ks < KS; ++ks) { const s16x8 av = *(const s16x8*)(ap + 16 * ks), b0 = *(const s16x8*)(bp0 + 16 * ks), b1 = *(const s16x8*)(bp1 + 16 * ks);
        acc0 = __builtin_amdgcn_mfma_f32_32x32x16_bf16(av, b0, acc0, 0, 0, 0); acc1 = __builtin_amdgcn_mfma_f32_32x32x16_bf16(av, b1, acc1, 0, 0, 0); }
    LAS float* Lf = (LAS float*)lds_raw;
#pragma unroll
    for (int r = 0; r < 16; ++r) { const int row = (r & 3) + 8 * (r >> 2) + 4 * hi; Lf[(wave * 32 + row) * 64 + r32] = acc0[r]; Lf[(wave * 32 + row) * 64 + 32 + r32] = acc1[r]; }
    LDS_WAIT(); __syncthreads();
    v4f t = *(const LAS v4f*)(Lf + (tid >> 4) * 64 + 4 * (tid & 15));
#pragma unroll
    for (int w = 1; w < 8; ++w) t += *(const LAS v4f*)(Lf + (w * 32 + (tid >> 4)) * 64 + 4 * (tid & 15));
    LDS_WAIT(); __syncthreads();
    return t;
}
DI float sum16(float v) { v += __shfl_xor(v, 1); v += __shfl_xor(v, 2); v += __shfl_xor(v, 4); v += __shfl_xor(v, 8); return v; }
}

#define W_in_t ((bf16*)(ws + cfg::WS_WIN_T))
#define W_pa_t ((bf16*)(ws + cfg::WS_WPA_T))
#define W_pb_t ((bf16*)(ws + cfg::WS_WPB_T))
#define W_out_t ((bf16*)(ws + cfg::WS_WOUT_T))
#define W_up_t ((bf16*)(ws + cfg::WS_WUP_T))
#define W_dn_t ((bf16*)(ws + cfg::WS_WDN_T))
#define RSTD1 ((float*)(ws + cfg::WS_RSTD1))
#define SSV ((float*)(ws + cfg::WS_SSV))
#define SS2 ((float*)(ws + cfg::WS_SS2))
#define SS3 ((float*)(ws + cfg::WS_SS3))
#define NSAG ((float*)(ws + cfg::WS_NSAG))
#define XB ((bf16*)(ws + cfg::WS_XB))
#define Qb ((bf16*)(ws + cfg::WS_Q))
#define KVB ((bf16*)(ws + cfg::WS_KVB))
#define Ub ((bf16*)(ws + cfg::WS_U))
#define VG ((bf16*)(ws + cfg::WS_VG))
#define GT ((bf16*)(ws + cfg::WS_GT))
#define OC ((bf16*)(ws + cfg::WS_ONSA))
#define MIX ((bf16*)(ws + cfg::WS_MIX))
#define X1F ((float*)(ws + cfg::WS_X1F))
#define X1B ((bf16*)(ws + cfg::WS_X1B))
#define AB ((bf16*)(ws + cfg::WS_AB))
#define ACT ((bf16*)(ws + cfg::WS_ACT))
__global__ void __launch_bounds__(NWAVES * 64, 2) nsa_hybrid_fwd(Args a) {
    extern __shared__ __attribute__((aligned(16))) unsigned char lds_raw[];
    LAS unsigned char* lds = (LAS unsigned char*)lds_raw;
    const int tid = threadIdx.x, lane = tid & 63, wave = __builtin_amdgcn_readfirstlane(tid >> 6);
    const int G = gridDim.x, gw = blockIdx.x * NWAVES + wave, NGW = G * NWAVES;
    unsigned char* ws = a.ws;
    for (int u = tid; u < (cfg::LDS_BYTES - cfg::LDSCTL_OFF) / 4; u += NWAVES * 64) ((LAS unsigned*)(lds + cfg::LDSCTL_OFF))[u] = 0u;
    __syncthreads();
    volatile LAS unsigned* MISC = (volatile LAS unsigned*)(lds + cfg::MISC_OFF);
    XcdBarrier bar = xcd_barrier_post((unsigned*)(ws + cfg::WS_CTL) + cfg::CW_BAR, MISC + 8, wave);


    #if (PHMASK >> 0) & 1
    if (a.ph_lo <= 0 && 0 < a.ph_hi) {
#if PROBE_PH == 0
    if (blockIdx.x == 0 && xb_thread0(wave)) ((unsigned long long*)(a.ws + cfg::WS_CTL))[65536] = __builtin_amdgcn_s_memrealtime();
#endif
    for (int rep_ = 0; rep_ < (int)((REPMASK >> 0) & 1) + 1; ++rep_) {
    unsigned char* ws = a.ws; asm volatile("" : "+s"(ws)); const int lane = (int)__builtin_amdgcn_mbcnt_hi(~0u, __builtin_amdgcn_mbcnt_lo(~0u, 0u)), tid = wave * 64 + lane;
    {
        LAS float* scr = (LAS float*)(lds + wave * 16384);
        constexpr int I_IN = 16 * (cfg::INP / 32), I_PA = 8 * 32, I_PB = 8 * 32, I_OUT = 16 * 32, I_UP = 16 * (cfg::UPN / 32), I_DN = (cfg::DFF / 64) * 32;
        constexpr int NITEMS = I_IN + I_PA + I_PB + I_OUT + I_UP + I_DN;
        for (int it = gw; it < NITEMS; it += NGW) { int r = it;
            if (r < I_IN) { transpose_item<1>(a.w_in, 1024, cfg::INC, a.norm_mix, W_in_t, scr, r, cfg::INP / 32, lane); continue; } r -= I_IN;
            if (r < I_PA) { transpose_item<0>(a.w_proj_a, 1024, 1024, nullptr, W_pa_t, scr, r, 32, lane); continue; } r -= I_PA;
            if (r < I_PB) { transpose_item<0>(a.w_proj_b, 1024, 1024, nullptr, W_pa_t + 512, scr, r, 32, lane); continue; } r -= I_PB;
            if (r < I_OUT) { transpose_item<0>(a.w_out, 1024, 1024, nullptr, W_out_t, scr, r, 32, lane); continue; } r -= I_OUT;
            if (r < I_UP) { transpose_item<2>(a.w_up, 1024, cfg::UPN, a.norm_ffn, W_up_t, scr, r, cfg::UPN / 32, lane); continue; } r -= I_UP;
            transpose_item<0>(a.w_down, cfg::DFF, 1024, nullptr, W_dn_t, scr, r, 32, lane); }
        for (int m = gw; m < cfg::MPAD; m += NGW) {
            const float* xr = m < cfg::MP ? a.x_prompt + (size_t)m * 1024 : (m < cfg::MROWS ? a.x_sample + (size_t)(m - cfg::MP) * 1024 : nullptr);
            v4f v[4]; float s = 0.f;
#pragma unroll
            for (int j = 0; j < 4; ++j) { v[j] = xr ? *(const v4f*)(xr + j * 256 + lane * 4) : (v4f){0.f, 0.f, 0.f, 0.f}; s += (v[j].x * v[j].x + v[j].y * v[j].y) + (v[j].z * v[j].z + v[j].w * v[j].w); }
            s = wave_sum(s);
            if (lane == 0) RSTD1[m] = xr ? 1.0f / sqrtf(s * (1.0f / 1024.0f) + cfg::EPS) : 0.f;
#pragma unroll
            for (int j = 0; j < 4; ++j) { v2u o; o.x = pk2(v[j].x, v[j].y); o.y = pk2(v[j].z, v[j].w); *(v2u*)(XB + (size_t)m * 1024 + j * 256 + lane * 4) = o; }
            if (m >= cfg::MROWS) {
                v4u z = (v4u){0u, 0u, 0u, 0u}; *(v4u*)(X1B + (size_t)m * 1024 + lane * 8) = z; *(v4u*)(X1B + (size_t)m * 1024 + 512 + lane * 8) = z; if (lane < 16) SS2[(size_t)m * 16 + lane] = 0.f; }
        }
        { const size_t n4 = (size_t)cfg::DB * 511 * 64;
          for (size_t i = (size_t)blockIdx.x * 512 + tid; i < n4; i += (size_t)G * 512) { const size_t bb = i / (511 * 64), rem = i % (511 * 64);
              ((v4f*)(a.out + cfg::OFF_WIN_S))[bb * 512 * 64 + rem] = ((const v4f*)a.cache_win)[bb * 512 * 64 + 64 + rem]; }
          for (int i = blockIdx.x * 512 + tid; i < cfg::DB * cfg::DFF; i += G * 512) { const int bb = i / cfg::DFF, f = i % cfg::DFF; a.out[cfg::OFF_CONV_S + (size_t)bb * 2 * cfg::DFF + f] = a.state_conv[(size_t)bb * 2 * cfg::DFF + cfg::DFF + f]; } }
        { bf16* W1T = (bf16*)(ws + cfg::WS_W1T);
          for (int it = gw; it < 4 * 64; it += NGW) { const int kr = it >> 6; transpose_item<0>(a.cmp_w1 + (size_t)kr * 1024 * 128, 1024, 128, nullptr, W1T + (size_t)kr * 128 * 1024, scr, it & 63, 4, lane); }
          bf16* W2F = (bf16*)(ws + cfg::WS_W2F);
          for (int e = blockIdx.x * 512 + tid; e < 2 * 8 * 2 * 64 * 8; e += G * 512) { const int j = e & 7, ln = (e >> 3) & 63, cb = (e >> 9) & 1, ks = (e >> 10) & 7, kv = e >> 13;
              W2F[e] = (bf16)f2bf(a.cmp_w2[(size_t)kv * 128 * 64 + (16 * ks + 8 * (ln >> 5) + j) * 64 + 32 * cb + (ln & 31)]); }
          bf16* WTR = (bf16*)(ws + cfg::WS_WTRIL);
          for (int e = blockIdx.x * 512 + tid; e < 4 * 128 * 128; e += G * 512) { const int j = e & 127, i = (e >> 7) & 127; WTR[e] = (bf16)f2bf(j <= i ? a.gmlp_ws[e] : 0.f); }
          float* PB = (float*)(ws + cfg::WS_PB);
          for (int it = gw; it < 64; it += NGW) { const int kv = it >> 5, c = it & 31; float s0 = 0.f, s1 = 0.f;
#pragma unroll 8
              for (int i = 0; i < 64; ++i) { const int k = c * 64 + i; const float pv = a.cmp_pe[kv * 2048 + k]; s0 += pv * a.cmp_w1[((size_t)kv * 2048 + k) * 128 + lane]; s1 += pv * a.cmp_w1[((size_t)kv * 2048 + k) * 128 + 64 + lane]; }
              PB[(kv * 32 + c) * 128 + lane] = s0; PB[(kv * 32 + c) * 128 + 64 + lane] = s1; } }

    }
    }
    if (1 < a.ph_hi) { xcd_barrier(bar); if (BARX) xcd_barrier(bar); }
#if PROBE_PH == 0
    if (blockIdx.x == 0 && xb_thread0(wave)) ((unsigned long long*)(a.ws + cfg::WS_CTL))[65537] = __builtin_amdgcn_s_memrealtime();
#endif
    }

    #endif
#if (PHMASK >> 1) & 1
    if (a.ph_lo <= 1 && 1 < a.ph_hi) {
#if PROBE_PH == 1
    if (blockIdx.x == 0 && xb_thread0(wave)) ((unsigned long long*)(a.ws + cfg::WS_CTL))[65536] = __builtin_amdgcn_s_memrealtime();
#endif
    for (int rep_ = 0; rep_ < (int)((REPMASK >> 1) & 1) + 1; ++rep_) {
    unsigned char* ws = a.ws; asm volatile("" : "+s"(ws)); const int lane = (int)__builtin_amdgcn_mbcnt_hi(~0u, __builtin_amdgcn_mbcnt_lo(~0u, 0u)), tid = wave * 64 + lane;
    { LAS float* biasL = (LAS float*)(lds + cfg::BIAS_OFF); load_cmp_bias(a, biasL, tid);
      for (int part = 0; part < 2; ++part) {
        if ((part == 0) == ((blockIdx.x & 1) == 0)) {
          for (int rest = blockIdx.x; rest < 256; rest += G) {
            int tid3 = tid; asm volatile("" : "+v"(tid3)); cmpx::unit(a, rest, (const bf16*)(ws + cfg::WS_W1T), (bf16*)(ws + cfg::WS_PS), biasL, lds, tid3); }
        } else {
          pg8::Gemm g{XB, W_in_t, cfg::MPAD, cfg::INP, 1024, 1024, 1024}; pg8::StaticOrder S; S.init(cfg::MPAD, cfg::INP, G, (int)blockIdx.x, XB, W_in_t, 1024);
          pg8::EpiIn E{RSTD1, Qb, KVB, Ub, VG, SSV, GT, NSAG, a.out, (bf16*)(ws + cfg::WS_CBP)};
          pg8::gemm_phase<pg8::EpiIn, pg8::StaticOrder, true, true>(lds, g, S, E, wave); }
      } }
    }
    if (2 < a.ph_hi) { xcd_barrier(bar); if (BARX) xcd_barrier(bar); }
#if PROBE_PH == 1
    if (blockIdx.x == 0 && xb_thread0(wave)) ((unsigned long long*)(a.ws + cfg::WS_CTL))[65537] = __builtin_amdgcn_s_memrealtime();
#endif
    }

    #endif
#if (PHMASK >> 2) & 1
    if (a.ph_lo <= 2 && 2 < a.ph_hi) {
#if PROBE_PH == 2
    if (blockIdx.x == 0 && xb_thread0(wave)) ((unsigned long long*)(a.ws + cfg::WS_CTL))[65536] = __builtin_amdgcn_s_memrealtime();
#endif
    for (int rep_ = 0; rep_ < (int)((REPMASK >> 2) & 1) + 1; ++rep_) {
    unsigned char* ws = a.ws; asm volatile("" : "+s"(ws)); const int lane = (int)__builtin_amdgcn_mbcnt_hi(~0u, __builtin_amdgcn_mbcnt_lo(~0u, 0u)), tid = wave * 64 + lane;
    {
        const bf16* W2F = (const bf16*)(ws + cfg::WS_W2F);
        if (blockIdx.x < 16) {
            const int kv = blockIdx.x >> 3, bg = blockIdx.x & 7; LAS float* biasL = (LAS float*)(lds + cfg::BIAS_OFF); load_cmp_bias(a, biasL, tid);
            bf16* PP = (bf16*)(ws + cfg::WS_PP);
            OneOrder S; S.u0.pm = bg; S.u0.pn = 0; S.u0.kind = 1 + kv; S.u0.a = (const char*)(ws + cfg::WS_CBP) + (size_t)(kv * 8 + bg) * 4096 * 64 * 2; S.u0.b = (const char*)(ws + cfg::WS_W1T) + (size_t)kv * 256 * 1024 * 2;
            pg8::Gemm g{nullptr, nullptr, 256, 256, 1024, 1024, 1024}; pg8::EpiP E{PP, (size_t)2048 * 256, biasL};
            pg8::gemm_phase<pg8::EpiP, OneOrder, false, true>(lds, g, S, E, wave);
            asm volatile("s_waitcnt vmcnt(0)" ::: "memory"); __syncthreads();
            cmp_stage2_tile<bf16>(PP + ((size_t)kv * 2048 + bg * 256) * 256, 256, wave * 32, W2F + (size_t)kv * 8192, (bf16*)(ws + (kv ? cfg::WS_VCP : cfg::WS_KCP)) + (size_t)bg * 256 * 64, 255, lane);
        } else {
            const int gw2 = (blockIdx.x - 16) * NWAVES + wave, NGW2 = (G - 16) * NWAVES;
            for (int task = gw2; task < 2 * 64 * 32; task += NGW2) { const int kv = task >> 11, bg = (task >> 5) & 63, tl = task & 31;
                cmp_stage2_tile<float>((const bf16*)(ws + cfg::WS_PS) + ((size_t)kv * 65536 + bg * 1024) * 256, 1024, tl * 32, W2F + (size_t)kv * 8192, (float*)(ws + (kv ? cfg::WS_VCS : cfg::WS_KCS)) + (size_t)bg * 1024 * 64, 1023, lane); }
            for (int task = blockIdx.x - 16; task < 4 * 32 * 4; task += G - 16) cmx::unit(a, task >> 7, (task >> 2) & 31, task & 3, lds, tid);
        }
        for (int i = 512 + gw; i < 4 * 128 + cfg::DB; i += NGW) {
            const bool smp = i >= 512; const int row = smp ? cfg::MP + (i - 512) : (i >> 7) * 4096 + 3968 + (i & 127);
            float* dst = smp ? a.out + cfg::OFF_V_S + (size_t)(i - 512) * 512 : a.out + cfg::OFF_V_P + (size_t)i * 512;
            const float rs = rstd_v(SSV, row); float vn[8]; load8(VG + (size_t)row * 512 + lane * 8, vn);
#pragma unroll
            for (int j = 0; j < 8; ++j) vn[j] = vn[j] * rs * a.gmlp_norm[lane * 8 + j];
            *(v4f*)(dst + lane * 8) = (v4f){vn[0], vn[1], vn[2], vn[3]}; *(v4f*)(dst + lane * 8 + 4) = (v4f){vn[4], vn[5], vn[6], vn[7]};
            if (smp) { const int gi = lane >> 4; const float w00 = a.gmlp_ws[(size_t)gi * 128 * 128], bs = a.gmlp_bs[gi * 128]; float uu[8]; load8(Ub + (size_t)row * 512 + lane * 8, uu);
                v4u o; o.x = pk2(uu[0] * (w00 * vn[0] + bs), uu[1] * (w00 * vn[1] + bs)); o.y = pk2(uu[2] * (w00 * vn[2] + bs), uu[3] * (w00 * vn[3] + bs));
                o.z = pk2(uu[4] * (w00 * vn[4] + bs), uu[5] * (w00 * vn[5] + bs)); o.w = pk2(uu[6] * (w00 * vn[6] + bs), uu[7] * (w00 * vn[7] + bs));
                *(v4u*)(OC + (size_t)row * 1024 + 512 + lane * 8) = o; }
        }
    }
    }
    if (3 < a.ph_hi) { xcd_barrier(bar); if (BARX) xcd_barrier(bar); }
#if PROBE_PH == 2
    if (blockIdx.x == 0 && xb_thread0(wave)) ((unsigned long long*)(a.ws + cfg::WS_CTL))[65537] = __builtin_amdgcn_s_memrealtime();
#endif
    }

    #endif
#if (PHMASK >> 3) & 1
    if (a.ph_lo <= 3 && 3 < a.ph_hi) {
#if PROBE_PH == 3
    if (blockIdx.x == 0 && xb_thread0(wave)) ((unsigned long long*)(a.ws + cfg::WS_CTL))[65536] = __builtin_amdgcn_s_memrealtime();
#endif
    for (int rep_ = 0; rep_ < (int)((REPMASK >> 3) & 1) + 1; ++rep_) {
    unsigned char* ws = a.ws; asm volatile("" : "+s"(ws)); const int lane = (int)__builtin_amdgcn_mbcnt_hi(~0u, __builtin_amdgcn_mbcnt_lo(~0u, 0u)), tid = wave * 64 + lane;
    {
        gu32* qbase = (gu32*)(ws + cfg::WS_CTL) + 8192 + 1024 * rep_; volatile LAS int* qslot = (volatile LAS int*)(lds + cfg::MISC_OFF + 64);
        const int q0 = (int)(xb_xcc_id() & 7u);
        for (int qi = 0; qi < 8; ++qi) { const int bgi = (q0 + qi) & 7; gu32* qctr = qbase + 64 * bgi;
            for (;;) {
                if (tid == 0) qslot[0] = (int)__hip_atomic_fetch_add(qctr, 1u, __ATOMIC_RELAXED, __HIP_MEMORY_SCOPE_AGENT);
                LDS_WAIT(); __syncthreads();
                const int item = qslot[0];
                __syncthreads();
                if (item >= 8 + 64) break;
                int tid2 = tid; asm volatile("" : "+v"(tid2));
#if ATT_EXP == 5
                if (item < 8) continue;
#endif
#if ATT_EXP == 13
                if (item < 8) dec::sample_unit(a, 4 * bgi + (item >> 1), item & 1, lds, tid2);
#endif
                if (item < 8) dec::sample_unit(a, 4 * bgi + (item >> 1), item & 1, lds, tid2);
#if ATT_EXP == 6
                else if (item >= 8) continue;
#endif
                else att::prompt_unit(a, bgi >> 1, bgi & 1, 63 - (item - 8), lds, tid2);
            } }
    }
    }
    if (4 < a.ph_hi) { xcd_barrier(bar); if (BARX) xcd_barrier(bar); }
#if PROBE_PH == 3
    if (blockIdx.x == 0 && xb_thread0(wave)) ((unsigned long long*)(a.ws + cfg::WS_CTL))[65537] = __builtin_amdgcn_s_memrealtime();
#endif
    }

    #endif
#if (PHMASK >> 4) & 1
    if (a.ph_lo <= 4 && 4 < a.ph_hi) {
#if PROBE_PH == 4
    if (blockIdx.x == 0 && xb_thread0(wave)) ((unsigned long long*)(a.ws + cfg::WS_CTL))[65536] = __builtin_amdgcn_s_memrealtime();
#endif
    for (int rep_ = 0; rep_ < (int)((REPMASK >> 4) & 1) + 1; ++rep_) {
    unsigned char* ws = a.ws; asm volatile("" : "+s"(ws)); const int lane = (int)__builtin_amdgcn_mbcnt_hi(~0u, __builtin_amdgcn_mbcnt_lo(~0u, 0u)), tid = wave * 64 + lane;
    if (blockIdx.x < 16) {
        const int cbk = blockIdx.x, row = cfg::MP + (tid >> 4), col = 64 * cbk + 4 * (tid & 15);
        const v4f ya = thin::gemm<4>(OC + (size_t)cfg::MP * 1024, 1024, W_pa_t, 1024, cbk, lds, tid), yb = thin::gemm<4>(OC + (size_t)cfg::MP * 1024 + 512, 1024, W_pa_t + 512, 1024, cbk, lds, tid);
        const v2u ga = *(const v2u*)(GT + (size_t)row * 2048 + col), gb = *(const v2u*)(GT + (size_t)row * 2048 + 1024 + col);
        const v4f g0 = (v4f){__uint_as_float(ga.x << 16), __uint_as_float(ga.x & 0xffff0000u), __uint_as_float(ga.y << 16), __uint_as_float(ga.y & 0xffff0000u)};
        const v4f g1 = (v4f){__uint_as_float(gb.x << 16), __uint_as_float(gb.x & 0xffff0000u), __uint_as_float(gb.y << 16), __uint_as_float(gb.y & 0xffff0000u)};
        const v4f mx = g0 * ya + g1 * yb; v2u o; o.x = pg8::cvt_pk_bf16(mx.x, mx.y); o.y = pg8::cvt_pk_bf16(mx.z, mx.w); *(v2u*)(MIX + (size_t)row * 1024 + col) = o; }
    { PairOrder S; S.s1.init(cfg::MP, 1024, G, (int)blockIdx.x, OC, W_pa_t, 1024); pg8::Gemm g{OC, W_pa_t, cfg::MP, 1024, 512, 1024, 1024}; pg8::EpiMixAB E{GT, MIX};
      pg8::gemm_phase<pg8::EpiMixAB, PairOrder, true, true>(lds, g, S, E, wave); }
    }
    if (5 < a.ph_hi) { xcd_barrier(bar); if (BARX) xcd_barrier(bar); }
#if PROBE_PH == 4
    if (blockIdx.x == 0 && xb_thread0(wave)) ((unsigned long long*)(a.ws + cfg::WS_CTL))[65537] = __builtin_amdgcn_s_memrealtime();
#endif
    }

    #endif
#if (PHMASK >> 5) & 1
    if (a.ph_lo <= 5 && 5 < a.ph_hi) {
#if PROBE_PH == 5
    if (blockIdx.x == 0 && xb_thread0(wave)) ((unsigned long long*)(a.ws + cfg::WS_CTL))[65536] = __builtin_amdgcn_s_memrealtime();
#endif
    for (int rep_ = 0; rep_ < (int)((REPMASK >> 5) & 1) + 1; ++rep_) {
    unsigned char* ws = a.ws; asm volatile("" : "+s"(ws)); const int lane = (int)__builtin_amdgcn_mbcnt_hi(~0u, __builtin_amdgcn_mbcnt_lo(~0u, 0u)), tid = wave * 64 + lane;
    if (blockIdx.x < 16) {
        const int cbk = blockIdx.x, r = tid >> 4, row = cfg::MP + r, col = 64 * cbk + 4 * (tid & 15);
        const v4f y = thin::gemm<8>(MIX + (size_t)cfg::MP * 1024, 1024, W_out_t, 1024, cbk, lds, tid);
        const v4f x1 = *(const v4f*)(a.x_sample + (size_t)r * 1024 + col) + y; *(v4f*)(X1F + (size_t)row * 1024 + col) = x1;
        v2u o; o.x = pg8::cvt_pk_bf16(x1.x, x1.y); o.y = pg8::cvt_pk_bf16(x1.z, x1.w); *(v2u*)(X1B + (size_t)row * 1024 + col) = o;
        const float ss = thin::sum16((x1.x * x1.x + x1.y * x1.y) + (x1.z * x1.z + x1.w * x1.w)); if ((tid & 15) == 0) SS2[(size_t)row * 16 + cbk] = ss; }
    { pg8::Gemm g{MIX, W_out_t, cfg::MP, 1024, 1024, 1024, 1024}; pg8::StaticOrder S; S.init(cfg::MP, 1024, G, (int)blockIdx.x, MIX, W_out_t, 1024);
      pg8::EpiOut E{a.x_prompt, a.x_sample, X1F, X1B, SS2}; pg8::gemm_phase<pg8::EpiOut, pg8::StaticOrder, true, true>(lds, g, S, E, wave); }
    }
    if (6 < a.ph_hi) { xcd_barrier(bar); if (BARX) xcd_barrier(bar); }
#if PROBE_PH == 5
    if (blockIdx.x == 0 && xb_thread0(wave)) ((unsigned long long*)(a.ws + cfg::WS_CTL))[65537] = __builtin_amdgcn_s_memrealtime();
#endif
    }

    #endif
#if (PHMASK >> 6) & 1
    if (a.ph_lo <= 6 && 6 < a.ph_hi) {
#if PROBE_PH == 6
    if (blockIdx.x == 0 && xb_thread0(wave)) ((unsigned long long*)(a.ws + cfg::WS_CTL))[65536] = __builtin_amdgcn_s_memrealtime();
#endif
    for (int rep_ = 0; rep_ < (int)((REPMASK >> 6) & 1) + 1; ++rep_) {
    unsigned char* ws = a.ws; asm volatile("" : "+s"(ws)); const int lane = (int)__builtin_amdgcn_mbcnt_hi(~0u, __builtin_amdgcn_mbcnt_lo(~0u, 0u)), tid = wave * 64 + lane;
    { pg8::Gemm g{X1B, W_up_t, cfg::MPAD, cfg::UPN, 1024, 1024, 1024}; OrdOrder S; S.s1.init(cfg::MPAD, cfg::UPN, G, (int)blockIdx.x, X1B, W_up_t, 1024);
      LAS float* rsl = (LAS float*)(lds + cfg::BIAS_OFF); { pg8::Unit u; for (int ui = 0; ui < 14 && S.next(ui, u); ++ui) if (tid < 256) rsl[ui * 256 + tid] = rstd16(SS2, u.pm * 256 + tid); }
      LDS_WAIT(); __syncthreads();
      pg8::EpiUpConv E{rsl, ACT, a.out, a.conv_w, a.conv_b, a.state_conv, (float*)(ws + cfg::WS_AB), (float*)(ws + cfg::WS_AB + 4 * cfg::MiB)}; pg8::gemm_phase<pg8::EpiUpConv, OrdOrder, true, true>(lds, g, S, E, wave); }
    }
    if (7 < a.ph_hi) { xcd_barrier(bar); if (BARX) xcd_barrier(bar); }
#if PROBE_PH == 6
    if (blockIdx.x == 0 && xb_thread0(wave)) ((unsigned long long*)(a.ws + cfg::WS_CTL))[65537] = __builtin_amdgcn_s_memrealtime();
#endif
    }

    #endif
#if (PHMASK >> 7) & 1
    if (a.ph_lo <= 7 && 7 < a.ph_hi) {
#if PROBE_PH == 7
    if (blockIdx.x == 0 && xb_thread0(wave)) ((unsigned long long*)(a.ws + cfg::WS_CTL))[65536] = __builtin_amdgcn_s_memrealtime();
#endif
    for (int rep_ = 0; rep_ < (int)((REPMASK >> 7) & 1) + 1; ++rep_) {
    unsigned char* ws = a.ws; asm volatile("" : "+s"(ws)); const int lane = (int)__builtin_amdgcn_mbcnt_hi(~0u, __builtin_amdgcn_mbcnt_lo(~0u, 0u)), tid = wave * 64 + lane;
    }
    }

    #endif
#if (PHMASK >> 8) & 1
    if (a.ph_lo <= 8 && 8 < a.ph_hi) {
#if PROBE_PH == 8
    if (blockIdx.x == 0 && xb_thread0(wave)) ((unsigned long long*)(a.ws + cfg::WS_CTL))[65536] = __builtin_amdgcn_s_memrealtime();
#endif
    for (int rep_ = 0; rep_ < (int)((REPMASK >> 8) & 1) + 1; ++rep_) {
    unsigned char* ws = a.ws; asm volatile("" : "+s"(ws)); const int lane = (int)__builtin_amdgcn_mbcnt_hi(~0u, __builtin_amdgcn_mbcnt_lo(~0u, 0u)), tid = wave * 64 + lane;
    if (blockIdx.x < 16) {
        const int cbk = blockIdx.x, r = tid >> 4, row = cfg::MP + r, col = 64 * cbk + 4 * (tid & 15);
        const v4f y = thin::gemm<22>(ACT + (size_t)cfg::MP * cfg::DFF, cfg::DFF, W_dn_t, cfg::DFF, cbk, lds, tid);
        const v4f x2 = *(const v4f*)(X1F + (size_t)row * 1024 + col) + y; *(v4f*)(a.out + (size_t)row * 1024 + col) = x2;
        const float ss = thin::sum16((x2.x * x2.x + x2.y * x2.y) + (x2.z * x2.z + x2.w * x2.w)); if ((tid & 15) == 0) SS3[(size_t)row * 16 + cbk] = ss; }
    { pg8::Gemm g{ACT, W_dn_t, cfg::MP, 1024, cfg::DFF, cfg::DFF, cfg::DFF}; pg8::StaticOrder S; S.init(cfg::MP, 1024, G, (int)blockIdx.x, ACT, W_dn_t, cfg::DFF);
      { const float* HALO = (const float*)(ws + cfg::WS_AB); const float* RAW = (const float*)(ws + cfg::WS_AB + 4 * cfg::MiB); pg8::Unit u;
        for (int ui = 0; S.next(ui, u); ++ui) { const int pm = u.pm;
            for (int i = tid; i < 4 * (cfg::DFF / 4); i += NWAVES * 64) { const int f = (i % (cfg::DFF / 4)) * 4, we = i / (cfg::DFF / 4), wh = we >> 1, e = we & 1;
                const float* rw = RAW + (size_t)((pm * 2 + wh) * 2) * 2 * cfg::DFF + f; const v4f a0 = *(const v4f*)rw, b0 = *(const v4f*)(rw + cfg::DFF), a1 = *(const v4f*)(rw + 2 * cfg::DFF), b1 = *(const v4f*)(rw + 3 * cfg::DFF);
                v4f h6 = (v4f){0.f, 0.f, 0.f, 0.f}, h7 = h6;
                if (wh == 1 || (pm & 15) != 0) { const float* hl = HALO + (size_t)(((wh ? pm : pm - 1) * 2 + (wh ? 0 : 1)) * 2) * cfg::DFF + f; h6 = *(const v4f*)hl; h7 = *(const v4f*)(hl + cfg::DFF); }
                const v4f w0 = *(const v4f*)(a.conv_w + f), w1 = *(const v4f*)(a.conv_w + cfg::DFF + f), w2 = *(const v4f*)(a.conv_w + 2 * cfg::DFF + f), cb = *(const v4f*)(a.conv_b + f);
                const v4f c = e ? cb + w0 * h7 + w1 * a0 + w2 * a1 : cb + w0 * h6 + w1 * h7 + w2 * a0, bb = e ? b1 : b0;
                v2u o; o.x = pg8::cvt_pk_bf16(gelu_tanh(c.x) * bb.x, gelu_tanh(c.y) * bb.y); o.y = pg8::cvt_pk_bf16(gelu_tanh(c.z) * bb.z, gelu_tanh(c.w) * bb.w);
                *(v2u*)(ACT + (size_t)(pm * 256 + 128 * wh + e) * cfg::DFF + f) = o; } }
        asm volatile("s_waitcnt vmcnt(0)" ::: "memory"); __syncthreads(); }
      pg8::EpiDown E{X1F, a.out, SS3}; pg8::gemm_phase<pg8::EpiDown, pg8::StaticOrder, true, true>(lds, g, S, E, wave); }
    }
    if (9 < a.ph_hi) { xcd_barrier(bar); if (BARX) xcd_barrier(bar); }
#if PROBE_PH == 8
    if (blockIdx.x == 0 && xb_thread0(wave)) ((unsigned long long*)(a.ws + cfg::WS_CTL))[65537] = __builtin_amdgcn_s_memrealtime();
#endif
    }

    #endif
#if (PHMASK >> 9) & 1
    if (a.ph_lo <= 9 && 9 < a.ph_hi) {
#if PROBE_PH == 9
    if (blockIdx.x == 0 && xb_thread0(wave)) ((unsigned long long*)(a.ws + cfg::WS_CTL))[65536] = __builtin_amdgcn_s_memrealtime();
#endif
    for (int rep_ = 0; rep_ < (int)((REPMASK >> 9) & 1) + 1; ++rep_) {
    unsigned char* ws = a.ws; asm volatile("" : "+s"(ws)); const int lane = (int)__builtin_amdgcn_mbcnt_hi(~0u, __builtin_amdgcn_mbcnt_lo(~0u, 0u)), tid = wave * 64 + lane;
#ifdef DUMP
    for (int m = gw; m < cfg::MROWS; m += NGW) { float* yr = a.out + (size_t)m * 1024;
        if (DUMP == 4) continue;
#pragma unroll
        for (int j = 0; j < 4; ++j) { const int c = j * 256 + lane * 4; v4f v;
            if (DUMP == 1) { v.x = bf2f(MIX[(size_t)m * 1024 + c]); v.y = bf2f(MIX[(size_t)m * 1024 + c + 1]); v.z = bf2f(MIX[(size_t)m * 1024 + c + 2]); v.w = bf2f(MIX[(size_t)m * 1024 + c + 3]); }
            else if (DUMP == 2) v = *(const v4f*)(X1F + (size_t)m * 1024 + c);
            else if (DUMP == 3) { v.x = bf2f(ACT[(size_t)m * 2816 + c]); v.y = bf2f(ACT[(size_t)m * 2816 + c + 1]); v.z = bf2f(ACT[(size_t)m * 2816 + c + 2]); v.w = bf2f(ACT[(size_t)m * 2816 + c + 3]); }
            else { v.x = bf2f(AB[(size_t)m * 5632 + c]); v.y = bf2f(AB[(size_t)m * 5632 + c + 1]); v.z = bf2f(AB[(size_t)m * 5632 + c + 2]); v.w = bf2f(AB[(size_t)m * 5632 + c + 3]); }
            *(v4f*)(yr + c) = v; } }
#else
    for (int m = gw; m < cfg::MROWS; m += NGW) { const float rs = rstd16(SS3, m); float* yr = a.out + (size_t)m * 1024;
#pragma unroll
        for (int j = 0; j < 4; ++j) { const v4f v = *(const v4f*)(yr + j * 256 + lane * 4), gn = *(const v4f*)(a.norm_final + j * 256 + lane * 4); *(v4f*)(yr + j * 256 + lane * 4) = v * rs * gn; } }
#endif
    }
    }
#endif
#if PROBE_PH >= 0
    if (blockIdx.x == 0) {
        __syncthreads();
        const unsigned long long* tsp = (const unsigned long long*)(a.ws + cfg::WS_CTL) + 65536;
        unsigned long long t1 = tsp[1]; if (PROBE_PH == 9) t1 = __builtin_amdgcn_s_memrealtime();
        const float sc = 1.0f + (float)(t1 - tsp[0]) * (1.0f / 524288.0f);
        for (int i = wave * 64 + (int)__builtin_amdgcn_mbcnt_hi(~0u, __builtin_amdgcn_mbcnt_lo(~0u, 0u)); i < 16384; i += 512) a.out[cfg::OFF_V_S + i] *= sc;
    }
#endif
}

extern "C" void kernel_launch(void* const* d_in, const int* in_sizes, int n_in, void* d_out, int out_size, void* d_ws, size_t ws_size, hipStream_t stream) {
    static int grid = 0;
    if (grid == 0) {
        if (n_in != 25 || in_sizes[0] != cfg::MP * 1024 || (size_t)out_size != cfg::OUT_TOTAL || ws_size < cfg::WS_END) {
            fprintf(stderr, "kernel_launch: unexpected shapes (n_in %d, in0 %d, out %d, ws %zu); nothing launched\n", n_in, n_in > 0 ? in_sizes[0] : -1, out_size, ws_size); grid = -1; return; }
        int dev = 0, cus = 0, per_cu = 0;
        if (hipGetDevice(&dev) != hipSuccess || hipDeviceGetAttribute(&cus, hipDeviceAttributeMultiprocessorCount, dev) != hipSuccess) { grid = -1; return; }
        if (hipFuncSetAttribute((const void*)nsa_hybrid_fwd, hipFuncAttributeMaxDynamicSharedMemorySize, cfg::LDS_BYTES) != hipSuccess) { fprintf(stderr, "kernel_launch: hipFuncSetAttribute failed\n"); grid = -1; return; }
        if (hipOccupancyMaxActiveBlocksPerMultiprocessor(&per_cu, (const void*)nsa_hybrid_fwd, NWAVES * 64, cfg::LDS_BYTES) != hipSuccess || per_cu < 1)
            fprintf(stderr, "kernel_launch: note: occupancy query reports %d workgroups per CU\n", per_cu);
        (void)hipGetLastError();
        grid = cus;
    }
    if (grid < 0) return;
    if (hipMemsetAsync((char*)d_ws + cfg::WS_CTL, 0, cfg::CTL_ZERO_BYTES, stream) != hipSuccess) return;
    Args a{};
    a.x_prompt = (const float*)d_in[0]; a.x_sample = (const float*)d_in[1]; a.cache_cmp = (const float*)d_in[2]; a.cache_slc = (const float*)d_in[3]; a.cache_win = (const float*)d_in[4];
    a.state_conv = (const float*)d_in[5]; a.page_table = (const int*)d_in[6]; a.norm_mix = (const float*)d_in[7]; a.w_in = (const float*)d_in[8]; a.cmp_pe = (const float*)d_in[9];
    a.cmp_w1 = (const float*)d_in[10]; a.cmp_b1 = (const float*)d_in[11]; a.cmp_w2 = (const float*)d_in[12]; a.gmlp_norm = (const float*)d_in[13]; a.gmlp_ws = (const float*)d_in[14];
    a.gmlp_bs = (const float*)d_in[15]; a.w_proj_a = (const float*)d_in[16]; a.w_proj_b = (const float*)d_in[17]; a.w_out = (const float*)d_in[18]; a.norm_ffn = (const float*)d_in[19];
    a.w_up = (const float*)d_in[20]; a.conv_w = (const float*)d_in[21]; a.conv_b = (const float*)d_in[22]; a.w_down = (const float*)d_in[23]; a.norm_final = (const float*)d_in[24];
    a.out = (float*)d_out; a.ws = (unsigned char*)d_ws;
    for (int li = 0; li < MK_N_LAUNCHES; ++li) {
        a.ph_lo = (MK_N_LAUNCHES == 1) ? 0 : li; a.ph_hi = (MK_N_LAUNCHES == 1) ? 10 : li + 1;
        hipLaunchKernelGGL(nsa_hybrid_fwd, dim3(grid), dim3(NWAVES * 64), cfg::LDS_BYTES, stream, a);
        const hipError_t le = hipPeekAtLastError();
        if (le != hipSuccess) { fprintf(stderr, "kernel_launch: launch failed: %s\n", hipGetErrorName(le)); break; }
    }
}
```
